# Optimizing an MI355X kernel written in HIP

```python
import math
import jax
import jax.numpy as jnp
from jax import lax
import numpy as np

D_MODEL = 1024
BATCH = 8
SEQ = 8192
DEPTH = 4
DEC_BATCH = 32
DEC_SEQ = 2048
PAST_LEN = 128

D_CONV = D_MODEL
CONV_WIDTH = 3
D_MLSTM = D_MODEL
N_MLSTM_HEADS = 4
HEAD_DIM = D_MLSTM // N_MLSTM_HEADS
CHUNK = 128
N_GATE_SLOTS = 4
D_IN = 4 * D_CONV + 5 * D_MLSTM + N_GATE_SLOTS * N_MLSTM_HEADS + 2 * D_MODEL
EPS = 1e-6
NEG_BIG = -1e30

kernel_name = "hybrid_conv_mlstm_bidir_encoder"


def rms_norm(x, g):
    xf = x.astype(jnp.float32)
    y = xf * lax.rsqrt(jnp.mean(xf * xf, axis=-1, keepdims=True) + EPS)
    return (y * g.astype(jnp.float32)).astype(x.dtype)


def split_combined(p):
    sizes = [D_CONV, D_CONV, D_CONV, D_CONV,
             D_MLSTM, D_MLSTM, D_MLSTM, D_MLSTM, D_MLSTM,
             N_GATE_SLOTS * N_MLSTM_HEADS,
             2 * D_MODEL]
    idx = []
    acc = 0
    for s in sizes[:-1]:
        acc += s
        idx.append(acc)
    return jnp.split(p, idx, axis=-1)


def centred_dwconv3(u, w, b):
    up = jnp.pad(u, ((0, 0), (1, 1), (0, 0)))
    return up[:, :-2] * w[0] + up[:, 1:-1] * w[1] + up[:, 2:] * w[2] + b


def mlstm_chunkwise(q, k, v, i_pre, f_pre):
    bsz, seq, nh, d = q.shape
    nc = seq // CHUNK

    def chunks4(a):
        return a.reshape(bsz, nc, CHUNK, nh, d).transpose(1, 0, 3, 2, 4)

    def chunks3(a):
        return a.reshape(bsz, nc, CHUNK, nh).transpose(1, 0, 3, 2)

    logf = jax.nn.log_sigmoid(f_pre)
    mask = jnp.tril(jnp.ones((CHUNK, CHUNK), dtype=bool))

    def body(carry, inp):
        C, n, m = carry
        qc, kc, vc, ic, lfc = inp
        b = jnp.cumsum(lfc, axis=-1)
        Dlog = b[..., :, None] - b[..., None, :] + ic[..., None, :]
        Dlog = jnp.where(mask, Dlog, NEG_BIG)
        inter = b + m[..., None]
        m_t = jnp.maximum(jnp.max(Dlog, axis=-1), inter)
        Dexp = jnp.exp(Dlog - m_t[..., None])
        inter_w = jnp.exp(inter - m_t)
        S = jnp.einsum('bhtd,bhsd->bhts', qc, kc) * Dexp
        num = jnp.einsum('bhts,bhsd->bhtd', S, vc) + inter_w[..., None] * jnp.einsum('bhtd,bhde->bhte', qc, C)
        den_raw = jnp.sum(S, axis=-1) + inter_w * jnp.einsum('bhtd,bhd->bht', qc, n)
        den = jnp.maximum(jnp.abs(den_raw), jnp.exp(-m_t))
        h = num / den[..., None]
        bL = b[..., -1]
        a = bL[..., None] - b + ic
        m_new = jnp.maximum(bL + m, jnp.max(a, axis=-1))
        w = jnp.exp(a - m_new[..., None])
        decay = jnp.exp(bL + m - m_new)
        C_new = decay[..., None, None] * C + jnp.einsum('bhs,bhsd,bhse->bhde', w, kc, vc)
        n_new = decay[..., None] * n + jnp.einsum('bhs,bhsd->bhd', w, kc)
        return (C_new, n_new, m_new), h

    init = (jnp.zeros((bsz, nh, d, d), jnp.float32),
            jnp.zeros((bsz, nh, d), jnp.float32),
            jnp.zeros((bsz, nh), jnp.float32))
    _, hs = lax.scan(body, init, (chunks4(q), chunks4(k), chunks4(v), chunks3(i_pre), chunks3(logf)))
    return hs.transpose(1, 0, 3, 2, 4).reshape(bsz, seq, nh, d)


def mixer_layer(x, c, w_ada, b_ada, norm_g, w_in, b_gates, conv_w, conv_b, mh_norm_g,
                w_proj_conv, w_proj_mlstm, w_out):
    bsz, seq, _ = x.shape
    mod = c @ w_ada + b_ada
    shift, scale, gate = jnp.split(mod[:, None, :], 3, axis=-1)
    h = rms_norm(x, norm_g) * (1.0 + scale) + shift
    p = h @ w_in
    cb, cc, cx, cz, q, k, v, o, mz, gpre, gmerge = split_combined(p)

    y_conv = cb * centred_dwconv3(cc * cx, conv_w, conv_b) * jax.nn.silu(cz)

    qf = q.astype(jnp.float32).reshape(bsz, seq, N_MLSTM_HEADS, HEAD_DIM)
    kf = k.astype(jnp.float32).reshape(bsz, seq, N_MLSTM_HEADS, HEAD_DIM) * (HEAD_DIM ** -0.5)
    vf = v.astype(jnp.float32).reshape(bsz, seq, N_MLSTM_HEADS, HEAD_DIM)
    g = gpre.astype(jnp.float32).reshape(bsz, seq, N_GATE_SLOTS, N_MLSTM_HEADS) + b_gates.astype(jnp.float32)
    h_fwd = mlstm_chunkwise(qf, kf, vf, g[:, :, 0], g[:, :, 1])
    h_bwd = jnp.flip(mlstm_chunkwise(jnp.flip(qf, 1), jnp.flip(kf, 1), jnp.flip(vf, 1),
                                     jnp.flip(g[:, :, 2], 1), jnp.flip(g[:, :, 3], 1)), 1)
    hm = h_fwd + h_bwd
    hm = hm * lax.rsqrt(jnp.mean(hm * hm, axis=-1, keepdims=True) + EPS)
    hm = hm * mh_norm_g.astype(jnp.float32).reshape(N_MLSTM_HEADS, HEAD_DIM)
    hm = hm.reshape(bsz, seq, D_MLSTM).astype(x.dtype)
    y_m = jax.nn.sigmoid(o) * hm * jax.nn.silu(mz)

    g_conv, g_mlstm = jnp.split(jax.nn.sigmoid(gmerge), 2, axis=-1)
    merged = g_conv * (y_conv @ w_proj_conv) + g_mlstm * (y_m @ w_proj_mlstm)
    return x + gate * (merged @ w_out)


def setup_inputs(seed: int = 0) -> dict:
    key = jax.random.key(seed)
    ks = jax.random.split(key, 20)
    f32 = jnp.float32
    D = D_MODEL
    nrm = lambda k, shape, s: jax.random.normal(k, shape, f32) * s
    forget_base = 3.0 + jnp.linspace(0.0, 3.0, N_MLSTM_HEADS, dtype=f32)
    b_gates = jnp.stack([
        nrm(ks[0], (DEPTH, N_MLSTM_HEADS), 0.1),
        forget_base + nrm(ks[1], (DEPTH, N_MLSTM_HEADS), 0.1),
        nrm(ks[2], (DEPTH, N_MLSTM_HEADS), 0.1),
        forget_base + nrm(ks[3], (DEPTH, N_MLSTM_HEADS), 0.1),
    ], axis=1)
    return {
        "x_prompt": nrm(ks[4], (BATCH, SEQ, D), 1.0),
        "x_sample": nrm(ks[5], (DEC_BATCH, DEC_SEQ, D), 1.0),
        "c_prompt": nrm(ks[6], (BATCH, D), 1.0),
        "c_sample": nrm(ks[7], (DEC_BATCH, D), 1.0),
        "w_ada": nrm(ks[8], (DEPTH, D, 3 * D), 0.1 * D ** -0.5),
        "b_ada": nrm(ks[9], (DEPTH, 3 * D), 0.02),
        "norm_g": 1.0 + nrm(ks[10], (DEPTH, D), 0.02),
        "w_in": nrm(ks[11], (DEPTH, D, D_IN), D ** -0.5),
        "b_gates": b_gates,
        "conv_w": nrm(ks[12], (DEPTH, CONV_WIDTH, D_CONV), CONV_WIDTH ** -0.5),
        "conv_b": nrm(ks[13], (DEPTH, D_CONV), 0.02),
        "mh_norm_g": 1.0 + nrm(ks[14], (DEPTH, D_MLSTM), 0.02),
        "w_proj_conv": nrm(ks[15], (DEPTH, D_CONV, D), D_CONV ** -0.5),
        "w_proj_mlstm": nrm(ks[16], (DEPTH, D_MLSTM, D), D_MLSTM ** -0.5),
        "w_out": nrm(ks[17], (DEPTH, D, D), D ** -0.5),
        "final_norm_g": 1.0 + nrm(ks[18], (D,), 0.02),
    }


def reference(x_prompt, x_sample, c_prompt, c_sample, w_ada, b_ada, norm_g, w_in, b_gates,
              conv_w, conv_b, mh_norm_g, w_proj_conv, w_proj_mlstm, w_out, final_norm_g):
    def trunk(x, c):
        for l in range(DEPTH):
            x = mixer_layer(x, c, w_ada[l], b_ada[l], norm_g[l], w_in[l], b_gates[l], conv_w[l],
                            conv_b[l], mh_norm_g[l], w_proj_conv[l], w_proj_mlstm[l], w_out[l])
        return rms_norm(x, final_norm_g)

    y_prompt = trunk(x_prompt, c_prompt)
    y_sample = trunk(x_sample, c_sample)
    return (y_prompt, y_sample)
```

```cpp
#include <hip/hip_runtime.h>
#include <hip/hip_cooperative_groups.h>
#include <cstdio>
namespace cg = cooperative_groups;

typedef unsigned short u16;
using bf16x8 = __attribute__((ext_vector_type(8))) short;
using f32x4  = __attribute__((ext_vector_type(4))) float;
using s16x4  = __attribute__((ext_vector_type(4))) short;
using u32x4  = __attribute__((ext_vector_type(4))) unsigned;
#define DI __device__ __forceinline__

constexpr int D = 1024, DIN = 11280, DEPTH = 4;
constexpr int NT = 512;
constexpr int W_QKV = 0, W_C = 3328, W_G = 9472, W_PC = 11520, W_PM = 12544, W_O = 13568, WROWS = 14592;
constexpr int LDT = 72;
constexpr int KS = 264, VS = 136;
constexpr int LDS_BYTES = (128 * KS + 2 * 80 * VS + 80 * KS) * 2 + 4 * 128 * 4;

struct Params {
  const float* x_prompt; const float* x_sample; const float* c_prompt; const float* c_sample;
  const float* w_ada; const float* b_ada; const float* norm_g; const float* w_in; const float* b_gates;
  const float* conv_w; const float* conv_b; const float* mh_norm_g; const float* w_pc; const float* w_pm;
  const float* w_out; const float* final_g;
  float* out; unsigned char* ws;
  int G; int pad;
};

struct Ctx {
  int G, Tg, half;
  u16 *Rh, *R1, *R2, *R3, *R4, *Rhf, *Rhb;
  u16* W; float* mod; float* sc; int* ctr;
};

DI u16 f2bf(float x) { unsigned u = __float_as_uint(x); u += 0x7fffu + ((u >> 16) & 1u); return (u16)(u >> 16); }
DI float bf2f(unsigned h) { return __uint_as_float(h << 16); }
DI unsigned pack2(float a, float b) { return (unsigned)f2bf(a) | ((unsigned)f2bf(b) << 16); }
DI uint2 pack4(float a, float b, float c, float d) { uint2 r; r.x = pack2(a, b); r.y = pack2(c, d); return r; }
DI uint2 pack4v(f32x4 v) { return pack4(v[0], v[1], v[2], v[3]); }
DI float4 unpack4(uint2 v) { float4 r; r.x = bf2f(v.x & 0xffffu); r.y = bf2f(v.x >> 16); r.z = bf2f(v.y & 0xffffu); r.w = bf2f(v.y >> 16); return r; }
DI float sigmoidf_(float x) { return 1.f / (1.f + __expf(-x)); }
DI float siluf_(float x) { return x * sigmoidf_(x); }
DI float wave_sum(float v) {
#pragma unroll
  for (int o = 32; o >= 1; o >>= 1) v += __shfl_xor(v, o);
  return v;
}
DI int opaque_tid() { int t = threadIdx.x; asm volatile("" : "+v"(t)); return t; }
DI f32x4 mfma16(bf16x8 a, bf16x8 b, f32x4 c) { return __builtin_amdgcn_mfma_f32_16x16x32_bf16(a, b, c, 0, 0, 0); }

DI int gtok(const Ctx& c, int g, int lt) { return lt < c.half ? g * c.half + lt : 65536 + g * c.half + (lt - c.half); }
DI int batch_of(int tok) { return tok < 65536 ? (tok >> 13) : 8 + ((tok - 65536) >> 11); }
DI const float* xin_row(const Params& p, int tok) {
  return tok < 65536 ? p.x_prompt + (long)tok * D : p.x_sample + (long)(tok - 65536) * D;
}

template <int MT>
DI void gemm_tile(const u16* __restrict__ P, const u16* __restrict__ Q, f32x4 (&acc)[MT][4], u16* lds) {
  const int tid = opaque_tid(), lane = tid & 63, wave = __builtin_amdgcn_readfirstlane(tid >> 6), wm = wave & 3, wn = wave >> 2;
  const int lr = lane & 15, lg = lane >> 4;
  constexpr int PROWS = 64 * MT;
  u16* pbuf = lds;
  u16* qbuf = lds + 2 * PROWS * LDT;
  uint4 rp[MT], rq[2];
  const int lrow = tid >> 3, lkc = (tid & 7) * 8;
#pragma unroll
  for (int i = 0; i < MT; i++)
#pragma unroll
    for (int j = 0; j < 4; j++) acc[i][j] = (f32x4){0.f, 0.f, 0.f, 0.f};
#pragma unroll
  for (int i = 0; i < MT; i++) rp[i] = *(const uint4*)(P + (long)(lrow + 64 * i) * D + lkc);
#pragma unroll
  for (int i = 0; i < 2; i++) rq[i] = *(const uint4*)(Q + (long)(lrow + 64 * i) * D + lkc);
#pragma unroll
  for (int i = 0; i < MT; i++) *(uint4*)(pbuf + (lrow + 64 * i) * LDT + lkc) = rp[i];
#pragma unroll
  for (int i = 0; i < 2; i++) *(uint4*)(qbuf + (lrow + 64 * i) * LDT + lkc) = rq[i];
  __syncthreads();
  constexpr int NK = D / 64;
  for (int kt = 0; kt < NK; ++kt) {
    const int cur = kt & 1;
    if (kt + 1 < NK) {
      const int k0 = (kt + 1) * 64;
#pragma unroll
      for (int i = 0; i < MT; i++) rp[i] = *(const uint4*)(P + (long)(lrow + 64 * i) * D + k0 + lkc);
#pragma unroll
      for (int i = 0; i < 2; i++) rq[i] = *(const uint4*)(Q + (long)(lrow + 64 * i) * D + k0 + lkc);
    }
    const u16* pb = pbuf + cur * PROWS * LDT + (wm * 16 * MT + lr) * LDT + lg * 8;
    const u16* qb = qbuf + cur * 128 * LDT + (wn * 64 + lr) * LDT + lg * 8;
#pragma unroll
    for (int ks = 0; ks < 2; ++ks) {
      bf16x8 a[MT], b[4];
#pragma unroll
      for (int i = 0; i < MT; i++) a[i] = *(const bf16x8*)(pb + i * 16 * LDT + ks * 32);
#pragma unroll
      for (int j = 0; j < 4; j++) b[j] = *(const bf16x8*)(qb + j * 16 * LDT + ks * 32);
#pragma unroll
      for (int i = 0; i < MT; i++)
#pragma unroll
        for (int j = 0; j < 4; j++) acc[i][j] = mfma16(a[i], b[j], acc[i][j]);
    }
    if (kt + 1 < NK) {
      const int nx = cur ^ 1;
#pragma unroll
      for (int i = 0; i < MT; i++) *(uint4*)(pbuf + nx * PROWS * LDT + (lrow + 64 * i) * LDT + lkc) = rp[i];
#pragma unroll
      for (int i = 0; i < 2; i++) *(uint4*)(qbuf + nx * 128 * LDT + (lrow + 64 * i) * LDT + lkc) = rq[i];
    }
    __syncthreads();
  }
}

DI void wsrc(const Params& p, int l, int n, const float*& src, int& ld, int& col, float& scale) {
  scale = 1.f;
  src = p.w_in + (long)l * D * DIN; ld = DIN;
  if (n < W_C) {
    if (n < 1024) col = 4096 + n;
    else if (n < 2048) { col = 5120 + (n - 1024); scale = 0.0625f; }
    else if (n < 3072) col = 6144 + (n - 2048);
    else if (n < 3088) col = 9216 + (n - 3072);
    else col = -1;
  } else if (n < W_G) {
    int n2 = n - W_C;
    if (n2 < 4096) { int blk = n2 >> 6, sl = (n2 >> 4) & 3, cl = n2 & 15; col = sl * 1024 + blk * 16 + cl; }
    else { int n3 = n2 - 4096; int blk = n3 >> 5, sl = (n3 >> 4) & 1, cl = n3 & 15; col = (sl ? 8192 : 7168) + blk * 16 + cl; }
  } else if (n < W_PC) {
    int n4 = n - W_G; int blk = n4 >> 5, sl = (n4 >> 4) & 1, cl = n4 & 15; col = 9232 + sl * 1024 + blk * 16 + cl;
  } else if (n < W_PM) { src = p.w_pc + (long)l * D * D; ld = D; col = n - W_PC; }
  else if (n < W_O)  { src = p.w_pm + (long)l * D * D; ld = D; col = n - W_PM; }
  else               { src = p.w_out + (long)l * D * D; ld = D; col = n - W_O; }
}

DI void phase_prep(const Params& p, const Ctx& c, float* ldsf) {
  const int tid = opaque_tid();
  if (blockIdx.x == 0 && tid < 64) c.ctr[tid] = 0;
  const int nItems = DEPTH * (WROWS / 64) * 16;
  for (int it = blockIdx.x; it < nItems; it += gridDim.x) {
    const int kb = (it & 15) * 64; const int rb = it >> 4;
    const int l = rb / (WROWS / 64); const int nb = (rb % (WROWS / 64)) * 64;
    const float* src; int ld, col; float scale;
    const int nl = tid & 63;
    wsrc(p, l, nb + nl, src, ld, col, scale);
#pragma unroll
    for (int i = 0; i < 8; i++) {
      const int kl = (tid >> 6) + 8 * i;
      float v = (col >= 0) ? src[(long)(kb + kl) * ld + col] * scale : 0.f;
      ldsf[kl * 65 + nl] = v;
    }
    __syncthreads();
    {
      const int nl2 = tid >> 3, kc = tid & 7;
      float v[8];
#pragma unroll
      for (int j = 0; j < 8; j++) v[j] = ldsf[(kc * 8 + j) * 65 + nl2];
      uint4 o; o.x = pack2(v[0], v[1]); o.y = pack2(v[2], v[3]); o.z = pack2(v[4], v[5]); o.w = pack2(v[6], v[7]);
      *(uint4*)(c.W + ((long)l * WROWS + nb + nl2) * D + kb + kc * 8) = o;
    }
    __syncthreads();
  }
  const int nMod = DEPTH * 48;
  for (int it = blockIdx.x; it < nMod; it += gridDim.x) {
    const int l = it / 48, jb = (it % 48) * 64;
    const int cl = tid & 63, kc = tid >> 6;
    float acc[40];
#pragma unroll
    for (int b = 0; b < 40; b++) acc[b] = 0.f;
    const float* wa = p.w_ada + (long)l * D * 3072 + jb + cl;
    for (int k = kc * 128; k < kc * 128 + 128; ++k) {
      const float wv = wa[(long)k * 3072];
#pragma unroll
      for (int b = 0; b < 40; b++) {
        const float cv = (b < 8) ? p.c_prompt[b * D + k] : p.c_sample[(b - 8) * D + k];
        acc[b] += cv * wv;
      }
    }
#pragma unroll
    for (int b = 0; b < 40; b++) ldsf[(kc * 40 + b) * 64 + cl] = acc[b];
    __syncthreads();
    for (int idx = tid; idx < 40 * 64; idx += NT) {
      const int b = idx >> 6, cc = idx & 63;
      float s = p.b_ada[l * 3072 + jb + cc];
#pragma unroll
      for (int q = 0; q < 8; q++) s += ldsf[(q * 40 + b) * 64 + cc];
      c.mod[((long)l * 40 + b) * 3072 + jb + cc] = s;
    }
    __syncthreads();
  }
}

DI void phase_rows(const Params& p, const Ctx& c, int l, int g, bool fin) {
  const int tid_ = opaque_tid(); const int lane = tid_ & 63, w = tid_ >> 6;
  for (int lt = blockIdx.x * 8 + w; lt < c.Tg; lt += gridDim.x * 8) {
    const int tok = gtok(c, g, lt);
    const float* xr = (l == 0) ? xin_row(p, tok) : p.out + (long)tok * D;
    float4 v[4]; float ss = 0.f;
#pragma unroll
    for (int i = 0; i < 4; i++) {
      v[i] = *(const float4*)(xr + 4 * lane + 256 * i);
      ss += v[i].x * v[i].x + v[i].y * v[i].y + v[i].z * v[i].z + v[i].w * v[i].w;
    }
    ss = wave_sum(ss);
    const float rstd = rsqrtf(ss * (1.f / 1024.f) + 1e-6f);
    if (fin) {
#pragma unroll
      for (int i = 0; i < 4; i++) {
        const int k = 4 * lane + 256 * i;
        const float4 fg = *(const float4*)(p.final_g + k);
        float4 o; o.x = v[i].x * rstd * fg.x; o.y = v[i].y * rstd * fg.y; o.z = v[i].z * rstd * fg.z; o.w = v[i].w * rstd * fg.w;
        *(float4*)(p.out + (long)tok * D + k) = o;
      }
    } else {
      const float* mp = c.mod + ((long)l * 40 + batch_of(tok)) * 3072;
#pragma unroll
      for (int i = 0; i < 4; i++) {
        const int k = 4 * lane + 256 * i;
        const float4 ng = *(const float4*)(p.norm_g + l * D + k);
        const float4 scl = *(const float4*)(mp + 1024 + k);
        const float4 sh = *(const float4*)(mp + k);
        const float h0 = v[i].x * rstd * ng.x * (1.f + scl.x) + sh.x;
        const float h1 = v[i].y * rstd * ng.y * (1.f + scl.y) + sh.y;
        const float h2 = v[i].z * rstd * ng.z * (1.f + scl.z) + sh.z;
        const float h3 = v[i].w * rstd * ng.w * (1.f + scl.w) + sh.w;
        *(uint2*)(c.Rh + (long)lt * D + k) = pack4(h0, h1, h2, h3);
      }
    }
  }
}

DI void phase_A(const Params& p, const Ctx& c, int l, u16* lds) {
  const int tid = opaque_tid(), lane = tid & 63, wave = tid >> 6, wm = wave & 3, wn = wave >> 2, lr = lane & 15, lg = lane >> 4;
  const u16* W = c.W + (long)l * WROWS * D;
  u16* Rq = c.R1; u16* Rk = c.R2; u16* RvT = c.R4;
  const int nTiles = (c.Tg / 256) * 26;
  for (int tile = blockIdx.x; tile < nTiles; tile += gridDim.x) {
    const int tb = tile / 26, j = tile % 26;
    f32x4 acc[4][4];
    if (j < 16) {
      const int isk = j >> 3, head = (j >> 1) & 3, ch = tb * 2 + (j & 1);
      gemm_tile<4>(W + (long)(isk * 1024 + head * 256) * D, c.Rh + (long)ch * 128 * D, acc, lds);
      u16* dst = isk ? Rk : Rq;
#pragma unroll
      for (int i = 0; i < 4; i++)
#pragma unroll
        for (int jn = 0; jn < 4; jn++) {
          const int d = 64 * wm + 16 * i + 4 * lg, t = 64 * wn + 16 * jn + lr;
          const uint2 pk = pack4v(acc[i][jn]);
          *(uint2*)(dst + (long)(ch * 128 + t) * D + head * 256 + d) = pk;
        }
    } else if (j < 24) {
      const int vt = j - 16, head = vt >> 1;
      gemm_tile<4>(c.Rh + (long)tb * 256 * D, W + (long)(2048 + vt * 128) * D, acc, lds);
#pragma unroll
      for (int i = 0; i < 4; i++)
#pragma unroll
        for (int jn = 0; jn < 4; jn++) {
          const int tokl = 64 * wm + 16 * i + 4 * lg, e = (vt & 1) * 128 + 64 * wn + 16 * jn + lr;
          const int ch = tb * 2 + (tokl >> 7), s = tokl & 127;
          *(uint2*)(RvT + ((long)(ch * 4 + head) * 256 + e) * 128 + s) = pack4v(acc[i][jn]);
        }
    } else {
      const int ch = tb * 2 + (j - 24);
      gemm_tile<4>(W + (long)3072 * D, c.Rh + (long)ch * 128 * D, acc, lds);
      float* gl = (float*)lds;
      if (wm == 0) {
#pragma unroll
        for (int jn = 0; jn < 4; jn++) {
          const int t = 64 * wn + 16 * jn + lr;
#pragma unroll
          for (int r = 0; r < 4; r++) {
            float v = acc[0][jn][r] + p.b_gates[l * 16 + lg * 4 + r];
            if (lg & 1) v = fminf(v, 0.f) - log1pf(expf(-fabsf(v)));
            gl[t * 16 + lg * 4 + r] = v;
          }
        }
      }
      __syncthreads();
      if (tid < 8) {
        const int head = tid & 3, dir = tid >> 2;
        float* o = c.sc + (((long)(ch * 4 + head) * 2 + dir) * 3) * 128;
        float bs = 0.f, pm = -3.0e38f;
        for (int q = 0; q < 128; ++q) {
          const int t = dir ? 127 - q : q;
          const float iv = gl[t * 16 + dir * 8 + head], lf = gl[t * 16 + dir * 8 + 4 + head];
          bs += lf; const float gg = iv - bs; pm = fmaxf(pm, gg);
          o[t] = bs; o[128 + t] = gg; o[256 + t] = pm;
        }
      }
      __syncthreads();
    }
  }
}

DI void phase_scan(const Params& p, const Ctx& c, int ctrIdx, char* smem) {
  __shared__ int s_task;
  const int tid = opaque_tid(), lane = tid & 63, w = __builtin_amdgcn_readfirstlane(tid >> 6), lr = lane & 15, lg = lane >> 4;
  u16* Kb = (u16*)smem;
  u16* Vt = Kb + 128 * KS;
  u16* Vw = Vt + 80 * VS;
  u16* Ct = Vw + 80 * VS;
  float* scg = (float*)(Ct + 80 * KS); float* scmu = scg + 128; float* sciw = scmu + 128; float* scfl = sciw + 128;
  const u16* Rq = c.R1; const u16* Rk = c.R2; const u16* RvT = c.R4;
  const int nLong = (8 / c.G) * 32, nTasks = nLong + (32 / c.G) * 32;
  int* ctr = c.ctr + ctrIdx;
  while (true) {
    __syncthreads();
    if (tid == 0) s_task = atomicAdd(ctr, 1);
    __syncthreads();
    const int task = s_task;
    if (task >= nTasks) break;
    int seq, r, chunk0, nc;
    if (task < nLong) { seq = task >> 5; r = task & 31; chunk0 = seq * 64; nc = 64; }
    else { const int t2 = task - nLong; seq = t2 >> 5; r = t2 & 31; chunk0 = (c.half >> 7) + seq * 16; nc = 16; }
    const int head = r >> 3, dir = (r >> 2) & 1, es = r & 3;
    const int last = dir ? 0 : 127;
    u16* Rho = dir ? c.Rhb : c.Rhf;
    for (int idx = tid; idx < 80 * KS / 2; idx += NT) ((unsigned*)Ct)[idx] = 0u;
    for (int idx = tid; idx < 16 * VS / 2; idx += NT) { ((unsigned*)(Vt + 64 * VS))[idx] = 0u; ((unsigned*)(Vw + 64 * VS))[idx] = 0u; }
    __syncthreads();
    if (tid < 128) Vt[64 * VS + tid] = (u16)0x3F80;
    f32x4 st[2][5];
#pragma unroll
    for (int i = 0; i < 2; i++)
#pragma unroll
      for (int jn = 0; jn < 5; jn++) st[i][jn] = (f32x4){0.f, 0.f, 0.f, 0.f};
    float m = 0.f;
    const int vrow = tid >> 4, vsc = tid & 15;
    const int krow = tid >> 5, kkc = (tid & 31) * 8;
    for (int j = 0; j < nc; ++j) {
      const int cc = chunk0 + (dir ? nc - 1 - j : j);
      u32x4 kpre[8], vpre[2]; float4 g8a, g8b; float bLn, gmaxn, myb, myg, mypm;
      bf16x8 qf[8];
#pragma unroll
      for (int ks = 0; ks < 8; ks++)
        qf[ks] = *(const bf16x8*)(Rq + (long)(cc * 128 + 16 * w + lr) * D + head * 256 + 32 * ks + 8 * lg);
      {
#pragma unroll
        for (int i = 0; i < 8; i++) kpre[i] = *(const u32x4*)(Rk + (long)(cc * 128 + krow + 16 * i) * D + head * 256 + kkc);
#pragma unroll
        for (int i = 0; i < 2; i++) vpre[i] = *(const u32x4*)(RvT + ((long)(cc * 4 + head) * 256 + es * 64 + vrow + 32 * i) * 128 + vsc * 8);
        const float* scb = c.sc + ((long)(cc * 4 + head) * 2 + dir) * 384;
        g8a = *(const float4*)(scb + 128 + vsc * 8); g8b = *(const float4*)(scb + 128 + vsc * 8 + 4);
        bLn = scb[last]; gmaxn = scb[256 + last];
        myb = scb[tid & 127]; myg = scb[128 + (tid & 127)]; mypm = scb[256 + (tid & 127)];
      }
      __syncthreads();
      const float muL = fmaxf(m, gmaxn);
      const float decay = __expf(m - muL);
      const float mnext = bLn + muL;
#pragma unroll
      for (int i = 0; i < 2; i++)
#pragma unroll
        for (int jn = 0; jn < 5; jn++)
          *(uint2*)(Ct + (16 * jn + lr) * KS + 32 * w + 16 * i + 4 * lg) = pack4v(st[i][jn]);
#pragma unroll
      for (int i = 0; i < 8; i++) *(u32x4*)(Kb + (krow + 16 * i) * KS + kkc) = kpre[i];
      {
        float w8[8];
        w8[0] = __expf(g8a.x - muL); w8[1] = __expf(g8a.y - muL); w8[2] = __expf(g8a.z - muL); w8[3] = __expf(g8a.w - muL);
        w8[4] = __expf(g8b.x - muL); w8[5] = __expf(g8b.y - muL); w8[6] = __expf(g8b.z - muL); w8[7] = __expf(g8b.w - muL);
#pragma unroll
        for (int i = 0; i < 2; i++) {
          const u32x4 vv = vpre[i];
          *(u32x4*)(Vt + (vrow + 32 * i) * VS + vsc * 8) = vv;
          uint4 v; v.x = vv[0]; v.y = vv[1]; v.z = vv[2]; v.w = vv[3];
          uint4 o;
          o.x = pack2(bf2f(v.x & 0xffffu) * w8[0], bf2f(v.x >> 16) * w8[1]);
          o.y = pack2(bf2f(v.y & 0xffffu) * w8[2], bf2f(v.y >> 16) * w8[3]);
          o.z = pack2(bf2f(v.z & 0xffffu) * w8[4], bf2f(v.z >> 16) * w8[5]);
          o.w = pack2(bf2f(v.w & 0xffffu) * w8[6], bf2f(v.w >> 16) * w8[7]);
          *(uint4*)(Vw + (vrow + 32 * i) * VS + vsc * 8) = o;
        }
        if (tid < 16) {
          uint4 o; o.x = pack2(w8[0], w8[1]); o.y = pack2(w8[2], w8[3]); o.z = pack2(w8[4], w8[5]); o.w = pack2(w8[6], w8[7]);
          *(uint4*)(Vw + 64 * VS + vsc * 8) = o;
        }
      }
      if (tid < 128) {
        const float mu = fmaxf(m, mypm);
        scg[tid] = myg; scmu[tid] = mu; sciw[tid] = __expf(m - mu); scfl[tid] = __expf(-(mu + myb));
      }
      __syncthreads();
      const int t = 16 * w + lr;
      bf16x8 spk[4];
      {
        f32x4 sacc[8];
#pragma unroll
        for (int i = 0; i < 8; i++) sacc[i] = (f32x4){0.f, 0.f, 0.f, 0.f};
#pragma unroll
        for (int i = 0; i < 8; i++) {
          const bool need = dir ? (i >= w) : (i <= w);
          if (need) {
#pragma unroll
            for (int ks = 0; ks < 8; ks++) {
              const bf16x8 a = *(const bf16x8*)(Kb + (16 * i + lr) * KS + 32 * ks + 8 * lg);
              sacc[i] = mfma16(a, qf[ks], sacc[i]);
            }
          }
        }
        const float mu_t = scmu[t];
        int tt = t; asm volatile("" : "+v"(tt));
        const int sgn = dir ? -1 : 1;
#pragma unroll
        for (int ks = 0; ks < 4; ks++) {
          float sv[8];
#pragma unroll
          for (int hh = 0; hh < 2; hh++) {
            const int i = 2 * ks + hh;
            const float4 gs = *(const float4*)(scg + 16 * i + 4 * lg);
            const float gv[4] = {gs.x, gs.y, gs.z, gs.w};
#pragma unroll
            for (int r2 = 0; r2 < 4; r2++) {
              const int s = 16 * i + 4 * lg + r2;
              const bool valid = (s - tt) * sgn <= 0;
              sv[hh * 4 + r2] = valid ? sacc[i][r2] * __expf(gv[r2] - mu_t) : 0.f;
            }
          }
          uint4 o; o.x = pack2(sv[0], sv[1]); o.y = pack2(sv[2], sv[3]); o.z = pack2(sv[4], sv[5]); o.w = pack2(sv[6], sv[7]);
          spk[ks] = __builtin_bit_cast(bf16x8, o);
        }
      }
      f32x4 num[5];
#pragma unroll
      for (int i = 0; i < 5; i++) num[i] = (f32x4){0.f, 0.f, 0.f, 0.f};
#pragma unroll
      for (int ks = 0; ks < 8; ks++)
#pragma unroll
        for (int i = 0; i < 5; i++) {
          const bf16x8 a = *(const bf16x8*)(Ct + (16 * i + lr) * KS + 32 * ks + 8 * lg);
          num[i] = mfma16(a, qf[ks], num[i]);
        }
      {
        const float iw = sciw[t];
#pragma unroll
        for (int i = 0; i < 5; i++) num[i] *= iw;
      }
#pragma unroll
      for (int ks = 0; ks < 4; ks++) {
        const bool need = dir ? (2 * ks + 1 >= w) : (2 * ks <= w);
        if (need) {
#pragma unroll
          for (int i = 0; i < 5; i++) {
            const uint2 lo = *(const uint2*)(Vt + (16 * i + lr) * VS + 32 * ks + 4 * lg);
            const uint2 hi = *(const uint2*)(Vt + (16 * i + lr) * VS + 32 * ks + 16 + 4 * lg);
            uint4 av; av.x = lo.x; av.y = lo.y; av.z = hi.x; av.w = hi.y;
            num[i] = mfma16(__builtin_bit_cast(bf16x8, av), spk[ks], num[i]);
          }
        }
      }
      {
        const float fl = scfl[t];
        const float dr = __shfl(num[4][0], lr);
        const float inv = 1.f / fmaxf(fabsf(dr), fl);
        u16* dst = Rho + (long)(cc * 128 + t) * D + head * 256 + es * 64 + 4 * lg;
#pragma unroll
        for (int i = 0; i < 4; i++)
          *(uint2*)(dst + 16 * i) = pack4(num[i][0] * inv, num[i][1] * inv, num[i][2] * inv, num[i][3] * inv);
      }
#pragma unroll
      for (int i = 0; i < 2; i++)
#pragma unroll
        for (int jn = 0; jn < 5; jn++) st[i][jn] *= decay;
#pragma unroll
      for (int ks = 0; ks < 4; ks++) {
        bf16x8 kTf[2];
#pragma unroll
        for (int i = 0; i < 2; i++) {
          const u16* ap = Kb + (32 * ks + 8 * lg + (lr >> 2)) * KS + 32 * w + 16 * i + 4 * (lr & 3);
          const s16x4 lo = __builtin_amdgcn_ds_read_tr16_b64_v4i16((s16x4 __attribute__((address_space(3)))*)ap);
          const s16x4 hi = __builtin_amdgcn_ds_read_tr16_b64_v4i16((s16x4 __attribute__((address_space(3)))*)(ap + 4 * KS));
          kTf[i] = __builtin_shufflevector(lo, hi, 0, 1, 2, 3, 4, 5, 6, 7);
        }
#pragma unroll
        for (int jn = 0; jn < 5; jn++) {
          const bf16x8 b = *(const bf16x8*)(Vw + (16 * jn + lr) * VS + 32 * ks + 8 * lg);
#pragma unroll
          for (int i = 0; i < 2; i++) st[i][jn] = mfma16(kTf[i], b, st[i][jn]);
        }
      }
      m = mnext;
    }
  }
}

DI void phase_C(const Params& p, const Ctx& c, int l, u16* lds) {
  const int tid = opaque_tid(), lane = tid & 63, wave = tid >> 6, wm = wave & 3, wn = wave >> 2, lr = lane & 15, lg = lane >> 4;
  const u16* W = c.W + ((long)l * WROWS + W_C) * D;
  u16* Ru = c.R1; u16* Ryp = c.R2; u16* Rog = c.R3;
  const int nTiles = (c.Tg / 128) * 24;
  for (int tile = blockIdx.x; tile < nTiles; tile += gridDim.x) {
    const int ch = tile / 24, pt = tile % 24;
    f32x4 acc[4][4];
    gemm_tile<4>(W + (long)pt * 256 * D, c.Rh + (long)ch * 128 * D, acc, lds);
    if (pt < 16) {
      const int chn = pt * 64 + wm * 16 + 4 * lg;
#pragma unroll
      for (int jn = 0; jn < 4; jn++) {
        const long lt = ch * 128 + 64 * wn + 16 * jn + lr;
        float u[4], y[4];
#pragma unroll
        for (int r = 0; r < 4; r++) { u[r] = acc[1][jn][r] * acc[2][jn][r]; y[r] = acc[0][jn][r] * siluf_(acc[3][jn][r]); }
        *(uint2*)(Ru + lt * D + chn) = pack4(u[0], u[1], u[2], u[3]);
        *(uint2*)(Ryp + lt * D + chn) = pack4(y[0], y[1], y[2], y[3]);
      }
    } else {
      const int chn = (pt - 16) * 128 + wm * 32 + 4 * lg;
#pragma unroll
      for (int jn = 0; jn < 4; jn++) {
        const long lt = ch * 128 + 64 * wn + 16 * jn + lr;
#pragma unroll
        for (int hh = 0; hh < 2; hh++) {
          float o[4];
#pragma unroll
          for (int r = 0; r < 4; r++) o[r] = sigmoidf_(acc[2 * hh][jn][r]) * siluf_(acc[2 * hh + 1][jn][r]);
          *(uint2*)(Rog + lt * D + chn + 16 * hh) = pack4(o[0], o[1], o[2], o[3]);
        }
      }
    }
  }
}

DI void phase_E(const Params& p, const Ctx& c, int l) {
  const int tid_ = opaque_tid(); const int lane = tid_ & 63, w = tid_ >> 6;
  const u16* Ru = c.R1; u16* Ryp = c.R2; u16* Rog = c.R3;
  const float* cw = p.conv_w + (long)l * 3 * D; const float* cb = p.conv_b + (long)l * D; const float* mg = p.mh_norm_g + (long)l * D;
  for (int lt = blockIdx.x * 8 + w; lt < c.Tg; lt += gridDim.x * 8) {
    const int sl = lt < c.half ? 8192 : 2048;
    const int pos = (lt < c.half ? lt : lt - c.half) & (sl - 1);
    const bool first = pos == 0, lastp = pos == sl - 1;
#pragma unroll
    for (int i = 0; i < 4; i++) {
      const int k = 4 * lane + 256 * i;
      uint2 z; z.x = 0u; z.y = 0u;
      const uint2 u0 = first ? z : *(const uint2*)(Ru + (long)(lt - 1) * D + k);
      const uint2 u1 = *(const uint2*)(Ru + (long)lt * D + k);
      const uint2 u2 = lastp ? z : *(const uint2*)(Ru + (long)(lt + 1) * D + k);
      const float4 a0 = unpack4(u0), a1 = unpack4(u1), a2 = unpack4(u2);
      const float4 yp = unpack4(*(const uint2*)(Ryp + (long)lt * D + k));
      const float4 w0 = *(const float4*)(cw + k), w1 = *(const float4*)(cw + D + k), w2 = *(const float4*)(cw + 2 * D + k), bb = *(const float4*)(cb + k);
      const float y0 = yp.x * (w0.x * a0.x + w1.x * a1.x + w2.x * a2.x + bb.x);
      const float y1 = yp.y * (w0.y * a0.y + w1.y * a1.y + w2.y * a2.y + bb.y);
      const float y2 = yp.z * (w0.z * a0.z + w1.z * a1.z + w2.z * a2.z + bb.z);
      const float y3 = yp.w * (w0.w * a0.w + w1.w * a1.w + w2.w * a2.w + bb.w);
      *(uint2*)(Ryp + (long)lt * D + k) = pack4(y0, y1, y2, y3);
      const float4 hf = unpack4(*(const uint2*)(c.Rhf + (long)lt * D + k));
      const float4 hb = unpack4(*(const uint2*)(c.Rhb + (long)lt * D + k));
      const float s0 = hf.x + hb.x, s1 = hf.y + hb.y, s2 = hf.z + hb.z, s3 = hf.w + hb.w;
      const float ss = wave_sum(s0 * s0 + s1 * s1 + s2 * s2 + s3 * s3);
      const float rstd = rsqrtf(ss * (1.f / 256.f) + 1e-6f);
      const float4 og = unpack4(*(const uint2*)(Rog + (long)lt * D + k));
      const float4 gg = *(const float4*)(mg + k);
      *(uint2*)(Rog + (long)lt * D + k) = pack4(og.x * s0 * rstd * gg.x, og.y * s1 * rstd * gg.y, og.z * s2 * rstd * gg.z, og.w * s3 * rstd * gg.w);
    }
  }
}

DI void phase_D1(const Params& p, const Ctx& c, int l, u16* lds) {
  const int tid = opaque_tid(), lane = tid & 63, wave = tid >> 6, wm = wave & 3, wn = wave >> 2, lr = lane & 15, lg = lane >> 4;
  const u16* W = c.W + (long)l * WROWS * D;
  const u16* Ryc = c.R2; const u16* Rym = c.R3; u16* Rmg = c.R4;
  const int nTiles = (c.Tg / 128) * 8;
  for (int tile = blockIdx.x; tile < nTiles; tile += gridDim.x) {
    const int ch = tile >> 3, mt = tile & 7;
    f32x4 a2[2][4], M[2][4];
    uint2 gk[4][4];
    {
      f32x4 a1[4][4];
      gemm_tile<4>(W + (long)(W_G + mt * 256) * D, c.Rh + (long)ch * 128 * D, a1, lds);
#pragma unroll
      for (int i = 0; i < 4; i++)
#pragma unroll
        for (int jn = 0; jn < 4; jn++)
          gk[i][jn] = pack4(sigmoidf_(a1[i][jn][0]), sigmoidf_(a1[i][jn][1]), sigmoidf_(a1[i][jn][2]), sigmoidf_(a1[i][jn][3]));
    }
    gemm_tile<2>(W + (long)(W_PC + mt * 128) * D, Ryc + (long)ch * 128 * D, a2, lds);
#pragma unroll
    for (int i = 0; i < 2; i++)
#pragma unroll
      for (int jn = 0; jn < 4; jn++) {
        const float4 gg = unpack4(gk[2 * i][jn]);
        M[i][jn] = (f32x4){gg.x * a2[i][jn][0], gg.y * a2[i][jn][1], gg.z * a2[i][jn][2], gg.w * a2[i][jn][3]};
      }
    gemm_tile<2>(W + (long)(W_PM + mt * 128) * D, Rym + (long)ch * 128 * D, a2, lds);
#pragma unroll
    for (int i = 0; i < 2; i++)
#pragma unroll
      for (int jn = 0; jn < 4; jn++) {
        const float4 gg = unpack4(gk[2 * i + 1][jn]);
        const int col = mt * 128 + 32 * wm + 16 * i + 4 * lg;
        const long lt = ch * 128 + 64 * wn + 16 * jn + lr;
        *(uint2*)(Rmg + lt * D + col) = pack4(M[i][jn][0] + gg.x * a2[i][jn][0], M[i][jn][1] + gg.y * a2[i][jn][1],
                                              M[i][jn][2] + gg.z * a2[i][jn][2], M[i][jn][3] + gg.w * a2[i][jn][3]);
      }
  }
}

DI void phase_D2(const Params& p, const Ctx& c, int l, int g, u16* lds) {
  const int tid = opaque_tid(), lane = tid & 63, wave = tid >> 6, wm = wave & 3, wn = wave >> 2, lr = lane & 15, lg = lane >> 4;
  const u16* W = c.W + ((long)l * WROWS + W_O) * D;
  const u16* Rmg = c.R4;
  const int nTiles = (c.Tg / 128) * 4;
  for (int tile = blockIdx.x; tile < nTiles; tile += gridDim.x) {
    const int ch = tile >> 2, pt = tile & 3;
    f32x4 acc[4][4];
    gemm_tile<4>(W + (long)pt * 256 * D, Rmg + (long)ch * 128 * D, acc, lds);
    const int tok0 = gtok(c, g, ch * 128);
    const float* gp = c.mod + ((long)l * 40 + batch_of(tok0)) * 3072 + 2048;
#pragma unroll
    for (int i = 0; i < 4; i++) {
      const int col = pt * 256 + 64 * wm + 16 * i + 4 * lg;
      const float4 gt = *(const float4*)(gp + col);
#pragma unroll
      for (int jn = 0; jn < 4; jn++) {
        const int tok = tok0 + 64 * wn + 16 * jn + lr;
        const float* xr = (l == 0) ? xin_row(p, tok) : p.out + (long)tok * D;
        const float4 xv = *(const float4*)(xr + col);
        float4 o;
        o.x = xv.x + gt.x * acc[i][jn][0]; o.y = xv.y + gt.y * acc[i][jn][1];
        o.z = xv.z + gt.z * acc[i][jn][2]; o.w = xv.w + gt.w * acc[i][jn][3];
        *(float4*)(p.out + (long)tok * D + col) = o;
      }
    }
  }
}

__global__ void __launch_bounds__(NT) mega(Params p) {
  extern __shared__ __attribute__((aligned(16))) char smem[];
  cg::grid_group grid = cg::this_grid();
  Ctx c;
  c.G = p.G; c.Tg = 131072 / p.G; c.half = c.Tg >> 1;
  const size_t REG = (size_t)c.Tg * D * 2;
  c.Rh = (u16*)(p.ws); c.R1 = (u16*)(p.ws + REG); c.R2 = (u16*)(p.ws + 2 * REG); c.R3 = (u16*)(p.ws + 3 * REG);
  c.R4 = (u16*)(p.ws + 4 * REG); c.Rhf = (u16*)(p.ws + 5 * REG); c.Rhb = (u16*)(p.ws + 6 * REG);
  unsigned char* q = p.ws + 7 * REG;
  c.W = (u16*)q; q += (size_t)DEPTH * WROWS * D * 2;
  c.mod = (float*)q; q += (size_t)DEPTH * 40 * 3072 * 4;
  c.sc = (float*)q; q += (size_t)c.Tg * 96;
  c.ctr = (int*)q;

  phase_prep(p, c, (float*)smem);
  grid.sync();
  for (int g = 0; g < c.G; ++g) {
    for (int l = 0; l < DEPTH; ++l) {
      phase_rows(p, c, l, g, false);
      grid.sync();
      phase_A(p, c, l, (u16*)smem);
      grid.sync();
      phase_scan(p, c, g * DEPTH + l, smem);
      grid.sync();
      phase_C(p, c, l, (u16*)smem);
      grid.sync();
      phase_E(p, c, l);
      grid.sync();
      phase_D1(p, c, l, (u16*)smem);
      grid.sync();
      phase_D2(p, c, l, g, (u16*)smem);
      grid.sync();
    }
    phase_rows(p, c, DEPTH, g, true);
  }
}

extern "C" void kernel_launch(void* const* d_in, const int* in_sizes, int n_in, void* d_out, int out_size,
                              void* d_ws, size_t ws_size, hipStream_t stream) {
  static int grid_blocks = 0;
  static int Gsel = 2;
  if (!grid_blocks) {
    int dev = 0, cus = 0, per_cu = 0;
    hipGetDevice(&dev);
    hipDeviceGetAttribute(&cus, hipDeviceAttributeMultiprocessorCount, dev);
    hipFuncSetAttribute((const void*)mega, hipFuncAttributeMaxDynamicSharedMemorySize, LDS_BYTES);
    hipOccupancyMaxActiveBlocksPerMultiprocessor(&per_cu, (const void*)mega, NT, LDS_BYTES);
    if (per_cu < 1) per_cu = 1;
    grid_blocks = cus * per_cu;
    const size_t fixed = (size_t)DEPTH * WROWS * D * 2 + (size_t)DEPTH * 40 * 3072 * 4 + 4096;
    Gsel = 2;
    while (Gsel < 8 && 7 * ((size_t)(131072 / Gsel) * D * 2) + fixed + (size_t)(131072 / Gsel) * 96 > ws_size) Gsel *= 2;
  }
  Params p{};
  p.x_prompt = (const float*)d_in[0]; p.x_sample = (const float*)d_in[1]; p.c_prompt = (const float*)d_in[2]; p.c_sample = (const float*)d_in[3];
  p.w_ada = (const float*)d_in[4]; p.b_ada = (const float*)d_in[5]; p.norm_g = (const float*)d_in[6]; p.w_in = (const float*)d_in[7];
  p.b_gates = (const float*)d_in[8]; p.conv_w = (const float*)d_in[9]; p.conv_b = (const float*)d_in[10]; p.mh_norm_g = (const float*)d_in[11];
  p.w_pc = (const float*)d_in[12]; p.w_pm = (const float*)d_in[13]; p.w_out = (const float*)d_in[14]; p.final_g = (const float*)d_in[15];
  p.out = (float*)d_out; p.ws = (unsigned char*)d_ws; p.G = Gsel; p.pad = 0;
  void* args[] = {&p};
  hipError_t e = hipLaunchCooperativeKernel((const void*)mega, dim3(grid_blocks), dim3(NT), args, LDS_BYTES, stream);
  if (e != hipSuccess) fprintf(stderr, "cooperative launch failed: %s (grid %d)\n", hipGetErrorString(e), grid_blocks);
}
```

```cpp
#include <hip/hip_runtime.h>
#include <hip/hip_cooperative_groups.h>
#include <cstdio>
namespace cg = cooperative_groups;

typedef unsigned short u16;
using bf16x8 = __attribute__((ext_vector_type(8))) short;
using f32x4  = __attribute__((ext_vector_type(4))) float;
using s16x4  = __attribute__((ext_vector_type(4))) short;
using u32x4  = __attribute__((ext_vector_type(4))) unsigned;
#define DI __device__ __forceinline__

constexpr int D = 1024, DIN = 11280, DEPTH = 4;
constexpr int NT = 512;
constexpr int W_QKV = 0, W_C = 3328, W_G = 9472, W_PC = 11520, W_PM = 12544, W_O = 13568, WROWS = 14592;
constexpr int LDT = 72;
constexpr int KS = 264, VS = 136;
constexpr int LDS_BYTES = (128 * KS + 2 * 80 * VS + 80 * KS) * 2 + 4 * 128 * 4;

struct Params {
  const float* x_prompt; const float* x_sample; const float* c_prompt; const float* c_sample;
  const float* w_ada; const float* b_ada; const float* norm_g; const float* w_in; const float* b_gates;
  const float* conv_w; const float* conv_b; const float* mh_norm_g; const float* w_pc; const float* w_pm;
  const float* w_out; const float* final_g;
  float* out; unsigned char* ws;
  int G; int pad;
};

struct Ctx {
  int G, Tg, half;
  u16 *Rh, *R1, *R2, *R3, *R4, *Rhf, *Rhb;
  u16* W; float* mod; float* sc; int* ctr;
};

DI u16 f2bf(float x) { unsigned u = __float_as_uint(x); u += 0x7fffu + ((u >> 16) & 1u); return (u16)(u >> 16); }
DI float bf2f(unsigned h) { return __uint_as_float(h << 16); }
DI unsigned pack2(float a, float b) { return (unsigned)f2bf(a) | ((unsigned)f2bf(b) << 16); }
DI uint2 pack4(float a, float b, float c, float d) { uint2 r; r.x = pack2(a, b); r.y = pack2(c, d); return r; }
DI uint2 pack4v(f32x4 v) { return pack4(v[0], v[1], v[2], v[3]); }
DI float4 unpack4(uint2 v) { float4 r; r.x = bf2f(v.x & 0xffffu); r.y = bf2f(v.x >> 16); r.z = bf2f(v.y & 0xffffu); r.w = bf2f(v.y >> 16); return r; }
DI float sigmoidf_(float x) { return 1.f / (1.f + __expf(-x)); }
DI float siluf_(float x) { return x * sigmoidf_(x); }
DI float wave_sum(float v) {
#pragma unroll
  for (int o = 32; o >= 1; o >>= 1) v += __shfl_xor(v, o);
  return v;
}
DI int opaque_tid() { int t = threadIdx.x; asm volatile("" : "+v"(t)); return t; }
DI f32x4 mfma16(bf16x8 a, bf16x8 b, f32x4 c) { return __builtin_amdgcn_mfma_f32_16x16x32_bf16(a, b, c, 0, 0, 0); }

DI int gtok(const Ctx& c, int g, int lt) { return lt < c.half ? g * c.half + lt : 65536 + g * c.half + (lt - c.half); }
DI int batch_of(int tok) { return tok < 65536 ? (tok >> 13) : 8 + ((tok - 65536) >> 11); }
DI const float* xin_row(const Params& p, int tok) {
  return tok < 65536 ? p.x_prompt + (long)tok * D : p.x_sample + (long)(tok - 65536) * D;
}

template <int MT>
DI void gemm_tile(const u16* __restrict__ P, const u16* __restrict__ Q, f32x4 (&acc)[MT][4], u16* lds) {
  const int tid = opaque_tid(), lane = tid & 63, wave = __builtin_amdgcn_readfirstlane(tid >> 6), wm = wave & 3, wn = wave >> 2;
  const int lr = lane & 15, lg = lane >> 4;
  constexpr int PROWS = 64 * MT;
  char* pbase = (char*)lds;
  char* qbase = pbase + 2 * PROWS * 128;
  const int drow = lane >> 3, dpos = lane & 7;
  const u16* gp[MT]; const u16* gq[2];
#pragma unroll
  for (int i = 0; i < MT; i++) { const int r = 8 * (wave + 8 * i) + drow; gp[i] = P + (long)r * D + ((dpos ^ ((r >> 1) & 7)) << 3); }
#pragma unroll
  for (int i = 0; i < 2; i++) { const int r = 8 * (wave + 8 * i) + drow; gq[i] = Q + (long)r * D + ((dpos ^ ((r >> 1) & 7)) << 3); }
  char* dp = pbase + wave * 1024 + lane * 16;
  char* dq = qbase + wave * 1024 + lane * 16;
#pragma unroll
  for (int i = 0; i < MT; i++)
#pragma unroll
    for (int j = 0; j < 4; j++) acc[i][j] = (f32x4){0.f, 0.f, 0.f, 0.f};
#pragma unroll
  for (int i = 0; i < MT; i++) __builtin_amdgcn_global_load_lds((const unsigned*)gp[i], (unsigned*)(dp + i * 8192), 16, 0, 0);
#pragma unroll
  for (int i = 0; i < 2; i++) __builtin_amdgcn_global_load_lds((const unsigned*)gq[i], (unsigned*)(dq + i * 8192), 16, 0, 0);
  asm volatile("s_waitcnt vmcnt(0)" ::: "memory");
  __syncthreads();
  const int swz = (lr >> 1) & 7;
  const int o0 = (lg ^ swz) << 4, o1 = ((4 + lg) ^ swz) << 4;
  const char* pa = pbase + (wm * 16 * MT + lr) * 128;
  const char* qa = qbase + (wn * 64 + lr) * 128;
  constexpr int NK = D / 64;
  for (int kt = 0; kt < NK; ++kt) {
    const int cur = kt & 1;
    if (kt + 1 < NK) {
      const int nx = cur ^ 1;
#pragma unroll
      for (int i = 0; i < MT; i++) __builtin_amdgcn_global_load_lds((const unsigned*)(gp[i] + (kt + 1) * 64), (unsigned*)(dp + nx * PROWS * 128 + i * 8192), 16, 0, 0);
#pragma unroll
      for (int i = 0; i < 2; i++) __builtin_amdgcn_global_load_lds((const unsigned*)(gq[i] + (kt + 1) * 64), (unsigned*)(dq + nx * 128 * 128 + i * 8192), 16, 0, 0);
    }
    const char* pb = pa + cur * PROWS * 128;
    const char* qb = qa + cur * 128 * 128;
#pragma unroll
    for (int ks = 0; ks < 2; ++ks) {
      const int oo = ks ? o1 : o0;
      bf16x8 a[MT], b[4];
#pragma unroll
      for (int i = 0; i < MT; i++) a[i] = *(const bf16x8*)(pb + i * 2048 + oo);
#pragma unroll
      for (int j = 0; j < 4; j++) b[j] = *(const bf16x8*)(qb + j * 2048 + oo);
#pragma unroll
      for (int i = 0; i < MT; i++)
#pragma unroll
        for (int j = 0; j < 4; j++) acc[i][j] = mfma16(a[i], b[j], acc[i][j]);
    }
    asm volatile("s_waitcnt vmcnt(0)" ::: "memory");
    __syncthreads();
  }
}

DI void wsrc(const Params& p, int l, int n, const float*& src, int& ld, int& col, float& scale) {
  scale = 1.f;
  src = p.w_in + (long)l * D * DIN; ld = DIN;
  if (n < W_C) {
    if (n < 1024) col = 4096 + n;
    else if (n < 2048) { col = 5120 + (n - 1024); scale = 0.0625f; }
    else if (n < 3072) col = 6144 + (n - 2048);
    else if (n < 3088) col = 9216 + (n - 3072);
    else col = -1;
  } else if (n < W_G) {
    int n2 = n - W_C;
    if (n2 < 4096) { int blk = n2 >> 6, sl = (n2 >> 4) & 3, cl = n2 & 15; col = sl * 1024 + blk * 16 + cl; }
    else { int n3 = n2 - 4096; int blk = n3 >> 5, sl = (n3 >> 4) & 1, cl = n3 & 15; col = (sl ? 8192 : 7168) + blk * 16 + cl; }
  } else if (n < W_PC) {
    int n4 = n - W_G; int blk = n4 >> 5, sl = (n4 >> 4) & 1, cl = n4 & 15; col = 9232 + sl * 1024 + blk * 16 + cl;
  } else if (n < W_PM) { src = p.w_pc + (long)l * D * D; ld = D; col = n - W_PC; }
  else if (n < W_O)  { src = p.w_pm + (long)l * D * D; ld = D; col = n - W_PM; }
  else               { src = p.w_out + (long)l * D * D; ld = D; col = n - W_O; }
}

DI void phase_prep(const Params& p, const Ctx& c, float* ldsf) {
  const int tid = opaque_tid();
  if (blockIdx.x == 0 && tid < 64) c.ctr[tid] = 0;
  const int nItems = DEPTH * (WROWS / 64) * 16;
  for (int it = blockIdx.x; it < nItems; it += gridDim.x) {
    const int kb = (it & 15) * 64; const int rb = it >> 4;
    const int l = rb / (WROWS / 64); const int nb = (rb % (WROWS / 64)) * 64;
    const float* src; int ld, col; float scale;
    const int nl = tid & 63;
    wsrc(p, l, nb + nl, src, ld, col, scale);
#pragma unroll
    for (int i = 0; i < 8; i++) {
      const int kl = (tid >> 6) + 8 * i;
      float v = (col >= 0) ? src[(long)(kb + kl) * ld + col] * scale : 0.f;
      ldsf[kl * 65 + nl] = v;
    }
    __syncthreads();
    {
      const int nl2 = tid >> 3, kc = tid & 7;
      float v[8];
#pragma unroll
      for (int j = 0; j < 8; j++) v[j] = ldsf[(kc * 8 + j) * 65 + nl2];
      uint4 o; o.x = pack2(v[0], v[1]); o.y = pack2(v[2], v[3]); o.z = pack2(v[4], v[5]); o.w = pack2(v[6], v[7]);
      *(uint4*)(c.W + ((long)l * WROWS + nb + nl2) * D + kb + kc * 8) = o;
    }
    __syncthreads();
  }
  const int nMod = DEPTH * 48;
  for (int it = blockIdx.x; it < nMod; it += gridDim.x) {
    const int l = it / 48, jb = (it % 48) * 64;
    const int cl = tid & 63, kc = tid >> 6;
    float acc[40];
#pragma unroll
    for (int b = 0; b < 40; b++) acc[b] = 0.f;
    const float* wa = p.w_ada + (long)l * D * 3072 + jb + cl;
    for (int k = kc * 128; k < kc * 128 + 128; ++k) {
      const float wv = wa[(long)k * 3072];
#pragma unroll
      for (int b = 0; b < 40; b++) {
        const float cv = (b < 8) ? p.c_prompt[b * D + k] : p.c_sample[(b - 8) * D + k];
        acc[b] += cv * wv;
      }
    }
#pragma unroll
    for (int b = 0; b < 40; b++) ldsf[(kc * 40 + b) * 64 + cl] = acc[b];
    __syncthreads();
    for (int idx = tid; idx < 40 * 64; idx += NT) {
      const int b = idx >> 6, cc = idx & 63;
      float s = p.b_ada[l * 3072 + jb + cc];
#pragma unroll
      for (int q = 0; q < 8; q++) s += ldsf[(q * 40 + b) * 64 + cc];
      c.mod[((long)l * 40 + b) * 3072 + jb + cc] = s;
    }
    __syncthreads();
  }
}

DI void phase_rows(const Params& p, const Ctx& c, int l, int g, bool fin) {
  const int tid_ = opaque_tid(); const int lane = tid_ & 63, w = tid_ >> 6;
  for (int lt = blockIdx.x * 8 + w; lt < c.Tg; lt += gridDim.x * 8) {
    const int tok = gtok(c, g, lt);
    const float* xr = (l == 0) ? xin_row(p, tok) : p.out + (long)tok * D;
    float4 v[4]; float ss = 0.f;
#pragma unroll
    for (int i = 0; i < 4; i++) {
      v[i] = *(const float4*)(xr + 4 * lane + 256 * i);
      ss += v[i].x * v[i].x + v[i].y * v[i].y + v[i].z * v[i].z + v[i].w * v[i].w;
    }
    ss = wave_sum(ss);
    const float rstd = rsqrtf(ss * (1.f / 1024.f) + 1e-6f);
    if (fin) {
#pragma unroll
      for (int i = 0; i < 4; i++) {
        const int k = 4 * lane + 256 * i;
        const float4 fg = *(const float4*)(p.final_g + k);
        float4 o; o.x = v[i].x * rstd * fg.x; o.y = v[i].y * rstd * fg.y; o.z = v[i].z * rstd * fg.z; o.w = v[i].w * rstd * fg.w;
        *(float4*)(p.out + (long)tok * D + k) = o;
      }
    } else {
      const float* mp = c.mod + ((long)l * 40 + batch_of(tok)) * 3072;
#pragma unroll
      for (int i = 0; i < 4; i++) {
        const int k = 4 * lane + 256 * i;
        const float4 ng = *(const float4*)(p.norm_g + l * D + k);
        const float4 scl = *(const float4*)(mp + 1024 + k);
        const float4 sh = *(const float4*)(mp + k);
        const float h0 = v[i].x * rstd * ng.x * (1.f + scl.x) + sh.x;
        const float h1 = v[i].y * rstd * ng.y * (1.f + scl.y) + sh.y;
        const float h2 = v[i].z * rstd * ng.z * (1.f + scl.z) + sh.z;
        const float h3 = v[i].w * rstd * ng.w * (1.f + scl.w) + sh.w;
        *(uint2*)(c.Rh + (long)lt * D + k) = pack4(h0, h1, h2, h3);
      }
    }
  }
}

DI void phase_A(const Params& p, const Ctx& c, int l, u16* lds) {
  const int tid = opaque_tid(), lane = tid & 63, wave = tid >> 6, wm = wave & 3, wn = wave >> 2, lr = lane & 15, lg = lane >> 4;
  const u16* W = c.W + (long)l * WROWS * D;
  u16* Rq = c.R1; u16* Rk = c.R2; u16* RvT = c.R4;
  const int nTiles = (c.Tg / 256) * 26;
  for (int tile = blockIdx.x; tile < nTiles; tile += gridDim.x) {
    const int tb = tile / 26, j = tile % 26;
    f32x4 acc[4][4];
    if (j < 16) {
      const int isk = j >> 3, head = (j >> 1) & 3, ch = tb * 2 + (j & 1);
      gemm_tile<4>(W + (long)(isk * 1024 + head * 256) * D, c.Rh + (long)ch * 128 * D, acc, lds);
      u16* dst = isk ? Rk : Rq;
#pragma unroll
      for (int i = 0; i < 4; i++)
#pragma unroll
        for (int jn = 0; jn < 4; jn++) {
          const int d = 64 * wm + 16 * i + 4 * lg, t = 64 * wn + 16 * jn + lr;
          const uint2 pk = pack4v(acc[i][jn]);
          *(uint2*)(dst + (long)(ch * 128 + t) * D + head * 256 + d) = pk;
        }
    } else if (j < 24) {
      const int vt = j - 16, head = vt >> 1;
      gemm_tile<4>(c.Rh + (long)tb * 256 * D, W + (long)(2048 + vt * 128) * D, acc, lds);
#pragma unroll
      for (int i = 0; i < 4; i++)
#pragma unroll
        for (int jn = 0; jn < 4; jn++) {
          const int tokl = 64 * wm + 16 * i + 4 * lg, e = (vt & 1) * 128 + 64 * wn + 16 * jn + lr;
          const int ch = tb * 2 + (tokl >> 7), s = tokl & 127;
          *(uint2*)(RvT + ((long)(ch * 4 + head) * 256 + e) * 128 + s) = pack4v(acc[i][jn]);
        }
    } else {
      const int ch = tb * 2 + (j - 24);
      gemm_tile<4>(W + (long)3072 * D, c.Rh + (long)ch * 128 * D, acc, lds);
      float* gl = (float*)lds;
      if (wm == 0) {
#pragma unroll
        for (int jn = 0; jn < 4; jn++) {
          const int t = 64 * wn + 16 * jn + lr;
#pragma unroll
          for (int r = 0; r < 4; r++) {
            float v = acc[0][jn][r] + p.b_gates[l * 16 + lg * 4 + r];
            if (lg & 1) v = fminf(v, 0.f) - log1pf(expf(-fabsf(v)));
            gl[t * 16 + lg * 4 + r] = v;
          }
        }
      }
      __syncthreads();
      if (tid < 8) {
        const int head = tid & 3, dir = tid >> 2;
        float* o = c.sc + (((long)(ch * 4 + head) * 2 + dir) * 3) * 128;
        float bs = 0.f, pm = -3.0e38f;
        for (int q = 0; q < 128; ++q) {
          const int t = dir ? 127 - q : q;
          const float iv = gl[t * 16 + dir * 8 + head], lf = gl[t * 16 + dir * 8 + 4 + head];
          bs += lf; const float gg = iv - bs; pm = fmaxf(pm, gg);
          o[t] = bs; o[128 + t] = gg; o[256 + t] = pm;
        }
      }
      __syncthreads();
    }
  }
}

DI void phase_scan(const Params& p, const Ctx& c, int ctrIdx, char* smem) {
  __shared__ int s_task;
  const int tid = opaque_tid(), lane = tid & 63, w = __builtin_amdgcn_readfirstlane(tid >> 6), lr = lane & 15, lg = lane >> 4;
  u16* Kb = (u16*)smem;
  u16* Vt = Kb + 128 * KS;
  u16* Vw = Vt + 80 * VS;
  u16* Ct = Vw + 80 * VS;
  float* scg = (float*)(Ct + 80 * KS); float* scmu = scg + 128; float* sciw = scmu + 128; float* scfl = sciw + 128;
  const u16* Rq = c.R1; const u16* Rk = c.R2; const u16* RvT = c.R4;
  const int nLong = (8 / c.G) * 32, nTasks = nLong + (32 / c.G) * 32;
  int* ctr = c.ctr + ctrIdx;
  while (true) {
    __syncthreads();
    if (tid == 0) s_task = atomicAdd(ctr, 1);
    __syncthreads();
    const int task = s_task;
    if (task >= nTasks) break;
    int seq, r, chunk0, nc;
    if (task < nLong) { seq = task >> 5; r = task & 31; chunk0 = seq * 64; nc = 64; }
    else { const int t2 = task - nLong; seq = t2 >> 5; r = t2 & 31; chunk0 = (c.half >> 7) + seq * 16; nc = 16; }
    const int head = r >> 3, dir = (r >> 2) & 1, es = r & 3;
    const int last = dir ? 0 : 127;
    u16* Rho = dir ? c.Rhb : c.Rhf;
    for (int idx = tid; idx < 80 * KS / 2; idx += NT) ((unsigned*)Ct)[idx] = 0u;
    for (int idx = tid; idx < 16 * VS / 2; idx += NT) { ((unsigned*)(Vt + 64 * VS))[idx] = 0u; ((unsigned*)(Vw + 64 * VS))[idx] = 0u; }
    __syncthreads();
    if (tid < 128) Vt[64 * VS + tid] = (u16)0x3F80;
    f32x4 st[2][5];
#pragma unroll
    for (int i = 0; i < 2; i++)
#pragma unroll
      for (int jn = 0; jn < 5; jn++) st[i][jn] = (f32x4){0.f, 0.f, 0.f, 0.f};
    float m = 0.f;
    const int vrow = tid >> 4, vsc = tid & 15;
    const int krow = tid >> 5, kkc = (tid & 31) * 8;
    for (int j = 0; j < nc; ++j) {
      const int cc = chunk0 + (dir ? nc - 1 - j : j);
      u32x4 kpre[8], vpre[2]; float4 g8a, g8b; float bLn, gmaxn, myb, myg, mypm;
      bf16x8 qf[8];
#pragma unroll
      for (int ks = 0; ks < 8; ks++)
        qf[ks] = *(const bf16x8*)(Rq + (long)(cc * 128 + 16 * w + lr) * D + head * 256 + 32 * ks + 8 * lg);
      {
#pragma unroll
        for (int i = 0; i < 8; i++) kpre[i] = *(const u32x4*)(Rk + (long)(cc * 128 + krow + 16 * i) * D + head * 256 + kkc);
#pragma unroll
        for (int i = 0; i < 2; i++) vpre[i] = *(const u32x4*)(RvT + ((long)(cc * 4 + head) * 256 + es * 64 + vrow + 32 * i) * 128 + vsc * 8);
        const float* scb = c.sc + ((long)(cc * 4 + head) * 2 + dir) * 384;
        g8a = *(const float4*)(scb + 128 + vsc * 8); g8b = *(const float4*)(scb + 128 + vsc * 8 + 4);
        bLn = scb[last]; gmaxn = scb[256 + last];
        myb = scb[tid & 127]; myg = scb[128 + (tid & 127)]; mypm = scb[256 + (tid & 127)];
      }
      __syncthreads();
      const float muL = fmaxf(m, gmaxn);
      const float decay = __expf(m - muL);
      const float mnext = bLn + muL;
#pragma unroll
      for (int i = 0; i < 2; i++)
#pragma unroll
        for (int jn = 0; jn < 5; jn++)
          *(uint2*)(Ct + (16 * jn + lr) * KS + 32 * w + 16 * i + 4 * lg) = pack4v(st[i][jn]);
#pragma unroll
      for (int i = 0; i < 8; i++) *(u32x4*)(Kb + (krow + 16 * i) * KS + kkc) = kpre[i];
      {
        float w8[8];
        w8[0] = __expf(g8a.x - muL); w8[1] = __expf(g8a.y - muL); w8[2] = __expf(g8a.z - muL); w8[3] = __expf(g8a.w - muL);
        w8[4] = __expf(g8b.x - muL); w8[5] = __expf(g8b.y - muL); w8[6] = __expf(g8b.z - muL); w8[7] = __expf(g8b.w - muL);
#pragma unroll
        for (int i = 0; i < 2; i++) {
          const u32x4 vv = vpre[i];
          *(u32x4*)(Vt + (vrow + 32 * i) * VS + vsc * 8) = vv;
          uint4 v; v.x = vv[0]; v.y = vv[1]; v.z = vv[2]; v.w = vv[3];
          uint4 o;
          o.x = pack2(bf2f(v.x & 0xffffu) * w8[0], bf2f(v.x >> 16) * w8[1]);
          o.y = pack2(bf2f(v.y & 0xffffu) * w8[2], bf2f(v.y >> 16) * w8[3]);
          o.z = pack2(bf2f(v.z & 0xffffu) * w8[4], bf2f(v.z >> 16) * w8[5]);
          o.w = pack2(bf2f(v.w & 0xffffu) * w8[6], bf2f(v.w >> 16) * w8[7]);
          *(uint4*)(Vw + (vrow + 32 * i) * VS + vsc * 8) = o;
        }
        if (tid < 16) {
          uint4 o; o.x = pack2(w8[0], w8[1]); o.y = pack2(w8[2], w8[3]); o.z = pack2(w8[4], w8[5]); o.w = pack2(w8[6], w8[7]);
          *(uint4*)(Vw + 64 * VS + vsc * 8) = o;
        }
      }
      if (tid < 128) {
        const float mu = fmaxf(m, mypm);
        scg[tid] = myg; scmu[tid] = mu; sciw[tid] = __expf(m - mu); scfl[tid] = __expf(-(mu + myb));
      }
      __syncthreads();
      const int t = 16 * w + lr;
      bf16x8 spk[4];
      {
        f32x4 sacc[8];
#pragma unroll
        for (int i = 0; i < 8; i++) sacc[i] = (f32x4){0.f, 0.f, 0.f, 0.f};
#pragma unroll
        for (int i = 0; i < 8; i++) {
          const bool need = dir ? (i >= w) : (i <= w);
          if (need) {
#pragma unroll
            for (int ks = 0; ks < 8; ks++) {
              const bf16x8 a = *(const bf16x8*)(Kb + (16 * i + lr) * KS + 32 * ks + 8 * lg);
              sacc[i] = mfma16(a, qf[ks], sacc[i]);
            }
          }
        }
        const float mu_t = scmu[t];
        int tt = t; asm volatile("" : "+v"(tt));
        const int sgn = dir ? -1 : 1;
#pragma unroll
        for (int ks = 0; ks < 4; ks++) {
          float sv[8];
#pragma unroll
          for (int hh = 0; hh < 2; hh++) {
            const int i = 2 * ks + hh;
            const float4 gs = *(const float4*)(scg + 16 * i + 4 * lg);
            const float gv[4] = {gs.x, gs.y, gs.z, gs.w};
#pragma unroll
            for (int r2 = 0; r2 < 4; r2++) {
              const int s = 16 * i + 4 * lg + r2;
              const bool valid = (s - tt) * sgn <= 0;
              sv[hh * 4 + r2] = valid ? sacc[i][r2] * __expf(gv[r2] - mu_t) : 0.f;
            }
          }
          uint4 o; o.x = pack2(sv[0], sv[1]); o.y = pack2(sv[2], sv[3]); o.z = pack2(sv[4], sv[5]); o.w = pack2(sv[6], sv[7]);
          spk[ks] = __builtin_bit_cast(bf16x8, o);
        }
      }
      f32x4 num[5];
#pragma unroll
      for (int i = 0; i < 5; i++) num[i] = (f32x4){0.f, 0.f, 0.f, 0.f};
#pragma unroll
      for (int ks = 0; ks < 8; ks++)
#pragma unroll
        for (int i = 0; i < 5; i++) {
          const bf16x8 a = *(const bf16x8*)(Ct + (16 * i + lr) * KS + 32 * ks + 8 * lg);
          num[i] = mfma16(a, qf[ks], num[i]);
        }
      {
        const float iw = sciw[t];
#pragma unroll
        for (int i = 0; i < 5; i++) num[i] *= iw;
      }
#pragma unroll
      for (int ks = 0; ks < 4; ks++) {
        const bool need = dir ? (2 * ks + 1 >= w) : (2 * ks <= w);
        if (need) {
#pragma unroll
          for (int i = 0; i < 5; i++) {
            const uint2 lo = *(const uint2*)(Vt + (16 * i + lr) * VS + 32 * ks + 4 * lg);
            const uint2 hi = *(const uint2*)(Vt + (16 * i + lr) * VS + 32 * ks + 16 + 4 * lg);
            uint4 av; av.x = lo.x; av.y = lo.y; av.z = hi.x; av.w = hi.y;
            num[i] = mfma16(__builtin_bit_cast(bf16x8, av), spk[ks], num[i]);
          }
        }
      }
      {
        const float fl = scfl[t];
        const float dr = __shfl(num[4][0], lr);
        const float inv = 1.f / fmaxf(fabsf(dr), fl);
        u16* dst = Rho + (long)(cc * 128 + t) * D + head * 256 + es * 64 + 4 * lg;
#pragma unroll
        for (int i = 0; i < 4; i++)
          *(uint2*)(dst + 16 * i) = pack4(num[i][0] * inv, num[i][1] * inv, num[i][2] * inv, num[i][3] * inv);
      }
#pragma unroll
      for (int i = 0; i < 2; i++)
#pragma unroll
        for (int jn = 0; jn < 5; jn++) st[i][jn] *= decay;
#pragma unroll
      for (int ks = 0; ks < 4; ks++) {
        bf16x8 kTf[2];
#pragma unroll
        for (int i = 0; i < 2; i++) {
          const u16* ap = Kb + (32 * ks + 8 * lg + (lr >> 2)) * KS + 32 * w + 16 * i + 4 * (lr & 3);
          const s16x4 lo = __builtin_amdgcn_ds_read_tr16_b64_v4i16((s16x4 __attribute__((address_space(3)))*)ap);
          const s16x4 hi = __builtin_amdgcn_ds_read_tr16_b64_v4i16((s16x4 __attribute__((address_space(3)))*)(ap + 4 * KS));
          kTf[i] = __builtin_shufflevector(lo, hi, 0, 1, 2, 3, 4, 5, 6, 7);
        }
#pragma unroll
        for (int jn = 0; jn < 5; jn++) {
          const bf16x8 b = *(const bf16x8*)(Vw + (16 * jn + lr) * VS + 32 * ks + 8 * lg);
#pragma unroll
          for (int i = 0; i < 2; i++) st[i][jn] = mfma16(kTf[i], b, st[i][jn]);
        }
      }
      m = mnext;
    }
  }
}

DI void phase_C(const Params& p, const Ctx& c, int l, u16* lds) {
  const int tid = opaque_tid(), lane = tid & 63, wave = tid >> 6, wm = wave & 3, wn = wave >> 2, lr = lane & 15, lg = lane >> 4;
  const u16* W = c.W + ((long)l * WROWS + W_C) * D;
  u16* Ru = c.R1; u16* Ryp = c.R2; u16* Rog = c.R3;
  const int nTiles = (c.Tg / 128) * 24;
  for (int tile = blockIdx.x; tile < nTiles; tile += gridDim.x) {
    const int ch = tile / 24, pt = tile % 24;
    f32x4 acc[4][4];
    gemm_tile<4>(W + (long)pt * 256 * D, c.Rh + (long)ch * 128 * D, acc, lds);
    if (pt < 16) {
      const int chn = pt * 64 + wm * 16 + 4 * lg;
#pragma unroll
      for (int jn = 0; jn < 4; jn++) {
        const long lt = ch * 128 + 64 * wn + 16 * jn + lr;
        float u[4], y[4];
#pragma unroll
        for (int r = 0; r < 4; r++) { u[r] = acc[1][jn][r] * acc[2][jn][r]; y[r] = acc[0][jn][r] * siluf_(acc[3][jn][r]); }
        *(uint2*)(Ru + lt * D + chn) = pack4(u[0], u[1], u[2], u[3]);
        *(uint2*)(Ryp + lt * D + chn) = pack4(y[0], y[1], y[2], y[3]);
      }
    } else {
      const int chn = (pt - 16) * 128 + wm * 32 + 4 * lg;
#pragma unroll
      for (int jn = 0; jn < 4; jn++) {
        const long lt = ch * 128 + 64 * wn + 16 * jn + lr;
#pragma unroll
        for (int hh = 0; hh < 2; hh++) {
          float o[4];
#pragma unroll
          for (int r = 0; r < 4; r++) o[r] = sigmoidf_(acc[2 * hh][jn][r]) * siluf_(acc[2 * hh + 1][jn][r]);
          *(uint2*)(Rog + lt * D + chn + 16 * hh) = pack4(o[0], o[1], o[2], o[3]);
        }
      }
    }
  }
}

DI void phase_E(const Params& p, const Ctx& c, int l) {
  const int tid_ = opaque_tid(); const int lane = tid_ & 63, w = tid_ >> 6;
  const u16* Ru = c.R1; u16* Ryp = c.R2; u16* Rog = c.R3;
  const float* cw = p.conv_w + (long)l * 3 * D; const float* cb = p.conv_b + (long)l * D; const float* mg = p.mh_norm_g + (long)l * D;
  for (int lt = blockIdx.x * 8 + w; lt < c.Tg; lt += gridDim.x * 8) {
    const int sl = lt < c.half ? 8192 : 2048;
    const int pos = (lt < c.half ? lt : lt - c.half) & (sl - 1);
    const bool first = pos == 0, lastp = pos == sl - 1;
#pragma unroll
    for (int i = 0; i < 4; i++) {
      const int k = 4 * lane + 256 * i;
      uint2 z; z.x = 0u; z.y = 0u;
      const uint2 u0 = first ? z : *(const uint2*)(Ru + (long)(lt - 1) * D + k);
      const uint2 u1 = *(const uint2*)(Ru + (long)lt * D + k);
      const uint2 u2 = lastp ? z : *(const uint2*)(Ru + (long)(lt + 1) * D + k);
      const float4 a0 = unpack4(u0), a1 = unpack4(u1), a2 = unpack4(u2);
      const float4 yp = unpack4(*(const uint2*)(Ryp + (long)lt * D + k));
      const float4 w0 = *(const float4*)(cw + k), w1 = *(const float4*)(cw + D + k), w2 = *(const float4*)(cw + 2 * D + k), bb = *(const float4*)(cb + k);
      const float y0 = yp.x * (w0.x * a0.x + w1.x * a1.x + w2.x * a2.x + bb.x);
      const float y1 = yp.y * (w0.y * a0.y + w1.y * a1.y + w2.y * a2.y + bb.y);
      const float y2 = yp.z * (w0.z * a0.z + w1.z * a1.z + w2.z * a2.z + bb.z);
      const float y3 = yp.w * (w0.w * a0.w + w1.w * a1.w + w2.w * a2.w + bb.w);
      *(uint2*)(Ryp + (long)lt * D + k) = pack4(y0, y1, y2, y3);
      const float4 hf = unpack4(*(const uint2*)(c.Rhf + (long)lt * D + k));
      const float4 hb = unpack4(*(const uint2*)(c.Rhb + (long)lt * D + k));
      const float s0 = hf.x + hb.x, s1 = hf.y + hb.y, s2 = hf.z + hb.z, s3 = hf.w + hb.w;
      const float ss = wave_sum(s0 * s0 + s1 * s1 + s2 * s2 + s3 * s3);
      const float rstd = rsqrtf(ss * (1.f / 256.f) + 1e-6f);
      const float4 og = unpack4(*(const uint2*)(Rog + (long)lt * D + k));
      const float4 gg = *(const float4*)(mg + k);
      *(uint2*)(Rog + (long)lt * D + k) = pack4(og.x * s0 * rstd * gg.x, og.y * s1 * rstd * gg.y, og.z * s2 * rstd * gg.z, og.w * s3 * rstd * gg.w);
    }
  }
}

DI void phase_D1(const Params& p, const Ctx& c, int l, u16* lds) {
  const int tid = opaque_tid(), lane = tid & 63, wave = tid >> 6, wm = wave & 3, wn = wave >> 2, lr = lane & 15, lg = lane >> 4;
  const u16* W = c.W + (long)l * WROWS * D;
  const u16* Ryc = c.R2; const u16* Rym = c.R3; u16* Rmg = c.R4;
  const int nTiles = (c.Tg / 128) * 8;
  for (int tile = blockIdx.x; tile < nTiles; tile += gridDim.x) {
    const int ch = tile >> 3, mt = tile & 7;
    f32x4 a2[2][4], M[2][4];
    uint2 gk[4][4];
    {
      f32x4 a1[4][4];
      gemm_tile<4>(W + (long)(W_G + mt * 256) * D, c.Rh + (long)ch * 128 * D, a1, lds);
#pragma unroll
      for (int i = 0; i < 4; i++)
#pragma unroll
        for (int jn = 0; jn < 4; jn++)
          gk[i][jn] = pack4(sigmoidf_(a1[i][jn][0]), sigmoidf_(a1[i][jn][1]), sigmoidf_(a1[i][jn][2]), sigmoidf_(a1[i][jn][3]));
    }
    gemm_tile<2>(W + (long)(W_PC + mt * 128) * D, Ryc + (long)ch * 128 * D, a2, lds);
#pragma unroll
    for (int i = 0; i < 2; i++)
#pragma unroll
      for (int jn = 0; jn < 4; jn++) {
        const float4 gg = unpack4(gk[2 * i][jn]);
        M[i][jn] = (f32x4){gg.x * a2[i][jn][0], gg.y * a2[i][jn][1], gg.z * a2[i][jn][2], gg.w * a2[i][jn][3]};
      }
    gemm_tile<2>(W + (long)(W_PM + mt * 128) * D, Rym + (long)ch * 128 * D, a2, lds);
#pragma unroll
    for (int i = 0; i < 2; i++)
#pragma unroll
      for (int jn = 0; jn < 4; jn++) {
        const float4 gg = unpack4(gk[2 * i + 1][jn]);
        const int col = mt * 128 + 32 * wm + 16 * i + 4 * lg;
        const long lt = ch * 128 + 64 * wn + 16 * jn + lr;
        *(uint2*)(Rmg + lt * D + col) = pack4(M[i][jn][0] + gg.x * a2[i][jn][0], M[i][jn][1] + gg.y * a2[i][jn][1],
                                              M[i][jn][2] + gg.z * a2[i][jn][2], M[i][jn][3] + gg.w * a2[i][jn][3]);
      }
  }
}

DI void phase_D2(const Params& p, const Ctx& c, int l, int g, u16* lds) {
  const int tid = opaque_tid(), lane = tid & 63, wave = tid >> 6, wm = wave & 3, wn = wave >> 2, lr = lane & 15, lg = lane >> 4;
  const u16* W = c.W + ((long)l * WROWS + W_O) * D;
  const u16* Rmg = c.R4;
  const int nTiles = (c.Tg / 128) * 4;
  for (int tile = blockIdx.x; tile < nTiles; tile += gridDim.x) {
    const int ch = tile >> 2, pt = tile & 3;
    f32x4 acc[4][4];
    gemm_tile<4>(W + (long)pt * 256 * D, Rmg + (long)ch * 128 * D, acc, lds);
    const int tok0 = gtok(c, g, ch * 128);
    const float* gp = c.mod + ((long)l * 40 + batch_of(tok0)) * 3072 + 2048;
#pragma unroll
    for (int i = 0; i < 4; i++) {
      const int col = pt * 256 + 64 * wm + 16 * i + 4 * lg;
      const float4 gt = *(const float4*)(gp + col);
#pragma unroll
      for (int jn = 0; jn < 4; jn++) {
        const int tok = tok0 + 64 * wn + 16 * jn + lr;
        const float* xr = (l == 0) ? xin_row(p, tok) : p.out + (long)tok * D;
        const float4 xv = *(const float4*)(xr + col);
        float4 o;
        o.x = xv.x + gt.x * acc[i][jn][0]; o.y = xv.y + gt.y * acc[i][jn][1];
        o.z = xv.z + gt.z * acc[i][jn][2]; o.w = xv.w + gt.w * acc[i][jn][3];
        *(float4*)(p.out + (long)tok * D + col) = o;
      }
    }
  }
}

__global__ void __launch_bounds__(NT) mega(Params p) {
  extern __shared__ __attribute__((aligned(16))) char smem[];
  cg::grid_group grid = cg::this_grid();
  Ctx c;
  c.G = p.G; c.Tg = 131072 / p.G; c.half = c.Tg >> 1;
  const size_t REG = (size_t)c.Tg * D * 2;
  c.Rh = (u16*)(p.ws); c.R1 = (u16*)(p.ws + REG); c.R2 = (u16*)(p.ws + 2 * REG); c.R3 = (u16*)(p.ws + 3 * REG);
  c.R4 = (u16*)(p.ws + 4 * REG); c.Rhf = (u16*)(p.ws + 5 * REG); c.Rhb = (u16*)(p.ws + 6 * REG);
  unsigned char* q = p.ws + 7 * REG;
  c.W = (u16*)q; q += (size_t)DEPTH * WROWS * D * 2;
  c.mod = (float*)q; q += (size_t)DEPTH * 40 * 3072 * 4;
  c.sc = (float*)q; q += (size_t)c.Tg * 96;
  c.ctr = (int*)q;

  phase_prep(p, c, (float*)smem);
  grid.sync();
  for (int g = 0; g < c.G; ++g) {
    for (int l = 0; l < DEPTH; ++l) {
      phase_rows(p, c, l, g, false);
      grid.sync();
      phase_A(p, c, l, (u16*)smem);
      grid.sync();
      phase_scan(p, c, g * DEPTH + l, smem);
      grid.sync();
      phase_C(p, c, l, (u16*)smem);
      grid.sync();
      phase_E(p, c, l);
      grid.sync();
      phase_D1(p, c, l, (u16*)smem);
      grid.sync();
      phase_D2(p, c, l, g, (u16*)smem);
      grid.sync();
    }
    phase_rows(p, c, DEPTH, g, true);
  }
}

extern "C" void kernel_launch(void* const* d_in, const int* in_sizes, int n_in, void* d_out, int out_size,
                              void* d_ws, size_t ws_size, hipStream_t stream) {
  static int grid_blocks = 0;
  static int Gsel = 2;
  if (!grid_blocks) {
    int dev = 0, cus = 0, per_cu = 0;
    hipGetDevice(&dev);
    hipDeviceGetAttribute(&cus, hipDeviceAttributeMultiprocessorCount, dev);
    hipFuncSetAttribute((const void*)mega, hipFuncAttributeMaxDynamicSharedMemorySize, LDS_BYTES);
    hipOccupancyMaxActiveBlocksPerMultiprocessor(&per_cu, (const void*)mega, NT, LDS_BYTES);
    if (per_cu < 1) per_cu = 1;
    grid_blocks = cus * per_cu;
    const size_t fixed = (size_t)DEPTH * WROWS * D * 2 + (size_t)DEPTH * 40 * 3072 * 4 + 4096;
    Gsel = 2;
    while (Gsel < 8 && 7 * ((size_t)(131072 / Gsel) * D * 2) + fixed + (size_t)(131072 / Gsel) * 96 > ws_size) Gsel *= 2;
  }
  Params p{};
  p.x_prompt = (const float*)d_in[0]; p.x_sample = (const float*)d_in[1]; p.c_prompt = (const float*)d_in[2]; p.c_sample = (const float*)d_in[3];
  p.w_ada = (const float*)d_in[4]; p.b_ada = (const float*)d_in[5]; p.norm_g = (const float*)d_in[6]; p.w_in = (const float*)d_in[7];
  p.b_gates = (const float*)d_in[8]; p.conv_w = (const float*)d_in[9]; p.conv_b = (const float*)d_in[10]; p.mh_norm_g = (const float*)d_in[11];
  p.w_pc = (const float*)d_in[12]; p.w_pm = (const float*)d_in[13]; p.w_out = (const float*)d_in[14]; p.final_g = (const float*)d_in[15];
  p.out = (float*)d_out; p.ws = (unsigned char*)d_ws; p.G = Gsel; p.pad = 0;
  void* args[] = {&p};
  hipError_t e = hipLaunchCooperativeKernel((const void*)mega, dim3(grid_blocks), dim3(NT), args, LDS_BYTES, stream);
  if (e != hipSuccess) fprintf(stderr, "cooperative launch failed: %s (grid %d)\n", hipGetErrorString(e), grid_blocks);
}
```

```cpp
#include <hip/hip_runtime.h>
#include <hip/hip_cooperative_groups.h>
#include <cstdio>
namespace cg = cooperative_groups;

typedef unsigned short u16;
using bf16x8 = __attribute__((ext_vector_type(8))) short;
using f32x4  = __attribute__((ext_vector_type(4))) float;
using s16x4  = __attribute__((ext_vector_type(4))) short;
using u32x4  = __attribute__((ext_vector_type(4))) unsigned;
#define DI __device__ __forceinline__

constexpr int D = 1024, DIN = 11280, DEPTH = 4;
constexpr int NT = 512;
constexpr int W_QKV = 0, W_C = 3328, W_G = 9472, W_PC = 11520, W_PM = 12544, W_O = 13568, WROWS = 14592;
constexpr int LDT = 72;
constexpr int KS = 264, VS = 136;
constexpr int LDS_BYTES = (128 * KS + 2 * 80 * VS + 80 * KS) * 2 + 4 * 128 * 4;

struct Params {
  const float* x_prompt; const float* x_sample; const float* c_prompt; const float* c_sample;
  const float* w_ada; const float* b_ada; const float* norm_g; const float* w_in; const float* b_gates;
  const float* conv_w; const float* conv_b; const float* mh_norm_g; const float* w_pc; const float* w_pm;
  const float* w_out; const float* final_g;
  float* out; unsigned char* ws;
  int G; int pad;
};

struct Ctx {
  int G, Tg, half;
  u16 *Rh, *R1, *R2, *R3, *R4, *Rhf, *Rhb;
  u16* W; float* mod; float* sc; int* ctr;
};

DI u16 f2bf(float x) { unsigned u = __float_as_uint(x); u += 0x7fffu + ((u >> 16) & 1u); return (u16)(u >> 16); }
DI float bf2f(unsigned h) { return __uint_as_float(h << 16); }
DI unsigned pack2(float a, float b) { return (unsigned)f2bf(a) | ((unsigned)f2bf(b) << 16); }
DI uint2 pack4(float a, float b, float c, float d) { uint2 r; r.x = pack2(a, b); r.y = pack2(c, d); return r; }
DI uint2 pack4v(f32x4 v) { return pack4(v[0], v[1], v[2], v[3]); }
DI float4 unpack4(uint2 v) { float4 r; r.x = bf2f(v.x & 0xffffu); r.y = bf2f(v.x >> 16); r.z = bf2f(v.y & 0xffffu); r.w = bf2f(v.y >> 16); return r; }
DI float sigmoidf_(float x) { return 1.f / (1.f + __expf(-x)); }
DI float siluf_(float x) { return x * sigmoidf_(x); }
DI float wave_sum(float v) {
#pragma unroll
  for (int o = 32; o >= 1; o >>= 1) v += __shfl_xor(v, o);
  return v;
}
DI int opaque_tid() { int t = threadIdx.x; asm volatile("" : "+v"(t)); return t; }
DI f32x4 mfma16(bf16x8 a, bf16x8 b, f32x4 c) { return __builtin_amdgcn_mfma_f32_16x16x32_bf16(a, b, c, 0, 0, 0); }

DI int gtok(const Ctx& c, int g, int lt) { return lt < c.half ? g * c.half + lt : 65536 + g * c.half + (lt - c.half); }
DI int batch_of(int tok) { return tok < 65536 ? (tok >> 13) : 8 + ((tok - 65536) >> 11); }
DI const float* xin_row(const Params& p, int tok) {
  return tok < 65536 ? p.x_prompt + (long)tok * D : p.x_sample + (long)(tok - 65536) * D;
}

template <int MT, int NT, int ST>
DI void gemm_tile(const u16* __restrict__ P, const u16* __restrict__ Q, f32x4 (&acc)[MT][NT], u16* lds) {
  const int tid = opaque_tid(), lane = tid & 63, wave = __builtin_amdgcn_readfirstlane(tid >> 6), wm = wave & 3, wn = wave >> 2;
  const int lr = lane & 15, lg = lane >> 4;
  constexpr int PROWS = 64 * MT, QROWS = 32 * NT, NQI = NT / 2, NDMA = MT + NQI;
  char* pbase = (char*)lds;
  char* qbase = pbase + ST * PROWS * 128;
  const int drow = lane >> 3, dpos = lane & 7;
  const u16* gp[MT]; const u16* gq[NQI];
#pragma unroll
  for (int i = 0; i < MT; i++) { const int r = 8 * (wave + 8 * i) + drow; gp[i] = P + (long)r * D + ((dpos ^ ((r >> 1) & 7)) << 3); }
#pragma unroll
  for (int i = 0; i < NQI; i++) { const int r = 8 * (wave + 8 * i) + drow; gq[i] = Q + (long)r * D + ((dpos ^ ((r >> 1) & 7)) << 3); }
  char* dp = pbase + wave * 1024 + lane * 16;
  char* dq = qbase + wave * 1024 + lane * 16;
#pragma unroll
  for (int i = 0; i < MT; i++)
#pragma unroll
    for (int j = 0; j < NT; j++) acc[i][j] = (f32x4){0.f, 0.f, 0.f, 0.f};
#pragma unroll
  for (int t0 = 0; t0 < ST - 1; t0++) {
#pragma unroll
    for (int i = 0; i < MT; i++) __builtin_amdgcn_global_load_lds((const unsigned*)(gp[i] + t0 * 64), (unsigned*)(dp + t0 * PROWS * 128 + i * 8192), 16, 0, 0);
#pragma unroll
    for (int i = 0; i < NQI; i++) __builtin_amdgcn_global_load_lds((const unsigned*)(gq[i] + t0 * 64), (unsigned*)(dq + t0 * QROWS * 128 + i * 8192), 16, 0, 0);
  }
  asm volatile("s_waitcnt vmcnt(%0)" :: "n"((ST - 2) * NDMA) : "memory");
  __builtin_amdgcn_s_barrier();
  asm volatile("" ::: "memory");
  const int swz = (lr >> 1) & 7;
  const int o0 = (lg ^ swz) << 4, o1 = ((4 + lg) ^ swz) << 4;
  const char* pa = pbase + (wm * 16 * MT + lr) * 128;
  const char* qa = qbase + (wn * 16 * NT + lr) * 128;
  constexpr int NK = D / 64;
  int cur = 0, nxs = ST - 1;
  for (int kt = 0; kt < NK; ++kt) {
    if (kt + ST - 1 < NK) {
#pragma unroll
      for (int i = 0; i < MT; i++) __builtin_amdgcn_global_load_lds((const unsigned*)(gp[i] + (kt + ST - 1) * 64), (unsigned*)(dp + nxs * PROWS * 128 + i * 8192), 16, 0, 0);
#pragma unroll
      for (int i = 0; i < NQI; i++) __builtin_amdgcn_global_load_lds((const unsigned*)(gq[i] + (kt + ST - 1) * 64), (unsigned*)(dq + nxs * QROWS * 128 + i * 8192), 16, 0, 0);
    }
    const char* pb = pa + cur * PROWS * 128;
    const char* qb = qa + cur * QROWS * 128;
#pragma unroll
    for (int ks = 0; ks < 2; ++ks) {
      const int oo = ks ? o1 : o0;
      bf16x8 a[MT], b[NT];
#pragma unroll
      for (int i = 0; i < MT; i++) a[i] = *(const bf16x8*)(pb + i * 2048 + oo);
#pragma unroll
      for (int j = 0; j < NT; j++) b[j] = *(const bf16x8*)(qb + j * 2048 + oo);
#pragma unroll
      for (int i = 0; i < MT; i++)
#pragma unroll
        for (int j = 0; j < NT; j++) acc[i][j] = mfma16(a[i], b[j], acc[i][j]);
    }
    if (kt + ST - 1 < NK) asm volatile("s_waitcnt vmcnt(%0)" :: "n"((ST - 2) * NDMA) : "memory");
    else asm volatile("s_waitcnt vmcnt(0)" ::: "memory");
    __builtin_amdgcn_s_barrier();
    asm volatile("" ::: "memory");
    cur = (cur == ST - 1) ? 0 : cur + 1;
    nxs = (nxs == ST - 1) ? 0 : nxs + 1;
  }
}

DI void wsrc(const Params& p, int l, int n, const float*& src, int& ld, int& col, float& scale) {
  scale = 1.f;
  src = p.w_in + (long)l * D * DIN; ld = DIN;
  if (n < W_C) {
    if (n < 1024) col = 4096 + n;
    else if (n < 2048) { col = 5120 + (n - 1024); scale = 0.0625f; }
    else if (n < 3072) col = 6144 + (n - 2048);
    else if (n < 3088) col = 9216 + (n - 3072);
    else col = -1;
  } else if (n < W_G) {
    int n2 = n - W_C;
    if (n2 < 4096) { int blk = n2 >> 6, sl = (n2 >> 4) & 3, cl = n2 & 15; col = sl * 1024 + blk * 16 + cl; }
    else { int n3 = n2 - 4096; int blk = n3 >> 5, sl = (n3 >> 4) & 1, cl = n3 & 15; col = (sl ? 8192 : 7168) + blk * 16 + cl; }
  } else if (n < W_PC) {
    int n4 = n - W_G; int blk = n4 >> 5, sl = (n4 >> 4) & 1, cl = n4 & 15; col = 9232 + sl * 1024 + blk * 16 + cl;
  } else if (n < W_PM) { src = p.w_pc + (long)l * D * D; ld = D; col = n - W_PC; }
  else if (n < W_O)  { src = p.w_pm + (long)l * D * D; ld = D; col = n - W_PM; }
  else               { src = p.w_out + (long)l * D * D; ld = D; col = n - W_O; }
}

DI void phase_prep(const Params& p, const Ctx& c, float* ldsf) {
  const int tid = opaque_tid();
  if (blockIdx.x == 0 && tid < 64) c.ctr[tid] = 0;
  const int nItems = DEPTH * (WROWS / 64) * 16;
  for (int it = blockIdx.x; it < nItems; it += gridDim.x) {
    const int kb = (it & 15) * 64; const int rb = it >> 4;
    const int l = rb / (WROWS / 64); const int nb = (rb % (WROWS / 64)) * 64;
    const float* src; int ld, col; float scale;
    const int nl = tid & 63;
    wsrc(p, l, nb + nl, src, ld, col, scale);
#pragma unroll
    for (int i = 0; i < 8; i++) {
      const int kl = (tid >> 6) + 8 * i;
      float v = (col >= 0) ? src[(long)(kb + kl) * ld + col] * scale : 0.f;
      ldsf[kl * 65 + nl] = v;
    }
    __syncthreads();
    {
      const int nl2 = tid >> 3, kc = tid & 7;
      float v[8];
#pragma unroll
      for (int j = 0; j < 8; j++) v[j] = ldsf[(kc * 8 + j) * 65 + nl2];
      uint4 o; o.x = pack2(v[0], v[1]); o.y = pack2(v[2], v[3]); o.z = pack2(v[4], v[5]); o.w = pack2(v[6], v[7]);
      *(uint4*)(c.W + ((long)l * WROWS + nb + nl2) * D + kb + kc * 8) = o;
    }
    __syncthreads();
  }
  const int nMod = DEPTH * 48;
  for (int it = blockIdx.x; it < nMod; it += gridDim.x) {
    const int l = it / 48, jb = (it % 48) * 64;
    const int cl = tid & 63, kc = tid >> 6;
    float acc[40];
#pragma unroll
    for (int b = 0; b < 40; b++) acc[b] = 0.f;
    const float* wa = p.w_ada + (long)l * D * 3072 + jb + cl;
    for (int k = kc * 128; k < kc * 128 + 128; ++k) {
      const float wv = wa[(long)k * 3072];
#pragma unroll
      for (int b = 0; b < 40; b++) {
        const float cv = (b < 8) ? p.c_prompt[b * D + k] : p.c_sample[(b - 8) * D + k];
        acc[b] += cv * wv;
      }
    }
#pragma unroll
    for (int b = 0; b < 40; b++) ldsf[(kc * 40 + b) * 64 + cl] = acc[b];
    __syncthreads();
    for (int idx = tid; idx < 40 * 64; idx += NT) {
      const int b = idx >> 6, cc = idx & 63;
      float s = p.b_ada[l * 3072 + jb + cc];
#pragma unroll
      for (int q = 0; q < 8; q++) s += ldsf[(q * 40 + b) * 64 + cc];
      c.mod[((long)l * 40 + b) * 3072 + jb + cc] = s;
    }
    __syncthreads();
  }
}

DI void phase_rows(const Params& p, const Ctx& c, int l, int g, bool fin) {
  const int tid_ = opaque_tid(); const int lane = tid_ & 63, w = tid_ >> 6;
  for (int lt = blockIdx.x * 8 + w; lt < c.Tg; lt += gridDim.x * 8) {
    const int tok = gtok(c, g, lt);
    const float* xr = (l == 0) ? xin_row(p, tok) : p.out + (long)tok * D;
    float4 v[4]; float ss = 0.f;
#pragma unroll
    for (int i = 0; i < 4; i++) {
      v[i] = *(const float4*)(xr + 4 * lane + 256 * i);
      ss += v[i].x * v[i].x + v[i].y * v[i].y + v[i].z * v[i].z + v[i].w * v[i].w;
    }
    ss = wave_sum(ss);
    const float rstd = rsqrtf(ss * (1.f / 1024.f) + 1e-6f);
    if (fin) {
#pragma unroll
      for (int i = 0; i < 4; i++) {
        const int k = 4 * lane + 256 * i;
        const float4 fg = *(const float4*)(p.final_g + k);
        float4 o; o.x = v[i].x * rstd * fg.x; o.y = v[i].y * rstd * fg.y; o.z = v[i].z * rstd * fg.z; o.w = v[i].w * rstd * fg.w;
        *(float4*)(p.out + (long)tok * D + k) = o;
      }
    } else {
      const float* mp = c.mod + ((long)l * 40 + batch_of(tok)) * 3072;
#pragma unroll
      for (int i = 0; i < 4; i++) {
        const int k = 4 * lane + 256 * i;
        const float4 ng = *(const float4*)(p.norm_g + l * D + k);
        const float4 scl = *(const float4*)(mp + 1024 + k);
        const float4 sh = *(const float4*)(mp + k);
        const float h0 = v[i].x * rstd * ng.x * (1.f + scl.x) + sh.x;
        const float h1 = v[i].y * rstd * ng.y * (1.f + scl.y) + sh.y;
        const float h2 = v[i].z * rstd * ng.z * (1.f + scl.z) + sh.z;
        const float h3 = v[i].w * rstd * ng.w * (1.f + scl.w) + sh.w;
        *(uint2*)(c.Rh + (long)lt * D + k) = pack4(h0, h1, h2, h3);
      }
    }
  }
}

DI void phase_A(const Params& p, const Ctx& c, int l, u16* lds) {
  const int tid = opaque_tid(), lane = tid & 63, wave = tid >> 6, wm = wave & 3, wn = wave >> 2, lr = lane & 15, lg = lane >> 4;
  const u16* W = c.W + (long)l * WROWS * D;
  u16* Rq = c.R1; u16* Rk = c.R2; u16* RvT = c.R4;
  const int nTiles = (c.Tg / 256) * 13;
  for (int tile = blockIdx.x; tile < nTiles; tile += gridDim.x) {
    const int tb = tile / 13, j = tile % 13;
    f32x4 acc[4][8];
    if (j < 8) {
      const int isk = j >> 2, head = j & 3;
      gemm_tile<4, 8, 2>(W + (long)(isk * 1024 + head * 256) * D, c.Rh + (long)tb * 256 * D, acc, lds);
      u16* dst = isk ? Rk : Rq;
#pragma unroll
      for (int i = 0; i < 4; i++)
#pragma unroll
        for (int jn = 0; jn < 8; jn++) {
          const int d = 64 * wm + 16 * i + 4 * lg, t = 128 * wn + 16 * jn + lr;
          *(uint2*)(dst + (long)(tb * 256 + t) * D + head * 256 + d) = pack4v(acc[i][jn]);
        }
    } else if (j < 12) {
      const int head = j - 8;
      gemm_tile<4, 8, 2>(c.Rh + (long)tb * 256 * D, W + (long)(2048 + head * 256) * D, acc, lds);
#pragma unroll
      for (int i = 0; i < 4; i++)
#pragma unroll
        for (int jn = 0; jn < 8; jn++) {
          const int tokl = 64 * wm + 16 * i + 4 * lg, e = 128 * wn + 16 * jn + lr;
          const int ch = tb * 2 + (tokl >> 7), sidx = tokl & 127;
          *(uint2*)(RvT + ((long)(ch * 4 + head) * 256 + e) * 128 + sidx) = pack4v(acc[i][jn]);
        }
    } else {
      gemm_tile<4, 8, 2>(W + (long)3072 * D, c.Rh + (long)tb * 256 * D, acc, lds);
      float* gl = (float*)lds;
      if (wm == 0) {
#pragma unroll
        for (int jn = 0; jn < 8; jn++) {
          const int t = 128 * wn + 16 * jn + lr;
#pragma unroll
          for (int r = 0; r < 4; r++) {
            float v = acc[0][jn][r] + p.b_gates[l * 16 + lg * 4 + r];
            if (lg & 1) v = fminf(v, 0.f) - log1pf(expf(-fabsf(v)));
            gl[t * 16 + lg * 4 + r] = v;
          }
        }
      }
      __syncthreads();
      if (tid < 16) {
        const int head = tid & 3, dir = (tid >> 2) & 1, cl = tid >> 3;
        const int ch = tb * 2 + cl;
        float* o = c.sc + (((long)(ch * 4 + head) * 2 + dir) * 3) * 128;
        const float* glc = gl + cl * 128 * 16;
        float bs = 0.f, pm = -3.0e38f;
        for (int q = 0; q < 128; ++q) {
          const int t = dir ? 127 - q : q;
          const float iv = glc[t * 16 + dir * 8 + head], lf = glc[t * 16 + dir * 8 + 4 + head];
          bs += lf; const float gg = iv - bs; pm = fmaxf(pm, gg);
          o[t] = bs; o[128 + t] = gg; o[256 + t] = pm;
        }
      }
      __syncthreads();
    }
  }
}

DI void phase_scan(const Params& p, const Ctx& c, int ctrIdx, char* smem) {
  __shared__ int s_task;
  const int tid = opaque_tid(), lane = tid & 63, w = __builtin_amdgcn_readfirstlane(tid >> 6), lr = lane & 15, lg = lane >> 4;
  u16* Kb = (u16*)smem;
  u16* Vt = Kb + 128 * KS;
  u16* Vw = Vt + 80 * VS;
  u16* Ct = Vw + 80 * VS;
  float* scg = (float*)(Ct + 80 * KS); float* scmu = scg + 128; float* sciw = scmu + 128; float* scfl = sciw + 128;
  const u16* Rq = c.R1; const u16* Rk = c.R2; const u16* RvT = c.R4;
  const int nLong = (8 / c.G) * 32, nTasks = nLong + (32 / c.G) * 32;
  int* ctr = c.ctr + ctrIdx;
  while (true) {
    __syncthreads();
    if (tid == 0) s_task = atomicAdd(ctr, 1);
    __syncthreads();
    const int task = s_task;
    if (task >= nTasks) break;
    int seq, r, chunk0, nc;
    if (task < nLong) { seq = task >> 5; r = task & 31; chunk0 = seq * 64; nc = 64; }
    else { const int t2 = task - nLong; seq = t2 >> 5; r = t2 & 31; chunk0 = (c.half >> 7) + seq * 16; nc = 16; }
    const int head = r >> 3, dir = (r >> 2) & 1, es = r & 3;
    const int last = dir ? 0 : 127;
    u16* Rho = dir ? c.Rhb : c.Rhf;
    for (int idx = tid; idx < 80 * KS / 2; idx += NT) ((unsigned*)Ct)[idx] = 0u;
    for (int idx = tid; idx < 16 * VS / 2; idx += NT) { ((unsigned*)(Vt + 64 * VS))[idx] = 0u; ((unsigned*)(Vw + 64 * VS))[idx] = 0u; }
    __syncthreads();
    if (tid < 128) Vt[64 * VS + tid] = (u16)0x3F80;
    f32x4 st[2][5];
#pragma unroll
    for (int i = 0; i < 2; i++)
#pragma unroll
      for (int jn = 0; jn < 5; jn++) st[i][jn] = (f32x4){0.f, 0.f, 0.f, 0.f};
    float m = 0.f;
    const int vrow = tid >> 4, vsc = tid & 15;
    const int krow = tid >> 5, kkc = (tid & 31) * 8;
    for (int j = 0; j < nc; ++j) {
      const int cc = chunk0 + (dir ? nc - 1 - j : j);
      u32x4 kpre[8], vpre[2]; float4 g8a, g8b; float bLn, gmaxn, myb, myg, mypm;
      bf16x8 qf[8];
#pragma unroll
      for (int ks = 0; ks < 8; ks++)
        qf[ks] = *(const bf16x8*)(Rq + (long)(cc * 128 + 16 * w + lr) * D + head * 256 + 32 * ks + 8 * lg);
      {
#pragma unroll
        for (int i = 0; i < 8; i++) kpre[i] = *(const u32x4*)(Rk + (long)(cc * 128 + krow + 16 * i) * D + head * 256 + kkc);
#pragma unroll
        for (int i = 0; i < 2; i++) vpre[i] = *(const u32x4*)(RvT + ((long)(cc * 4 + head) * 256 + es * 64 + vrow + 32 * i) * 128 + vsc * 8);
        const float* scb = c.sc + ((long)(cc * 4 + head) * 2 + dir) * 384;
        g8a = *(const float4*)(scb + 128 + vsc * 8); g8b = *(const float4*)(scb + 128 + vsc * 8 + 4);
        bLn = scb[last]; gmaxn = scb[256 + last];
        myb = scb[tid & 127]; myg = scb[128 + (tid & 127)]; mypm = scb[256 + (tid & 127)];
      }
      __syncthreads();
      const float muL = fmaxf(m, gmaxn);
      const float decay = __expf(m - muL);
      const float mnext = bLn + muL;
#pragma unroll
      for (int i = 0; i < 2; i++)
#pragma unroll
        for (int jn = 0; jn < 5; jn++)
          *(uint2*)(Ct + (16 * jn + lr) * KS + 32 * w + 16 * i + 4 * lg) = pack4v(st[i][jn]);
#pragma unroll
      for (int i = 0; i < 8; i++) *(u32x4*)(Kb + (krow + 16 * i) * KS + kkc) = kpre[i];
      {
        float w8[8];
        w8[0] = __expf(g8a.x - muL); w8[1] = __expf(g8a.y - muL); w8[2] = __expf(g8a.z - muL); w8[3] = __expf(g8a.w - muL);
        w8[4] = __expf(g8b.x - muL); w8[5] = __expf(g8b.y - muL); w8[6] = __expf(g8b.z - muL); w8[7] = __expf(g8b.w - muL);
#pragma unroll
        for (int i = 0; i < 2; i++) {
          const u32x4 vv = vpre[i];
          *(u32x4*)(Vt + (vrow + 32 * i) * VS + vsc * 8) = vv;
          uint4 v; v.x = vv[0]; v.y = vv[1]; v.z = vv[2]; v.w = vv[3];
          uint4 o;
          o.x = pack2(bf2f(v.x & 0xffffu) * w8[0], bf2f(v.x >> 16) * w8[1]);
          o.y = pack2(bf2f(v.y & 0xffffu) * w8[2], bf2f(v.y >> 16) * w8[3]);
          o.z = pack2(bf2f(v.z & 0xffffu) * w8[4], bf2f(v.z >> 16) * w8[5]);
          o.w = pack2(bf2f(v.w & 0xffffu) * w8[6], bf2f(v.w >> 16) * w8[7]);
          *(uint4*)(Vw + (vrow + 32 * i) * VS + vsc * 8) = o;
        }
        if (tid < 16) {
          uint4 o; o.x = pack2(w8[0], w8[1]); o.y = pack2(w8[2], w8[3]); o.z = pack2(w8[4], w8[5]); o.w = pack2(w8[6], w8[7]);
          *(uint4*)(Vw + 64 * VS + vsc * 8) = o;
        }
      }
      if (tid < 128) {
        const float mu = fmaxf(m, mypm);
        scg[tid] = myg; scmu[tid] = mu; sciw[tid] = __expf(m - mu); scfl[tid] = __expf(-(mu + myb));
      }
      __syncthreads();
      const int t = 16 * w + lr;
      bf16x8 spk[4];
      {
        f32x4 sacc[8];
#pragma unroll
        for (int i = 0; i < 8; i++) sacc[i] = (f32x4){0.f, 0.f, 0.f, 0.f};
#pragma unroll
        for (int i = 0; i < 8; i++) {
          const bool need = dir ? (i >= w) : (i <= w);
          if (need) {
#pragma unroll
            for (int ks = 0; ks < 8; ks++) {
              const bf16x8 a = *(const bf16x8*)(Kb + (16 * i + lr) * KS + 32 * ks + 8 * lg);
              sacc[i] = mfma16(a, qf[ks], sacc[i]);
            }
          }
        }
        const float mu_t = scmu[t];
        int tt = t; asm volatile("" : "+v"(tt));
        const int sgn = dir ? -1 : 1;
#pragma unroll
        for (int ks = 0; ks < 4; ks++) {
          float sv[8];
#pragma unroll
          for (int hh = 0; hh < 2; hh++) {
            const int i = 2 * ks + hh;
            const float4 gs = *(const float4*)(scg + 16 * i + 4 * lg);
            const float gv[4] = {gs.x, gs.y, gs.z, gs.w};
#pragma unroll
            for (int r2 = 0; r2 < 4; r2++) {
              const int s = 16 * i + 4 * lg + r2;
              const bool valid = (s - tt) * sgn <= 0;
              sv[hh * 4 + r2] = valid ? sacc[i][r2] * __expf(gv[r2] - mu_t) : 0.f;
            }
          }
          uint4 o; o.x = pack2(sv[0], sv[1]); o.y = pack2(sv[2], sv[3]); o.z = pack2(sv[4], sv[5]); o.w = pack2(sv[6], sv[7]);
          spk[ks] = __builtin_bit_cast(bf16x8, o);
        }
      }
      f32x4 num[5];
#pragma unroll
      for (int i = 0; i < 5; i++) num[i] = (f32x4){0.f, 0.f, 0.f, 0.f};
#pragma unroll
      for (int ks = 0; ks < 8; ks++)
#pragma unroll
        for (int i = 0; i < 5; i++) {
          const bf16x8 a = *(const bf16x8*)(Ct + (16 * i + lr) * KS + 32 * ks + 8 * lg);
          num[i] = mfma16(a, qf[ks], num[i]);
        }
      {
        const float iw = sciw[t];
#pragma unroll
        for (int i = 0; i < 5; i++) num[i] *= iw;
      }
#pragma unroll
      for (int ks = 0; ks < 4; ks++) {
        const bool need = dir ? (2 * ks + 1 >= w) : (2 * ks <= w);
        if (need) {
#pragma unroll
          for (int i = 0; i < 5; i++) {
            const uint2 lo = *(const uint2*)(Vt + (16 * i + lr) * VS + 32 * ks + 4 * lg);
            const uint2 hi = *(const uint2*)(Vt + (16 * i + lr) * VS + 32 * ks + 16 + 4 * lg);
            uint4 av; av.x = lo.x; av.y = lo.y; av.z = hi.x; av.w = hi.y;
            num[i] = mfma16(__builtin_bit_cast(bf16x8, av), spk[ks], num[i]);
          }
        }
      }
      {
        const float fl = scfl[t];
        const float dr = __shfl(num[4][0], lr);
        const float inv = 1.f / fmaxf(fabsf(dr), fl);
        u16* dst = Rho + (long)(cc * 128 + t) * D + head * 256 + es * 64 + 4 * lg;
#pragma unroll
        for (int i = 0; i < 4; i++)
          *(uint2*)(dst + 16 * i) = pack4(num[i][0] * inv, num[i][1] * inv, num[i][2] * inv, num[i][3] * inv);
      }
#pragma unroll
      for (int i = 0; i < 2; i++)
#pragma unroll
        for (int jn = 0; jn < 5; jn++) st[i][jn] *= decay;
#pragma unroll
      for (int ks = 0; ks < 4; ks++) {
        bf16x8 kTf[2];
#pragma unroll
        for (int i = 0; i < 2; i++) {
          const u16* ap = Kb + (32 * ks + 8 * lg + (lr >> 2)) * KS + 32 * w + 16 * i + 4 * (lr & 3);
          const s16x4 lo = __builtin_amdgcn_ds_read_tr16_b64_v4i16((s16x4 __attribute__((address_space(3)))*)ap);
          const s16x4 hi = __builtin_amdgcn_ds_read_tr16_b64_v4i16((s16x4 __attribute__((address_space(3)))*)(ap + 4 * KS));
          kTf[i] = __builtin_shufflevector(lo, hi, 0, 1, 2, 3, 4, 5, 6, 7);
        }
#pragma unroll
        for (int jn = 0; jn < 5; jn++) {
          const bf16x8 b = *(const bf16x8*)(Vw + (16 * jn + lr) * VS + 32 * ks + 8 * lg);
#pragma unroll
          for (int i = 0; i < 2; i++) st[i][jn] = mfma16(kTf[i], b, st[i][jn]);
        }
      }
      m = mnext;
    }
  }
}

DI void phase_C(const Params& p, const Ctx& c, int l, u16* lds) {
  const int tid = opaque_tid(), lane = tid & 63, wave = tid >> 6, wm = wave & 3, wn = wave >> 2, lr = lane & 15, lg = lane >> 4;
  const u16* W = c.W + ((long)l * WROWS + W_C) * D;
  u16* Ru = c.R1; u16* Ryp = c.R2; u16* Rog = c.R3;
  const int nTiles = (c.Tg / 256) * 24;
  for (int tile = blockIdx.x; tile < nTiles; tile += gridDim.x) {
    const int tb = tile / 24, pt = tile % 24;
    f32x4 acc[4][8];
    gemm_tile<4, 8, 2>(W + (long)pt * 256 * D, c.Rh + (long)tb * 256 * D, acc, lds);
    if (pt < 16) {
      const int chn = pt * 64 + wm * 16 + 4 * lg;
#pragma unroll
      for (int jn = 0; jn < 8; jn++) {
        const long lt = tb * 256 + 128 * wn + 16 * jn + lr;
        float u[4], y[4];
#pragma unroll
        for (int r = 0; r < 4; r++) { u[r] = acc[1][jn][r] * acc[2][jn][r]; y[r] = acc[0][jn][r] * siluf_(acc[3][jn][r]); }
        *(uint2*)(Ru + lt * D + chn) = pack4(u[0], u[1], u[2], u[3]);
        *(uint2*)(Ryp + lt * D + chn) = pack4(y[0], y[1], y[2], y[3]);
      }
    } else {
      const int chn = (pt - 16) * 128 + wm * 32 + 4 * lg;
#pragma unroll
      for (int jn = 0; jn < 8; jn++) {
        const long lt = tb * 256 + 128 * wn + 16 * jn + lr;
#pragma unroll
        for (int hh = 0; hh < 2; hh++) {
          float o[4];
#pragma unroll
          for (int r = 0; r < 4; r++) o[r] = sigmoidf_(acc[2 * hh][jn][r]) * siluf_(acc[2 * hh + 1][jn][r]);
          *(uint2*)(Rog + lt * D + chn + 16 * hh) = pack4(o[0], o[1], o[2], o[3]);
        }
      }
    }
  }
}

DI void phase_E(const Params& p, const Ctx& c, int l) {
  const int tid_ = opaque_tid(); const int lane = tid_ & 63, w = tid_ >> 6;
  const u16* Ru = c.R1; u16* Ryp = c.R2; u16* Rog = c.R3;
  const float* cw = p.conv_w + (long)l * 3 * D; const float* cb = p.conv_b + (long)l * D; const float* mg = p.mh_norm_g + (long)l * D;
  for (int lt = blockIdx.x * 8 + w; lt < c.Tg; lt += gridDim.x * 8) {
    const int sl = lt < c.half ? 8192 : 2048;
    const int pos = (lt < c.half ? lt : lt - c.half) & (sl - 1);
    const bool first = pos == 0, lastp = pos == sl - 1;
#pragma unroll
    for (int i = 0; i < 4; i++) {
      const int k = 4 * lane + 256 * i;
      uint2 z; z.x = 0u; z.y = 0u;
      const uint2 u0 = first ? z : *(const uint2*)(Ru + (long)(lt - 1) * D + k);
      const uint2 u1 = *(const uint2*)(Ru + (long)lt * D + k);
      const uint2 u2 = lastp ? z : *(const uint2*)(Ru + (long)(lt + 1) * D + k);
      const float4 a0 = unpack4(u0), a1 = unpack4(u1), a2 = unpack4(u2);
      const float4 yp = unpack4(*(const uint2*)(Ryp + (long)lt * D + k));
      const float4 w0 = *(const float4*)(cw + k), w1 = *(const float4*)(cw + D + k), w2 = *(const float4*)(cw + 2 * D + k), bb = *(const float4*)(cb + k);
      const float y0 = yp.x * (w0.x * a0.x + w1.x * a1.x + w2.x * a2.x + bb.x);
      const float y1 = yp.y * (w0.y * a0.y + w1.y * a1.y + w2.y * a2.y + bb.y);
      const float y2 = yp.z * (w0.z * a0.z + w1.z * a1.z + w2.z * a2.z + bb.z);
      const float y3 = yp.w * (w0.w * a0.w + w1.w * a1.w + w2.w * a2.w + bb.w);
      *(uint2*)(Ryp + (long)lt * D + k) = pack4(y0, y1, y2, y3);
      const float4 hf = unpack4(*(const uint2*)(c.Rhf + (long)lt * D + k));
      const float4 hb = unpack4(*(const uint2*)(c.Rhb + (long)lt * D + k));
      const float s0 = hf.x + hb.x, s1 = hf.y + hb.y, s2 = hf.z + hb.z, s3 = hf.w + hb.w;
      const float ss = wave_sum(s0 * s0 + s1 * s1 + s2 * s2 + s3 * s3);
      const float rstd = rsqrtf(ss * (1.f / 256.f) + 1e-6f);
      const float4 og = unpack4(*(const uint2*)(Rog + (long)lt * D + k));
      const float4 gg = *(const float4*)(mg + k);
      *(uint2*)(Rog + (long)lt * D + k) = pack4(og.x * s0 * rstd * gg.x, og.y * s1 * rstd * gg.y, og.z * s2 * rstd * gg.z, og.w * s3 * rstd * gg.w);
    }
  }
}

DI void phase_D1(const Params& p, const Ctx& c, int l, u16* lds) {
  const int tid = opaque_tid(), lane = tid & 63, wave = tid >> 6, wm = wave & 3, wn = wave >> 2, lr = lane & 15, lg = lane >> 4;
  const u16* W = c.W + (long)l * WROWS * D;
  const u16* Ryc = c.R2; const u16* Rym = c.R3; u16* Rmg = c.R4;
  const int nTiles = (c.Tg / 128) * 8;
  for (int tile = blockIdx.x; tile < nTiles; tile += gridDim.x) {
    const int ch = tile >> 3, mt = tile & 7;
    f32x4 a2[2][4], M[2][4];
    uint2 gk[4][4];
    {
      f32x4 a1[4][4];
      gemm_tile<4, 4, 3>(W + (long)(W_G + mt * 256) * D, c.Rh + (long)ch * 128 * D, a1, lds);
#pragma unroll
      for (int i = 0; i < 4; i++)
#pragma unroll
        for (int jn = 0; jn < 4; jn++)
          gk[i][jn] = pack4(sigmoidf_(a1[i][jn][0]), sigmoidf_(a1[i][jn][1]), sigmoidf_(a1[i][jn][2]), sigmoidf_(a1[i][jn][3]));
    }
    gemm_tile<2, 4, 3>(W + (long)(W_PC + mt * 128) * D, Ryc + (long)ch * 128 * D, a2, lds);
#pragma unroll
    for (int i = 0; i < 2; i++)
#pragma unroll
      for (int jn = 0; jn < 4; jn++) {
        const float4 gg = unpack4(gk[2 * i][jn]);
        M[i][jn] = (f32x4){gg.x * a2[i][jn][0], gg.y * a2[i][jn][1], gg.z * a2[i][jn][2], gg.w * a2[i][jn][3]};
      }
    gemm_tile<2, 4, 3>(W + (long)(W_PM + mt * 128) * D, Rym + (long)ch * 128 * D, a2, lds);
#pragma unroll
    for (int i = 0; i < 2; i++)
#pragma unroll
      for (int jn = 0; jn < 4; jn++) {
        const float4 gg = unpack4(gk[2 * i + 1][jn]);
        const int col = mt * 128 + 32 * wm + 16 * i + 4 * lg;
        const long lt = ch * 128 + 64 * wn + 16 * jn + lr;
        *(uint2*)(Rmg + lt * D + col) = pack4(M[i][jn][0] + gg.x * a2[i][jn][0], M[i][jn][1] + gg.y * a2[i][jn][1],
                                              M[i][jn][2] + gg.z * a2[i][jn][2], M[i][jn][3] + gg.w * a2[i][jn][3]);
      }
  }
}

DI void phase_D2(const Params& p, const Ctx& c, int l, int g, u16* lds) {
  const int tid = opaque_tid(), lane = tid & 63, wave = tid >> 6, wm = wave & 3, wn = wave >> 2, lr = lane & 15, lg = lane >> 4;
  const u16* W = c.W + ((long)l * WROWS + W_O) * D;
  const u16* Rmg = c.R4;
  const int nTiles = (c.Tg / 256) * 4;
  for (int tile = blockIdx.x; tile < nTiles; tile += gridDim.x) {
    const int tb = tile >> 2, pt = tile & 3;
    f32x4 acc[4][8];
    gemm_tile<4, 8, 2>(W + (long)pt * 256 * D, Rmg + (long)tb * 256 * D, acc, lds);
    const int tok0 = gtok(c, g, tb * 256);
    const float* gp = c.mod + ((long)l * 40 + batch_of(tok0)) * 3072 + 2048;
#pragma unroll
    for (int i = 0; i < 4; i++) {
      const int col = pt * 256 + 64 * wm + 16 * i + 4 * lg;
      const float4 gt = *(const float4*)(gp + col);
#pragma unroll
      for (int jn = 0; jn < 8; jn++) {
        const int tok = tok0 + 128 * wn + 16 * jn + lr;
        const float* xr = (l == 0) ? xin_row(p, tok) : p.out + (long)tok * D;
        const float4 xv = *(const float4*)(xr + col);
        float4 o;
        o.x = xv.x + gt.x * acc[i][jn][0]; o.y = xv.y + gt.y * acc[i][jn][1];
        o.z = xv.z + gt.z * acc[i][jn][2]; o.w = xv.w + gt.w * acc[i][jn][3];
        *(float4*)(p.out + (long)tok * D + col) = o;
      }
    }
  }
}

__global__ void __launch_bounds__(NT) mega(Params p) {
  extern __shared__ __attribute__((aligned(16))) char smem[];
  cg::grid_group grid = cg::this_grid();
  Ctx c;
  c.G = p.G; c.Tg = 131072 / p.G; c.half = c.Tg >> 1;
  const size_t REG = (size_t)c.Tg * D * 2;
  c.Rh = (u16*)(p.ws); c.R1 = (u16*)(p.ws + REG); c.R2 = (u16*)(p.ws + 2 * REG); c.R3 = (u16*)(p.ws + 3 * REG);
  c.R4 = (u16*)(p.ws + 4 * REG); c.Rhf = (u16*)(p.ws + 5 * REG); c.Rhb = (u16*)(p.ws + 6 * REG);
  unsigned char* q = p.ws + 7 * REG;
  c.W = (u16*)q; q += (size_t)DEPTH * WROWS * D * 2;
  c.mod = (float*)q; q += (size_t)DEPTH * 40 * 3072 * 4;
  c.sc = (float*)q; q += (size_t)c.Tg * 96;
  c.ctr = (int*)q;

  phase_prep(p, c, (float*)smem);
  grid.sync();
  for (int g = 0; g < c.G; ++g) {
    for (int l = 0; l < DEPTH; ++l) {
      phase_rows(p, c, l, g, false);
      grid.sync();
      phase_A(p, c, l, (u16*)smem);
      grid.sync();
      phase_scan(p, c, g * DEPTH + l, smem);
      grid.sync();
      phase_C(p, c, l, (u16*)smem);
      grid.sync();
      phase_E(p, c, l);
      grid.sync();
      phase_D1(p, c, l, (u16*)smem);
      grid.sync();
      phase_D2(p, c, l, g, (u16*)smem);
      grid.sync();
    }
    phase_rows(p, c, DEPTH, g, true);
  }
}

extern "C" void kernel_launch(void* const* d_in, const int* in_sizes, int n_in, void* d_out, int out_size,
                              void* d_ws, size_t ws_size, hipStream_t stream) {
  static int grid_blocks = 0;
  static int Gsel = 2;
  if (!grid_blocks) {
    int dev = 0, cus = 0, per_cu = 0;
    hipGetDevice(&dev);
    hipDeviceGetAttribute(&cus, hipDeviceAttributeMultiprocessorCount, dev);
    hipFuncSetAttribute((const void*)mega, hipFuncAttributeMaxDynamicSharedMemorySize, LDS_BYTES);
    hipOccupancyMaxActiveBlocksPerMultiprocessor(&per_cu, (const void*)mega, NT, LDS_BYTES);
    if (per_cu < 1) per_cu = 1;
    grid_blocks = cus * per_cu;
    const size_t fixed = (size_t)DEPTH * WROWS * D * 2 + (size_t)DEPTH * 40 * 3072 * 4 + 4096;
    Gsel = 2;
    while (Gsel < 8 && 7 * ((size_t)(131072 / Gsel) * D * 2) + fixed + (size_t)(131072 / Gsel) * 96 > ws_size) Gsel *= 2;
  }
  Params p{};
  p.x_prompt = (const float*)d_in[0]; p.x_sample = (const float*)d_in[1]; p.c_prompt = (const float*)d_in[2]; p.c_sample = (const float*)d_in[3];
  p.w_ada = (const float*)d_in[4]; p.b_ada = (const float*)d_in[5]; p.norm_g = (const float*)d_in[6]; p.w_in = (const float*)d_in[7];
  p.b_gates = (const float*)d_in[8]; p.conv_w = (const float*)d_in[9]; p.conv_b = (const float*)d_in[10]; p.mh_norm_g = (const float*)d_in[11];
  p.w_pc = (const float*)d_in[12]; p.w_pm = (const float*)d_in[13]; p.w_out = (const float*)d_in[14]; p.final_g = (const float*)d_in[15];
  p.out = (float*)d_out; p.ws = (unsigned char*)d_ws; p.G = Gsel; p.pad = 0;
  void* args[] = {&p};
  hipError_t e = hipLaunchCooperativeKernel((const void*)mega, dim3(grid_blocks), dim3(NT), args, LDS_BYTES, stream);
  if (e != hipSuccess) fprintf(stderr, "cooperative launch failed: %s (grid %d)\n", hipGetErrorString(e), grid_blocks);
}
```

```cpp
#include <hip/hip_runtime.h>
#include <hip/hip_cooperative_groups.h>
#include <cstdio>
namespace cg = cooperative_groups;

typedef unsigned short u16;
using bf16x8 = __attribute__((ext_vector_type(8))) short;
using f32x4  = __attribute__((ext_vector_type(4))) float;
using s16x4  = __attribute__((ext_vector_type(4))) short;
using u32x4  = __attribute__((ext_vector_type(4))) unsigned;
#define DI __device__ __forceinline__

constexpr int D = 1024, DIN = 11280, DEPTH = 4;
constexpr int NT = 512;
constexpr int W_QKV = 0, W_C = 3328, W_G = 9472, W_PC = 11520, W_PM = 12544, W_O = 13568, WROWS = 14592;
constexpr int LDT = 72;
constexpr int KS = 264, VS = 136;
constexpr int LDS_BYTES = (128 * KS + 2 * 80 * VS + 80 * KS) * 2 + 4 * 128 * 4;

struct Params {
  const float* x_prompt; const float* x_sample; const float* c_prompt; const float* c_sample;
  const float* w_ada; const float* b_ada; const float* norm_g; const float* w_in; const float* b_gates;
  const float* conv_w; const float* conv_b; const float* mh_norm_g; const float* w_pc; const float* w_pm;
  const float* w_out; const float* final_g;
  float* out; unsigned char* ws;
  int G; int pad;
};

struct Ctx {
  int G, Tg, half;
  u16 *Rh, *R1, *R2, *R3, *R4, *Rhf, *Rhb;
  u16* W; float* mod; float* sc; int* ctr;
};

DI u16 f2bf(float x) { unsigned u = __float_as_uint(x); u += 0x7fffu + ((u >> 16) & 1u); return (u16)(u >> 16); }
DI float bf2f(unsigned h) { return __uint_as_float(h << 16); }
DI unsigned pack2(float a, float b) { return (unsigned)f2bf(a) | ((unsigned)f2bf(b) << 16); }
DI uint2 pack4(float a, float b, float c, float d) { uint2 r; r.x = pack2(a, b); r.y = pack2(c, d); return r; }
DI uint2 pack4v(f32x4 v) { return pack4(v[0], v[1], v[2], v[3]); }
DI float4 unpack4(uint2 v) { float4 r; r.x = bf2f(v.x & 0xffffu); r.y = bf2f(v.x >> 16); r.z = bf2f(v.y & 0xffffu); r.w = bf2f(v.y >> 16); return r; }
DI float sigmoidf_(float x) { return 1.f / (1.f + __expf(-x)); }
DI float siluf_(float x) { return x * sigmoidf_(x); }
DI float wave_sum(float v) {
#pragma unroll
  for (int o = 32; o >= 1; o >>= 1) v += __shfl_xor(v, o);
  return v;
}
DI int opaque_tid() { int t = threadIdx.x; asm volatile("" : "+v"(t)); return t; }
DI f32x4 mfma16(bf16x8 a, bf16x8 b, f32x4 c) { return __builtin_amdgcn_mfma_f32_16x16x32_bf16(a, b, c, 0, 0, 0); }

DI int gtok(const Ctx& c, int g, int lt) { return lt < c.half ? g * c.half + lt : 65536 + g * c.half + (lt - c.half); }
DI int batch_of(int tok) { return tok < 65536 ? (tok >> 13) : 8 + ((tok - 65536) >> 11); }
DI const float* xin_row(const Params& p, int tok) {
  return tok < 65536 ? p.x_prompt + (long)tok * D : p.x_sample + (long)(tok - 65536) * D;
}

template <int MT, int NT, int ST>
DI void gemm_tile(const u16* __restrict__ P, const u16* __restrict__ Q, f32x4 (&acc)[MT][NT], u16* lds) {
  const int tid = opaque_tid(), lane = tid & 63, wave = __builtin_amdgcn_readfirstlane(tid >> 6), wm = wave & 3, wn = wave >> 2;
  const int lr = lane & 15, lg = lane >> 4;
  constexpr int PROWS = 64 * MT, QROWS = 32 * NT, NQI = NT / 2, NDMA = MT + NQI;
  char* pbase = (char*)lds;
  char* qbase = pbase + ST * PROWS * 128;
  const int drow = lane >> 3, dpos = lane & 7;
  const u16* gp[MT]; const u16* gq[NQI];
#pragma unroll
  for (int i = 0; i < MT; i++) { const int r = 8 * (wave + 8 * i) + drow; gp[i] = P + (long)r * D + ((dpos ^ ((r >> 1) & 7)) << 3); }
#pragma unroll
  for (int i = 0; i < NQI; i++) { const int r = 8 * (wave + 8 * i) + drow; gq[i] = Q + (long)r * D + ((dpos ^ ((r >> 1) & 7)) << 3); }
  char* dp = pbase + wave * 1024 + lane * 16;
  char* dq = qbase + wave * 1024 + lane * 16;
#pragma unroll
  for (int i = 0; i < MT; i++)
#pragma unroll
    for (int j = 0; j < NT; j++) acc[i][j] = (f32x4){0.f, 0.f, 0.f, 0.f};
#pragma unroll
  for (int t0 = 0; t0 < ST - 1; t0++) {
#pragma unroll
    for (int i = 0; i < MT; i++) __builtin_amdgcn_global_load_lds((const unsigned*)(gp[i] + t0 * 64), (unsigned*)(dp + t0 * PROWS * 128 + i * 8192), 16, 0, 0);
#pragma unroll
    for (int i = 0; i < NQI; i++) __builtin_amdgcn_global_load_lds((const unsigned*)(gq[i] + t0 * 64), (unsigned*)(dq + t0 * QROWS * 128 + i * 8192), 16, 0, 0);
  }
  asm volatile("s_waitcnt vmcnt(%0)" :: "n"((ST - 2) * NDMA) : "memory");
  __builtin_amdgcn_s_barrier();
  asm volatile("" ::: "memory");
  const int swz = (lr >> 1) & 7;
  const int o0 = (lg ^ swz) << 4, o1 = ((4 + lg) ^ swz) << 4;
  const char* pa = pbase + (wm * 16 * MT + lr) * 128;
  const char* qa = qbase + (wn * 16 * NT + lr) * 128;
  constexpr int NK = D / 64;
  int cur = 0, nxs = ST - 1;
  for (int kt = 0; kt < NK; ++kt) {
    if (kt + ST - 1 < NK) {
#pragma unroll
      for (int i = 0; i < MT; i++) __builtin_amdgcn_global_load_lds((const unsigned*)(gp[i] + (kt + ST - 1) * 64), (unsigned*)(dp + nxs * PROWS * 128 + i * 8192), 16, 0, 0);
#pragma unroll
      for (int i = 0; i < NQI; i++) __builtin_amdgcn_global_load_lds((const unsigned*)(gq[i] + (kt + ST - 1) * 64), (unsigned*)(dq + nxs * QROWS * 128 + i * 8192), 16, 0, 0);
    }
    const char* pb = pa + cur * PROWS * 128;
    const char* qb = qa + cur * QROWS * 128;
#pragma unroll
    for (int ks = 0; ks < 2; ++ks) {
      const int oo = ks ? o1 : o0;
      bf16x8 a[MT], b[NT];
#pragma unroll
      for (int i = 0; i < MT; i++) a[i] = *(const bf16x8*)(pb + i * 2048 + oo);
#pragma unroll
      for (int j = 0; j < NT; j++) b[j] = *(const bf16x8*)(qb + j * 2048 + oo);
#pragma unroll
      for (int i = 0; i < MT; i++)
#pragma unroll
        for (int j = 0; j < NT; j++) acc[i][j] = mfma16(a[i], b[j], acc[i][j]);
    }
    if (kt + ST - 1 < NK) asm volatile("s_waitcnt vmcnt(%0)" :: "n"((ST - 2) * NDMA) : "memory");
    else asm volatile("s_waitcnt vmcnt(0)" ::: "memory");
    __builtin_amdgcn_s_barrier();
    asm volatile("" ::: "memory");
    cur = (cur == ST - 1) ? 0 : cur + 1;
    nxs = (nxs == ST - 1) ? 0 : nxs + 1;
  }
}

DI void wsrc(const Params& p, int l, int n, const float*& src, int& ld, int& col, float& scale) {
  scale = 1.f;
  src = p.w_in + (long)l * D * DIN; ld = DIN;
  if (n < W_C) {
    if (n < 1024) col = 4096 + n;
    else if (n < 2048) { col = 5120 + (n - 1024); scale = 0.0625f; }
    else if (n < 3072) col = 6144 + (n - 2048);
    else if (n < 3088) col = 9216 + (n - 3072);
    else col = -1;
  } else if (n < W_G) {
    int n2 = n - W_C;
    if (n2 < 4096) { int blk = n2 >> 6, sl = (n2 >> 4) & 3, cl = n2 & 15; col = sl * 1024 + blk * 16 + cl; }
    else { int n3 = n2 - 4096; int blk = n3 >> 5, sl = (n3 >> 4) & 1, cl = n3 & 15; col = (sl ? 8192 : 7168) + blk * 16 + cl; }
  } else if (n < W_PC) {
    int n4 = n - W_G; int blk = n4 >> 5, sl = (n4 >> 4) & 1, cl = n4 & 15; col = 9232 + sl * 1024 + blk * 16 + cl;
  } else if (n < W_PM) { src = p.w_pc + (long)l * D * D; ld = D; col = n - W_PC; }
  else if (n < W_O)  { src = p.w_pm + (long)l * D * D; ld = D; col = n - W_PM; }
  else               { src = p.w_out + (long)l * D * D; ld = D; col = n - W_O; }
}

DI void phase_prep(const Params& p, const Ctx& c, float* ldsf) {
  const int tid = opaque_tid();
  if (blockIdx.x == 0 && tid < 64) c.ctr[tid] = 0;
  const int nItems = DEPTH * (WROWS / 64) * 16;
  for (int it = blockIdx.x; it < nItems; it += gridDim.x) {
    const int kb = (it & 15) * 64; const int rb = it >> 4;
    const int l = rb / (WROWS / 64); const int nb = (rb % (WROWS / 64)) * 64;
    const float* src; int ld, col; float scale;
    const int nl = tid & 63;
    wsrc(p, l, nb + nl, src, ld, col, scale);
#pragma unroll
    for (int i = 0; i < 8; i++) {
      const int kl = (tid >> 6) + 8 * i;
      float v = (col >= 0) ? src[(long)(kb + kl) * ld + col] * scale : 0.f;
      ldsf[kl * 65 + nl] = v;
    }
    __syncthreads();
    {
      const int nl2 = tid >> 3, kc = tid & 7;
      float v[8];
#pragma unroll
      for (int j = 0; j < 8; j++) v[j] = ldsf[(kc * 8 + j) * 65 + nl2];
      uint4 o; o.x = pack2(v[0], v[1]); o.y = pack2(v[2], v[3]); o.z = pack2(v[4], v[5]); o.w = pack2(v[6], v[7]);
      *(uint4*)(c.W + ((long)l * WROWS + nb + nl2) * D + kb + kc * 8) = o;
    }
    __syncthreads();
  }
  const int nMod = DEPTH * 48;
  for (int it = blockIdx.x; it < nMod; it += gridDim.x) {
    const int l = it / 48, jb = (it % 48) * 64;
    const int cl = tid & 63, kc = tid >> 6;
    float acc[40];
#pragma unroll
    for (int b = 0; b < 40; b++) acc[b] = 0.f;
    const float* wa = p.w_ada + (long)l * D * 3072 + jb + cl;
    for (int k = kc * 128; k < kc * 128 + 128; ++k) {
      const float wv = wa[(long)k * 3072];
#pragma unroll
      for (int b = 0; b < 40; b++) {
        const float cv = (b < 8) ? p.c_prompt[b * D + k] : p.c_sample[(b - 8) * D + k];
        acc[b] += cv * wv;
      }
    }
#pragma unroll
    for (int b = 0; b < 40; b++) ldsf[(kc * 40 + b) * 64 + cl] = acc[b];
    __syncthreads();
    for (int idx = tid; idx < 40 * 64; idx += NT) {
      const int b = idx >> 6, cc = idx & 63;
      float s = p.b_ada[l * 3072 + jb + cc];
#pragma unroll
      for (int q = 0; q < 8; q++) s += ldsf[(q * 40 + b) * 64 + cc];
      c.mod[((long)l * 40 + b) * 3072 + jb + cc] = s;
    }
    __syncthreads();
  }
}

DI void phase_rows(const Params& p, const Ctx& c, int l, int g, bool fin) {
  const int tid_ = opaque_tid(); const int lane = tid_ & 63, w = tid_ >> 6;
  for (int lt = blockIdx.x * 8 + w; lt < c.Tg; lt += gridDim.x * 8) {
    const int tok = gtok(c, g, lt);
    const float* xr = (l == 0) ? xin_row(p, tok) : p.out + (long)tok * D;
    float4 v[4]; float ss = 0.f;
#pragma unroll
    for (int i = 0; i < 4; i++) {
      v[i] = *(const float4*)(xr + 4 * lane + 256 * i);
      ss += v[i].x * v[i].x + v[i].y * v[i].y + v[i].z * v[i].z + v[i].w * v[i].w;
    }
    ss = wave_sum(ss);
    const float rstd = rsqrtf(ss * (1.f / 1024.f) + 1e-6f);
    if (fin) {
#pragma unroll
      for (int i = 0; i < 4; i++) {
        const int k = 4 * lane + 256 * i;
        const float4 fg = *(const float4*)(p.final_g + k);
        float4 o; o.x = v[i].x * rstd * fg.x; o.y = v[i].y * rstd * fg.y; o.z = v[i].z * rstd * fg.z; o.w = v[i].w * rstd * fg.w;
        *(float4*)(p.out + (long)tok * D + k) = o;
      }
    } else {
      const float* mp = c.mod + ((long)l * 40 + batch_of(tok)) * 3072;
      float4 ngv[4], sclv[4], shv[4];
#pragma unroll
      for (int i = 0; i < 4; i++) {
        const int k = 4 * lane + 256 * i;
        ngv[i] = *(const float4*)(p.norm_g + l * D + k); sclv[i] = *(const float4*)(mp + 1024 + k); shv[i] = *(const float4*)(mp + k);
      }
#pragma unroll
      for (int i = 0; i < 4; i++) {
        const int k = 4 * lane + 256 * i;
        const float4 ng = ngv[i], scl = sclv[i], sh = shv[i];
        const float h0 = v[i].x * rstd * ng.x * (1.f + scl.x) + sh.x;
        const float h1 = v[i].y * rstd * ng.y * (1.f + scl.y) + sh.y;
        const float h2 = v[i].z * rstd * ng.z * (1.f + scl.z) + sh.z;
        const float h3 = v[i].w * rstd * ng.w * (1.f + scl.w) + sh.w;
        *(uint2*)(c.Rh + (long)lt * D + k) = pack4(h0, h1, h2, h3);
      }
    }
  }
}

DI void phase_A(const Params& p, const Ctx& c, int l, u16* lds) {
  const int tid = opaque_tid(), lane = tid & 63, wave = tid >> 6, wm = wave & 3, wn = wave >> 2, lr = lane & 15, lg = lane >> 4;
  const u16* W = c.W + (long)l * WROWS * D;
  u16* Rq = c.R1; u16* Rk = c.R2; u16* RvT = c.R4;
  const int nTiles = (c.Tg / 256) * 13;
  for (int tile = blockIdx.x; tile < nTiles; tile += gridDim.x) {
    const int tb = tile / 13, j = tile % 13;
    f32x4 acc[4][8];
    if (j < 8) {
      const int isk = j >> 2, head = j & 3;
      gemm_tile<4, 8, 2>(W + (long)(isk * 1024 + head * 256) * D, c.Rh + (long)tb * 256 * D, acc, lds);
      u16* dst = isk ? Rk : Rq;
#pragma unroll
      for (int i = 0; i < 4; i++)
#pragma unroll
        for (int jn = 0; jn < 8; jn++) {
          const int d = 64 * wm + 16 * i + 4 * lg, t = 128 * wn + 16 * jn + lr;
          *(uint2*)(dst + (long)(tb * 256 + t) * D + head * 256 + d) = pack4v(acc[i][jn]);
        }
    } else if (j < 12) {
      const int head = j - 8;
      gemm_tile<4, 8, 2>(c.Rh + (long)tb * 256 * D, W + (long)(2048 + head * 256) * D, acc, lds);
#pragma unroll
      for (int i = 0; i < 4; i++)
#pragma unroll
        for (int jn = 0; jn < 8; jn++) {
          const int tokl = 64 * wm + 16 * i + 4 * lg, e = 128 * wn + 16 * jn + lr;
          const int ch = tb * 2 + (tokl >> 7), sidx = tokl & 127;
          *(uint2*)(RvT + ((long)(ch * 4 + head) * 256 + e) * 128 + sidx) = pack4v(acc[i][jn]);
        }
    } else {
      gemm_tile<4, 8, 2>(W + (long)3072 * D, c.Rh + (long)tb * 256 * D, acc, lds);
      float* gl = (float*)lds;
      if (wm == 0) {
#pragma unroll
        for (int jn = 0; jn < 8; jn++) {
          const int t = 128 * wn + 16 * jn + lr;
#pragma unroll
          for (int r = 0; r < 4; r++) {
            float v = acc[0][jn][r] + p.b_gates[l * 16 + lg * 4 + r];
            if (lg & 1) v = fminf(v, 0.f) - log1pf(expf(-fabsf(v)));
            gl[t * 16 + lg * 4 + r] = v;
          }
        }
      }
      __syncthreads();
      if (tid < 16) {
        const int head = tid & 3, dir = (tid >> 2) & 1, cl = tid >> 3;
        const int ch = tb * 2 + cl;
        float* o = c.sc + (((long)(ch * 4 + head) * 2 + dir) * 3) * 128;
        const float* glc = gl + cl * 128 * 16;
        float bs = 0.f, pm = -3.0e38f;
        for (int q = 0; q < 128; ++q) {
          const int t = dir ? 127 - q : q;
          const float iv = glc[t * 16 + dir * 8 + head], lf = glc[t * 16 + dir * 8 + 4 + head];
          bs += lf; const float gg = iv - bs; pm = fmaxf(pm, gg);
          o[t] = bs; o[128 + t] = gg; o[256 + t] = pm;
        }
      }
      __syncthreads();
    }
  }
}

DI void phase_scan(const Params& p, const Ctx& c, int ctrIdx, char* smem) {
  __shared__ int s_task;
  const int tid = opaque_tid(), lane = tid & 63, w = __builtin_amdgcn_readfirstlane(tid >> 6), lr = lane & 15, lg = lane >> 4;
  u16* Kb = (u16*)smem;
  u16* Vt = Kb + 128 * KS;
  u16* Vw = Vt + 80 * VS;
  u16* Ct = Vw + 80 * VS;
  float* scg = (float*)(Ct + 80 * KS); float* scmu = scg + 128; float* sciw = scmu + 128; float* scfl = sciw + 128;
  const u16* Rq = c.R1; const u16* Rk = c.R2; const u16* RvT = c.R4;
  const int nLong = (8 / c.G) * 32, nTasks = nLong + (32 / c.G) * 32;
  int* ctr = c.ctr + ctrIdx;
  while (true) {
    __syncthreads();
    if (tid == 0) s_task = atomicAdd(ctr, 1);
    __syncthreads();
    const int task = s_task;
    if (task >= nTasks) break;
    int seq, r, chunk0, nc;
    if (task < nLong) { seq = task >> 5; r = task & 31; chunk0 = seq * 64; nc = 64; }
    else { const int t2 = task - nLong; seq = t2 >> 5; r = t2 & 31; chunk0 = (c.half >> 7) + seq * 16; nc = 16; }
    const int head = r >> 3, dir = (r >> 2) & 1, es = r & 3;
    const int last = dir ? 0 : 127;
    u16* Rho = dir ? c.Rhb : c.Rhf;
    for (int idx = tid; idx < 80 * KS / 2; idx += NT) ((unsigned*)Ct)[idx] = 0u;
    for (int idx = tid; idx < 16 * VS / 2; idx += NT) { ((unsigned*)(Vt + 64 * VS))[idx] = 0u; ((unsigned*)(Vw + 64 * VS))[idx] = 0u; }
    __syncthreads();
    if (tid < 128) Vt[64 * VS + tid] = (u16)0x3F80;
    f32x4 st[2][5];
#pragma unroll
    for (int i = 0; i < 2; i++)
#pragma unroll
      for (int jn = 0; jn < 5; jn++) st[i][jn] = (f32x4){0.f, 0.f, 0.f, 0.f};
    float m = 0.f;
    const int vrow = tid >> 4, vsc = tid & 15;
    const int krow = tid >> 5, kkc = (tid & 31) * 8;
    for (int j = 0; j < nc; ++j) {
      const int cc = chunk0 + (dir ? nc - 1 - j : j);
      u32x4 kpre[8], vpre[2]; float4 g8a, g8b; float bLn, gmaxn, myb, myg, mypm;
      bf16x8 qf[8];
#pragma unroll
      for (int ks = 0; ks < 8; ks++)
        qf[ks] = *(const bf16x8*)(Rq + (long)(cc * 128 + 16 * w + lr) * D + head * 256 + 32 * ks + 8 * lg);
      {
#pragma unroll
        for (int i = 0; i < 8; i++) kpre[i] = *(const u32x4*)(Rk + (long)(cc * 128 + krow + 16 * i) * D + head * 256 + kkc);
#pragma unroll
        for (int i = 0; i < 2; i++) vpre[i] = *(const u32x4*)(RvT + ((long)(cc * 4 + head) * 256 + es * 64 + vrow + 32 * i) * 128 + vsc * 8);
        const float* scb = c.sc + ((long)(cc * 4 + head) * 2 + dir) * 384;
        g8a = *(const float4*)(scb + 128 + vsc * 8); g8b = *(const float4*)(scb + 128 + vsc * 8 + 4);
        bLn = scb[last]; gmaxn = scb[256 + last];
        myb = scb[tid & 127]; myg = scb[128 + (tid & 127)]; mypm = scb[256 + (tid & 127)];
      }
      __syncthreads();
      const float muL = fmaxf(m, gmaxn);
      const float decay = __expf(m - muL);
      const float mnext = bLn + muL;
#pragma unroll
      for (int i = 0; i < 2; i++)
#pragma unroll
        for (int jn = 0; jn < 5; jn++)
          *(uint2*)(Ct + (16 * jn + lr) * KS + 32 * w + 16 * i + 4 * lg) = pack4v(st[i][jn]);
#pragma unroll
      for (int i = 0; i < 8; i++) *(u32x4*)(Kb + (krow + 16 * i) * KS + kkc) = kpre[i];
      {
        float w8[8];
        w8[0] = __expf(g8a.x - muL); w8[1] = __expf(g8a.y - muL); w8[2] = __expf(g8a.z - muL); w8[3] = __expf(g8a.w - muL);
        w8[4] = __expf(g8b.x - muL); w8[5] = __expf(g8b.y - muL); w8[6] = __expf(g8b.z - muL); w8[7] = __expf(g8b.w - muL);
#pragma unroll
        for (int i = 0; i < 2; i++) {
          const u32x4 vv = vpre[i];
          *(u32x4*)(Vt + (vrow + 32 * i) * VS + vsc * 8) = vv;
          uint4 v; v.x = vv[0]; v.y = vv[1]; v.z = vv[2]; v.w = vv[3];
          uint4 o;
          o.x = pack2(bf2f(v.x & 0xffffu) * w8[0], bf2f(v.x >> 16) * w8[1]);
          o.y = pack2(bf2f(v.y & 0xffffu) * w8[2], bf2f(v.y >> 16) * w8[3]);
          o.z = pack2(bf2f(v.z & 0xffffu) * w8[4], bf2f(v.z >> 16) * w8[5]);
          o.w = pack2(bf2f(v.w & 0xffffu) * w8[6], bf2f(v.w >> 16) * w8[7]);
          *(uint4*)(Vw + (vrow + 32 * i) * VS + vsc * 8) = o;
        }
        if (tid < 16) {
          uint4 o; o.x = pack2(w8[0], w8[1]); o.y = pack2(w8[2], w8[3]); o.z = pack2(w8[4], w8[5]); o.w = pack2(w8[6], w8[7]);
          *(uint4*)(Vw + 64 * VS + vsc * 8) = o;
        }
      }
      if (tid < 128) {
        const float mu = fmaxf(m, mypm);
        scg[tid] = myg; scmu[tid] = mu; sciw[tid] = __expf(m - mu); scfl[tid] = __expf(-(mu + myb));
      }
      __syncthreads();
      const int t = 16 * w + lr;
      bf16x8 spk[4];
      {
        f32x4 sacc[8];
#pragma unroll
        for (int i = 0; i < 8; i++) sacc[i] = (f32x4){0.f, 0.f, 0.f, 0.f};
#pragma unroll
        for (int i = 0; i < 8; i++) {
          const bool need = dir ? (i >= w) : (i <= w);
          if (need) {
#pragma unroll
            for (int ks = 0; ks < 8; ks++) {
              const bf16x8 a = *(const bf16x8*)(Kb + (16 * i + lr) * KS + 32 * ks + 8 * lg);
              sacc[i] = mfma16(a, qf[ks], sacc[i]);
            }
          }
        }
        const float mu_t = scmu[t];
        int tt = t; asm volatile("" : "+v"(tt));
        const int sgn = dir ? -1 : 1;
#pragma unroll
        for (int ks = 0; ks < 4; ks++) {
          float sv[8];
#pragma unroll
          for (int hh = 0; hh < 2; hh++) {
            const int i = 2 * ks + hh;
            const float4 gs = *(const float4*)(scg + 16 * i + 4 * lg);
            const float gv[4] = {gs.x, gs.y, gs.z, gs.w};
#pragma unroll
            for (int r2 = 0; r2 < 4; r2++) {
              const int s = 16 * i + 4 * lg + r2;
              const bool valid = (s - tt) * sgn <= 0;
              sv[hh * 4 + r2] = valid ? sacc[i][r2] * __expf(gv[r2] - mu_t) : 0.f;
            }
          }
          uint4 o; o.x = pack2(sv[0], sv[1]); o.y = pack2(sv[2], sv[3]); o.z = pack2(sv[4], sv[5]); o.w = pack2(sv[6], sv[7]);
          spk[ks] = __builtin_bit_cast(bf16x8, o);
        }
      }
      f32x4 num[5];
#pragma unroll
      for (int i = 0; i < 5; i++) num[i] = (f32x4){0.f, 0.f, 0.f, 0.f};
#pragma unroll
      for (int ks = 0; ks < 8; ks++)
#pragma unroll
        for (int i = 0; i < 5; i++) {
          const bf16x8 a = *(const bf16x8*)(Ct + (16 * i + lr) * KS + 32 * ks + 8 * lg);
          num[i] = mfma16(a, qf[ks], num[i]);
        }
      {
        const float iw = sciw[t];
#pragma unroll
        for (int i = 0; i < 5; i++) num[i] *= iw;
      }
#pragma unroll
      for (int ks = 0; ks < 4; ks++) {
        const bool need = dir ? (2 * ks + 1 >= w) : (2 * ks <= w);
        if (need) {
#pragma unroll
          for (int i = 0; i < 5; i++) {
            const uint2 lo = *(const uint2*)(Vt + (16 * i + lr) * VS + 32 * ks + 4 * lg);
            const uint2 hi = *(const uint2*)(Vt + (16 * i + lr) * VS + 32 * ks + 16 + 4 * lg);
            uint4 av; av.x = lo.x; av.y = lo.y; av.z = hi.x; av.w = hi.y;
            num[i] = mfma16(__builtin_bit_cast(bf16x8, av), spk[ks], num[i]);
          }
        }
      }
      {
        const float fl = scfl[t];
        const float dr = __shfl(num[4][0], lr);
        const float inv = 1.f / fmaxf(fabsf(dr), fl);
        u16* dst = Rho + (long)(cc * 128 + t) * D + head * 256 + es * 64 + 4 * lg;
#pragma unroll
        for (int i = 0; i < 4; i++)
          *(uint2*)(dst + 16 * i) = pack4(num[i][0] * inv, num[i][1] * inv, num[i][2] * inv, num[i][3] * inv);
      }
#pragma unroll
      for (int i = 0; i < 2; i++)
#pragma unroll
        for (int jn = 0; jn < 5; jn++) st[i][jn] *= decay;
#pragma unroll
      for (int ks = 0; ks < 4; ks++) {
        bf16x8 kTf[2];
#pragma unroll
        for (int i = 0; i < 2; i++) {
          const u16* ap = Kb + (32 * ks + 8 * lg + (lr >> 2)) * KS + 32 * w + 16 * i + 4 * (lr & 3);
          const s16x4 lo = __builtin_amdgcn_ds_read_tr16_b64_v4i16((s16x4 __attribute__((address_space(3)))*)ap);
          const s16x4 hi = __builtin_amdgcn_ds_read_tr16_b64_v4i16((s16x4 __attribute__((address_space(3)))*)(ap + 4 * KS));
          kTf[i] = __builtin_shufflevector(lo, hi, 0, 1, 2, 3, 4, 5, 6, 7);
        }
#pragma unroll
        for (int jn = 0; jn < 5; jn++) {
          const bf16x8 b = *(const bf16x8*)(Vw + (16 * jn + lr) * VS + 32 * ks + 8 * lg);
#pragma unroll
          for (int i = 0; i < 2; i++) st[i][jn] = mfma16(kTf[i], b, st[i][jn]);
        }
      }
      m = mnext;
    }
  }
}

DI void phase_C(const Params& p, const Ctx& c, int l, u16* lds) {
  const int tid = opaque_tid(), lane = tid & 63, wave = tid >> 6, wm = wave & 3, wn = wave >> 2, lr = lane & 15, lg = lane >> 4;
  const u16* W = c.W + ((long)l * WROWS + W_C) * D;
  u16* Ru = c.R1; u16* Ryp = c.R2; u16* Rog = c.R3;
  const int nTiles = (c.Tg / 256) * 24;
  for (int tile = blockIdx.x; tile < nTiles; tile += gridDim.x) {
    const int tb = tile / 24, pt = tile % 24;
    f32x4 acc[4][8];
    gemm_tile<4, 8, 2>(W + (long)pt * 256 * D, c.Rh + (long)tb * 256 * D, acc, lds);
    if (pt < 16) {
      const int chn = pt * 64 + wm * 16 + 4 * lg;
#pragma unroll
      for (int jn = 0; jn < 8; jn++) {
        const long lt = tb * 256 + 128 * wn + 16 * jn + lr;
        float u[4], y[4];
#pragma unroll
        for (int r = 0; r < 4; r++) { u[r] = acc[1][jn][r] * acc[2][jn][r]; y[r] = acc[0][jn][r] * siluf_(acc[3][jn][r]); }
        *(uint2*)(Ru + lt * D + chn) = pack4(u[0], u[1], u[2], u[3]);
        *(uint2*)(Ryp + lt * D + chn) = pack4(y[0], y[1], y[2], y[3]);
      }
    } else {
      const int chn = (pt - 16) * 128 + wm * 32 + 4 * lg;
#pragma unroll
      for (int jn = 0; jn < 8; jn++) {
        const long lt = tb * 256 + 128 * wn + 16 * jn + lr;
#pragma unroll
        for (int hh = 0; hh < 2; hh++) {
          float o[4];
#pragma unroll
          for (int r = 0; r < 4; r++) o[r] = sigmoidf_(acc[2 * hh][jn][r]) * siluf_(acc[2 * hh + 1][jn][r]);
          *(uint2*)(Rog + lt * D + chn + 16 * hh) = pack4(o[0], o[1], o[2], o[3]);
        }
      }
    }
  }
}

DI void phase_E(const Params& p, const Ctx& c, int l) {
  const int tid_ = opaque_tid(); const int lane = tid_ & 63, w = tid_ >> 6;
  const u16* Ru = c.R1; u16* Ryp = c.R2; u16* Rog = c.R3;
  const float* cw = p.conv_w + (long)l * 3 * D; const float* cb = p.conv_b + (long)l * D; const float* mg = p.mh_norm_g + (long)l * D;
  float4 w0[4], w1[4], w2[4], bb[4], gg[4];
#pragma unroll
  for (int i = 0; i < 4; i++) {
    const int k = 4 * lane + 256 * i;
    w0[i] = *(const float4*)(cw + k); w1[i] = *(const float4*)(cw + D + k); w2[i] = *(const float4*)(cw + 2 * D + k);
    bb[i] = *(const float4*)(cb + k); gg[i] = *(const float4*)(mg + k);
  }
  for (int lt = blockIdx.x * 8 + w; lt < c.Tg; lt += gridDim.x * 8) {
    const int sl = lt < c.half ? 8192 : 2048;
    const int pos = (lt < c.half ? lt : lt - c.half) & (sl - 1);
    const bool first = pos == 0, lastp = pos == sl - 1;
    uint2 U0[4], U1[4], U2[4], YP[4], OG[4], HF[4], HB[4];
#pragma unroll
    for (int i = 0; i < 4; i++) {
      const int k = 4 * lane + 256 * i;
      U0[i] = *(const uint2*)(Ru + (long)(first ? lt : lt - 1) * D + k);
      U1[i] = *(const uint2*)(Ru + (long)lt * D + k);
      U2[i] = *(const uint2*)(Ru + (long)(lastp ? lt : lt + 1) * D + k);
      if (first) { U0[i].x = 0u; U0[i].y = 0u; }
      if (lastp) { U2[i].x = 0u; U2[i].y = 0u; }
      YP[i] = *(const uint2*)(Ryp + (long)lt * D + k);
      OG[i] = *(const uint2*)(Rog + (long)lt * D + k);
      HF[i] = *(const uint2*)(c.Rhf + (long)lt * D + k);
      HB[i] = *(const uint2*)(c.Rhb + (long)lt * D + k);
    }
#pragma unroll
    for (int i = 0; i < 4; i++) {
      const int k = 4 * lane + 256 * i;
      const float4 a0 = unpack4(U0[i]), a1 = unpack4(U1[i]), a2 = unpack4(U2[i]), yp = unpack4(YP[i]);
      const float y0 = yp.x * (w0[i].x * a0.x + w1[i].x * a1.x + w2[i].x * a2.x + bb[i].x);
      const float y1 = yp.y * (w0[i].y * a0.y + w1[i].y * a1.y + w2[i].y * a2.y + bb[i].y);
      const float y2 = yp.z * (w0[i].z * a0.z + w1[i].z * a1.z + w2[i].z * a2.z + bb[i].z);
      const float y3 = yp.w * (w0[i].w * a0.w + w1[i].w * a1.w + w2[i].w * a2.w + bb[i].w);
      *(uint2*)(Ryp + (long)lt * D + k) = pack4(y0, y1, y2, y3);
      const float4 hf = unpack4(HF[i]), hb = unpack4(HB[i]), og = unpack4(OG[i]);
      const float s0 = hf.x + hb.x, s1 = hf.y + hb.y, s2 = hf.z + hb.z, s3 = hf.w + hb.w;
      const float ss = wave_sum(s0 * s0 + s1 * s1 + s2 * s2 + s3 * s3);
      const float rstd = rsqrtf(ss * (1.f / 256.f) + 1e-6f);
      *(uint2*)(Rog + (long)lt * D + k) = pack4(og.x * s0 * rstd * gg[i].x, og.y * s1 * rstd * gg[i].y, og.z * s2 * rstd * gg[i].z, og.w * s3 * rstd * gg[i].w);
    }
  }
}

DI void phase_D1(const Params& p, const Ctx& c, int l, u16* lds) {
  const int tid = opaque_tid(), lane = tid & 63, wave = tid >> 6, wm = wave & 3, wn = wave >> 2, lr = lane & 15, lg = lane >> 4;
  const u16* W = c.W + (long)l * WROWS * D;
  const u16* Ryc = c.R2; const u16* Rym = c.R3; u16* Rmg = c.R4;
  const int nTiles = (c.Tg / 128) * 8;
  for (int tile = blockIdx.x; tile < nTiles; tile += gridDim.x) {
    const int ch = tile >> 3, mt = tile & 7;
    f32x4 a2[2][4], M[2][4];
    uint2 gk[4][4];
    {
      f32x4 a1[4][4];
      gemm_tile<4, 4, 3>(W + (long)(W_G + mt * 256) * D, c.Rh + (long)ch * 128 * D, a1, lds);
#pragma unroll
      for (int i = 0; i < 4; i++)
#pragma unroll
        for (int jn = 0; jn < 4; jn++)
          gk[i][jn] = pack4(sigmoidf_(a1[i][jn][0]), sigmoidf_(a1[i][jn][1]), sigmoidf_(a1[i][jn][2]), sigmoidf_(a1[i][jn][3]));
    }
    gemm_tile<2, 4, 3>(W + (long)(W_PC + mt * 128) * D, Ryc + (long)ch * 128 * D, a2, lds);
#pragma unroll
    for (int i = 0; i < 2; i++)
#pragma unroll
      for (int jn = 0; jn < 4; jn++) {
        const float4 gg = unpack4(gk[2 * i][jn]);
        M[i][jn] = (f32x4){gg.x * a2[i][jn][0], gg.y * a2[i][jn][1], gg.z * a2[i][jn][2], gg.w * a2[i][jn][3]};
      }
    gemm_tile<2, 4, 3>(W + (long)(W_PM + mt * 128) * D, Rym + (long)ch * 128 * D, a2, lds);
#pragma unroll
    for (int i = 0; i < 2; i++)
#pragma unroll
      for (int jn = 0; jn < 4; jn++) {
        const float4 gg = unpack4(gk[2 * i + 1][jn]);
        const int col = mt * 128 + 32 * wm + 16 * i + 4 * lg;
        const long lt = ch * 128 + 64 * wn + 16 * jn + lr;
        *(uint2*)(Rmg + lt * D + col) = pack4(M[i][jn][0] + gg.x * a2[i][jn][0], M[i][jn][1] + gg.y * a2[i][jn][1],
                                              M[i][jn][2] + gg.z * a2[i][jn][2], M[i][jn][3] + gg.w * a2[i][jn][3]);
      }
  }
}

DI void phase_D2(const Params& p, const Ctx& c, int l, int g, u16* lds) {
  const int tid = opaque_tid(), lane = tid & 63, wave = tid >> 6, wm = wave & 3, wn = wave >> 2, lr = lane & 15, lg = lane >> 4;
  const u16* W = c.W + ((long)l * WROWS + W_O) * D;
  const u16* Rmg = c.R4;
  const int nTiles = (c.Tg / 256) * 4;
  for (int tile = blockIdx.x; tile < nTiles; tile += gridDim.x) {
    const int tb = tile >> 2, pt = tile & 3;
    f32x4 acc[4][8];
    gemm_tile<4, 8, 2>(W + (long)pt * 256 * D, Rmg + (long)tb * 256 * D, acc, lds);
    const int tok0 = gtok(c, g, tb * 256);
    const float* gp = c.mod + ((long)l * 40 + batch_of(tok0)) * 3072 + 2048;
#pragma unroll
    for (int i = 0; i < 4; i++) {
      const int col = pt * 256 + 64 * wm + 16 * i + 4 * lg;
      const float4 gt = *(const float4*)(gp + col);
      float4 xv[8];
#pragma unroll
      for (int jn = 0; jn < 8; jn++) {
        const int tok = tok0 + 128 * wn + 16 * jn + lr;
        const float* xr = (l == 0) ? xin_row(p, tok) : p.out + (long)tok * D;
        xv[jn] = *(const float4*)(xr + col);
      }
#pragma unroll
      for (int jn = 0; jn < 8; jn++) {
        const int tok = tok0 + 128 * wn + 16 * jn + lr;
        float4 o;
        o.x = xv[jn].x + gt.x * acc[i][jn][0]; o.y = xv[jn].y + gt.y * acc[i][jn][1];
        o.z = xv[jn].z + gt.z * acc[i][jn][2]; o.w = xv[jn].w + gt.w * acc[i][jn][3];
        *(float4*)(p.out + (long)tok * D + col) = o;
      }
    }
  }
}

__global__ void __launch_bounds__(NT) mega(Params p) {
  extern __shared__ __attribute__((aligned(16))) char smem[];
  cg::grid_group grid = cg::this_grid();
  Ctx c;
  c.G = p.G; c.Tg = 131072 / p.G; c.half = c.Tg >> 1;
  const size_t REG = (size_t)c.Tg * D * 2;
  c.Rh = (u16*)(p.ws); c.R1 = (u16*)(p.ws + REG); c.R2 = (u16*)(p.ws + 2 * REG); c.R3 = (u16*)(p.ws + 3 * REG);
  c.R4 = (u16*)(p.ws + 4 * REG); c.Rhf = (u16*)(p.ws + 5 * REG); c.Rhb = (u16*)(p.ws + 6 * REG);
  unsigned char* q = p.ws + 7 * REG;
  c.W = (u16*)q; q += (size_t)DEPTH * WROWS * D * 2;
  c.mod = (float*)q; q += (size_t)DEPTH * 40 * 3072 * 4;
  c.sc = (float*)q; q += (size_t)c.Tg * 96;
  c.ctr = (int*)q;

  phase_prep(p, c, (float*)smem);
  grid.sync();
  for (int g = 0; g < c.G; ++g) {
    for (int l = 0; l < DEPTH; ++l) {
      phase_rows(p, c, l, g, false);
      grid.sync();
      phase_A(p, c, l, (u16*)smem);
      grid.sync();
      phase_scan(p, c, g * DEPTH + l, smem);
      grid.sync();
      phase_C(p, c, l, (u16*)smem);
      grid.sync();
      phase_E(p, c, l);
      grid.sync();
      phase_D1(p, c, l, (u16*)smem);
      grid.sync();
      phase_D2(p, c, l, g, (u16*)smem);
      grid.sync();
    }
    phase_rows(p, c, DEPTH, g, true);
  }
}

extern "C" void kernel_launch(void* const* d_in, const int* in_sizes, int n_in, void* d_out, int out_size,
                              void* d_ws, size_t ws_size, hipStream_t stream) {
  static int grid_blocks = 0;
  static int Gsel = 2;
  if (!grid_blocks) {
    int dev = 0, cus = 0, per_cu = 0;
    hipGetDevice(&dev);
    hipDeviceGetAttribute(&cus, hipDeviceAttributeMultiprocessorCount, dev);
    hipFuncSetAttribute((const void*)mega, hipFuncAttributeMaxDynamicSharedMemorySize, LDS_BYTES);
    hipOccupancyMaxActiveBlocksPerMultiprocessor(&per_cu, (const void*)mega, NT, LDS_BYTES);
    if (per_cu < 1) per_cu = 1;
    grid_blocks = cus * per_cu;
    const size_t fixed = (size_t)DEPTH * WROWS * D * 2 + (size_t)DEPTH * 40 * 3072 * 4 + 4096;
    Gsel = 2;
    while (Gsel < 8 && 7 * ((size_t)(131072 / Gsel) * D * 2) + fixed + (size_t)(131072 / Gsel) * 96 > ws_size) Gsel *= 2;
  }
  Params p{};
  p.x_prompt = (const float*)d_in[0]; p.x_sample = (const float*)d_in[1]; p.c_prompt = (const float*)d_in[2]; p.c_sample = (const float*)d_in[3];
  p.w_ada = (const float*)d_in[4]; p.b_ada = (const float*)d_in[5]; p.norm_g = (const float*)d_in[6]; p.w_in = (const float*)d_in[7];
  p.b_gates = (const float*)d_in[8]; p.conv_w = (const float*)d_in[9]; p.conv_b = (const float*)d_in[10]; p.mh_norm_g = (const float*)d_in[11];
  p.w_pc = (const float*)d_in[12]; p.w_pm = (const float*)d_in[13]; p.w_out = (const float*)d_in[14]; p.final_g = (const float*)d_in[15];
  p.out = (float*)d_out; p.ws = (unsigned char*)d_ws; p.G = Gsel; p.pad = 0;
  void* args[] = {&p};
  hipError_t e = hipLaunchCooperativeKernel((const void*)mega, dim3(grid_blocks), dim3(NT), args, LDS_BYTES, stream);
  if (e != hipSuccess) fprintf(stderr, "cooperative launch failed: %s (grid %d)\n", hipGetErrorString(e), grid_blocks);
}
```

```cpp
#include <hip/hip_runtime.h>
#include <hip/hip_cooperative_groups.h>
#include <cstdio>
namespace cg = cooperative_groups;

typedef unsigned short u16;
using bf16x8 = __attribute__((ext_vector_type(8))) short;
using f32x4  = __attribute__((ext_vector_type(4))) float;
using s16x4  = __attribute__((ext_vector_type(4))) short;
using u32x4  = __attribute__((ext_vector_type(4))) unsigned;
#define DI __device__ __forceinline__

constexpr int D = 1024, DIN = 11280, DEPTH = 4;
constexpr int NT = 512;
constexpr int W_QKV = 0, W_C = 3328, W_G = 9472, W_PC = 11520, W_PM = 12544, W_O = 13568, WROWS = 14592;
constexpr int LDT = 72;
constexpr int KS = 264, VS = 136;
constexpr int LDS_BYTES = (128 * KS + 2 * 80 * VS + 80 * KS) * 2 + 4 * 128 * 4;

struct Params {
  const float* x_prompt; const float* x_sample; const float* c_prompt; const float* c_sample;
  const float* w_ada; const float* b_ada; const float* norm_g; const float* w_in; const float* b_gates;
  const float* conv_w; const float* conv_b; const float* mh_norm_g; const float* w_pc; const float* w_pm;
  const float* w_out; const float* final_g;
  float* out; unsigned char* ws;
  int G; int pad;
};

struct Ctx {
  int G, Tg, half;
  u16 *Rh, *R1, *R2, *R3, *R4, *Rhf, *Rhb;
  u16* W; float* mod; float* sc; int* ctr;
};

DI u16 f2bf(float x) { unsigned u = __float_as_uint(x); u += 0x7fffu + ((u >> 16) & 1u); return (u16)(u >> 16); }
DI float bf2f(unsigned h) { return __uint_as_float(h << 16); }
DI unsigned pack2(float a, float b) { return (unsigned)f2bf(a) | ((unsigned)f2bf(b) << 16); }
DI uint2 pack4(float a, float b, float c, float d) { uint2 r; r.x = pack2(a, b); r.y = pack2(c, d); return r; }
DI uint2 pack4v(f32x4 v) { return pack4(v[0], v[1], v[2], v[3]); }
DI float4 unpack4(uint2 v) { float4 r; r.x = bf2f(v.x & 0xffffu); r.y = bf2f(v.x >> 16); r.z = bf2f(v.y & 0xffffu); r.w = bf2f(v.y >> 16); return r; }
DI float sigmoidf_(float x) { return 1.f / (1.f + __expf(-x)); }
DI float siluf_(float x) { return x * sigmoidf_(x); }
DI float wave_sum(float v) {
#pragma unroll
  for (int o = 32; o >= 1; o >>= 1) v += __shfl_xor(v, o);
  return v;
}
DI int opaque_tid() { int t = threadIdx.x; asm volatile("" : "+v"(t)); return t; }
DI f32x4 mfma16(bf16x8 a, bf16x8 b, f32x4 c) { return __builtin_amdgcn_mfma_f32_16x16x32_bf16(a, b, c, 0, 0, 0); }

DI int gtok(const Ctx& c, int g, int lt) { return lt < c.half ? g * c.half + lt : 65536 + g * c.half + (lt - c.half); }
DI int batch_of(int tok) { return tok < 65536 ? (tok >> 13) : 8 + ((tok - 65536) >> 11); }
DI const float* xin_row(const Params& p, int tok) {
  return tok < 65536 ? p.x_prompt + (long)tok * D : p.x_sample + (long)(tok - 65536) * D;
}


#define XB_TMO      128
#define XB_XCNT(j)  (256  + 64 * (j))
#define XB_XSUB(j)  (1280 + 64 * (j))
#define XB_XGEN(j)  (2304 + 64 * (j))
#define XB_TOP      3328
#define XB_TOPGEN   3392
#define XCD_BAR_WORDS 3456
#define XB_SPIN_CAP (1u << 18)
#define LAS __attribute__((address_space(3)))
DI unsigned xb_ld(unsigned* p)              { return __hip_atomic_load(p, __ATOMIC_RELAXED, __HIP_MEMORY_SCOPE_AGENT); }
DI unsigned xb_add(unsigned* p, unsigned v) { return __hip_atomic_fetch_add(p, v, __ATOMIC_RELAXED, __HIP_MEMORY_SCOPE_AGENT); }
DI unsigned xb_xcc_id() { return (unsigned)__builtin_amdgcn_s_getreg((3 << 11) | 20) & 0xFu; }
#define XB_SPIN(cond, bar) do { unsigned _sp = 0; while (cond) { __builtin_amdgcn_s_sleep(1); \
    if ((++_sp & 255u) == 0u) { if (xb_ld(&(bar)[XB_TMO])) break; if (_sp > XB_SPIN_CAP) { atomicAdd(&(bar)[XB_TMO], 1u); break; } } } } while (0)
struct XcdBarrier { unsigned* bar; unsigned x; volatile LAS unsigned* st; };
DI XcdBarrier xcd_barrier_post(unsigned* bar, volatile LAS unsigned* st) {
  XcdBarrier b; b.bar = bar; b.x = xb_xcc_id(); b.st = st;
  if (threadIdx.x == 0) (void)xb_add(&bar[XB_XCNT(b.x)], 1u);
  return b;
}
DI void xcd_barrier_complete(unsigned* bar, unsigned x, unsigned& nloc, unsigned& nx) {
  const unsigned G = gridDim.x * gridDim.y * gridDim.z;
  unsigned sum, cnt, mine, sp = 0u;
  for (;;) {
    sum = 0u; cnt = 0u; mine = 0u;
#pragma unroll
    for (unsigned j = 0; j < 16; ++j) { const unsigned c = xb_ld(&bar[XB_XCNT(j)]); sum += c; cnt += (c > 0u) ? 1u : 0u; mine = (j == x) ? c : mine; }
    if (sum == G) break;
    __builtin_amdgcn_s_sleep(1);
    if ((++sp & 255u) == 0u) { if (xb_ld(&bar[XB_TMO])) break; if (sp > XB_SPIN_CAP) { atomicAdd(&bar[XB_TMO], 1u); break; } }
  }
  nloc = mine > 0u ? mine : 1u; nx = cnt > 0u ? cnt : 1u;
}
DI void xcd_barrier(const XcdBarrier& b) {
  asm volatile("s_waitcnt vmcnt(0)" ::: "memory");
  __syncthreads();
  if (threadIdx.x == 0) {
    unsigned* bar = b.bar;
    __builtin_amdgcn_s_waitcnt(0);
    unsigned nloc = b.st[0], nx = b.st[1];
    if (nloc == 0u) { xcd_barrier_complete(bar, b.x, nloc, nx); b.st[0] = nloc; b.st[1] = nx; }
    const unsigned old = xb_add(&bar[XB_XSUB(b.x)], 1u);
    const unsigned gen = old / nloc;
    if (old + 1u == (gen + 1u) * nloc) {
      __builtin_amdgcn_fence(__ATOMIC_RELEASE, "agent");
      asm volatile("s_waitcnt vmcnt(0)" ::: "memory");
      const unsigned og = xb_add(&bar[XB_TOP], 1u);
      const unsigned tg = og / nx;
      if (og + 1u == (tg + 1u) * nx) xb_add(&bar[XB_TOPGEN], 1u);
      else XB_SPIN(xb_ld(&bar[XB_TOPGEN]) == tg, bar);
      __builtin_amdgcn_fence(__ATOMIC_ACQUIRE, "agent");
      xb_add(&bar[XB_XGEN(b.x)], 1u);
      asm volatile("s_waitcnt vmcnt(0)" ::: "memory");
    } else {
      XB_SPIN(xb_ld(&bar[XB_XGEN(b.x)]) == gen, bar);
      __builtin_amdgcn_fence(__ATOMIC_ACQUIRE, "agent");
      asm volatile("s_waitcnt vmcnt(0)" ::: "memory");
    }
  }
  __syncthreads();
}

template <int MT, int NT, int ST>
DI void gemm_tile(const u16* __restrict__ P, const u16* __restrict__ Q, f32x4 (&acc)[MT][NT], u16* lds) {
  const int tid = opaque_tid(), lane = tid & 63, wave = __builtin_amdgcn_readfirstlane(tid >> 6), wm = wave & 3, wn = wave >> 2;
  const int lr = lane & 15, lg = lane >> 4;
  constexpr int PROWS = 64 * MT, QROWS = 32 * NT, NQI = NT / 2, NDMA = MT + NQI;
  char* pbase = (char*)lds;
  char* qbase = pbase + ST * PROWS * 128;
  const int drow = lane >> 3, dpos = lane & 7;
  const u16* gp[MT]; const u16* gq[NQI];
#pragma unroll
  for (int i = 0; i < MT; i++) { const int r = 8 * (wave + 8 * i) + drow; gp[i] = P + (long)r * D + ((dpos ^ ((r >> 1) & 7)) << 3); }
#pragma unroll
  for (int i = 0; i < NQI; i++) { const int r = 8 * (wave + 8 * i) + drow; gq[i] = Q + (long)r * D + ((dpos ^ ((r >> 1) & 7)) << 3); }
  char* dp = pbase + wave * 1024 + lane * 16;
  char* dq = qbase + wave * 1024 + lane * 16;
#pragma unroll
  for (int i = 0; i < MT; i++)
#pragma unroll
    for (int j = 0; j < NT; j++) acc[i][j] = (f32x4){0.f, 0.f, 0.f, 0.f};
#pragma unroll
  for (int t0 = 0; t0 < ST - 1; t0++) {
#pragma unroll
    for (int i = 0; i < MT; i++) __builtin_amdgcn_global_load_lds((const unsigned*)(gp[i] + t0 * 64), (unsigned*)(dp + t0 * PROWS * 128 + i * 8192), 16, 0, 0);
#pragma unroll
    for (int i = 0; i < NQI; i++) __builtin_amdgcn_global_load_lds((const unsigned*)(gq[i] + t0 * 64), (unsigned*)(dq + t0 * QROWS * 128 + i * 8192), 16, 0, 0);
  }
  asm volatile("s_waitcnt vmcnt(%0)" :: "n"((ST - 2) * NDMA) : "memory");
  __builtin_amdgcn_s_barrier();
  asm volatile("" ::: "memory");
  const int swz = (lr >> 1) & 7;
  const int o0 = (lg ^ swz) << 4, o1 = ((4 + lg) ^ swz) << 4;
  const char* pa = pbase + (wm * 16 * MT + lr) * 128;
  const char* qa = qbase + (wn * 16 * NT + lr) * 128;
  constexpr int NK = D / 64;
  int cur = 0, nxs = ST - 1;
  for (int kt = 0; kt < NK; ++kt) {
    if (kt + ST - 1 < NK) {
#pragma unroll
      for (int i = 0; i < MT; i++) __builtin_amdgcn_global_load_lds((const unsigned*)(gp[i] + (kt + ST - 1) * 64), (unsigned*)(dp + nxs * PROWS * 128 + i * 8192), 16, 0, 0);
#pragma unroll
      for (int i = 0; i < NQI; i++) __builtin_amdgcn_global_load_lds((const unsigned*)(gq[i] + (kt + ST - 1) * 64), (unsigned*)(dq + nxs * QROWS * 128 + i * 8192), 16, 0, 0);
    }
    const char* pb = pa + cur * PROWS * 128;
    const char* qb = qa + cur * QROWS * 128;
#pragma unroll
    for (int ks = 0; ks < 2; ++ks) {
      const int oo = ks ? o1 : o0;
      bf16x8 a[MT], b[NT];
#pragma unroll
      for (int i = 0; i < MT; i++) a[i] = *(const bf16x8*)(pb + i * 2048 + oo);
#pragma unroll
      for (int j = 0; j < NT; j++) b[j] = *(const bf16x8*)(qb + j * 2048 + oo);
#pragma unroll
      for (int i = 0; i < MT; i++)
#pragma unroll
        for (int j = 0; j < NT; j++) acc[i][j] = mfma16(a[i], b[j], acc[i][j]);
    }
    if (kt + ST - 1 < NK) asm volatile("s_waitcnt vmcnt(%0)" :: "n"((ST - 2) * NDMA) : "memory");
    else asm volatile("s_waitcnt vmcnt(0)" ::: "memory");
    __builtin_amdgcn_s_barrier();
    asm volatile("" ::: "memory");
    cur = (cur == ST - 1) ? 0 : cur + 1;
    nxs = (nxs == ST - 1) ? 0 : nxs + 1;
  }
}

DI void wsrc(const Params& p, int l, int n, const float*& src, int& ld, int& col, float& scale) {
  scale = 1.f;
  src = p.w_in + (long)l * D * DIN; ld = DIN;
  if (n < W_C) {
    if (n < 1024) col = 4096 + n;
    else if (n < 2048) { col = 5120 + (n - 1024); scale = 0.0625f; }
    else if (n < 3072) col = 6144 + (n - 2048);
    else if (n < 3088) col = 9216 + (n - 3072);
    else col = -1;
  } else if (n < W_G) {
    int n2 = n - W_C;
    if (n2 < 4096) { int blk = n2 >> 6, sl = (n2 >> 4) & 3, cl = n2 & 15; col = sl * 1024 + blk * 16 + cl; }
    else { int n3 = n2 - 4096; int blk = n3 >> 5, sl = (n3 >> 4) & 1, cl = n3 & 15; col = (sl ? 8192 : 7168) + blk * 16 + cl; }
  } else if (n < W_PC) {
    int n4 = n - W_G; int blk = n4 >> 5, sl = (n4 >> 4) & 1, cl = n4 & 15; col = 9232 + sl * 1024 + blk * 16 + cl;
  } else if (n < W_PM) { src = p.w_pc + (long)l * D * D; ld = D; col = n - W_PC; }
  else if (n < W_O)  { src = p.w_pm + (long)l * D * D; ld = D; col = n - W_PM; }
  else               { src = p.w_out + (long)l * D * D; ld = D; col = n - W_O; }
}

DI void phase_prep(const Params& p, const Ctx& c, float* ldsf) {
  const int tid = opaque_tid();
  if (blockIdx.x == 0 && tid < 64) c.ctr[tid] = 0;
  const int nItems = DEPTH * (WROWS / 64) * 16;
  for (int it = blockIdx.x; it < nItems; it += gridDim.x) {
    const int kb = (it & 15) * 64; const int rb = it >> 4;
    const int l = rb / (WROWS / 64); const int nb = (rb % (WROWS / 64)) * 64;
    const float* src; int ld, col; float scale;
    const int nl = tid & 63;
    wsrc(p, l, nb + nl, src, ld, col, scale);
#pragma unroll
    for (int i = 0; i < 8; i++) {
      const int kl = (tid >> 6) + 8 * i;
      float v = (col >= 0) ? src[(long)(kb + kl) * ld + col] * scale : 0.f;
      ldsf[kl * 65 + nl] = v;
    }
    __syncthreads();
    {
      const int nl2 = tid >> 3, kc = tid & 7;
      float v[8];
#pragma unroll
      for (int j = 0; j < 8; j++) v[j] = ldsf[(kc * 8 + j) * 65 + nl2];
      uint4 o; o.x = pack2(v[0], v[1]); o.y = pack2(v[2], v[3]); o.z = pack2(v[4], v[5]); o.w = pack2(v[6], v[7]);
      *(uint4*)(c.W + ((long)l * WROWS + nb + nl2) * D + kb + kc * 8) = o;
    }
    __syncthreads();
  }
  const int nMod = DEPTH * 48;
  for (int it = blockIdx.x; it < nMod; it += gridDim.x) {
    const int l = it / 48, jb = (it % 48) * 64;
    const int cl = tid & 63, kc = tid >> 6;
    float acc[40];
#pragma unroll
    for (int b = 0; b < 40; b++) acc[b] = 0.f;
    const float* wa = p.w_ada + (long)l * D * 3072 + jb + cl;
    for (int k = kc * 128; k < kc * 128 + 128; ++k) {
      const float wv = wa[(long)k * 3072];
#pragma unroll
      for (int b = 0; b < 40; b++) {
        const float cv = (b < 8) ? p.c_prompt[b * D + k] : p.c_sample[(b - 8) * D + k];
        acc[b] += cv * wv;
      }
    }
#pragma unroll
    for (int b = 0; b < 40; b++) ldsf[(kc * 40 + b) * 64 + cl] = acc[b];
    __syncthreads();
    for (int idx = tid; idx < 40 * 64; idx += NT) {
      const int b = idx >> 6, cc = idx & 63;
      float s = p.b_ada[l * 3072 + jb + cc];
#pragma unroll
      for (int q = 0; q < 8; q++) s += ldsf[(q * 40 + b) * 64 + cc];
      c.mod[((long)l * 40 + b) * 3072 + jb + cc] = s;
    }
    __syncthreads();
  }
}

DI void phase_rows(const Params& p, const Ctx& c, int l, int g, bool fin) {
  const int tid_ = opaque_tid(); const int lane = tid_ & 63, w = tid_ >> 6;
  for (int lt = blockIdx.x * 8 + w; lt < c.Tg; lt += gridDim.x * 8) {
    const int tok = gtok(c, g, lt);
    const float* xr = (l == 0) ? xin_row(p, tok) : p.out + (long)tok * D;
    float4 v[4]; float ss = 0.f;
#pragma unroll
    for (int i = 0; i < 4; i++) {
      v[i] = *(const float4*)(xr + 4 * lane + 256 * i);
      ss += v[i].x * v[i].x + v[i].y * v[i].y + v[i].z * v[i].z + v[i].w * v[i].w;
    }
    ss = wave_sum(ss);
    const float rstd = rsqrtf(ss * (1.f / 1024.f) + 1e-6f);
    if (fin) {
#pragma unroll
      for (int i = 0; i < 4; i++) {
        const int k = 4 * lane + 256 * i;
        const float4 fg = *(const float4*)(p.final_g + k);
        float4 o; o.x = v[i].x * rstd * fg.x; o.y = v[i].y * rstd * fg.y; o.z = v[i].z * rstd * fg.z; o.w = v[i].w * rstd * fg.w;
        *(float4*)(p.out + (long)tok * D + k) = o;
      }
    } else {
      const float* mp = c.mod + ((long)l * 40 + batch_of(tok)) * 3072;
      float4 ngv[4], sclv[4], shv[4];
#pragma unroll
      for (int i = 0; i < 4; i++) {
        const int k = 4 * lane + 256 * i;
        ngv[i] = *(const float4*)(p.norm_g + l * D + k); sclv[i] = *(const float4*)(mp + 1024 + k); shv[i] = *(const float4*)(mp + k);
      }
#pragma unroll
      for (int i = 0; i < 4; i++) {
        const int k = 4 * lane + 256 * i;
        const float4 ng = ngv[i], scl = sclv[i], sh = shv[i];
        const float h0 = v[i].x * rstd * ng.x * (1.f + scl.x) + sh.x;
        const float h1 = v[i].y * rstd * ng.y * (1.f + scl.y) + sh.y;
        const float h2 = v[i].z * rstd * ng.z * (1.f + scl.z) + sh.z;
        const float h3 = v[i].w * rstd * ng.w * (1.f + scl.w) + sh.w;
        *(uint2*)(c.Rh + (long)lt * D + k) = pack4(h0, h1, h2, h3);
      }
    }
  }
}

DI void phase_A(const Params& p, const Ctx& c, int l, u16* lds) {
  const int tid = opaque_tid(), lane = tid & 63, wave = tid >> 6, wm = wave & 3, wn = wave >> 2, lr = lane & 15, lg = lane >> 4;
  const u16* W = c.W + (long)l * WROWS * D;
  u16* Rq = c.R1; u16* Rk = c.R2; u16* RvT = c.R4;
  const int nTiles = (c.Tg / 256) * 13;
  for (int tile = blockIdx.x; tile < nTiles; tile += gridDim.x) {
    const int tb = tile / 13, j = tile % 13;
    f32x4 acc[4][8];
    if (j < 8) {
      const int isk = j >> 2, head = j & 3;
      gemm_tile<4, 8, 2>(W + (long)(isk * 1024 + head * 256) * D, c.Rh + (long)tb * 256 * D, acc, lds);
      u16* dst = isk ? Rk : Rq;
#pragma unroll
      for (int i = 0; i < 4; i++)
#pragma unroll
        for (int jn = 0; jn < 8; jn++) {
          const int d = 64 * wm + 16 * i + 4 * lg, t = 128 * wn + 16 * jn + lr;
          *(uint2*)(dst + (long)(tb * 256 + t) * D + head * 256 + d) = pack4v(acc[i][jn]);
        }
    } else if (j < 12) {
      const int head = j - 8;
      gemm_tile<4, 8, 2>(c.Rh + (long)tb * 256 * D, W + (long)(2048 + head * 256) * D, acc, lds);
#pragma unroll
      for (int i = 0; i < 4; i++)
#pragma unroll
        for (int jn = 0; jn < 8; jn++) {
          const int tokl = 64 * wm + 16 * i + 4 * lg, e = 128 * wn + 16 * jn + lr;
          const int ch = tb * 2 + (tokl >> 7), sidx = tokl & 127;
          *(uint2*)(RvT + ((long)(ch * 4 + head) * 256 + e) * 128 + sidx) = pack4v(acc[i][jn]);
        }
    } else {
      gemm_tile<4, 8, 2>(W + (long)3072 * D, c.Rh + (long)tb * 256 * D, acc, lds);
      float* gl = (float*)lds;
      if (wm == 0) {
#pragma unroll
        for (int jn = 0; jn < 8; jn++) {
          const int t = 128 * wn + 16 * jn + lr;
#pragma unroll
          for (int r = 0; r < 4; r++) {
            float v = acc[0][jn][r] + p.b_gates[l * 16 + lg * 4 + r];
            if (lg & 1) v = fminf(v, 0.f) - log1pf(expf(-fabsf(v)));
            gl[t * 16 + lg * 4 + r] = v;
          }
        }
      }
      __syncthreads();
      if (tid < 16) {
        const int head = tid & 3, dir = (tid >> 2) & 1, cl = tid >> 3;
        const int ch = tb * 2 + cl;
        float* o = c.sc + (((long)(ch * 4 + head) * 2 + dir) * 3) * 128;
        const float* glc = gl + cl * 128 * 16;
        float bs = 0.f, pm = -3.0e38f;
        for (int q = 0; q < 128; ++q) {
          const int t = dir ? 127 - q : q;
          const float iv = glc[t * 16 + dir * 8 + head], lf = glc[t * 16 + dir * 8 + 4 + head];
          bs += lf; const float gg = iv - bs; pm = fmaxf(pm, gg);
          o[t] = bs; o[128 + t] = gg; o[256 + t] = pm;
        }
      }
      __syncthreads();
    }
  }
}

DI void phase_scan(const Params& p, const Ctx& c, int ctrIdx, char* smem) {
  __shared__ int s_task;
  const int tid = opaque_tid(), lane = tid & 63, w = __builtin_amdgcn_readfirstlane(tid >> 6), lr = lane & 15, lg = lane >> 4;
  u16* Kb = (u16*)smem;
  u16* Vt = Kb + 128 * KS;
  u16* Vw = Vt + 80 * VS;
  u16* Ct = Vw + 80 * VS;
  float* scg = (float*)(Ct + 80 * KS); float* scmu = scg + 128; float* sciw = scmu + 128; float* scfl = sciw + 128;
  const u16* Rq = c.R1; const u16* Rk = c.R2; const u16* RvT = c.R4;
  const int nLong = (8 / c.G) * 32, nTasks = nLong + (32 / c.G) * 32;
  int* ctr = c.ctr + ctrIdx;
  while (true) {
    __syncthreads();
    if (tid == 0) s_task = atomicAdd(ctr, 1);
    __syncthreads();
    const int task = s_task;
    if (task >= nTasks) break;
    int seq, r, chunk0, nc;
    if (task < nLong) { seq = task >> 5; r = task & 31; chunk0 = seq * 64; nc = 64; }
    else { const int t2 = task - nLong; seq = t2 >> 5; r = t2 & 31; chunk0 = (c.half >> 7) + seq * 16; nc = 16; }
    const int head = r >> 3, dir = (r >> 2) & 1, es = r & 3;
    const int last = dir ? 0 : 127;
    u16* Rho = dir ? c.Rhb : c.Rhf;
    for (int idx = tid; idx < 80 * KS / 2; idx += NT) ((unsigned*)Ct)[idx] = 0u;
    for (int idx = tid; idx < 16 * VS / 2; idx += NT) { ((unsigned*)(Vt + 64 * VS))[idx] = 0u; ((unsigned*)(Vw + 64 * VS))[idx] = 0u; }
    __syncthreads();
    if (tid < 128) Vt[64 * VS + tid] = (u16)0x3F80;
    f32x4 st[2][5];
#pragma unroll
    for (int i = 0; i < 2; i++)
#pragma unroll
      for (int jn = 0; jn < 5; jn++) st[i][jn] = (f32x4){0.f, 0.f, 0.f, 0.f};
    float m = 0.f;
    const int vrow = tid >> 4, vsc = tid & 15;
    const int krow = tid >> 5, kkc = (tid & 31) * 8;
    u32x4 kpre[8], vpre[2]; float4 g8a, g8b; float bLn, gmaxn, myb, myg, mypm;
    bf16x8 qf[8];
    auto scan_load = [&](int cq) {
#pragma unroll
      for (int ks = 0; ks < 8; ks++)
        qf[ks] = *(const bf16x8*)(Rq + (long)(cq * 128 + 16 * w + lr) * D + head * 256 + 32 * ks + 8 * lg);
#pragma unroll
      for (int i = 0; i < 8; i++) kpre[i] = *(const u32x4*)(Rk + (long)(cq * 128 + krow + 16 * i) * D + head * 256 + kkc);
#pragma unroll
      for (int i = 0; i < 2; i++) vpre[i] = *(const u32x4*)(RvT + ((long)(cq * 4 + head) * 256 + es * 64 + vrow + 32 * i) * 128 + vsc * 8);
      const float* scb = c.sc + ((long)(cq * 4 + head) * 2 + dir) * 384;
      g8a = *(const float4*)(scb + 128 + vsc * 8); g8b = *(const float4*)(scb + 128 + vsc * 8 + 4);
      bLn = scb[last]; gmaxn = scb[256 + last];
      myb = scb[tid & 127]; myg = scb[128 + (tid & 127)]; mypm = scb[256 + (tid & 127)];
    };
    scan_load(chunk0 + (dir ? nc - 1 : 0));
    for (int j = 0; j < nc; ++j) {
      const int cc = chunk0 + (dir ? nc - 1 - j : j);
      __syncthreads();
      const float muL = fmaxf(m, gmaxn);
      const float decay = __expf(m - muL);
      const float mnext = bLn + muL;
#pragma unroll
      for (int i = 0; i < 2; i++)
#pragma unroll
        for (int jn = 0; jn < 5; jn++)
          *(uint2*)(Ct + (16 * jn + lr) * KS + 32 * w + 16 * i + 4 * lg) = pack4v(st[i][jn]);
#pragma unroll
      for (int i = 0; i < 8; i++) *(u32x4*)(Kb + (krow + 16 * i) * KS + kkc) = kpre[i];
      {
        float w8[8];
        w8[0] = __expf(g8a.x - muL); w8[1] = __expf(g8a.y - muL); w8[2] = __expf(g8a.z - muL); w8[3] = __expf(g8a.w - muL);
        w8[4] = __expf(g8b.x - muL); w8[5] = __expf(g8b.y - muL); w8[6] = __expf(g8b.z - muL); w8[7] = __expf(g8b.w - muL);
#pragma unroll
        for (int i = 0; i < 2; i++) {
          const u32x4 vv = vpre[i];
          *(u32x4*)(Vt + (vrow + 32 * i) * VS + vsc * 8) = vv;
          uint4 v; v.x = vv[0]; v.y = vv[1]; v.z = vv[2]; v.w = vv[3];
          uint4 o;
          o.x = pack2(bf2f(v.x & 0xffffu) * w8[0], bf2f(v.x >> 16) * w8[1]);
          o.y = pack2(bf2f(v.y & 0xffffu) * w8[2], bf2f(v.y >> 16) * w8[3]);
          o.z = pack2(bf2f(v.z & 0xffffu) * w8[4], bf2f(v.z >> 16) * w8[5]);
          o.w = pack2(bf2f(v.w & 0xffffu) * w8[6], bf2f(v.w >> 16) * w8[7]);
          *(uint4*)(Vw + (vrow + 32 * i) * VS + vsc * 8) = o;
        }
        if (tid < 16) {
          uint4 o; o.x = pack2(w8[0], w8[1]); o.y = pack2(w8[2], w8[3]); o.z = pack2(w8[4], w8[5]); o.w = pack2(w8[6], w8[7]);
          *(uint4*)(Vw + 64 * VS + vsc * 8) = o;
        }
      }
      if (tid < 128) {
        const float mu = fmaxf(m, mypm);
        scg[tid] = myg; scmu[tid] = mu; sciw[tid] = __expf(m - mu); scfl[tid] = __expf(-(mu + myb));
      }
      __syncthreads();
      const int t = 16 * w + lr;
      bf16x8 spk[4];
      {
        f32x4 sacc[8];
#pragma unroll
        for (int i = 0; i < 8; i++) sacc[i] = (f32x4){0.f, 0.f, 0.f, 0.f};
#pragma unroll
        for (int i = 0; i < 8; i++) {
          const bool need = dir ? (i >= w) : (i <= w);
          if (need) {
#pragma unroll
            for (int ks = 0; ks < 8; ks++) {
              const bf16x8 a = *(const bf16x8*)(Kb + (16 * i + lr) * KS + 32 * ks + 8 * lg);
              sacc[i] = mfma16(a, qf[ks], sacc[i]);
            }
          }
        }
        const float mu_t = scmu[t];
        int tt = t; asm volatile("" : "+v"(tt));
        const int sgn = dir ? -1 : 1;
#pragma unroll
        for (int ks = 0; ks < 4; ks++) {
          float sv[8];
#pragma unroll
          for (int hh = 0; hh < 2; hh++) {
            const int i = 2 * ks + hh;
            const float4 gs = *(const float4*)(scg + 16 * i + 4 * lg);
            const float gv[4] = {gs.x, gs.y, gs.z, gs.w};
#pragma unroll
            for (int r2 = 0; r2 < 4; r2++) {
              const int s = 16 * i + 4 * lg + r2;
              const bool valid = (s - tt) * sgn <= 0;
              sv[hh * 4 + r2] = valid ? sacc[i][r2] * __expf(gv[r2] - mu_t) : 0.f;
            }
          }
          uint4 o; o.x = pack2(sv[0], sv[1]); o.y = pack2(sv[2], sv[3]); o.z = pack2(sv[4], sv[5]); o.w = pack2(sv[6], sv[7]);
          spk[ks] = __builtin_bit_cast(bf16x8, o);
        }
      }
      f32x4 num[5];
#pragma unroll
      for (int i = 0; i < 5; i++) num[i] = (f32x4){0.f, 0.f, 0.f, 0.f};
#pragma unroll
      for (int ks = 0; ks < 8; ks++)
#pragma unroll
        for (int i = 0; i < 5; i++) {
          const bf16x8 a = *(const bf16x8*)(Ct + (16 * i + lr) * KS + 32 * ks + 8 * lg);
          num[i] = mfma16(a, qf[ks], num[i]);
        }
      {
        const float iw = sciw[t];
#pragma unroll
        for (int i = 0; i < 5; i++) num[i] *= iw;
      }
#pragma unroll
      for (int ks = 0; ks < 4; ks++) {
        const bool need = dir ? (2 * ks + 1 >= w) : (2 * ks <= w);
        if (need) {
#pragma unroll
          for (int i = 0; i < 5; i++) {
            const uint2 lo = *(const uint2*)(Vt + (16 * i + lr) * VS + 32 * ks + 4 * lg);
            const uint2 hi = *(const uint2*)(Vt + (16 * i + lr) * VS + 32 * ks + 16 + 4 * lg);
            uint4 av; av.x = lo.x; av.y = lo.y; av.z = hi.x; av.w = hi.y;
            num[i] = mfma16(__builtin_bit_cast(bf16x8, av), spk[ks], num[i]);
          }
        }
      }
      {
        const float fl = scfl[t];
        const float dr = __shfl(num[4][0], lr);
        const float inv = 1.f / fmaxf(fabsf(dr), fl);
        u16* dst = Rho + (long)(cc * 128 + t) * D + head * 256 + es * 64 + 4 * lg;
#pragma unroll
        for (int i = 0; i < 4; i++)
          *(uint2*)(dst + 16 * i) = pack4(num[i][0] * inv, num[i][1] * inv, num[i][2] * inv, num[i][3] * inv);
      }
      __builtin_amdgcn_sched_barrier(0);
      { const int jn1 = (j + 1 < nc) ? j + 1 : j; scan_load(chunk0 + (dir ? nc - 1 - jn1 : jn1)); }
      __builtin_amdgcn_sched_barrier(0);
#pragma unroll
      for (int i = 0; i < 2; i++)
#pragma unroll
        for (int jn = 0; jn < 5; jn++) st[i][jn] *= decay;
#pragma unroll
      for (int ks = 0; ks < 4; ks++) {
        bf16x8 kTf[2];
#pragma unroll
        for (int i = 0; i < 2; i++) {
          const u16* ap = Kb + (32 * ks + 8 * lg + (lr >> 2)) * KS + 32 * w + 16 * i + 4 * (lr & 3);
          const s16x4 lo = __builtin_amdgcn_ds_read_tr16_b64_v4i16((s16x4 __attribute__((address_space(3)))*)ap);
          const s16x4 hi = __builtin_amdgcn_ds_read_tr16_b64_v4i16((s16x4 __attribute__((address_space(3)))*)(ap + 4 * KS));
          kTf[i] = __builtin_shufflevector(lo, hi, 0, 1, 2, 3, 4, 5, 6, 7);
        }
#pragma unroll
        for (int jn = 0; jn < 5; jn++) {
          const bf16x8 b = *(const bf16x8*)(Vw + (16 * jn + lr) * VS + 32 * ks + 8 * lg);
#pragma unroll
          for (int i = 0; i < 2; i++) st[i][jn] = mfma16(kTf[i], b, st[i][jn]);
        }
      }
      m = mnext;
    }
  }
}

DI void phase_C(const Params& p, const Ctx& c, int l, u16* lds) {
  const int tid = opaque_tid(), lane = tid & 63, wave = tid >> 6, wm = wave & 3, wn = wave >> 2, lr = lane & 15, lg = lane >> 4;
  const u16* W = c.W + ((long)l * WROWS + W_C) * D;
  u16* Ru = c.R1; u16* Ryp = c.R2; u16* Rog = c.R3;
  const int nTiles = (c.Tg / 256) * 24;
  for (int tile = blockIdx.x; tile < nTiles; tile += gridDim.x) {
    const int tb = tile / 24, pt = tile % 24;
    f32x4 acc[4][8];
    gemm_tile<4, 8, 2>(W + (long)pt * 256 * D, c.Rh + (long)tb * 256 * D, acc, lds);
    if (pt < 16) {
      const int chn = pt * 64 + wm * 16 + 4 * lg;
#pragma unroll
      for (int jn = 0; jn < 8; jn++) {
        const long lt = tb * 256 + 128 * wn + 16 * jn + lr;
        float u[4], y[4];
#pragma unroll
        for (int r = 0; r < 4; r++) { u[r] = acc[1][jn][r] * acc[2][jn][r]; y[r] = acc[0][jn][r] * siluf_(acc[3][jn][r]); }
        *(uint2*)(Ru + lt * D + chn) = pack4(u[0], u[1], u[2], u[3]);
        *(uint2*)(Ryp + lt * D + chn) = pack4(y[0], y[1], y[2], y[3]);
      }
    } else {
      const int chn = (pt - 16) * 128 + wm * 32 + 4 * lg;
#pragma unroll
      for (int jn = 0; jn < 8; jn++) {
        const long lt = tb * 256 + 128 * wn + 16 * jn + lr;
#pragma unroll
        for (int hh = 0; hh < 2; hh++) {
          float o[4];
#pragma unroll
          for (int r = 0; r < 4; r++) o[r] = sigmoidf_(acc[2 * hh][jn][r]) * siluf_(acc[2 * hh + 1][jn][r]);
          *(uint2*)(Rog + lt * D + chn + 16 * hh) = pack4(o[0], o[1], o[2], o[3]);
        }
      }
    }
  }
}

DI void phase_E(const Params& p, const Ctx& c, int l) {
  const int tid_ = opaque_tid(); const int lane = tid_ & 63, w = tid_ >> 6;
  const u16* Ru = c.R1; u16* Ryp = c.R2; u16* Rog = c.R3;
  const float* cw = p.conv_w + (long)l * 3 * D; const float* cb = p.conv_b + (long)l * D; const float* mg = p.mh_norm_g + (long)l * D;
  float4 w0[4], w1[4], w2[4], bb[4], gg[4];
#pragma unroll
  for (int i = 0; i < 4; i++) {
    const int k = 4 * lane + 256 * i;
    w0[i] = *(const float4*)(cw + k); w1[i] = *(const float4*)(cw + D + k); w2[i] = *(const float4*)(cw + 2 * D + k);
    bb[i] = *(const float4*)(cb + k); gg[i] = *(const float4*)(mg + k);
  }
  for (int lt = blockIdx.x * 8 + w; lt < c.Tg; lt += gridDim.x * 8) {
    const int sl = lt < c.half ? 8192 : 2048;
    const int pos = (lt < c.half ? lt : lt - c.half) & (sl - 1);
    const bool first = pos == 0, lastp = pos == sl - 1;
    uint2 U0[4], U1[4], U2[4], YP[4], OG[4], HF[4], HB[4];
#pragma unroll
    for (int i = 0; i < 4; i++) {
      const int k = 4 * lane + 256 * i;
      U0[i] = *(const uint2*)(Ru + (long)(first ? lt : lt - 1) * D + k);
      U1[i] = *(const uint2*)(Ru + (long)lt * D + k);
      U2[i] = *(const uint2*)(Ru + (long)(lastp ? lt : lt + 1) * D + k);
      if (first) { U0[i].x = 0u; U0[i].y = 0u; }
      if (lastp) { U2[i].x = 0u; U2[i].y = 0u; }
      YP[i] = *(const uint2*)(Ryp + (long)lt * D + k);
      OG[i] = *(const uint2*)(Rog + (long)lt * D + k);
      HF[i] = *(const uint2*)(c.Rhf + (long)lt * D + k);
      HB[i] = *(const uint2*)(c.Rhb + (long)lt * D + k);
    }
#pragma unroll
    for (int i = 0; i < 4; i++) {
      const int k = 4 * lane + 256 * i;
      const float4 a0 = unpack4(U0[i]), a1 = unpack4(U1[i]), a2 = unpack4(U2[i]), yp = unpack4(YP[i]);
      const float y0 = yp.x * (w0[i].x * a0.x + w1[i].x * a1.x + w2[i].x * a2.x + bb[i].x);
      const float y1 = yp.y * (w0[i].y * a0.y + w1[i].y * a1.y + w2[i].y * a2.y + bb[i].y);
      const float y2 = yp.z * (w0[i].z * a0.z + w1[i].z * a1.z + w2[i].z * a2.z + bb[i].z);
      const float y3 = yp.w * (w0[i].w * a0.w + w1[i].w * a1.w + w2[i].w * a2.w + bb[i].w);
      *(uint2*)(Ryp + (long)lt * D + k) = pack4(y0, y1, y2, y3);
      const float4 hf = unpack4(HF[i]), hb = unpack4(HB[i]), og = unpack4(OG[i]);
      const float s0 = hf.x + hb.x, s1 = hf.y + hb.y, s2 = hf.z + hb.z, s3 = hf.w + hb.w;
      const float ss = wave_sum(s0 * s0 + s1 * s1 + s2 * s2 + s3 * s3);
      const float rstd = rsqrtf(ss * (1.f / 256.f) + 1e-6f);
      *(uint2*)(Rog + (long)lt * D + k) = pack4(og.x * s0 * rstd * gg[i].x, og.y * s1 * rstd * gg[i].y, og.z * s2 * rstd * gg[i].z, og.w * s3 * rstd * gg[i].w);
    }
  }
}

DI void phase_D1(const Params& p, const Ctx& c, int l, u16* lds) {
  const int tid = opaque_tid(), lane = tid & 63, wave = tid >> 6, wm = wave & 3, wn = wave >> 2, lr = lane & 15, lg = lane >> 4;
  const u16* W = c.W + (long)l * WROWS * D;
  const u16* Ryc = c.R2; const u16* Rym = c.R3; u16* Rmg = c.R4;
  const int nTiles = (c.Tg / 128) * 8;
  for (int tile = blockIdx.x; tile < nTiles; tile += gridDim.x) {
    const int ch = tile >> 3, mt = tile & 7;
    f32x4 a2[2][4], M[2][4];
    uint2 gk[4][4];
    {
      f32x4 a1[4][4];
      gemm_tile<4, 4, 3>(W + (long)(W_G + mt * 256) * D, c.Rh + (long)ch * 128 * D, a1, lds);
#pragma unroll
      for (int i = 0; i < 4; i++)
#pragma unroll
        for (int jn = 0; jn < 4; jn++)
          gk[i][jn] = pack4(sigmoidf_(a1[i][jn][0]), sigmoidf_(a1[i][jn][1]), sigmoidf_(a1[i][jn][2]), sigmoidf_(a1[i][jn][3]));
    }
    gemm_tile<2, 4, 3>(W + (long)(W_PC + mt * 128) * D, Ryc + (long)ch * 128 * D, a2, lds);
#pragma unroll
    for (int i = 0; i < 2; i++)
#pragma unroll
      for (int jn = 0; jn < 4; jn++) {
        const float4 gg = unpack4(gk[2 * i][jn]);
        M[i][jn] = (f32x4){gg.x * a2[i][jn][0], gg.y * a2[i][jn][1], gg.z * a2[i][jn][2], gg.w * a2[i][jn][3]};
      }
    gemm_tile<2, 4, 3>(W + (long)(W_PM + mt * 128) * D, Rym + (long)ch * 128 * D, a2, lds);
#pragma unroll
    for (int i = 0; i < 2; i++)
#pragma unroll
      for (int jn = 0; jn < 4; jn++) {
        const float4 gg = unpack4(gk[2 * i + 1][jn]);
        const int col = mt * 128 + 32 * wm + 16 * i + 4 * lg;
        const long lt = ch * 128 + 64 * wn + 16 * jn + lr;
        *(uint2*)(Rmg + lt * D + col) = pack4(M[i][jn][0] + gg.x * a2[i][jn][0], M[i][jn][1] + gg.y * a2[i][jn][1],
                                              M[i][jn][2] + gg.z * a2[i][jn][2], M[i][jn][3] + gg.w * a2[i][jn][3]);
      }
  }
}

DI void phase_D2(const Params& p, const Ctx& c, int l, int g, u16* lds) {
  const int tid = opaque_tid(), lane = tid & 63, wave = tid >> 6, wm = wave & 3, wn = wave >> 2, lr = lane & 15, lg = lane >> 4;
  const u16* W = c.W + ((long)l * WROWS + W_O) * D;
  const u16* Rmg = c.R4;
  const int nTiles = (c.Tg / 256) * 4;
  for (int tile = blockIdx.x; tile < nTiles; tile += gridDim.x) {
    const int tb = tile >> 2, pt = tile & 3;
    f32x4 acc[4][8];
    gemm_tile<4, 8, 2>(W + (long)pt * 256 * D, Rmg + (long)tb * 256 * D, acc, lds);
    const int tok0 = gtok(c, g, tb * 256);
    const float* gp = c.mod + ((long)l * 40 + batch_of(tok0)) * 3072 + 2048;
#pragma unroll
    for (int i = 0; i < 4; i++) {
      const int col = pt * 256 + 64 * wm + 16 * i + 4 * lg;
      const float4 gt = *(const float4*)(gp + col);
      float4 xv[8];
#pragma unroll
      for (int jn = 0; jn < 8; jn++) {
        const int tok = tok0 + 128 * wn + 16 * jn + lr;
        const float* xr = (l == 0) ? xin_row(p, tok) : p.out + (long)tok * D;
        xv[jn] = *(const float4*)(xr + col);
      }
#pragma unroll
      for (int jn = 0; jn < 8; jn++) {
        const int tok = tok0 + 128 * wn + 16 * jn + lr;
        float4 o;
        o.x = xv[jn].x + gt.x * acc[i][jn][0]; o.y = xv[jn].y + gt.y * acc[i][jn][1];
        o.z = xv[jn].z + gt.z * acc[i][jn][2]; o.w = xv[jn].w + gt.w * acc[i][jn][3];
        *(float4*)(p.out + (long)tok * D + col) = o;
      }
    }
  }
}

__global__ void __launch_bounds__(NT) mega(Params p) {
  extern __shared__ __attribute__((aligned(16))) char smem[];
  cg::grid_group grid = cg::this_grid();
  Ctx c;
  c.G = p.G; c.Tg = 131072 / p.G; c.half = c.Tg >> 1;
  const size_t REG = (size_t)c.Tg * D * 2;
  c.Rh = (u16*)(p.ws); c.R1 = (u16*)(p.ws + REG); c.R2 = (u16*)(p.ws + 2 * REG); c.R3 = (u16*)(p.ws + 3 * REG);
  c.R4 = (u16*)(p.ws + 4 * REG); c.Rhf = (u16*)(p.ws + 5 * REG); c.Rhb = (u16*)(p.ws + 6 * REG);
  unsigned char* q = p.ws + 7 * REG;
  c.W = (u16*)q; q += (size_t)DEPTH * WROWS * D * 2;
  c.mod = (float*)q; q += (size_t)DEPTH * 40 * 3072 * 4;
  c.sc = (float*)q; q += (size_t)c.Tg * 96;
  c.ctr = (int*)q; q += 4096;
  unsigned* xbar = (unsigned*)q;
  __shared__ uint4 xb_words;
  if (threadIdx.x == 0) xb_words = make_uint4(0u, 0u, 0u, 0u);
  __syncthreads();
  XcdBarrier xb = xcd_barrier_post(xbar, (volatile LAS unsigned*)&xb_words);

  phase_prep(p, c, (float*)smem);
  grid.sync();
  for (int g = 0; g < c.G; ++g) {
    for (int l = 0; l < DEPTH; ++l) {
      phase_rows(p, c, l, g, false);
      xcd_barrier(xb);
      phase_A(p, c, l, (u16*)smem);
      xcd_barrier(xb);
      phase_scan(p, c, g * DEPTH + l, smem);
      xcd_barrier(xb);
      phase_C(p, c, l, (u16*)smem);
      xcd_barrier(xb);
      phase_E(p, c, l);
      xcd_barrier(xb);
      phase_D1(p, c, l, (u16*)smem);
      xcd_barrier(xb);
      phase_D2(p, c, l, g, (u16*)smem);
      xcd_barrier(xb);
    }
    phase_rows(p, c, DEPTH, g, true);
  }
}

extern "C" void kernel_launch(void* const* d_in, const int* in_sizes, int n_in, void* d_out, int out_size,
                              void* d_ws, size_t ws_size, hipStream_t stream) {
  static int grid_blocks = 0;
  static int Gsel = 2;
  if (!grid_blocks) {
    int dev = 0, cus = 0, per_cu = 0;
    hipGetDevice(&dev);
    hipDeviceGetAttribute(&cus, hipDeviceAttributeMultiprocessorCount, dev);
    hipFuncSetAttribute((const void*)mega, hipFuncAttributeMaxDynamicSharedMemorySize, LDS_BYTES);
    hipOccupancyMaxActiveBlocksPerMultiprocessor(&per_cu, (const void*)mega, NT, LDS_BYTES);
    if (per_cu < 1) per_cu = 1;
    grid_blocks = cus * per_cu;
    const size_t fixed = (size_t)DEPTH * WROWS * D * 2 + (size_t)DEPTH * 40 * 3072 * 4 + 4096 + XCD_BAR_WORDS * 4;
    Gsel = 2;
    while (Gsel < 8 && 7 * ((size_t)(131072 / Gsel) * D * 2) + fixed + (size_t)(131072 / Gsel) * 96 > ws_size) Gsel *= 2;
  }
  Params p{};
  p.x_prompt = (const float*)d_in[0]; p.x_sample = (const float*)d_in[1]; p.c_prompt = (const float*)d_in[2]; p.c_sample = (const float*)d_in[3];
  p.w_ada = (const float*)d_in[4]; p.b_ada = (const float*)d_in[5]; p.norm_g = (const float*)d_in[6]; p.w_in = (const float*)d_in[7];
  p.b_gates = (const float*)d_in[8]; p.conv_w = (const float*)d_in[9]; p.conv_b = (const float*)d_in[10]; p.mh_norm_g = (const float*)d_in[11];
  p.w_pc = (const float*)d_in[12]; p.w_pm = (const float*)d_in[13]; p.w_out = (const float*)d_in[14]; p.final_g = (const float*)d_in[15];
  p.out = (float*)d_out; p.ws = (unsigned char*)d_ws; p.G = Gsel; p.pad = 0;
  {
    const size_t Tg = 131072 / Gsel;
    const size_t off = 7 * (Tg * D * 2) + (size_t)DEPTH * WROWS * D * 2 + (size_t)DEPTH * 40 * 3072 * 4 + Tg * 96 + 4096;
    (void)hipMemsetAsync((unsigned char*)d_ws + off, 0, XCD_BAR_WORDS * 4, stream);
  }
  void* args[] = {&p};
  hipError_t e = hipLaunchCooperativeKernel((const void*)mega, dim3(grid_blocks), dim3(NT), args, LDS_BYTES, stream);
  if (e != hipSuccess) fprintf(stderr, "cooperative launch failed: %s (grid %d)\n", hipGetErrorString(e), grid_blocks);
}
```

```cpp
#include <hip/hip_runtime.h>
#include <hip/hip_cooperative_groups.h>
#include <cstdio>
namespace cg = cooperative_groups;

typedef unsigned short u16;
using bf16x8 = __attribute__((ext_vector_type(8))) short;
using f32x4  = __attribute__((ext_vector_type(4))) float;
using s16x4  = __attribute__((ext_vector_type(4))) short;
using u32x4  = __attribute__((ext_vector_type(4))) unsigned;
#define DI __device__ __forceinline__

constexpr int D = 1024, DIN = 11280, DEPTH = 4;
constexpr int NT = 512;
constexpr int W_QKV = 0, W_C = 3328, W_G = 9472, W_PC = 11520, W_PM = 12544, W_O = 13568, WROWS = 14592;
constexpr int LDT = 72;
constexpr int KS = 264, VS = 136;
constexpr int LDS_BYTES = (128 * KS + 2 * 80 * VS + 80 * KS) * 2 + 4 * 128 * 4;

struct Params {
  const float* x_prompt; const float* x_sample; const float* c_prompt; const float* c_sample;
  const float* w_ada; const float* b_ada; const float* norm_g; const float* w_in; const float* b_gates;
  const float* conv_w; const float* conv_b; const float* mh_norm_g; const float* w_pc; const float* w_pm;
  const float* w_out; const float* final_g;
  float* out; unsigned char* ws;
  int G; int pad;
};

struct Ctx {
  int G, Tg, half;
  u16 *Rh, *R1, *R2, *R3, *R4, *Rhf, *Rhb;
  u16* W; float* mod; float* sc; int* ctr;
};

DI u16 f2bf(float x) { unsigned u = __float_as_uint(x); u += 0x7fffu + ((u >> 16) & 1u); return (u16)(u >> 16); }
DI float bf2f(unsigned h) { return __uint_as_float(h << 16); }
DI unsigned pack2(float a, float b) { return (unsigned)f2bf(a) | ((unsigned)f2bf(b) << 16); }
DI uint2 pack4(float a, float b, float c, float d) { uint2 r; r.x = pack2(a, b); r.y = pack2(c, d); return r; }
DI uint2 pack4v(f32x4 v) { return pack4(v[0], v[1], v[2], v[3]); }
DI float4 unpack4(uint2 v) { float4 r; r.x = bf2f(v.x & 0xffffu); r.y = bf2f(v.x >> 16); r.z = bf2f(v.y & 0xffffu); r.w = bf2f(v.y >> 16); return r; }
DI float sigmoidf_(float x) { return 1.f / (1.f + __expf(-x)); }
DI float siluf_(float x) { return x * sigmoidf_(x); }
DI float wave_sum(float v) {
#pragma unroll
  for (int o = 32; o >= 1; o >>= 1) v += __shfl_xor(v, o);
  return v;
}
DI int opaque_tid() { int t = threadIdx.x; asm volatile("" : "+v"(t)); return t; }
DI f32x4 mfma16(bf16x8 a, bf16x8 b, f32x4 c) { return __builtin_amdgcn_mfma_f32_16x16x32_bf16(a, b, c, 0, 0, 0); }


typedef const Params __attribute__((address_space(4))) CParams;
template <class PT> DI Ctx make_ctx(const PT& p) {
  Ctx c;
  c.G = p.G; c.Tg = 131072 / p.G; c.half = c.Tg >> 1;
  const size_t REG = (size_t)c.Tg * D * 2;
  unsigned char* ws = p.ws;
  c.Rh = (u16*)(ws); c.R1 = (u16*)(ws + REG); c.R2 = (u16*)(ws + 2 * REG); c.R3 = (u16*)(ws + 3 * REG);
  c.R4 = (u16*)(ws + 4 * REG); c.Rhf = (u16*)(ws + 5 * REG); c.Rhb = (u16*)(ws + 6 * REG);
  unsigned char* q = ws + 7 * REG;
  c.W = (u16*)q; q += (size_t)DEPTH * WROWS * D * 2;
  c.mod = (float*)q; q += (size_t)DEPTH * 40 * 3072 * 4;
  c.sc = (float*)q; q += (size_t)c.Tg * 96;
  c.ctr = (int*)q;
  return c;
}
DI const CParams* launder_params(const Params* g) { asm volatile("" : "+s"(g)); return (const CParams*)(unsigned long long)g; }
DI int gtok(const Ctx& c, int g, int lt) { return lt < c.half ? g * c.half + lt : 65536 + g * c.half + (lt - c.half); }
DI int batch_of(int tok) { return tok < 65536 ? (tok >> 13) : 8 + ((tok - 65536) >> 11); }
template <class PT> DI const float* xin_row(const PT& p, int tok) {
  return tok < 65536 ? p.x_prompt + (long)tok * D : p.x_sample + (long)(tok - 65536) * D;
}


#define XB_TMO      128
#define XB_XCNT(j)  (256  + 64 * (j))
#define XB_XSUB(j)  (1280 + 64 * (j))
#define XB_XGEN(j)  (2304 + 64 * (j))
#define XB_TOP      3328
#define XB_TOPGEN   3392
#define XCD_BAR_WORDS 3456
#define XB_SPIN_CAP (1u << 18)
#define LAS __attribute__((address_space(3)))
DI unsigned xb_ld(unsigned* p)              { return __hip_atomic_load(p, __ATOMIC_RELAXED, __HIP_MEMORY_SCOPE_AGENT); }
DI unsigned xb_add(unsigned* p, unsigned v) { return __hip_atomic_fetch_add(p, v, __ATOMIC_RELAXED, __HIP_MEMORY_SCOPE_AGENT); }
DI unsigned xb_xcc_id() { return (unsigned)__builtin_amdgcn_s_getreg((3 << 11) | 20) & 0xFu; }
#define XB_SPIN(cond, bar) do { unsigned _sp = 0; while (cond) { __builtin_amdgcn_s_sleep(1); \
    if ((++_sp & 255u) == 0u) { if (xb_ld(&(bar)[XB_TMO])) break; if (_sp > XB_SPIN_CAP) { atomicAdd(&(bar)[XB_TMO], 1u); break; } } } } while (0)
struct XcdBarrier { unsigned* bar; unsigned x; volatile LAS unsigned* st; };
DI XcdBarrier xcd_barrier_post(unsigned* bar, volatile LAS unsigned* st) {
  XcdBarrier b; b.bar = bar; b.x = xb_xcc_id(); b.st = st;
  if (threadIdx.x == 0) (void)xb_add(&bar[XB_XCNT(b.x)], 1u);
  return b;
}
DI void xcd_barrier_complete(unsigned* bar, unsigned x, unsigned& nloc, unsigned& nx) {
  const unsigned G = gridDim.x * gridDim.y * gridDim.z;
  unsigned sum, cnt, mine, sp = 0u;
  for (;;) {
    sum = 0u; cnt = 0u; mine = 0u;
#pragma unroll
    for (unsigned j = 0; j < 16; ++j) { const unsigned c = xb_ld(&bar[XB_XCNT(j)]); sum += c; cnt += (c > 0u) ? 1u : 0u; }
    mine = xb_ld(&bar[XB_XCNT(x)]);
    if (sum == G) break;
    __builtin_amdgcn_s_sleep(1);
    if ((++sp & 255u) == 0u) { if (xb_ld(&bar[XB_TMO])) break; if (sp > XB_SPIN_CAP) { atomicAdd(&bar[XB_TMO], 1u); break; } }
  }
  nloc = mine > 0u ? mine : 1u; nx = cnt > 0u ? cnt : 1u;
}
DI void xcd_barrier(const XcdBarrier& b) {
  asm volatile("s_waitcnt vmcnt(0)" ::: "memory");
  __syncthreads();
  if (threadIdx.x == 0) {
    unsigned* bar = b.bar;
    asm volatile("" : "+s"(bar));
    __builtin_amdgcn_s_waitcnt(0);
    unsigned nloc = b.st[0], nx = b.st[1];
    if (nloc == 0u) { xcd_barrier_complete(bar, b.x, nloc, nx); b.st[0] = nloc; b.st[1] = nx; }
    const unsigned old = xb_add(&bar[XB_XSUB(b.x)], 1u);
    const unsigned gen = old / nloc;
    if (old + 1u == (gen + 1u) * nloc) {
      __builtin_amdgcn_fence(__ATOMIC_RELEASE, "agent");
      asm volatile("s_waitcnt vmcnt(0)" ::: "memory");
      const unsigned og = xb_add(&bar[XB_TOP], 1u);
      const unsigned tg = og / nx;
      if (og + 1u == (tg + 1u) * nx) xb_add(&bar[XB_TOPGEN], 1u);
      else XB_SPIN(xb_ld(&bar[XB_TOPGEN]) == tg, bar);
      __builtin_amdgcn_fence(__ATOMIC_ACQUIRE, "agent");
      xb_add(&bar[XB_XGEN(b.x)], 1u);
      asm volatile("s_waitcnt vmcnt(0)" ::: "memory");
    } else {
      XB_SPIN(xb_ld(&bar[XB_XGEN(b.x)]) == gen, bar);
      __builtin_amdgcn_fence(__ATOMIC_ACQUIRE, "agent");
      asm volatile("s_waitcnt vmcnt(0)" ::: "memory");
    }
  }
  __syncthreads();
}

template <int MT, int NT, int ST>
DI void gemm_tile(const u16* __restrict__ P, const u16* __restrict__ Q, f32x4 (&acc)[MT][NT], u16* lds,
                  const u16* Pn = nullptr, const u16* Qn = nullptr, bool primed = false) {
  const int tid = opaque_tid(), lane = tid & 63, wave = __builtin_amdgcn_readfirstlane(tid >> 6), wm = wave & 3, wn = wave >> 2;
  const int lr = lane & 15, lg = lane >> 4;
  constexpr int PROWS = 64 * MT, QROWS = 32 * NT, NQI = NT / 2, NDMA = MT + NQI;
  char* pbase = (char*)lds;
  char* qbase = pbase + ST * PROWS * 128;
  const int drow = lane >> 3, dpos = lane & 7;
  const int r0 = 8 * wave + drow;
  const unsigned voff = (unsigned)(r0 * D + ((dpos ^ ((r0 >> 1) & 7)) << 3)) * 2u;
  const char* Pc = (const char*)P; const char* Qc = (const char*)Q;
  char* dp = pbase + wave * 1024 + lane * 16;
  char* dq = qbase + wave * 1024 + lane * 16;
#pragma unroll
  for (int i = 0; i < MT; i++)
#pragma unroll
    for (int j = 0; j < NT; j++) acc[i][j] = (f32x4){0.f, 0.f, 0.f, 0.f};
  if (!primed) {
#pragma unroll
    for (int t0 = 0; t0 < ST - 1; t0++) {
#pragma unroll
      for (int i = 0; i < MT; i++) __builtin_amdgcn_global_load_lds((const unsigned*)(Pc + (i * 64 * D * 2 + t0 * 128) + voff), (unsigned*)(dp + t0 * PROWS * 128 + i * 8192), 16, 0, 0);
#pragma unroll
      for (int i = 0; i < NQI; i++) __builtin_amdgcn_global_load_lds((const unsigned*)(Qc + (i * 64 * D * 2 + t0 * 128) + voff), (unsigned*)(dq + t0 * QROWS * 128 + i * 8192), 16, 0, 0);
    }
  }
  asm volatile("s_waitcnt vmcnt(%0)" :: "n"((ST - 2) * NDMA) : "memory");
  __builtin_amdgcn_s_barrier();
  asm volatile("" ::: "memory");
  const int swz = (lr >> 1) & 7;
  const int o0 = (lg ^ swz) << 4, o1 = ((4 + lg) ^ swz) << 4;
  const char* pa = pbase + (wm * 16 * MT + lr) * 128;
  const char* qa = qbase + (wn * 16 * NT + lr) * 128;
  constexpr int NK = D / 64;
  int cur = 0, nxs = ST - 1;
  for (int kt = 0; kt < NK; ++kt) {
    if (kt + ST - 1 < NK) {
#pragma unroll
      for (int i = 0; i < MT; i++) __builtin_amdgcn_global_load_lds((const unsigned*)(Pc + (i * 64 * D * 2 + (kt + ST - 1) * 128) + voff), (unsigned*)(dp + nxs * PROWS * 128 + i * 8192), 16, 0, 0);
#pragma unroll
      for (int i = 0; i < NQI; i++) __builtin_amdgcn_global_load_lds((const unsigned*)(Qc + (i * 64 * D * 2 + (kt + ST - 1) * 128) + voff), (unsigned*)(dq + nxs * QROWS * 128 + i * 8192), 16, 0, 0);
    }
    if (ST == 2 && kt == NK - 1 && Pn != nullptr) {
      const char* Pnc = (const char*)Pn; const char* Qnc = (const char*)Qn;
#pragma unroll
      for (int i = 0; i < MT; i++) __builtin_amdgcn_global_load_lds((const unsigned*)(Pnc + (i * 64 * D * 2) + voff), (unsigned*)(dp + i * 8192), 16, 0, 0);
#pragma unroll
      for (int i = 0; i < NQI; i++) __builtin_amdgcn_global_load_lds((const unsigned*)(Qnc + (i * 64 * D * 2) + voff), (unsigned*)(dq + i * 8192), 16, 0, 0);
    }
    const char* pb = pa + cur * PROWS * 128;
    const char* qb = qa + cur * QROWS * 128;
    if constexpr (NT == 8) {
      bf16x8 af[MT], b0[NT], b1[NT];
#pragma unroll
      for (int j = 0; j < NT; j++) b0[j] = *(const bf16x8*)(qb + j * 2048 + o0);
#pragma unroll
      for (int i = 0; i < MT; i++) af[i] = *(const bf16x8*)(pb + i * 2048 + o0);
#pragma unroll
      for (int i = 0; i < MT; i++) {
#pragma unroll
        for (int j = 0; j < NT; j++) acc[i][j] = mfma16(af[i], b0[j], acc[i][j]);
        b1[i] = *(const bf16x8*)(qb + i * 2048 + o1);
        af[i] = *(const bf16x8*)(pb + i * 2048 + o1);
      }
#pragma unroll
      for (int j = MT; j < NT; j++) b1[j] = *(const bf16x8*)(qb + j * 2048 + o1);
#pragma unroll
      for (int i = 0; i < MT; i++)
#pragma unroll
        for (int j = 0; j < NT; j++) acc[i][j] = mfma16(af[i], b1[j], acc[i][j]);
      __builtin_amdgcn_sched_group_barrier(0x100, NT + MT, 0);
#pragma unroll
      for (int r = 0; r < MT; r++) {
        __builtin_amdgcn_sched_group_barrier(0x008, 4, 0);
        __builtin_amdgcn_sched_group_barrier(0x100, 1, 0);
        __builtin_amdgcn_sched_group_barrier(0x008, 4, 0);
        __builtin_amdgcn_sched_group_barrier(0x100, 1, 0);
      }
      __builtin_amdgcn_sched_group_barrier(0x100, NT - MT, 0);
      __builtin_amdgcn_sched_group_barrier(0x008, MT * NT, 0);
    } else {
#pragma unroll
      for (int ks = 0; ks < 2; ++ks) {
        const int oo = ks ? o1 : o0;
        bf16x8 a[MT], b[NT];
#pragma unroll
        for (int i = 0; i < MT; i++) a[i] = *(const bf16x8*)(pb + i * 2048 + oo);
#pragma unroll
        for (int j = 0; j < NT; j++) b[j] = *(const bf16x8*)(qb + j * 2048 + oo);
#pragma unroll
        for (int i = 0; i < MT; i++)
#pragma unroll
          for (int j = 0; j < NT; j++) acc[i][j] = mfma16(a[i], b[j], acc[i][j]);
      }
    }
    if (kt + ST - 1 < NK) asm volatile("s_waitcnt vmcnt(%0)" :: "n"((ST - 2) * NDMA) : "memory");
    else if (!(ST == 2 && Pn != nullptr)) asm volatile("s_waitcnt vmcnt(0)" ::: "memory");
    __builtin_amdgcn_s_barrier();
    asm volatile("" ::: "memory");
    cur = (cur == ST - 1) ? 0 : cur + 1;
    nxs = (nxs == ST - 1) ? 0 : nxs + 1;
  }
}

template <class PT> DI void wsrc(const PT& p, int l, int n, const float*& src, int& ld, int& col, float& scale) {
  scale = 1.f;
  src = p.w_in + (long)l * D * DIN; ld = DIN;
  if (n < W_C) {
    if (n < 1024) col = 4096 + n;
    else if (n < 2048) { col = 5120 + (n - 1024); scale = 0.0625f; }
    else if (n < 3072) col = 6144 + (n - 2048);
    else if (n < 3088) col = 9216 + (n - 3072);
    else col = -1;
  } else if (n < W_G) {
    int n2 = n - W_C;
    if (n2 < 4096) { int blk = n2 >> 6, sl = (n2 >> 4) & 3, cl = n2 & 15; col = sl * 1024 + blk * 16 + cl; }
    else { int n3 = n2 - 4096; int blk = n3 >> 5, sl = (n3 >> 4) & 1, cl = n3 & 15; col = (sl ? 8192 : 7168) + blk * 16 + cl; }
  } else if (n < W_PC) {
    int n4 = n - W_G; int blk = n4 >> 5, sl = (n4 >> 4) & 1, cl = n4 & 15; col = 9232 + sl * 1024 + blk * 16 + cl;
  } else if (n < W_PM) { src = p.w_pc + (long)l * D * D; ld = D; col = n - W_PC; }
  else if (n < W_O)  { src = p.w_pm + (long)l * D * D; ld = D; col = n - W_PM; }
  else               { src = p.w_out + (long)l * D * D; ld = D; col = n - W_O; }
}

template <class PT> DI void phase_prep(const PT& p, const Ctx& c, float* ldsf) {
  const int tid = opaque_tid();
  if (blockIdx.x == 0 && tid < 64) c.ctr[tid] = 0;
  const int nItems = DEPTH * (WROWS / 64) * 16;
  for (int it = blockIdx.x; it < nItems; it += gridDim.x) {
    const int kb = (it & 15) * 64; const int rb = it >> 4;
    const int l = rb / (WROWS / 64); const int nb = (rb % (WROWS / 64)) * 64;
    const float* src; int ld, col; float scale;
    const int nl = tid & 63;
    wsrc(p, l, nb + nl, src, ld, col, scale);
#pragma unroll
    for (int i = 0; i < 8; i++) {
      const int kl = (tid >> 6) + 8 * i;
      float v = (col >= 0) ? src[(long)(kb + kl) * ld + col] * scale : 0.f;
      ldsf[kl * 65 + nl] = v;
    }
    __syncthreads();
    {
      const int nl2 = tid >> 3, kc = tid & 7;
      float v[8];
#pragma unroll
      for (int j = 0; j < 8; j++) v[j] = ldsf[(kc * 8 + j) * 65 + nl2];
      uint4 o; o.x = pack2(v[0], v[1]); o.y = pack2(v[2], v[3]); o.z = pack2(v[4], v[5]); o.w = pack2(v[6], v[7]);
      *(uint4*)(c.W + ((long)l * WROWS + nb + nl2) * D + kb + kc * 8) = o;
    }
    __syncthreads();
  }
  const int nMod = DEPTH * 48;
  for (int it = blockIdx.x; it < nMod; it += gridDim.x) {
    const int l = it / 48, jb = (it % 48) * 64;
    const int cl = tid & 63, kc = tid >> 6;
    float acc[40];
#pragma unroll
    for (int b = 0; b < 40; b++) acc[b] = 0.f;
    const float* wa = p.w_ada + (long)l * D * 3072 + jb + cl;
    for (int k = kc * 128; k < kc * 128 + 128; ++k) {
      const float wv = wa[(long)k * 3072];
#pragma unroll
      for (int b = 0; b < 40; b++) {
        const float cv = (b < 8) ? p.c_prompt[b * D + k] : p.c_sample[(b - 8) * D + k];
        acc[b] += cv * wv;
      }
    }
#pragma unroll
    for (int b = 0; b < 40; b++) ldsf[(kc * 40 + b) * 64 + cl] = acc[b];
    __syncthreads();
    for (int idx = tid; idx < 40 * 64; idx += NT) {
      const int b = idx >> 6, cc = idx & 63;
      float s = p.b_ada[l * 3072 + jb + cc];
#pragma unroll
      for (int q = 0; q < 8; q++) s += ldsf[(q * 40 + b) * 64 + cc];
      c.mod[((long)l * 40 + b) * 3072 + jb + cc] = s;
    }
    __syncthreads();
  }
}

template <class PT> DI void phase_rows(const PT& p, const Ctx& c, int l, int g, bool fin) {
  const int tid_ = opaque_tid(); const int lane = tid_ & 63, w = tid_ >> 6;
  for (int lt = blockIdx.x * 8 + w; lt < c.Tg; lt += gridDim.x * 8) {
    const int tok = gtok(c, g, lt);
    const float* xr = (l == 0) ? xin_row(p, tok) : p.out + (long)tok * D;
    float4 v[4]; float ss = 0.f;
#pragma unroll
    for (int i = 0; i < 4; i++) {
      v[i] = *(const float4*)(xr + 4 * lane + 256 * i);
      ss += v[i].x * v[i].x + v[i].y * v[i].y + v[i].z * v[i].z + v[i].w * v[i].w;
    }
    ss = wave_sum(ss);
    const float rstd = rsqrtf(ss * (1.f / 1024.f) + 1e-6f);
    if (fin) {
#pragma unroll
      for (int i = 0; i < 4; i++) {
        const int k = 4 * lane + 256 * i;
        const float4 fg = *(const float4*)(p.final_g + k);
        float4 o; o.x = v[i].x * rstd * fg.x; o.y = v[i].y * rstd * fg.y; o.z = v[i].z * rstd * fg.z; o.w = v[i].w * rstd * fg.w;
        *(float4*)(p.out + (long)tok * D + k) = o;
      }
    } else {
      const float* mp = c.mod + ((long)l * 40 + batch_of(tok)) * 3072;
      float4 ngv[4], sclv[4], shv[4];
#pragma unroll
      for (int i = 0; i < 4; i++) {
        const int k = 4 * lane + 256 * i;
        ngv[i] = *(const float4*)(p.norm_g + l * D + k); sclv[i] = *(const float4*)(mp + 1024 + k); shv[i] = *(const float4*)(mp + k);
      }
#pragma unroll
      for (int i = 0; i < 4; i++) {
        const int k = 4 * lane + 256 * i;
        const float4 ng = ngv[i], scl = sclv[i], sh = shv[i];
        const float h0 = v[i].x * rstd * ng.x * (1.f + scl.x) + sh.x;
        const float h1 = v[i].y * rstd * ng.y * (1.f + scl.y) + sh.y;
        const float h2 = v[i].z * rstd * ng.z * (1.f + scl.z) + sh.z;
        const float h3 = v[i].w * rstd * ng.w * (1.f + scl.w) + sh.w;
        *(uint2*)(c.Rh + (long)lt * D + k) = pack4(h0, h1, h2, h3);
      }
    }
  }
}

template <class PT> DI void phase_A(const PT& p, const Ctx& c, int l, u16* lds) {
  const int tid = opaque_tid(), lane = tid & 63, wave = tid >> 6, wm = wave & 3, wn = wave >> 2, lr = lane & 15, lg = lane >> 4;
  const u16* W = c.W + (long)l * WROWS * D;
  u16* Rq = c.R1; u16* Rk = c.R2; u16* RvT = c.R4;
  const int nTiles = (c.Tg / 256) * 13;
  auto ptrsA = [&](int tl, const u16*& Pp, const u16*& Qp) {
    const int tb_ = tl / 13, j_ = tl % 13;
    const u16* hp = c.Rh + (long)tb_ * 256 * D;
    if (j_ < 8) { Pp = W + (long)((j_ >> 2) * 1024 + (j_ & 3) * 256) * D; Qp = hp; }
    else if (j_ < 12) { Pp = hp; Qp = W + (long)(2048 + (j_ - 8) * 256) * D; }
    else { Pp = W + (long)3072 * D; Qp = hp; }
  };
  bool primed = false;
  for (int tile = blockIdx.x; tile < nTiles; tile += gridDim.x) {
    const int tb = tile / 13, j = tile % 13;
    f32x4 acc[4][8];
    const u16 *P0, *Q0, *P1 = nullptr, *Q1 = nullptr;
    ptrsA(tile, P0, Q0);
    if (tile + (int)gridDim.x < nTiles && j != 12) ptrsA(tile + gridDim.x, P1, Q1);
    const bool pr = primed; primed = (P1 != nullptr);
    if (j < 8) {
      const int isk = j >> 2, head = j & 3;
      gemm_tile<4, 8, 2>(P0, Q0, acc, lds, P1, Q1, pr);
      u16* dst = isk ? Rk : Rq;
#pragma unroll
      for (int i = 0; i < 4; i++)
#pragma unroll
        for (int jn = 0; jn < 8; jn++) {
          const int d = 64 * wm + 16 * i + 4 * lg, t = 128 * wn + 16 * jn + lr;
          *(uint2*)(dst + (long)(tb * 256 + t) * D + head * 256 + d) = pack4v(acc[i][jn]);
        }
    } else if (j < 12) {
      const int head = j - 8;
      gemm_tile<4, 8, 2>(P0, Q0, acc, lds, P1, Q1, pr);
#pragma unroll
      for (int i = 0; i < 4; i++)
#pragma unroll
        for (int jn = 0; jn < 8; jn++) {
          const int tokl = 64 * wm + 16 * i + 4 * lg, e = 128 * wn + 16 * jn + lr;
          const int ch = tb * 2 + (tokl >> 7), sidx = tokl & 127;
          *(uint2*)(RvT + ((long)(ch * 4 + head) * 256 + e) * 128 + sidx) = pack4v(acc[i][jn]);
        }
    } else {
      gemm_tile<4, 8, 2>(P0, Q0, acc, lds, P1, Q1, pr);
      float* gl = (float*)lds;
      if (wm == 0) {
#pragma unroll
        for (int jn = 0; jn < 8; jn++) {
          const int t = 128 * wn + 16 * jn + lr;
#pragma unroll
          for (int r = 0; r < 4; r++) {
            float v = acc[0][jn][r] + p.b_gates[l * 16 + lg * 4 + r];
            if (lg & 1) v = fminf(v, 0.f) - log1pf(expf(-fabsf(v)));
            gl[t * 16 + lg * 4 + r] = v;
          }
        }
      }
      __syncthreads();
      if (tid < 16) {
        const int head = tid & 3, dir = (tid >> 2) & 1, cl = tid >> 3;
        const int ch = tb * 2 + cl;
        float* o = c.sc + (((long)(ch * 4 + head) * 2 + dir) * 3) * 128;
        const float* glc = gl + cl * 128 * 16;
        float bs = 0.f, pm = -3.0e38f;
        for (int q = 0; q < 128; ++q) {
          const int t = dir ? 127 - q : q;
          const float iv = glc[t * 16 + dir * 8 + head], lf = glc[t * 16 + dir * 8 + 4 + head];
          bs += lf; const float gg = iv - bs; pm = fmaxf(pm, gg);
          o[t] = bs; o[128 + t] = gg; o[256 + t] = pm;
        }
      }
      __syncthreads();
    }
  }
}

template <class PT> DI void phase_scan(const PT& p, const Ctx& c, int ctrIdx, char* smem) {
  __shared__ int s_task;
  const int tid = opaque_tid(), lane = tid & 63, w0 = __builtin_amdgcn_readfirstlane(tid >> 6), lr = lane & 15, lg = lane >> 4;
  u16* Kb = (u16*)smem;
  u16* Vt = Kb + 128 * KS;
  u16* Vw = Vt + 80 * VS;
  u16* Ct = Vw + 80 * VS;
  float* scg = (float*)(Ct + 80 * KS); float* scmu = scg + 128; float* sciw = scmu + 128; float* scfl = sciw + 128;
  const u16* Rq = c.R1; const u16* Rk = c.R2; const u16* RvT = c.R4;
  const int nLong = (8 / c.G) * 32, nTasks = nLong + (32 / c.G) * 32;
  int* ctr = c.ctr + ctrIdx;
  while (true) {
    __syncthreads();
    if (tid == 0) s_task = atomicAdd(ctr, 1);
    __syncthreads();
    const int task = s_task;
    if (task >= nTasks) break;
    int seq, r, chunk0, nc;
    if (task < nLong) { seq = task >> 5; r = task & 31; chunk0 = seq * 64; nc = 64; }
    else { const int t2 = task - nLong; seq = t2 >> 5; r = t2 & 31; chunk0 = (c.half >> 7) + seq * 16; nc = 16; }
    const int head = r >> 3, dir = (r >> 2) & 1, es = r & 3;
    const int last = dir ? 0 : 127;
    u16* Rho = dir ? c.Rhb : c.Rhf;
    for (int idx = tid; idx < 80 * KS / 2; idx += NT) ((unsigned*)Ct)[idx] = 0u;
    for (int idx = tid; idx < 16 * VS / 2; idx += NT) { ((unsigned*)(Vt + 64 * VS))[idx] = 0u; ((unsigned*)(Vw + 64 * VS))[idx] = 0u; }
    __syncthreads();
    if (tid < 128) Vt[64 * VS + tid] = (u16)0x3F80;
    f32x4 st[2][5];
#pragma unroll
    for (int i = 0; i < 2; i++)
#pragma unroll
      for (int jn = 0; jn < 5; jn++) st[i][jn] = (f32x4){0.f, 0.f, 0.f, 0.f};
    float m = 0.f;
    const int vrow = tid >> 4, vsc = tid & 15;
    const int krow = tid >> 5, kkc = (tid & 31) * 8;
    u32x4 kpre[8], vpre[2]; float4 g8a, g8b; float bLn, gmaxn, myb, myg, mypm;
    bf16x8 qf[8];
    auto scan_load = [&](int cq) {
#pragma unroll
      for (int ks = 0; ks < 8; ks++)
        qf[ks] = *(const bf16x8*)(Rq + (long)(cq * 128 + 16 * w0 + lr) * D + head * 256 + 32 * ks + 8 * lg);
#pragma unroll
      for (int i = 0; i < 8; i++) kpre[i] = *(const u32x4*)(Rk + (long)(cq * 128 + krow + 16 * i) * D + head * 256 + kkc);
#pragma unroll
      for (int i = 0; i < 2; i++) vpre[i] = *(const u32x4*)(RvT + ((long)(cq * 4 + head) * 256 + es * 64 + vrow + 32 * i) * 128 + vsc * 8);
      const float* scb = c.sc + ((long)(cq * 4 + head) * 2 + dir) * 384;
      g8a = *(const float4*)(scb + 128 + vsc * 8); g8b = *(const float4*)(scb + 128 + vsc * 8 + 4);
      bLn = scb[last]; gmaxn = scb[256 + last];
      myb = scb[tid & 127]; myg = scb[128 + (tid & 127)]; mypm = scb[256 + (tid & 127)];
    };
    scan_load(chunk0 + (dir ? nc - 1 : 0));
    for (int j = 0; j < nc; ++j) {
      const int cc = chunk0 + (dir ? nc - 1 - j : j);
      int w = w0; asm volatile("" : "+s"(w));
      __syncthreads();
      const float muL = fmaxf(m, gmaxn);
      const float decay = __expf(m - muL);
      const float mnext = bLn + muL;
#pragma unroll
      for (int i = 0; i < 2; i++)
#pragma unroll
        for (int jn = 0; jn < 5; jn++)
          *(uint2*)(Ct + (16 * jn + lr) * KS + 32 * w + 16 * i + 4 * lg) = pack4v(st[i][jn]);
#pragma unroll
      for (int i = 0; i < 8; i++) *(u32x4*)(Kb + (krow + 16 * i) * KS + kkc) = kpre[i];
      {
        float w8[8];
        w8[0] = __expf(g8a.x - muL); w8[1] = __expf(g8a.y - muL); w8[2] = __expf(g8a.z - muL); w8[3] = __expf(g8a.w - muL);
        w8[4] = __expf(g8b.x - muL); w8[5] = __expf(g8b.y - muL); w8[6] = __expf(g8b.z - muL); w8[7] = __expf(g8b.w - muL);
#pragma unroll
        for (int i = 0; i < 2; i++) {
          const u32x4 vv = vpre[i];
          *(u32x4*)(Vt + (vrow + 32 * i) * VS + vsc * 8) = vv;
          uint4 v; v.x = vv[0]; v.y = vv[1]; v.z = vv[2]; v.w = vv[3];
          uint4 o;
          o.x = pack2(bf2f(v.x & 0xffffu) * w8[0], bf2f(v.x >> 16) * w8[1]);
          o.y = pack2(bf2f(v.y & 0xffffu) * w8[2], bf2f(v.y >> 16) * w8[3]);
          o.z = pack2(bf2f(v.z & 0xffffu) * w8[4], bf2f(v.z >> 16) * w8[5]);
          o.w = pack2(bf2f(v.w & 0xffffu) * w8[6], bf2f(v.w >> 16) * w8[7]);
          *(uint4*)(Vw + (vrow + 32 * i) * VS + vsc * 8) = o;
        }
        if (tid < 16) {
          uint4 o; o.x = pack2(w8[0], w8[1]); o.y = pack2(w8[2], w8[3]); o.z = pack2(w8[4], w8[5]); o.w = pack2(w8[6], w8[7]);
          *(uint4*)(Vw + 64 * VS + vsc * 8) = o;
        }
      }
      if (tid < 128) {
        const float mu = fmaxf(m, mypm);
        scg[tid] = myg; scmu[tid] = mu; sciw[tid] = __expf(m - mu); scfl[tid] = __expf(-(mu + myb));
      }
      __syncthreads();
      const int t = 16 * w + lr;
      bf16x8 spk[4];
      {
        f32x4 sacc[8];
#pragma unroll
        for (int i = 0; i < 8; i++) sacc[i] = (f32x4){0.f, 0.f, 0.f, 0.f};
#pragma unroll
        for (int i = 0; i < 8; i++) {
          const bool need = dir ? (i >= w) : (i <= w);
          if (need) {
#pragma unroll
            for (int ks = 0; ks < 8; ks++) {
              const bf16x8 a = *(const bf16x8*)(Kb + (16 * i + lr) * KS + 32 * ks + 8 * lg);
              sacc[i] = mfma16(a, qf[ks], sacc[i]);
            }
          }
        }
        const float mu_t = scmu[t];
        int tt = t; asm volatile("" : "+v"(tt));
        const int sgn = dir ? -1 : 1;
#pragma unroll
        for (int ks = 0; ks < 4; ks++) {
          float sv[8];
#pragma unroll
          for (int hh = 0; hh < 2; hh++) {
            const int i = 2 * ks + hh;
            const float4 gs = *(const float4*)(scg + 16 * i + 4 * lg);
            const float gv[4] = {gs.x, gs.y, gs.z, gs.w};
#pragma unroll
            for (int r2 = 0; r2 < 4; r2++) {
              const int s = 16 * i + 4 * lg + r2;
              const bool valid = (s - tt) * sgn <= 0;
              sv[hh * 4 + r2] = valid ? sacc[i][r2] * __expf(gv[r2] - mu_t) : 0.f;
            }
          }
          uint4 o; o.x = pack2(sv[0], sv[1]); o.y = pack2(sv[2], sv[3]); o.z = pack2(sv[4], sv[5]); o.w = pack2(sv[6], sv[7]);
          spk[ks] = __builtin_bit_cast(bf16x8, o);
        }
      }
      f32x4 num[5];
#pragma unroll
      for (int i = 0; i < 5; i++) num[i] = (f32x4){0.f, 0.f, 0.f, 0.f};
#pragma unroll
      for (int ks = 0; ks < 8; ks++)
#pragma unroll
        for (int i = 0; i < 5; i++) {
          const bf16x8 a = *(const bf16x8*)(Ct + (16 * i + lr) * KS + 32 * ks + 8 * lg);
          num[i] = mfma16(a, qf[ks], num[i]);
        }
      {
        const float iw = sciw[t];
#pragma unroll
        for (int i = 0; i < 5; i++) num[i] *= iw;
      }
#pragma unroll
      for (int ks = 0; ks < 4; ks++) {
        const bool need = dir ? (2 * ks + 1 >= w) : (2 * ks <= w);
        if (need) {
#pragma unroll
          for (int i = 0; i < 5; i++) {
            const uint2 lo = *(const uint2*)(Vt + (16 * i + lr) * VS + 32 * ks + 4 * lg);
            const uint2 hi = *(const uint2*)(Vt + (16 * i + lr) * VS + 32 * ks + 16 + 4 * lg);
            uint4 av; av.x = lo.x; av.y = lo.y; av.z = hi.x; av.w = hi.y;
            num[i] = mfma16(__builtin_bit_cast(bf16x8, av), spk[ks], num[i]);
          }
        }
      }
      {
        const float fl = scfl[t];
        const float dr = __shfl(num[4][0], lr);
        const float inv = 1.f / fmaxf(fabsf(dr), fl);
        u16* dst = Rho + (long)(cc * 128 + t) * D + head * 256 + es * 64 + 4 * lg;
#pragma unroll
        for (int i = 0; i < 4; i++)
          *(uint2*)(dst + 16 * i) = pack4(num[i][0] * inv, num[i][1] * inv, num[i][2] * inv, num[i][3] * inv);
      }
      __builtin_amdgcn_sched_barrier(0);
      { const int jn1 = (j + 1 < nc) ? j + 1 : j; scan_load(chunk0 + (dir ? nc - 1 - jn1 : jn1)); }
      __builtin_amdgcn_sched_barrier(0);
#pragma unroll
      for (int i = 0; i < 2; i++)
#pragma unroll
        for (int jn = 0; jn < 5; jn++) st[i][jn] *= decay;
#pragma unroll
      for (int ks = 0; ks < 4; ks++) {
        bf16x8 kTf[2];
#pragma unroll
        for (int i = 0; i < 2; i++) {
          const u16* ap = Kb + (32 * ks + 8 * lg + (lr >> 2)) * KS + 32 * w + 16 * i + 4 * (lr & 3);
          const s16x4 lo = __builtin_amdgcn_ds_read_tr16_b64_v4i16((s16x4 __attribute__((address_space(3)))*)ap);
          const s16x4 hi = __builtin_amdgcn_ds_read_tr16_b64_v4i16((s16x4 __attribute__((address_space(3)))*)(ap + 4 * KS));
          kTf[i] = __builtin_shufflevector(lo, hi, 0, 1, 2, 3, 4, 5, 6, 7);
        }
#pragma unroll
        for (int jn = 0; jn < 5; jn++) {
          const bf16x8 b = *(const bf16x8*)(Vw + (16 * jn + lr) * VS + 32 * ks + 8 * lg);
#pragma unroll
          for (int i = 0; i < 2; i++) st[i][jn] = mfma16(kTf[i], b, st[i][jn]);
        }
      }
      m = mnext;
    }
  }
}

template <class PT> DI void phase_C(const PT& p, const Ctx& c, int l, u16* lds) {
  const int tid = opaque_tid(), lane = tid & 63, wave = tid >> 6, wm = wave & 3, wn = wave >> 2, lr = lane & 15, lg = lane >> 4;
  const u16* W = c.W + ((long)l * WROWS + W_C) * D;
  u16* Ru = c.R1; u16* Ryp = c.R2; u16* Rog = c.R3;
  const int nTiles = (c.Tg / 256) * 24;
  for (int tile = blockIdx.x; tile < nTiles; tile += gridDim.x) {
    const int tb = tile / 24, pt = tile % 24;
    f32x4 acc[4][8];
    {
      const int tn = tile + gridDim.x;
      const bool has = tn < nTiles;
      gemm_tile<4, 8, 2>(W + (long)pt * 256 * D, c.Rh + (long)tb * 256 * D, acc, lds,
                         has ? W + (long)(tn % 24) * 256 * D : nullptr, has ? c.Rh + (long)(tn / 24) * 256 * D : nullptr, tile != (int)blockIdx.x);
    }
    if (pt < 16) {
      const int chn = pt * 64 + wm * 16 + 4 * lg;
#pragma unroll
      for (int jn = 0; jn < 8; jn++) {
        const long lt = tb * 256 + 128 * wn + 16 * jn + lr;
        float u[4], y[4];
#pragma unroll
        for (int r = 0; r < 4; r++) { u[r] = acc[1][jn][r] * acc[2][jn][r]; y[r] = acc[0][jn][r] * siluf_(acc[3][jn][r]); }
        *(uint2*)(Ru + lt * D + chn) = pack4(u[0], u[1], u[2], u[3]);
        *(uint2*)(Ryp + lt * D + chn) = pack4(y[0], y[1], y[2], y[3]);
      }
    } else {
      const int chn = (pt - 16) * 128 + wm * 32 + 4 * lg;
#pragma unroll
      for (int jn = 0; jn < 8; jn++) {
        const long lt = tb * 256 + 128 * wn + 16 * jn + lr;
#pragma unroll
        for (int hh = 0; hh < 2; hh++) {
          float o[4];
#pragma unroll
          for (int r = 0; r < 4; r++) o[r] = sigmoidf_(acc[2 * hh][jn][r]) * siluf_(acc[2 * hh + 1][jn][r]);
          *(uint2*)(Rog + lt * D + chn + 16 * hh) = pack4(o[0], o[1], o[2], o[3]);
        }
      }
    }
  }
}

template <class PT> DI void phase_E(const PT& p, const Ctx& c, int l) {
  const int tid_ = opaque_tid(); const int lane = tid_ & 63, w = tid_ >> 6;
  const u16* Ru = c.R1; u16* Ryp = c.R2; u16* Rog = c.R3;
  const float* cw = p.conv_w + (long)l * 3 * D; const float* cb = p.conv_b + (long)l * D; const float* mg = p.mh_norm_g + (long)l * D;
  float4 w0[4], w1[4], w2[4], bb[4], gg[4];
#pragma unroll
  for (int i = 0; i < 4; i++) {
    const int k = 4 * lane + 256 * i;
    w0[i] = *(const float4*)(cw + k); w1[i] = *(const float4*)(cw + D + k); w2[i] = *(const float4*)(cw + 2 * D + k);
    bb[i] = *(const float4*)(cb + k); gg[i] = *(const float4*)(mg + k);
  }
  for (int lt = blockIdx.x * 8 + w; lt < c.Tg; lt += gridDim.x * 8) {
    const int sl = lt < c.half ? 8192 : 2048;
    const int pos = (lt < c.half ? lt : lt - c.half) & (sl - 1);
    const bool first = pos == 0, lastp = pos == sl - 1;
    uint2 U0[4], U1[4], U2[4], YP[4], OG[4], HF[4], HB[4];
#pragma unroll
    for (int i = 0; i < 4; i++) {
      const int k = 4 * lane + 256 * i;
      U0[i] = *(const uint2*)(Ru + (long)(first ? lt : lt - 1) * D + k);
      U1[i] = *(const uint2*)(Ru + (long)lt * D + k);
      U2[i] = *(const uint2*)(Ru + (long)(lastp ? lt : lt + 1) * D + k);
      if (first) { U0[i].x = 0u; U0[i].y = 0u; }
      if (lastp) { U2[i].x = 0u; U2[i].y = 0u; }
      YP[i] = *(const uint2*)(Ryp + (long)lt * D + k);
      OG[i] = *(const uint2*)(Rog + (long)lt * D + k);
      HF[i] = *(const uint2*)(c.Rhf + (long)lt * D + k);
      HB[i] = *(const uint2*)(c.Rhb + (long)lt * D + k);
    }
#pragma unroll
    for (int i = 0; i < 4; i++) {
      const int k = 4 * lane + 256 * i;
      const float4 a0 = unpack4(U0[i]), a1 = unpack4(U1[i]), a2 = unpack4(U2[i]), yp = unpack4(YP[i]);
      const float y0 = yp.x * (w0[i].x * a0.x + w1[i].x * a1.x + w2[i].x * a2.x + bb[i].x);
      const float y1 = yp.y * (w0[i].y * a0.y + w1[i].y * a1.y + w2[i].y * a2.y + bb[i].y);
      const float y2 = yp.z * (w0[i].z * a0.z + w1[i].z * a1.z + w2[i].z * a2.z + bb[i].z);
      const float y3 = yp.w * (w0[i].w * a0.w + w1[i].w * a1.w + w2[i].w * a2.w + bb[i].w);
      *(uint2*)(Ryp + (long)lt * D + k) = pack4(y0, y1, y2, y3);
      const float4 hf = unpack4(HF[i]), hb = unpack4(HB[i]), og = unpack4(OG[i]);
      const float s0 = hf.x + hb.x, s1 = hf.y + hb.y, s2 = hf.z + hb.z, s3 = hf.w + hb.w;
      const float ss = wave_sum(s0 * s0 + s1 * s1 + s2 * s2 + s3 * s3);
      const float rstd = rsqrtf(ss * (1.f / 256.f) + 1e-6f);
      *(uint2*)(Rog + (long)lt * D + k) = pack4(og.x * s0 * rstd * gg[i].x, og.y * s1 * rstd * gg[i].y, og.z * s2 * rstd * gg[i].z, og.w * s3 * rstd * gg[i].w);
    }
  }
}

template <class PT> DI void phase_D1(const PT& p, const Ctx& c, int l, u16* lds) {
  const int tid = opaque_tid(), lane = tid & 63, wave = tid >> 6, wm = wave & 3, wn = wave >> 2, lr = lane & 15, lg = lane >> 4;
  const u16* W = c.W + (long)l * WROWS * D;
  const u16* Ryc = c.R2; const u16* Rym = c.R3; u16* Rmg = c.R4;
  const int nTiles = (c.Tg / 128) * 8;
  for (int tile = blockIdx.x; tile < nTiles; tile += gridDim.x) {
    const int ch = tile >> 3, mt = tile & 7;
    f32x4 a2[2][4], M[2][4];
    uint2 gk[4][4];
    {
      f32x4 a1[4][4];
      gemm_tile<4, 4, 3>(W + (long)(W_G + mt * 256) * D, c.Rh + (long)ch * 128 * D, a1, lds);
#pragma unroll
      for (int i = 0; i < 4; i++)
#pragma unroll
        for (int jn = 0; jn < 4; jn++)
          gk[i][jn] = pack4(sigmoidf_(a1[i][jn][0]), sigmoidf_(a1[i][jn][1]), sigmoidf_(a1[i][jn][2]), sigmoidf_(a1[i][jn][3]));
    }
    gemm_tile<2, 4, 3>(W + (long)(W_PC + mt * 128) * D, Ryc + (long)ch * 128 * D, a2, lds);
#pragma unroll
    for (int i = 0; i < 2; i++)
#pragma unroll
      for (int jn = 0; jn < 4; jn++) {
        const float4 gg = unpack4(gk[2 * i][jn]);
        M[i][jn] = (f32x4){gg.x * a2[i][jn][0], gg.y * a2[i][jn][1], gg.z * a2[i][jn][2], gg.w * a2[i][jn][3]};
      }
    gemm_tile<2, 4, 3>(W + (long)(W_PM + mt * 128) * D, Rym + (long)ch * 128 * D, a2, lds);
#pragma unroll
    for (int i = 0; i < 2; i++)
#pragma unroll
      for (int jn = 0; jn < 4; jn++) {
        const float4 gg = unpack4(gk[2 * i + 1][jn]);
        const int col = mt * 128 + 32 * wm + 16 * i + 4 * lg;
        const long lt = ch * 128 + 64 * wn + 16 * jn + lr;
        *(uint2*)(Rmg + lt * D + col) = pack4(M[i][jn][0] + gg.x * a2[i][jn][0], M[i][jn][1] + gg.y * a2[i][jn][1],
                                              M[i][jn][2] + gg.z * a2[i][jn][2], M[i][jn][3] + gg.w * a2[i][jn][3]);
      }
  }
}

template <class PT> DI void phase_D2(const PT& p, const Ctx& c, int l, int g, u16* lds) {
  const int tid = opaque_tid(), lane = tid & 63, wave = tid >> 6, wm = wave & 3, wn = wave >> 2, lr = lane & 15, lg = lane >> 4;
  const u16* W = c.W + ((long)l * WROWS + W_O) * D;
  const u16* Rmg = c.R4;
  const int nTiles = (c.Tg / 256) * 4;
  for (int tile = blockIdx.x; tile < nTiles; tile += gridDim.x) {
    const int tb = tile >> 2, pt = tile & 3;
    f32x4 acc[4][8];
    {
      const int tn = tile + gridDim.x;
      const bool has = tn < nTiles;
      gemm_tile<4, 8, 2>(W + (long)pt * 256 * D, Rmg + (long)tb * 256 * D, acc, lds,
                         has ? W + (long)(tn & 3) * 256 * D : nullptr, has ? Rmg + (long)(tn >> 2) * 256 * D : nullptr, tile != (int)blockIdx.x);
    }
    const int tok0 = gtok(c, g, tb * 256);
    const float* gp = c.mod + ((long)l * 40 + batch_of(tok0)) * 3072 + 2048;
#pragma unroll
    for (int i = 0; i < 4; i++) {
      const int col = pt * 256 + 64 * wm + 16 * i + 4 * lg;
      const float4 gt = *(const float4*)(gp + col);
      float4 xv[8];
#pragma unroll
      for (int jn = 0; jn < 8; jn++) {
        const int tok = tok0 + 128 * wn + 16 * jn + lr;
        const float* xr = (l == 0) ? xin_row(p, tok) : p.out + (long)tok * D;
        xv[jn] = *(const float4*)(xr + col);
      }
#pragma unroll
      for (int jn = 0; jn < 8; jn++) {
        const int tok = tok0 + 128 * wn + 16 * jn + lr;
        float4 o;
        o.x = xv[jn].x + gt.x * acc[i][jn][0]; o.y = xv[jn].y + gt.y * acc[i][jn][1];
        o.z = xv[jn].z + gt.z * acc[i][jn][2]; o.w = xv[jn].w + gt.w * acc[i][jn][3];
        *(float4*)(p.out + (long)tok * D + col) = o;
      }
    }
  }
}

__global__ void __launch_bounds__(NT) mega(Params p) {
  extern __shared__ __attribute__((aligned(16))) char smem[];
  cg::grid_group grid = cg::this_grid();
  const int nG = p.G;
  __shared__ uint4 xb_words;
  volatile LAS unsigned* xb_st = (volatile LAS unsigned*)&xb_words;
  Params* pg;
  unsigned* xbar;
  {
    const Ctx c0 = make_ctx(p);
    unsigned char* q = (unsigned char*)c0.ctr + 4096;
    xbar = (unsigned*)q; q += XCD_BAR_WORDS * 4;
    pg = (Params*)q;
    if (blockIdx.x == 0 && threadIdx.x == 0) *pg = p;
    if (threadIdx.x == 0) xb_words = make_uint4(0u, 0u, 0u, 0u);
    __syncthreads();
    XcdBarrier xb0 = xcd_barrier_post(xbar, xb_st);
    (void)xb0;
    phase_prep(p, c0, (float*)smem);
  }
  grid.sync();
#define PH(call) { const CParams* q_ = launder_params(pg); const CParams& P_ = *q_; const Ctx c = make_ctx(P_); call; }
#define BAR() { const CParams* q_ = launder_params(pg); const Ctx c = make_ctx(*q_); XcdBarrier xb; xb.bar = (unsigned*)((unsigned char*)c.ctr + 4096); xb.x = xb_xcc_id(); xb.st = xb_st; xcd_barrier(xb); }
  for (int g = 0; g < nG; ++g) {
    for (int l = 0; l < DEPTH; ++l) {
      PH(phase_rows(P_, c, l, g, false)); BAR();
      PH(phase_A(P_, c, l, (u16*)smem)); BAR();
      PH(phase_scan(P_, c, g * DEPTH + l, smem)); BAR();
      PH(phase_C(P_, c, l, (u16*)smem)); BAR();
      PH(phase_E(P_, c, l)); BAR();
      PH(phase_D1(P_, c, l, (u16*)smem)); BAR();
      PH(phase_D2(P_, c, l, g, (u16*)smem)); BAR();
    }
    PH(phase_rows(P_, c, DEPTH, g, true));
  }
}

extern "C" void kernel_launch(void* const* d_in, const int* in_sizes, int n_in, void* d_out, int out_size,
                              void* d_ws, size_t ws_size, hipStream_t stream) {
  static int grid_blocks = 0;
  static int Gsel = 2;
  if (!grid_blocks) {
    int dev = 0, cus = 0, per_cu = 0;
    hipGetDevice(&dev);
    hipDeviceGetAttribute(&cus, hipDeviceAttributeMultiprocessorCount, dev);
    hipFuncSetAttribute((const void*)mega, hipFuncAttributeMaxDynamicSharedMemorySize, LDS_BYTES);
    hipOccupancyMaxActiveBlocksPerMultiprocessor(&per_cu, (const void*)mega, NT, LDS_BYTES);
    if (per_cu < 1) per_cu = 1;
    grid_blocks = cus * per_cu;
    const size_t fixed = (size_t)DEPTH * WROWS * D * 2 + (size_t)DEPTH * 40 * 3072 * 4 + 4096 + XCD_BAR_WORDS * 4 + 1024;
    Gsel = 2;
    while (Gsel < 8 && 7 * ((size_t)(131072 / Gsel) * D * 2) + fixed + (size_t)(131072 / Gsel) * 96 > ws_size) Gsel *= 2;
  }
  Params p{};
  p.x_prompt = (const float*)d_in[0]; p.x_sample = (const float*)d_in[1]; p.c_prompt = (const float*)d_in[2]; p.c_sample = (const float*)d_in[3];
  p.w_ada = (const float*)d_in[4]; p.b_ada = (const float*)d_in[5]; p.norm_g = (const float*)d_in[6]; p.w_in = (const float*)d_in[7];
  p.b_gates = (const float*)d_in[8]; p.conv_w = (const float*)d_in[9]; p.conv_b = (const float*)d_in[10]; p.mh_norm_g = (const float*)d_in[11];
  p.w_pc = (const float*)d_in[12]; p.w_pm = (const float*)d_in[13]; p.w_out = (const float*)d_in[14]; p.final_g = (const float*)d_in[15];
  p.out = (float*)d_out; p.ws = (unsigned char*)d_ws; p.G = Gsel; p.pad = 0;
  {
    const size_t Tg = 131072 / Gsel;
    const size_t off = 7 * (Tg * D * 2) + (size_t)DEPTH * WROWS * D * 2 + (size_t)DEPTH * 40 * 3072 * 4 + Tg * 96 + 4096;
    (void)hipMemsetAsync((unsigned char*)d_ws + off, 0, XCD_BAR_WORDS * 4, stream);
  }
  void* args[] = {&p};
  hipError_t e = hipLaunchCooperativeKernel((const void*)mega, dim3(grid_blocks), dim3(NT), args, LDS_BYTES, stream);
  if (e != hipSuccess) fprintf(stderr, "cooperative launch failed: %s (grid %d)\n", hipGetErrorString(e), grid_blocks);
}
```

```cpp
#include <hip/hip_runtime.h>
#include <hip/hip_cooperative_groups.h>
#include <cstdio>
namespace cg = cooperative_groups;

typedef unsigned short u16;
using bf16x8 = __attribute__((ext_vector_type(8))) short;
using f32x4  = __attribute__((ext_vector_type(4))) float;
using s16x4  = __attribute__((ext_vector_type(4))) short;
using u32x4  = __attribute__((ext_vector_type(4))) unsigned;
#define DI __device__ __forceinline__

constexpr int D = 1024, DIN = 11280, DEPTH = 4;
constexpr int NT = 512;
constexpr int W_QKV = 0, W_C = 3328, W_G = 9472, W_PC = 11520, W_PM = 12544, W_O = 13568, WROWS = 14592;
constexpr int LDT = 72;
constexpr int KS = 264, VS = 136;
constexpr int LDS_BYTES = (128 * KS + 2 * 80 * VS + 80 * KS) * 2 + 4 * 128 * 4;

struct Params {
  const float* x_prompt; const float* x_sample; const float* c_prompt; const float* c_sample;
  const float* w_ada; const float* b_ada; const float* norm_g; const float* w_in; const float* b_gates;
  const float* conv_w; const float* conv_b; const float* mh_norm_g; const float* w_pc; const float* w_pm;
  const float* w_out; const float* final_g;
  float* out; unsigned char* ws;
  int G; int pad;
};

struct Ctx {
  int G, Tg, half;
  u16 *Rh, *R1, *R2, *R3, *R4, *Rhf, *Rhb;
  u16* W; float* mod; float* sc; int* ctr;
};

DI u16 f2bf(float x) { unsigned u = __float_as_uint(x); u += 0x7fffu + ((u >> 16) & 1u); return (u16)(u >> 16); }
DI float bf2f(unsigned h) { return __uint_as_float(h << 16); }
typedef __bf16 bf16x2_t __attribute__((ext_vector_type(2)));
typedef float f32x2_t __attribute__((ext_vector_type(2)));
DI unsigned pack2(float a, float b) { const f32x2_t v = {a, b}; return __builtin_bit_cast(unsigned, __builtin_convertvector(v, bf16x2_t)); }
DI uint2 pack4(float a, float b, float c, float d) { uint2 r; r.x = pack2(a, b); r.y = pack2(c, d); return r; }
DI uint2 pack4v(f32x4 v) { return pack4(v[0], v[1], v[2], v[3]); }
DI float4 unpack4(uint2 v) { float4 r; r.x = bf2f(v.x & 0xffffu); r.y = bf2f(v.x >> 16); r.z = bf2f(v.y & 0xffffu); r.w = bf2f(v.y >> 16); return r; }
DI float sigmoidf_(float x) { return __builtin_amdgcn_rcpf(1.f + __expf(-x)); }
DI float siluf_(float x) { return x * sigmoidf_(x); }
DI float wave_sum(float v) {
#pragma unroll
  for (int o = 32; o >= 1; o >>= 1) v += __shfl_xor(v, o);
  return v;
}
DI int opaque_tid() { int t = threadIdx.x; asm volatile("" : "+v"(t)); return t; }
DI f32x4 mfma16(bf16x8 a, bf16x8 b, f32x4 c) { return __builtin_amdgcn_mfma_f32_16x16x32_bf16(a, b, c, 0, 0, 0); }


typedef const Params __attribute__((address_space(4))) CParams;
template <class PT> DI Ctx make_ctx(const PT& p) {
  Ctx c;
  c.G = p.G; c.Tg = 131072 / p.G; c.half = c.Tg >> 1;
  const size_t REG = (size_t)c.Tg * D * 2;
  unsigned char* ws = p.ws;
  c.Rh = (u16*)(ws); c.R1 = (u16*)(ws + REG); c.R2 = (u16*)(ws + 2 * REG); c.R3 = (u16*)(ws + 3 * REG);
  c.R4 = (u16*)(ws + 4 * REG); c.Rhf = (u16*)(ws + 5 * REG); c.Rhb = (u16*)(ws + 6 * REG);
  unsigned char* q = ws + 7 * REG;
  c.W = (u16*)q; q += (size_t)DEPTH * WROWS * D * 2;
  c.mod = (float*)q; q += (size_t)DEPTH * 40 * 3072 * 4;
  c.sc = (float*)q; q += (size_t)c.Tg * 96;
  c.ctr = (int*)q;
  return c;
}
DI const CParams* launder_params(const Params* g) { asm volatile("" : "+s"(g)); return (const CParams*)(unsigned long long)g; }
DI int gtok(const Ctx& c, int g, int lt) { return lt < c.half ? g * c.half + lt : 65536 + g * c.half + (lt - c.half); }
DI int batch_of(int tok) { return tok < 65536 ? (tok >> 13) : 8 + ((tok - 65536) >> 11); }
template <class PT> DI const float* xin_row(const PT& p, int tok) {
  return tok < 65536 ? p.x_prompt + (long)tok * D : p.x_sample + (long)(tok - 65536) * D;
}


#define XB_TMO      128
#define XB_XCNT(j)  (256  + 64 * (j))
#define XB_XSUB(j)  (1280 + 64 * (j))
#define XB_XGEN(j)  (2304 + 64 * (j))
#define XB_TOP      3328
#define XB_TOPGEN   3392
#define XCD_BAR_WORDS 3456
#define XB_SPIN_CAP (1u << 18)
#define LAS __attribute__((address_space(3)))
DI unsigned xb_ld(unsigned* p)              { return __hip_atomic_load(p, __ATOMIC_RELAXED, __HIP_MEMORY_SCOPE_AGENT); }
DI unsigned xb_add(unsigned* p, unsigned v) { return __hip_atomic_fetch_add(p, v, __ATOMIC_RELAXED, __HIP_MEMORY_SCOPE_AGENT); }
DI unsigned xb_xcc_id() { return (unsigned)__builtin_amdgcn_s_getreg((3 << 11) | 20) & 0xFu; }
#define XB_SPIN(cond, bar) do { unsigned _sp = 0; while (cond) { __builtin_amdgcn_s_sleep(1); \
    if ((++_sp & 255u) == 0u) { if (xb_ld(&(bar)[XB_TMO])) break; if (_sp > XB_SPIN_CAP) { atomicAdd(&(bar)[XB_TMO], 1u); break; } } } } while (0)
struct XcdBarrier { unsigned* bar; unsigned x; volatile LAS unsigned* st; };
DI XcdBarrier xcd_barrier_post(unsigned* bar, volatile LAS unsigned* st) {
  XcdBarrier b; b.bar = bar; b.x = xb_xcc_id(); b.st = st;
  if (threadIdx.x == 0) (void)xb_add(&bar[XB_XCNT(b.x)], 1u);
  return b;
}
DI void xcd_barrier_complete(unsigned* bar, unsigned x, unsigned& nloc, unsigned& nx) {
  const unsigned G = gridDim.x * gridDim.y * gridDim.z;
  unsigned sum, cnt, mine, sp = 0u;
  for (;;) {
    sum = 0u; cnt = 0u; mine = 0u;
#pragma unroll
    for (unsigned j = 0; j < 16; ++j) { const unsigned c = xb_ld(&bar[XB_XCNT(j)]); sum += c; cnt += (c > 0u) ? 1u : 0u; }
    mine = xb_ld(&bar[XB_XCNT(x)]);
    if (sum == G) break;
    __builtin_amdgcn_s_sleep(1);
    if ((++sp & 255u) == 0u) { if (xb_ld(&bar[XB_TMO])) break; if (sp > XB_SPIN_CAP) { atomicAdd(&bar[XB_TMO], 1u); break; } }
  }
  nloc = mine > 0u ? mine : 1u; nx = cnt > 0u ? cnt : 1u;
}
DI void xcd_barrier(const XcdBarrier& b) {
  asm volatile("s_waitcnt vmcnt(0)" ::: "memory");
  __syncthreads();
  if (threadIdx.x == 0) {
    unsigned* bar = b.bar;
    asm volatile("" : "+s"(bar));
    __builtin_amdgcn_s_waitcnt(0);
    unsigned nloc = b.st[0], nx = b.st[1];
    if (nloc == 0u) { xcd_barrier_complete(bar, b.x, nloc, nx); b.st[0] = nloc; b.st[1] = nx; }
    const unsigned old = xb_add(&bar[XB_XSUB(b.x)], 1u);
    const unsigned gen = old / nloc;
    if (old + 1u == (gen + 1u) * nloc) {
      __builtin_amdgcn_fence(__ATOMIC_RELEASE, "agent");
      asm volatile("s_waitcnt vmcnt(0)" ::: "memory");
      const unsigned og = xb_add(&bar[XB_TOP], 1u);
      const unsigned tg = og / nx;
      if (og + 1u == (tg + 1u) * nx) xb_add(&bar[XB_TOPGEN], 1u);
      else XB_SPIN(xb_ld(&bar[XB_TOPGEN]) == tg, bar);
      __builtin_amdgcn_fence(__ATOMIC_ACQUIRE, "agent");
      xb_add(&bar[XB_XGEN(b.x)], 1u);
      asm volatile("s_waitcnt vmcnt(0)" ::: "memory");
    } else {
      XB_SPIN(xb_ld(&bar[XB_XGEN(b.x)]) == gen, bar);
      __builtin_amdgcn_fence(__ATOMIC_ACQUIRE, "agent");
      asm volatile("s_waitcnt vmcnt(0)" ::: "memory");
    }
  }
  __syncthreads();
}

template <int MT, int NT, int ST>
DI void gemm_tile(const u16* __restrict__ P, const u16* __restrict__ Q, f32x4 (&acc)[MT][NT], u16* lds,
                  const u16* Pn = nullptr, const u16* Qn = nullptr, bool primed = false) {
  const int tid = opaque_tid(), lane = tid & 63, wave = __builtin_amdgcn_readfirstlane(tid >> 6), wm = wave & 3, wn = wave >> 2;
  const int lr = lane & 15, lg = lane >> 4;
  constexpr int PROWS = 64 * MT, QROWS = 32 * NT, NQI = NT / 2, NDMA = MT + NQI;
  char* pbase = (char*)lds;
  char* qbase = pbase + ST * PROWS * 128;
  const int drow = lane >> 3, dpos = lane & 7;
  const int r0 = 8 * wave + drow;
  const unsigned voff = (unsigned)(r0 * D + ((dpos ^ ((r0 >> 1) & 7)) << 3)) * 2u;
  const char* Pc = (const char*)P; const char* Qc = (const char*)Q;
  char* dp = pbase + wave * 1024 + lane * 16;
  char* dq = qbase + wave * 1024 + lane * 16;
#pragma unroll
  for (int i = 0; i < MT; i++)
#pragma unroll
    for (int j = 0; j < NT; j++) acc[i][j] = (f32x4){0.f, 0.f, 0.f, 0.f};
  if (!primed) {
#pragma unroll
    for (int t0 = 0; t0 < ST - 1; t0++) {
#pragma unroll
      for (int i = 0; i < MT; i++) __builtin_amdgcn_global_load_lds((const unsigned*)(Pc + (i * 64 * D * 2 + t0 * 128) + voff), (unsigned*)(dp + t0 * PROWS * 128 + i * 8192), 16, 0, 0);
#pragma unroll
      for (int i = 0; i < NQI; i++) __builtin_amdgcn_global_load_lds((const unsigned*)(Qc + (i * 64 * D * 2 + t0 * 128) + voff), (unsigned*)(dq + t0 * QROWS * 128 + i * 8192), 16, 0, 0);
    }
  }
  asm volatile("s_waitcnt vmcnt(%0)" :: "n"((ST - 2) * NDMA) : "memory");
  __builtin_amdgcn_s_barrier();
  asm volatile("" ::: "memory");
  const int swz = (lr >> 1) & 7;
  const int o0 = (lg ^ swz) << 4, o1 = ((4 + lg) ^ swz) << 4;
  const char* pa = pbase + (wm * 16 * MT + lr) * 128;
  const char* qa = qbase + (wn * 16 * NT + lr) * 128;
  constexpr int NK = D / 64;
  int cur = 0, nxs = ST - 1;
  for (int kt = 0; kt < NK; ++kt) {
    if (kt + ST - 1 < NK) {
#pragma unroll
      for (int i = 0; i < MT; i++) __builtin_amdgcn_global_load_lds((const unsigned*)(Pc + (i * 64 * D * 2 + (kt + ST - 1) * 128) + voff), (unsigned*)(dp + nxs * PROWS * 128 + i * 8192), 16, 0, 0);
#pragma unroll
      for (int i = 0; i < NQI; i++) __builtin_amdgcn_global_load_lds((const unsigned*)(Qc + (i * 64 * D * 2 + (kt + ST - 1) * 128) + voff), (unsigned*)(dq + nxs * QROWS * 128 + i * 8192), 16, 0, 0);
    }
    if (ST == 2 && kt == NK - 1 && Pn != nullptr) {
      const char* Pnc = (const char*)Pn; const char* Qnc = (const char*)Qn;
#pragma unroll
      for (int i = 0; i < MT; i++) __builtin_amdgcn_global_load_lds((const unsigned*)(Pnc + (i * 64 * D * 2) + voff), (unsigned*)(dp + i * 8192), 16, 0, 0);
#pragma unroll
      for (int i = 0; i < NQI; i++) __builtin_amdgcn_global_load_lds((const unsigned*)(Qnc + (i * 64 * D * 2) + voff), (unsigned*)(dq + i * 8192), 16, 0, 0);
    }
    const char* pb = pa + cur * PROWS * 128;
    const char* qb = qa + cur * QROWS * 128;
    if constexpr (NT == 8) {
      bf16x8 af[MT], b0[NT], b1[NT];
#pragma unroll
      for (int j = 0; j < NT; j++) b0[j] = *(const bf16x8*)(qb + j * 2048 + o0);
#pragma unroll
      for (int i = 0; i < MT; i++) af[i] = *(const bf16x8*)(pb + i * 2048 + o0);
      __builtin_amdgcn_s_setprio(1);
#pragma unroll
      for (int i = 0; i < MT; i++) {
#pragma unroll
        for (int j = 0; j < NT; j++) acc[i][j] = mfma16(af[i], b0[j], acc[i][j]);
        b1[i] = *(const bf16x8*)(qb + i * 2048 + o1);
        af[i] = *(const bf16x8*)(pb + i * 2048 + o1);
      }
#pragma unroll
      for (int j = MT; j < NT; j++) b1[j] = *(const bf16x8*)(qb + j * 2048 + o1);
#pragma unroll
      for (int i = 0; i < MT; i++)
#pragma unroll
        for (int j = 0; j < NT; j++) acc[i][j] = mfma16(af[i], b1[j], acc[i][j]);
      __builtin_amdgcn_sched_group_barrier(0x100, NT + MT, 0);
#pragma unroll
      for (int r = 0; r < MT; r++) {
        __builtin_amdgcn_sched_group_barrier(0x008, 4, 0);
        __builtin_amdgcn_sched_group_barrier(0x100, 1, 0);
        __builtin_amdgcn_sched_group_barrier(0x008, 4, 0);
        __builtin_amdgcn_sched_group_barrier(0x100, 1, 0);
      }
      __builtin_amdgcn_sched_group_barrier(0x100, NT - MT, 0);
      __builtin_amdgcn_sched_group_barrier(0x008, MT * NT, 0);
      __builtin_amdgcn_s_setprio(0);
    } else {
#pragma unroll
      for (int ks = 0; ks < 2; ++ks) {
        const int oo = ks ? o1 : o0;
        bf16x8 a[MT], b[NT];
#pragma unroll
        for (int i = 0; i < MT; i++) a[i] = *(const bf16x8*)(pb + i * 2048 + oo);
#pragma unroll
        for (int j = 0; j < NT; j++) b[j] = *(const bf16x8*)(qb + j * 2048 + oo);
#pragma unroll
        for (int i = 0; i < MT; i++)
#pragma unroll
          for (int j = 0; j < NT; j++) acc[i][j] = mfma16(a[i], b[j], acc[i][j]);
      }
    }
    if (kt + ST - 1 < NK) asm volatile("s_waitcnt vmcnt(%0)" :: "n"((ST - 2) * NDMA) : "memory");
    else if (!(ST == 2 && Pn != nullptr)) asm volatile("s_waitcnt vmcnt(0)" ::: "memory");
    __builtin_amdgcn_s_barrier();
    asm volatile("" ::: "memory");
    cur = (cur == ST - 1) ? 0 : cur + 1;
    nxs = (nxs == ST - 1) ? 0 : nxs + 1;
  }
}

template <class PT> DI void wsrc(const PT& p, int l, int n, const float*& src, int& ld, int& col, float& scale) {
  scale = 1.f;
  src = p.w_in + (long)l * D * DIN; ld = DIN;
  if (n < W_C) {
    if (n < 1024) col = 4096 + n;
    else if (n < 2048) { col = 5120 + (n - 1024); scale = 0.0625f; }
    else if (n < 3072) col = 6144 + (n - 2048);
    else if (n < 3088) col = 9216 + (n - 3072);
    else col = -1;
  } else if (n < W_G) {
    int n2 = n - W_C;
    if (n2 < 4096) { int blk = n2 >> 6, sl = (n2 >> 4) & 3, cl = n2 & 15; col = sl * 1024 + blk * 16 + cl; }
    else { int n3 = n2 - 4096; int blk = n3 >> 5, sl = (n3 >> 4) & 1, cl = n3 & 15; col = (sl ? 8192 : 7168) + blk * 16 + cl; }
  } else if (n < W_PC) {
    int n4 = n - W_G; int blk = n4 >> 5, sl = (n4 >> 4) & 1, cl = n4 & 15; col = 9232 + sl * 1024 + blk * 16 + cl;
  } else if (n < W_PM) { src = p.w_pc + (long)l * D * D; ld = D; col = n - W_PC; }
  else if (n < W_O)  { src = p.w_pm + (long)l * D * D; ld = D; col = n - W_PM; }
  else               { src = p.w_out + (long)l * D * D; ld = D; col = n - W_O; }
}

template <class PT> DI void phase_prep(const PT& p, const Ctx& c, float* ldsf) {
  const int tid = opaque_tid();
  if (blockIdx.x == 0 && tid < 256) c.ctr[tid] = 0;
  const int nItems = DEPTH * (WROWS / 64) * 16;
  for (int it = blockIdx.x; it < nItems; it += gridDim.x) {
    const int kb = (it & 15) * 64; const int rb = it >> 4;
    const int l = rb / (WROWS / 64); const int nb = (rb % (WROWS / 64)) * 64;
    const float* src; int ld, col; float scale;
    const int nl = tid & 63;
    wsrc(p, l, nb + nl, src, ld, col, scale);
#pragma unroll
    for (int i = 0; i < 8; i++) {
      const int kl = (tid >> 6) + 8 * i;
      float v = (col >= 0) ? src[(long)(kb + kl) * ld + col] * scale : 0.f;
      ldsf[kl * 65 + nl] = v;
    }
    __syncthreads();
    {
      const int nl2 = tid >> 3, kc = tid & 7;
      float v[8];
#pragma unroll
      for (int j = 0; j < 8; j++) v[j] = ldsf[(kc * 8 + j) * 65 + nl2];
      uint4 o; o.x = pack2(v[0], v[1]); o.y = pack2(v[2], v[3]); o.z = pack2(v[4], v[5]); o.w = pack2(v[6], v[7]);
      *(uint4*)(c.W + ((long)l * WROWS + nb + nl2) * D + kb + kc * 8) = o;
    }
    __syncthreads();
  }
  const int nMod = DEPTH * 48;
  for (int it = blockIdx.x; it < nMod; it += gridDim.x) {
    const int l = it / 48, jb = (it % 48) * 64;
    const int cl = tid & 63, kc = tid >> 6;
    float acc[40];
#pragma unroll
    for (int b = 0; b < 40; b++) acc[b] = 0.f;
    const float* wa = p.w_ada + (long)l * D * 3072 + jb + cl;
    for (int k = kc * 128; k < kc * 128 + 128; ++k) {
      const float wv = wa[(long)k * 3072];
#pragma unroll
      for (int b = 0; b < 40; b++) {
        const float cv = (b < 8) ? p.c_prompt[b * D + k] : p.c_sample[(b - 8) * D + k];
        acc[b] += cv * wv;
      }
    }
#pragma unroll
    for (int b = 0; b < 40; b++) ldsf[(kc * 40 + b) * 64 + cl] = acc[b];
    __syncthreads();
    for (int idx = tid; idx < 40 * 64; idx += NT) {
      const int b = idx >> 6, cc = idx & 63;
      float s = p.b_ada[l * 3072 + jb + cc];
#pragma unroll
      for (int q = 0; q < 8; q++) s += ldsf[(q * 40 + b) * 64 + cc];
      c.mod[((long)l * 40 + b) * 3072 + jb + cc] = s;
    }
    __syncthreads();
  }
}

template <class PT> DI void phase_rows(const PT& p, const Ctx& c, int l, int g, bool fin) {
  const int tid_ = opaque_tid(); const int lane = tid_ & 63, w = tid_ >> 6;
  for (int lt = blockIdx.x * 8 + w; lt < c.Tg; lt += gridDim.x * 8) {
    const int tok = gtok(c, g, lt);
    const float* xr = (l == 0) ? xin_row(p, tok) : p.out + (long)tok * D;
    float4 v[4]; float ss = 0.f;
#pragma unroll
    for (int i = 0; i < 4; i++) {
      v[i] = *(const float4*)(xr + 4 * lane + 256 * i);
      ss += v[i].x * v[i].x + v[i].y * v[i].y + v[i].z * v[i].z + v[i].w * v[i].w;
    }
    ss = wave_sum(ss);
    const float rstd = rsqrtf(ss * (1.f / 1024.f) + 1e-6f);
    if (fin) {
#pragma unroll
      for (int i = 0; i < 4; i++) {
        const int k = 4 * lane + 256 * i;
        const float4 fg = *(const float4*)(p.final_g + k);
        float4 o; o.x = v[i].x * rstd * fg.x; o.y = v[i].y * rstd * fg.y; o.z = v[i].z * rstd * fg.z; o.w = v[i].w * rstd * fg.w;
        *(float4*)(p.out + (long)tok * D + k) = o;
      }
    } else {
      const float* mp = c.mod + ((long)l * 40 + batch_of(tok)) * 3072;
      float4 ngv[4], sclv[4], shv[4];
#pragma unroll
      for (int i = 0; i < 4; i++) {
        const int k = 4 * lane + 256 * i;
        ngv[i] = *(const float4*)(p.norm_g + l * D + k); sclv[i] = *(const float4*)(mp + 1024 + k); shv[i] = *(const float4*)(mp + k);
      }
#pragma unroll
      for (int i = 0; i < 4; i++) {
        const int k = 4 * lane + 256 * i;
        const float4 ng = ngv[i], scl = sclv[i], sh = shv[i];
        const float h0 = v[i].x * rstd * ng.x * (1.f + scl.x) + sh.x;
        const float h1 = v[i].y * rstd * ng.y * (1.f + scl.y) + sh.y;
        const float h2 = v[i].z * rstd * ng.z * (1.f + scl.z) + sh.z;
        const float h3 = v[i].w * rstd * ng.w * (1.f + scl.w) + sh.w;
        *(uint2*)(c.Rh + (long)lt * D + k) = pack4(h0, h1, h2, h3);
      }
    }
  }
}

template <class PT> DI void phase_A(const PT& p, const Ctx& c, int l, u16* lds) {
  const int tid = opaque_tid(), lane = tid & 63, wave = tid >> 6, wm = wave & 3, wn = wave >> 2, lr = lane & 15, lg = lane >> 4;
  const u16* W = c.W + (long)l * WROWS * D;
  u16* Rq = c.R1; u16* Rk = c.R2; u16* RvT = c.R4;
  const int nTiles = (c.Tg / 256) * 13;
  auto ptrsA = [&](int tl, const u16*& Pp, const u16*& Qp) {
    const int tb_ = tl / 13, j_ = tl % 13;
    const u16* hp = c.Rh + (long)tb_ * 256 * D;
    if (j_ < 8) { Pp = W + (long)((j_ >> 2) * 1024 + (j_ & 3) * 256) * D; Qp = hp; }
    else if (j_ < 12) { Pp = hp; Qp = W + (long)(2048 + (j_ - 8) * 256) * D; }
    else { Pp = W + (long)3072 * D; Qp = hp; }
  };
  bool primed = false;
  for (int tile = blockIdx.x; tile < nTiles; tile += gridDim.x) {
    const int tb = tile / 13, j = tile % 13;
    f32x4 acc[4][8];
    const u16 *P0, *Q0, *P1 = nullptr, *Q1 = nullptr;
    ptrsA(tile, P0, Q0);
    if (tile + (int)gridDim.x < nTiles && j != 12) ptrsA(tile + gridDim.x, P1, Q1);
    const bool pr = primed; primed = (P1 != nullptr);
    if (j < 8) {
      const int isk = j >> 2, head = j & 3;
      gemm_tile<4, 8, 2>(P0, Q0, acc, lds, P1, Q1, pr);
      u16* dst = isk ? Rk : Rq;
#pragma unroll
      for (int i = 0; i < 4; i++)
#pragma unroll
        for (int jn = 0; jn < 8; jn++) {
          const int d = 64 * wm + 16 * i + 4 * lg, t = 128 * wn + 16 * jn + lr;
          *(uint2*)(dst + (long)(tb * 256 + t) * D + head * 256 + d) = pack4v(acc[i][jn]);
        }
    } else if (j < 12) {
      const int head = j - 8;
      gemm_tile<4, 8, 2>(P0, Q0, acc, lds, P1, Q1, pr);
#pragma unroll
      for (int i = 0; i < 4; i++)
#pragma unroll
        for (int jn = 0; jn < 8; jn++) {
          const int tokl = 64 * wm + 16 * i + 4 * lg, e = 128 * wn + 16 * jn + lr;
          const int ch = tb * 2 + (tokl >> 7), sidx = tokl & 127;
          *(uint2*)(RvT + ((long)(ch * 4 + head) * 256 + e) * 128 + sidx) = pack4v(acc[i][jn]);
        }
    } else {
      gemm_tile<4, 8, 2>(P0, Q0, acc, lds, P1, Q1, pr);
      float* gl = (float*)lds;
      if (wm == 0) {
#pragma unroll
        for (int jn = 0; jn < 8; jn++) {
          const int t = 128 * wn + 16 * jn + lr;
#pragma unroll
          for (int r = 0; r < 4; r++) {
            float v = acc[0][jn][r] + p.b_gates[l * 16 + lg * 4 + r];
            if (lg & 1) v = fminf(v, 0.f) - log1pf(expf(-fabsf(v)));
            gl[t * 16 + lg * 4 + r] = v;
          }
        }
      }
      __syncthreads();
      if (tid < 16) {
        const int head = tid & 3, dir = (tid >> 2) & 1, cl = tid >> 3;
        const int ch = tb * 2 + cl;
        float* o = c.sc + (((long)(ch * 4 + head) * 2 + dir) * 3) * 128;
        const float* glc = gl + cl * 128 * 16;
        float bs = 0.f, pm = -3.0e38f;
        for (int q = 0; q < 128; ++q) {
          const int t = dir ? 127 - q : q;
          const float iv = glc[t * 16 + dir * 8 + head], lf = glc[t * 16 + dir * 8 + 4 + head];
          bs += lf; const float gg = iv - bs; pm = fmaxf(pm, gg);
          o[t] = bs; o[128 + t] = gg; o[256 + t] = pm;
        }
      }
      __syncthreads();
    }
  }
}

template <class PT> DI void phase_scan(const PT& p, const Ctx& c, int ctrIdx, char* smem) {
  __shared__ int s_task;
  const int tid = opaque_tid(), lane = tid & 63, w0 = __builtin_amdgcn_readfirstlane(tid >> 6), lr = lane & 15, lg = lane >> 4;
  u16* Kb = (u16*)smem;
  u16* Vt = Kb + 128 * KS;
  u16* Vw = Vt + 80 * VS;
  u16* Ct = Vw + 80 * VS;
  float* scg = (float*)(Ct + 80 * KS); float* scmu = scg + 128; float* sciw = scmu + 128; float* scfl = sciw + 128;
  const u16* Rq = c.R1; const u16* Rk = c.R2; const u16* RvT = c.R4;
  const int nLong = (8 / c.G) * 32;
  const int nLongQ8 = (8 / c.G), nShortQ8 = (32 / c.G);
  const int perQueue = (nLongQ8 + nShortQ8) * 4;
  int* ctr = c.ctr + ctrIdx * 8;
  const int myq = (int)(xb_xcc_id() & 7u);
  int qoff = 0;
  while (true) {
    __syncthreads();
    if (tid == 0) {
      int t = -1;
      while (qoff < 8) {
        const int qi = (myq + qoff) & 7;
        const int n = atomicAdd(ctr + qi, 1);
        if (n < perQueue) {
          const int quad = (n < nLongQ8 * 4) ? qi + 8 * (n >> 2) : nLongQ8 * 8 + qi + 8 * ((n - nLongQ8 * 4) >> 2);
          t = quad * 4 + (n & 3);
          break;
        }
        ++qoff;
      }
      s_task = t;
    }
    __syncthreads();
    const int task = s_task;
    if (task < 0) break;
    int seq, r, chunk0, nc;
    if (task < nLong) { seq = task >> 5; r = task & 31; chunk0 = seq * 64; nc = 64; }
    else { const int t2 = task - nLong; seq = t2 >> 5; r = t2 & 31; chunk0 = (c.half >> 7) + seq * 16; nc = 16; }
    const int head = r >> 3, dir = (r >> 2) & 1, es = r & 3;
    const int last = dir ? 0 : 127;
    u16* Rho = dir ? c.Rhb : c.Rhf;
    for (int idx = tid; idx < 80 * KS / 2; idx += NT) ((unsigned*)Ct)[idx] = 0u;
    for (int idx = tid; idx < 16 * VS / 2; idx += NT) { ((unsigned*)(Vt + 64 * VS))[idx] = 0u; ((unsigned*)(Vw + 64 * VS))[idx] = 0u; }
    __syncthreads();
    if (tid < 128) Vt[64 * VS + tid] = (u16)0x3F80;
    f32x4 st[2][5];
#pragma unroll
    for (int i = 0; i < 2; i++)
#pragma unroll
      for (int jn = 0; jn < 5; jn++) st[i][jn] = (f32x4){0.f, 0.f, 0.f, 0.f};
    float m = 0.f;
    const int vrow = tid >> 4, vsc = tid & 15;
    const int krow = tid >> 5, kkc = (tid & 31) * 8;
    u32x4 kpre[8], vpre[2]; float4 g8a, g8b; float bLn, gmaxn, myb, myg, mypm;
    bf16x8 qf[8];
    auto scan_load = [&](int cq) {
#pragma unroll
      for (int ks = 0; ks < 8; ks++)
        qf[ks] = *(const bf16x8*)(Rq + (long)(cq * 128 + 16 * w0 + lr) * D + head * 256 + 32 * ks + 8 * lg);
#pragma unroll
      for (int i = 0; i < 8; i++) kpre[i] = *(const u32x4*)(Rk + (long)(cq * 128 + krow + 16 * i) * D + head * 256 + kkc);
#pragma unroll
      for (int i = 0; i < 2; i++) vpre[i] = *(const u32x4*)(RvT + ((long)(cq * 4 + head) * 256 + es * 64 + vrow + 32 * i) * 128 + vsc * 8);
      const float* scb = c.sc + ((long)(cq * 4 + head) * 2 + dir) * 384;
      g8a = *(const float4*)(scb + 128 + vsc * 8); g8b = *(const float4*)(scb + 128 + vsc * 8 + 4);
      bLn = scb[last]; gmaxn = scb[256 + last];
      myb = scb[tid & 127]; myg = scb[128 + (tid & 127)]; mypm = scb[256 + (tid & 127)];
    };
    scan_load(chunk0 + (dir ? nc - 1 : 0));
    for (int j = 0; j < nc; ++j) {
      const int cc = chunk0 + (dir ? nc - 1 - j : j);
      int w = w0; asm volatile("" : "+s"(w));
      __syncthreads();
      const float muL = fmaxf(m, gmaxn);
      const float decay = __expf(m - muL);
      const float mnext = bLn + muL;
#pragma unroll
      for (int i = 0; i < 2; i++)
#pragma unroll
        for (int jn = 0; jn < 5; jn++)
          *(uint2*)(Ct + (16 * jn + lr) * KS + 32 * w + 16 * i + 4 * lg) = pack4v(st[i][jn]);
#pragma unroll
      for (int i = 0; i < 8; i++) *(u32x4*)(Kb + (krow + 16 * i) * KS + kkc) = kpre[i];
      {
        float w8[8];
        w8[0] = __expf(g8a.x - muL); w8[1] = __expf(g8a.y - muL); w8[2] = __expf(g8a.z - muL); w8[3] = __expf(g8a.w - muL);
        w8[4] = __expf(g8b.x - muL); w8[5] = __expf(g8b.y - muL); w8[6] = __expf(g8b.z - muL); w8[7] = __expf(g8b.w - muL);
#pragma unroll
        for (int i = 0; i < 2; i++) {
          const u32x4 vv = vpre[i];
          *(u32x4*)(Vt + (vrow + 32 * i) * VS + vsc * 8) = vv;
          uint4 v; v.x = vv[0]; v.y = vv[1]; v.z = vv[2]; v.w = vv[3];
          uint4 o;
          o.x = pack2(bf2f(v.x & 0xffffu) * w8[0], bf2f(v.x >> 16) * w8[1]);
          o.y = pack2(bf2f(v.y & 0xffffu) * w8[2], bf2f(v.y >> 16) * w8[3]);
          o.z = pack2(bf2f(v.z & 0xffffu) * w8[4], bf2f(v.z >> 16) * w8[5]);
          o.w = pack2(bf2f(v.w & 0xffffu) * w8[6], bf2f(v.w >> 16) * w8[7]);
          *(uint4*)(Vw + (vrow + 32 * i) * VS + vsc * 8) = o;
        }
        if (tid < 16) {
          uint4 o; o.x = pack2(w8[0], w8[1]); o.y = pack2(w8[2], w8[3]); o.z = pack2(w8[4], w8[5]); o.w = pack2(w8[6], w8[7]);
          *(uint4*)(Vw + 64 * VS + vsc * 8) = o;
        }
      }
      if (tid < 128) {
        const float mu = fmaxf(m, mypm);
        scg[tid] = myg; scmu[tid] = mu; sciw[tid] = __expf(m - mu); scfl[tid] = __expf(-(mu + myb));
      }
      __syncthreads();
      const int t = 16 * w + lr;
      bf16x8 spk[4];
      {
        f32x4 sacc[8];
#pragma unroll
        for (int i = 0; i < 8; i++) sacc[i] = (f32x4){0.f, 0.f, 0.f, 0.f};
#pragma unroll
        for (int i = 0; i < 8; i++) {
          const bool need = dir ? (i >= w) : (i <= w);
          if (need) {
#pragma unroll
            for (int ks = 0; ks < 8; ks++) {
              const bf16x8 a = *(const bf16x8*)(Kb + (16 * i + lr) * KS + 32 * ks + 8 * lg);
              sacc[i] = mfma16(a, qf[ks], sacc[i]);
            }
          }
        }
        const float mu_t = scmu[t];
        int tt = t; asm volatile("" : "+v"(tt));
        const int sgn = dir ? -1 : 1;
#pragma unroll
        for (int ks = 0; ks < 4; ks++) {
          float sv[8];
#pragma unroll
          for (int hh = 0; hh < 2; hh++) {
            const int i = 2 * ks + hh;
            const float4 gs = *(const float4*)(scg + 16 * i + 4 * lg);
            const float gv[4] = {gs.x, gs.y, gs.z, gs.w};
#pragma unroll
            for (int r2 = 0; r2 < 4; r2++) {
              const int s = 16 * i + 4 * lg + r2;
              const bool valid = (s - tt) * sgn <= 0;
              sv[hh * 4 + r2] = valid ? sacc[i][r2] * __expf(gv[r2] - mu_t) : 0.f;
            }
          }
          uint4 o; o.x = pack2(sv[0], sv[1]); o.y = pack2(sv[2], sv[3]); o.z = pack2(sv[4], sv[5]); o.w = pack2(sv[6], sv[7]);
          spk[ks] = __builtin_bit_cast(bf16x8, o);
        }
      }
      f32x4 num[5];
#pragma unroll
      for (int i = 0; i < 5; i++) num[i] = (f32x4){0.f, 0.f, 0.f, 0.f};
#pragma unroll
      for (int ks = 0; ks < 8; ks++)
#pragma unroll
        for (int i = 0; i < 5; i++) {
          const bf16x8 a = *(const bf16x8*)(Ct + (16 * i + lr) * KS + 32 * ks + 8 * lg);
          num[i] = mfma16(a, qf[ks], num[i]);
        }
      {
        const float iw = sciw[t];
#pragma unroll
        for (int i = 0; i < 5; i++) num[i] *= iw;
      }
#pragma unroll
      for (int ks = 0; ks < 4; ks++) {
        const bool need = dir ? (2 * ks + 1 >= w) : (2 * ks <= w);
        if (need) {
#pragma unroll
          for (int i = 0; i < 5; i++) {
            const uint2 lo = *(const uint2*)(Vt + (16 * i + lr) * VS + 32 * ks + 4 * lg);
            const uint2 hi = *(const uint2*)(Vt + (16 * i + lr) * VS + 32 * ks + 16 + 4 * lg);
            uint4 av; av.x = lo.x; av.y = lo.y; av.z = hi.x; av.w = hi.y;
            num[i] = mfma16(__builtin_bit_cast(bf16x8, av), spk[ks], num[i]);
          }
        }
      }
      {
        const float fl = scfl[t];
        const float dr = __shfl(num[4][0], lr);
        const float inv = 1.f / fmaxf(fabsf(dr), fl);
        u16* dst = Rho + (long)(cc * 128 + t) * D + head * 256 + es * 64 + 4 * lg;
#pragma unroll
        for (int i = 0; i < 4; i++)
          *(uint2*)(dst + 16 * i) = pack4(num[i][0] * inv, num[i][1] * inv, num[i][2] * inv, num[i][3] * inv);
      }
      __builtin_amdgcn_sched_barrier(0);
      { const int jn1 = (j + 1 < nc) ? j + 1 : j; scan_load(chunk0 + (dir ? nc - 1 - jn1 : jn1)); }
      __builtin_amdgcn_sched_barrier(0);
#pragma unroll
      for (int i = 0; i < 2; i++)
#pragma unroll
        for (int jn = 0; jn < 5; jn++) st[i][jn] *= decay;
#pragma unroll
      for (int ks = 0; ks < 4; ks++) {
        bf16x8 kTf[2];
#pragma unroll
        for (int i = 0; i < 2; i++) {
          const u16* ap = Kb + (32 * ks + 8 * lg + (lr >> 2)) * KS + 32 * w + 16 * i + 4 * (lr & 3);
          const s16x4 lo = __builtin_amdgcn_ds_read_tr16_b64_v4i16((s16x4 __attribute__((address_space(3)))*)ap);
          const s16x4 hi = __builtin_amdgcn_ds_read_tr16_b64_v4i16((s16x4 __attribute__((address_space(3)))*)(ap + 4 * KS));
          kTf[i] = __builtin_shufflevector(lo, hi, 0, 1, 2, 3, 4, 5, 6, 7);
        }
#pragma unroll
        for (int jn = 0; jn < 5; jn++) {
          const bf16x8 b = *(const bf16x8*)(Vw + (16 * jn + lr) * VS + 32 * ks + 8 * lg);
#pragma unroll
          for (int i = 0; i < 2; i++) st[i][jn] = mfma16(kTf[i], b, st[i][jn]);
        }
      }
      m = mnext;
    }
  }
}

template <class PT> DI void phase_C(const PT& p, const Ctx& c, int l, u16* lds) {
  const int tid = opaque_tid(), lane = tid & 63, wave = tid >> 6, wm = wave & 3, wn = wave >> 2, lr = lane & 15, lg = lane >> 4;
  const u16* W = c.W + ((long)l * WROWS + W_C) * D;
  u16* Ru = c.R1; u16* Ryp = c.R2; u16* Rog = c.R3;
  const int nTiles = (c.Tg / 256) * 24;
  for (int tile = blockIdx.x; tile < nTiles; tile += gridDim.x) {
    const int tb = tile / 24, pt = tile % 24;
    f32x4 acc[4][8];
    {
      const int tn = tile + gridDim.x;
      const bool has = tn < nTiles;
      gemm_tile<4, 8, 2>(W + (long)pt * 256 * D, c.Rh + (long)tb * 256 * D, acc, lds,
                         has ? W + (long)(tn % 24) * 256 * D : nullptr, has ? c.Rh + (long)(tn / 24) * 256 * D : nullptr, tile != (int)blockIdx.x);
    }
    if (pt < 16) {
      const int chn = pt * 64 + wm * 16 + 4 * lg;
#pragma unroll
      for (int jn = 0; jn < 8; jn++) {
        const long lt = tb * 256 + 128 * wn + 16 * jn + lr;
        float u[4], y[4];
#pragma unroll
        for (int r = 0; r < 4; r++) { u[r] = acc[1][jn][r] * acc[2][jn][r]; y[r] = acc[0][jn][r] * siluf_(acc[3][jn][r]); }
        *(uint2*)(Ru + lt * D + chn) = pack4(u[0], u[1], u[2], u[3]);
        *(uint2*)(Ryp + lt * D + chn) = pack4(y[0], y[1], y[2], y[3]);
      }
    } else {
      const int chn = (pt - 16) * 128 + wm * 32 + 4 * lg;
#pragma unroll
      for (int jn = 0; jn < 8; jn++) {
        const long lt = tb * 256 + 128 * wn + 16 * jn + lr;
#pragma unroll
        for (int hh = 0; hh < 2; hh++) {
          float o[4];
#pragma unroll
          for (int r = 0; r < 4; r++) o[r] = sigmoidf_(acc[2 * hh][jn][r]) * siluf_(acc[2 * hh + 1][jn][r]);
          *(uint2*)(Rog + lt * D + chn + 16 * hh) = pack4(o[0], o[1], o[2], o[3]);
        }
      }
    }
  }
}

template <class PT> DI void phase_E(const PT& p, const Ctx& c, int l) {
  const int tid_ = opaque_tid(); const int lane = tid_ & 63, w = tid_ >> 6;
  const u16* Ru = c.R1; u16* Ryp = c.R2; u16* Rog = c.R3;
  const float* cw = p.conv_w + (long)l * 3 * D; const float* cb = p.conv_b + (long)l * D; const float* mg = p.mh_norm_g + (long)l * D;
  float4 w0[4], w1[4], w2[4], bb[4], gg[4];
#pragma unroll
  for (int i = 0; i < 4; i++) {
    const int k = 4 * lane + 256 * i;
    w0[i] = *(const float4*)(cw + k); w1[i] = *(const float4*)(cw + D + k); w2[i] = *(const float4*)(cw + 2 * D + k);
    bb[i] = *(const float4*)(cb + k); gg[i] = *(const float4*)(mg + k);
  }
  for (int lt = blockIdx.x * 8 + w; lt < c.Tg; lt += gridDim.x * 8) {
    const int sl = lt < c.half ? 8192 : 2048;
    const int pos = (lt < c.half ? lt : lt - c.half) & (sl - 1);
    const bool first = pos == 0, lastp = pos == sl - 1;
    uint2 U0[4], U1[4], U2[4], YP[4], OG[4], HF[4], HB[4];
#pragma unroll
    for (int i = 0; i < 4; i++) {
      const int k = 4 * lane + 256 * i;
      U0[i] = *(const uint2*)(Ru + (long)(first ? lt : lt - 1) * D + k);
      U1[i] = *(const uint2*)(Ru + (long)lt * D + k);
      U2[i] = *(const uint2*)(Ru + (long)(lastp ? lt : lt + 1) * D + k);
      if (first) { U0[i].x = 0u; U0[i].y = 0u; }
      if (lastp) { U2[i].x = 0u; U2[i].y = 0u; }
      YP[i] = *(const uint2*)(Ryp + (long)lt * D + k);
      OG[i] = *(const uint2*)(Rog + (long)lt * D + k);
      HF[i] = *(const uint2*)(c.Rhf + (long)lt * D + k);
      HB[i] = *(const uint2*)(c.Rhb + (long)lt * D + k);
    }
#pragma unroll
    for (int i = 0; i < 4; i++) {
      const int k = 4 * lane + 256 * i;
      const float4 a0 = unpack4(U0[i]), a1 = unpack4(U1[i]), a2 = unpack4(U2[i]), yp = unpack4(YP[i]);
      const float y0 = yp.x * (w0[i].x * a0.x + w1[i].x * a1.x + w2[i].x * a2.x + bb[i].x);
      const float y1 = yp.y * (w0[i].y * a0.y + w1[i].y * a1.y + w2[i].y * a2.y + bb[i].y);
      const float y2 = yp.z * (w0[i].z * a0.z + w1[i].z * a1.z + w2[i].z * a2.z + bb[i].z);
      const float y3 = yp.w * (w0[i].w * a0.w + w1[i].w * a1.w + w2[i].w * a2.w + bb[i].w);
      *(uint2*)(Ryp + (long)lt * D + k) = pack4(y0, y1, y2, y3);
      const float4 hf = unpack4(HF[i]), hb = unpack4(HB[i]), og = unpack4(OG[i]);
      const float s0 = hf.x + hb.x, s1 = hf.y + hb.y, s2 = hf.z + hb.z, s3 = hf.w + hb.w;
      const float ss = wave_sum(s0 * s0 + s1 * s1 + s2 * s2 + s3 * s3);
      const float rstd = rsqrtf(ss * (1.f / 256.f) + 1e-6f);
      *(uint2*)(Rog + (long)lt * D + k) = pack4(og.x * s0 * rstd * gg[i].x, og.y * s1 * rstd * gg[i].y, og.z * s2 * rstd * gg[i].z, og.w * s3 * rstd * gg[i].w);
    }
  }
}

template <class PT> DI void phase_D1(const PT& p, const Ctx& c, int l, u16* lds) {
  const int tid = opaque_tid(), lane = tid & 63, wave = tid >> 6, wm = wave & 3, wn = wave >> 2, lr = lane & 15, lg = lane >> 4;
  const u16* W = c.W + (long)l * WROWS * D;
  const u16* Ryc = c.R2; const u16* Rym = c.R3; u16* Rmg = c.R4;
  const int nTiles = (c.Tg / 128) * 8;
  for (int tile = blockIdx.x; tile < nTiles; tile += gridDim.x) {
    const int ch = tile >> 3, mt = tile & 7;
    f32x4 a2[2][4], M[2][4];
    uint2 gk[4][4];
    {
      f32x4 a1[4][4];
      gemm_tile<4, 4, 3>(W + (long)(W_G + mt * 256) * D, c.Rh + (long)ch * 128 * D, a1, lds);
#pragma unroll
      for (int i = 0; i < 4; i++)
#pragma unroll
        for (int jn = 0; jn < 4; jn++)
          gk[i][jn] = pack4(sigmoidf_(a1[i][jn][0]), sigmoidf_(a1[i][jn][1]), sigmoidf_(a1[i][jn][2]), sigmoidf_(a1[i][jn][3]));
    }
    gemm_tile<2, 4, 3>(W + (long)(W_PC + mt * 128) * D, Ryc + (long)ch * 128 * D, a2, lds);
#pragma unroll
    for (int i = 0; i < 2; i++)
#pragma unroll
      for (int jn = 0; jn < 4; jn++) {
        const float4 gg = unpack4(gk[2 * i][jn]);
        M[i][jn] = (f32x4){gg.x * a2[i][jn][0], gg.y * a2[i][jn][1], gg.z * a2[i][jn][2], gg.w * a2[i][jn][3]};
      }
    gemm_tile<2, 4, 3>(W + (long)(W_PM + mt * 128) * D, Rym + (long)ch * 128 * D, a2, lds);
#pragma unroll
    for (int i = 0; i < 2; i++)
#pragma unroll
      for (int jn = 0; jn < 4; jn++) {
        const float4 gg = unpack4(gk[2 * i + 1][jn]);
        const int col = mt * 128 + 32 * wm + 16 * i + 4 * lg;
        const long lt = ch * 128 + 64 * wn + 16 * jn + lr;
        *(uint2*)(Rmg + lt * D + col) = pack4(M[i][jn][0] + gg.x * a2[i][jn][0], M[i][jn][1] + gg.y * a2[i][jn][1],
                                              M[i][jn][2] + gg.z * a2[i][jn][2], M[i][jn][3] + gg.w * a2[i][jn][3]);
      }
  }
}

template <class PT> DI void phase_D2(const PT& p, const Ctx& c, int l, int g, u16* lds) {
  const int tid = opaque_tid(), lane = tid & 63, wave = tid >> 6, wm = wave & 3, wn = wave >> 2, lr = lane & 15, lg = lane >> 4;
  const u16* W = c.W + ((long)l * WROWS + W_O) * D;
  const u16* Rmg = c.R4;
  const int nTiles = (c.Tg / 256) * 4;
  for (int tile = blockIdx.x; tile < nTiles; tile += gridDim.x) {
    const int tb = tile >> 2, pt = tile & 3;
    f32x4 acc[4][8];
    {
      const int tn = tile + gridDim.x;
      const bool has = tn < nTiles;
      gemm_tile<4, 8, 2>(W + (long)pt * 256 * D, Rmg + (long)tb * 256 * D, acc, lds,
                         has ? W + (long)(tn & 3) * 256 * D : nullptr, has ? Rmg + (long)(tn >> 2) * 256 * D : nullptr, tile != (int)blockIdx.x);
    }
    const int tok0 = gtok(c, g, tb * 256);
    const float* gp = c.mod + ((long)l * 40 + batch_of(tok0)) * 3072 + 2048;
#pragma unroll
    for (int i = 0; i < 4; i++) {
      const int col = pt * 256 + 64 * wm + 16 * i + 4 * lg;
      const float4 gt = *(const float4*)(gp + col);
      float4 xv[8];
#pragma unroll
      for (int jn = 0; jn < 8; jn++) {
        const int tok = tok0 + 128 * wn + 16 * jn + lr;
        const float* xr = (l == 0) ? xin_row(p, tok) : p.out + (long)tok * D;
        xv[jn] = *(const float4*)(xr + col);
      }
#pragma unroll
      for (int jn = 0; jn < 8; jn++) {
        const int tok = tok0 + 128 * wn + 16 * jn + lr;
        float4 o;
        o.x = xv[jn].x + gt.x * acc[i][jn][0]; o.y = xv[jn].y + gt.y * acc[i][jn][1];
        o.z = xv[jn].z + gt.z * acc[i][jn][2]; o.w = xv[jn].w + gt.w * acc[i][jn][3];
        *(float4*)(p.out + (long)tok * D + col) = o;
      }
    }
  }
}

__global__ void __launch_bounds__(NT) mega(Params p) {
  extern __shared__ __attribute__((aligned(16))) char smem[];
  cg::grid_group grid = cg::this_grid();
  const int nG = p.G;
  __shared__ uint4 xb_words;
  volatile LAS unsigned* xb_st = (volatile LAS unsigned*)&xb_words;
  Params* pg;
  unsigned* xbar;
  {
    const Ctx c0 = make_ctx(p);
    unsigned char* q = (unsigned char*)c0.ctr + 4096;
    xbar = (unsigned*)q; q += XCD_BAR_WORDS * 4;
    pg = (Params*)q;
    if (blockIdx.x == 0 && threadIdx.x == 0) *pg = p;
    if (threadIdx.x == 0) xb_words = make_uint4(0u, 0u, 0u, 0u);
    __syncthreads();
    XcdBarrier xb0 = xcd_barrier_post(xbar, xb_st);
    (void)xb0;
    phase_prep(p, c0, (float*)smem);
  }
  grid.sync();
#define PH(call) { const CParams* q_ = launder_params(pg); const CParams& P_ = *q_; const Ctx c = make_ctx(P_); call; }
#define BAR() { const CParams* q_ = launder_params(pg); const Ctx c = make_ctx(*q_); XcdBarrier xb; xb.bar = (unsigned*)((unsigned char*)c.ctr + 4096); xb.x = xb_xcc_id(); xb.st = xb_st; xcd_barrier(xb); }
  for (int g = 0; g < nG; ++g) {
    for (int l = 0; l < DEPTH; ++l) {
      PH(phase_rows(P_, c, l, g, false)); BAR();
      PH(phase_A(P_, c, l, (u16*)smem)); BAR();
      PH(phase_scan(P_, c, g * DEPTH + l, smem)); BAR();
      PH(phase_C(P_, c, l, (u16*)smem)); BAR();
      PH(phase_E(P_, c, l)); BAR();
      PH(phase_D1(P_, c, l, (u16*)smem)); BAR();
      PH(phase_D2(P_, c, l, g, (u16*)smem)); BAR();
    }
    PH(phase_rows(P_, c, DEPTH, g, true));
  }
}

extern "C" void kernel_launch(void* const* d_in, const int* in_sizes, int n_in, void* d_out, int out_size,
                              void* d_ws, size_t ws_size, hipStream_t stream) {
  static int grid_blocks = 0;
  static int Gsel = 2;
  if (!grid_blocks) {
    int dev = 0, cus = 0, per_cu = 0;
    hipGetDevice(&dev);
    hipDeviceGetAttribute(&cus, hipDeviceAttributeMultiprocessorCount, dev);
    hipFuncSetAttribute((const void*)mega, hipFuncAttributeMaxDynamicSharedMemorySize, LDS_BYTES);
    hipOccupancyMaxActiveBlocksPerMultiprocessor(&per_cu, (const void*)mega, NT, LDS_BYTES);
    if (per_cu < 1) per_cu = 1;
    grid_blocks = cus * per_cu;
    const size_t fixed = (size_t)DEPTH * WROWS * D * 2 + (size_t)DEPTH * 40 * 3072 * 4 + 4096 + XCD_BAR_WORDS * 4 + 1024;
    Gsel = 2;
    while (Gsel < 8 && 7 * ((size_t)(131072 / Gsel) * D * 2) + fixed + (size_t)(131072 / Gsel) * 96 > ws_size) Gsel *= 2;
  }
  Params p{};
  p.x_prompt = (const float*)d_in[0]; p.x_sample = (const float*)d_in[1]; p.c_prompt = (const float*)d_in[2]; p.c_sample = (const float*)d_in[3];
  p.w_ada = (const float*)d_in[4]; p.b_ada = (const float*)d_in[5]; p.norm_g = (const float*)d_in[6]; p.w_in = (const float*)d_in[7];
  p.b_gates = (const float*)d_in[8]; p.conv_w = (const float*)d_in[9]; p.conv_b = (const float*)d_in[10]; p.mh_norm_g = (const float*)d_in[11];
  p.w_pc = (const float*)d_in[12]; p.w_pm = (const float*)d_in[13]; p.w_out = (const float*)d_in[14]; p.final_g = (const float*)d_in[15];
  p.out = (float*)d_out; p.ws = (unsigned char*)d_ws; p.G = Gsel; p.pad = 0;
  {
    const size_t Tg = 131072 / Gsel;
    const size_t off = 7 * (Tg * D * 2) + (size_t)DEPTH * WROWS * D * 2 + (size_t)DEPTH * 40 * 3072 * 4 + Tg * 96 + 4096;
    (void)hipMemsetAsync((unsigned char*)d_ws + off, 0, XCD_BAR_WORDS * 4, stream);
  }
  void* args[] = {&p};
  hipError_t e = hipLaunchCooperativeKernel((const void*)mega, dim3(grid_blocks), dim3(NT), args, LDS_BYTES, stream);
  if (e != hipSuccess) fprintf(stderr, "cooperative launch failed: %s (grid %d)\n", hipGetErrorString(e), grid_blocks);
}
```

```cpp
#include <hip/hip_runtime.h>
#include <hip/hip_cooperative_groups.h>
#include <cstdio>
namespace cg = cooperative_groups;

typedef unsigned short u16;
using bf16x8 = __attribute__((ext_vector_type(8))) short;
using f32x4  = __attribute__((ext_vector_type(4))) float;
using s16x4  = __attribute__((ext_vector_type(4))) short;
using u32x4  = __attribute__((ext_vector_type(4))) unsigned;
using u32x2  = __attribute__((ext_vector_type(2))) unsigned;
#define DI __device__ __forceinline__

constexpr int D = 1024, DIN = 11280, DEPTH = 4;
constexpr int NT = 512;
constexpr int W_QKV = 0, W_C = 3328, W_G = 9472, W_PC = 11520, W_PM = 12544, W_O = 13568, WROWS = 14592;
constexpr int LDT = 72;
constexpr int KS = 264, VS = 136;
constexpr int LDS_BYTES = (128 * KS + 2 * 80 * VS + 80 * KS) * 2 + 4 * 128 * 4;

struct Params {
  const float* x_prompt; const float* x_sample; const float* c_prompt; const float* c_sample;
  const float* w_ada; const float* b_ada; const float* norm_g; const float* w_in; const float* b_gates;
  const float* conv_w; const float* conv_b; const float* mh_norm_g; const float* w_pc; const float* w_pm;
  const float* w_out; const float* final_g;
  float* out; unsigned char* ws;
  int G; int pad;
};

struct Ctx {
  int G, Tg, half;
  u16 *Rh, *R1, *R2, *R3, *R4, *Rhf, *Rhb;
  u16* W; float* mod; float* sc; int* ctr;
};

DI u16 f2bf(float x) { unsigned u = __float_as_uint(x); u += 0x7fffu + ((u >> 16) & 1u); return (u16)(u >> 16); }
DI float bf2f(unsigned h) { return __uint_as_float(h << 16); }
typedef __bf16 bf16x2_t __attribute__((ext_vector_type(2)));
typedef float f32x2_t __attribute__((ext_vector_type(2)));
DI unsigned pack2(float a, float b) { const f32x2_t v = {a, b}; return __builtin_bit_cast(unsigned, __builtin_convertvector(v, bf16x2_t)); }
DI uint2 pack4(float a, float b, float c, float d) { uint2 r; r.x = pack2(a, b); r.y = pack2(c, d); return r; }
DI uint2 pack4v(f32x4 v) { return pack4(v[0], v[1], v[2], v[3]); }
DI float4 unpack4(uint2 v) { float4 r; r.x = bf2f(v.x & 0xffffu); r.y = bf2f(v.x >> 16); r.z = bf2f(v.y & 0xffffu); r.w = bf2f(v.y >> 16); return r; }
DI float sigmoidf_(float x) { return __builtin_amdgcn_rcpf(1.f + __expf(-x)); }
DI float siluf_(float x) { return x * sigmoidf_(x); }
DI float wave_sum(float v) {
#pragma unroll
  for (int o = 32; o >= 1; o >>= 1) v += __shfl_xor(v, o);
  return v;
}
DI int opaque_tid() { int t = threadIdx.x; asm volatile("" : "+v"(t)); return t; }
DI f32x4 mfma16(bf16x8 a, bf16x8 b, f32x4 c) { return __builtin_amdgcn_mfma_f32_16x16x32_bf16(a, b, c, 0, 0, 0); }


typedef const Params __attribute__((address_space(4))) CParams;
template <class PT> DI Ctx make_ctx(const PT& p) {
  Ctx c;
  c.G = p.G; c.Tg = 131072 / p.G; c.half = c.Tg >> 1;
  const size_t REG = (size_t)c.Tg * D * 2;
  unsigned char* ws = p.ws;
  c.Rh = (u16*)(ws); c.R1 = (u16*)(ws + REG); c.R2 = (u16*)(ws + 2 * REG); c.R3 = (u16*)(ws + 3 * REG);
  c.R4 = (u16*)(ws + 4 * REG); c.Rhf = (u16*)(ws + 5 * REG); c.Rhb = (u16*)(ws + 6 * REG);
  unsigned char* q = ws + 7 * REG;
  c.W = (u16*)q; q += (size_t)DEPTH * WROWS * D * 2;
  c.mod = (float*)q; q += (size_t)DEPTH * 40 * 3072 * 4;
  c.sc = (float*)q; q += (size_t)c.Tg * 96;
  c.ctr = (int*)q;
  return c;
}
DI const CParams* launder_params(const Params* g) { asm volatile("" : "+s"(g)); return (const CParams*)(unsigned long long)g; }
DI int gtok(const Ctx& c, int g, int lt) { return lt < c.half ? g * c.half + lt : 65536 + g * c.half + (lt - c.half); }
DI int batch_of(int tok) { return tok < 65536 ? (tok >> 13) : 8 + ((tok - 65536) >> 11); }
template <class PT> DI const float* xin_row(const PT& p, int tok) {
  return tok < 65536 ? p.x_prompt + (long)tok * D : p.x_sample + (long)(tok - 65536) * D;
}


#define XB_TMO      128
#define XB_XCNT(j)  (256  + 64 * (j))
#define XB_XSUB(j)  (1280 + 64 * (j))
#define XB_XGEN(j)  (2304 + 64 * (j))
#define XB_TOP      3328
#define XB_TOPGEN   3392
#define XCD_BAR_WORDS 3456
#define XB_SPIN_CAP (1u << 18)
#define LAS __attribute__((address_space(3)))
DI unsigned xb_ld(unsigned* p)              { return __hip_atomic_load(p, __ATOMIC_RELAXED, __HIP_MEMORY_SCOPE_AGENT); }
DI unsigned xb_add(unsigned* p, unsigned v) { return __hip_atomic_fetch_add(p, v, __ATOMIC_RELAXED, __HIP_MEMORY_SCOPE_AGENT); }
DI unsigned xb_xcc_id() { return (unsigned)__builtin_amdgcn_s_getreg((3 << 11) | 20) & 0xFu; }
#define XB_SPIN(cond, bar) do { unsigned _sp = 0; while (cond) { __builtin_amdgcn_s_sleep(1); \
    if ((++_sp & 255u) == 0u) { if (xb_ld(&(bar)[XB_TMO])) break; if (_sp > XB_SPIN_CAP) { atomicAdd(&(bar)[XB_TMO], 1u); break; } } } } while (0)
struct XcdBarrier { unsigned* bar; unsigned x; volatile LAS unsigned* st; };
DI XcdBarrier xcd_barrier_post(unsigned* bar, volatile LAS unsigned* st) {
  XcdBarrier b; b.bar = bar; b.x = xb_xcc_id(); b.st = st;
  if (threadIdx.x == 0) (void)xb_add(&bar[XB_XCNT(b.x)], 1u);
  return b;
}
DI void xcd_barrier_complete(unsigned* bar, unsigned x, unsigned& nloc, unsigned& nx) {
  const unsigned G = gridDim.x * gridDim.y * gridDim.z;
  unsigned sum, cnt, mine, sp = 0u;
  for (;;) {
    sum = 0u; cnt = 0u; mine = 0u;
#pragma unroll
    for (unsigned j = 0; j < 16; ++j) { const unsigned c = xb_ld(&bar[XB_XCNT(j)]); sum += c; cnt += (c > 0u) ? 1u : 0u; }
    mine = xb_ld(&bar[XB_XCNT(x)]);
    if (sum == G) break;
    __builtin_amdgcn_s_sleep(1);
    if ((++sp & 255u) == 0u) { if (xb_ld(&bar[XB_TMO])) break; if (sp > XB_SPIN_CAP) { atomicAdd(&bar[XB_TMO], 1u); break; } }
  }
  nloc = mine > 0u ? mine : 1u; nx = cnt > 0u ? cnt : 1u;
}
DI void xcd_barrier(const XcdBarrier& b) {
  asm volatile("s_waitcnt vmcnt(0)" ::: "memory");
  __syncthreads();
  if (threadIdx.x == 0) {
    unsigned* bar = b.bar;
    asm volatile("" : "+s"(bar));
    __builtin_amdgcn_s_waitcnt(0);
    unsigned nloc = b.st[0], nx = b.st[1];
    if (nloc == 0u) { xcd_barrier_complete(bar, b.x, nloc, nx); b.st[0] = nloc; b.st[1] = nx; }
    const unsigned old = xb_add(&bar[XB_XSUB(b.x)], 1u);
    const unsigned gen = old / nloc;
    if (old + 1u == (gen + 1u) * nloc) {
      __builtin_amdgcn_fence(__ATOMIC_RELEASE, "agent");
      asm volatile("s_waitcnt vmcnt(0)" ::: "memory");
      const unsigned og = xb_add(&bar[XB_TOP], 1u);
      const unsigned tg = og / nx;
      if (og + 1u == (tg + 1u) * nx) xb_add(&bar[XB_TOPGEN], 1u);
      else XB_SPIN(xb_ld(&bar[XB_TOPGEN]) == tg, bar);
      __builtin_amdgcn_fence(__ATOMIC_ACQUIRE, "agent");
      xb_add(&bar[XB_XGEN(b.x)], 1u);
      asm volatile("s_waitcnt vmcnt(0)" ::: "memory");
    } else {
      XB_SPIN(xb_ld(&bar[XB_XGEN(b.x)]) == gen, bar);
      __builtin_amdgcn_fence(__ATOMIC_ACQUIRE, "agent");
      asm volatile("s_waitcnt vmcnt(0)" ::: "memory");
    }
  }
  __syncthreads();
}

template <int MT, int NT, int ST>
DI void gemm_tile(const u16* __restrict__ P, const u16* __restrict__ Q, f32x4 (&acc)[MT][NT], u16* lds,
                  const u16* Pn = nullptr, const u16* Qn = nullptr, bool primed = false) {
  const int tid = opaque_tid(), lane = tid & 63, wave = __builtin_amdgcn_readfirstlane(tid >> 6), wm = wave & 3, wn = wave >> 2;
  const int lr = lane & 15, lg = lane >> 4;
  constexpr int PROWS = 64 * MT, QROWS = 32 * NT, NQI = NT / 2, NDMA = MT + NQI;
  char* pbase = (char*)lds;
  char* qbase = pbase + ST * PROWS * 128;
  const int drow = lane >> 3, dpos = lane & 7;
  const int r0 = 8 * wave + drow;
  const unsigned voff = (unsigned)(r0 * D + ((dpos ^ ((r0 >> 1) & 7)) << 3)) * 2u;
  const char* Pc = (const char*)P; const char* Qc = (const char*)Q;
  char* dp = pbase + wave * 1024 + lane * 16;
  char* dq = qbase + wave * 1024 + lane * 16;
#pragma unroll
  for (int i = 0; i < MT; i++)
#pragma unroll
    for (int j = 0; j < NT; j++) acc[i][j] = (f32x4){0.f, 0.f, 0.f, 0.f};
  if (!primed) {
#pragma unroll
    for (int t0 = 0; t0 < ST - 1; t0++) {
#pragma unroll
      for (int i = 0; i < MT; i++) __builtin_amdgcn_global_load_lds((const unsigned*)(Pc + (i * 64 * D * 2 + t0 * 128) + voff), (unsigned*)(dp + t0 * PROWS * 128 + i * 8192), 16, 0, 0);
#pragma unroll
      for (int i = 0; i < NQI; i++) __builtin_amdgcn_global_load_lds((const unsigned*)(Qc + (i * 64 * D * 2 + t0 * 128) + voff), (unsigned*)(dq + t0 * QROWS * 128 + i * 8192), 16, 0, 0);
    }
  }
  asm volatile("s_waitcnt vmcnt(%0)" :: "n"((ST - 2) * NDMA) : "memory");
  __builtin_amdgcn_s_barrier();
  asm volatile("" ::: "memory");
  const int swz = (lr >> 1) & 7;
  const int o0 = (lg ^ swz) << 4, o1 = ((4 + lg) ^ swz) << 4;
  const char* pa = pbase + (wm * 16 * MT + lr) * 128;
  const char* qa = qbase + (wn * 16 * NT + lr) * 128;
  constexpr int NK = D / 64;
  int cur = 0, nxs = ST - 1;
  for (int kt = 0; kt < NK; ++kt) {
    if (kt + ST - 1 < NK) {
#pragma unroll
      for (int i = 0; i < MT; i++) __builtin_amdgcn_global_load_lds((const unsigned*)(Pc + (i * 64 * D * 2 + (kt + ST - 1) * 128) + voff), (unsigned*)(dp + nxs * PROWS * 128 + i * 8192), 16, 0, 0);
#pragma unroll
      for (int i = 0; i < NQI; i++) __builtin_amdgcn_global_load_lds((const unsigned*)(Qc + (i * 64 * D * 2 + (kt + ST - 1) * 128) + voff), (unsigned*)(dq + nxs * QROWS * 128 + i * 8192), 16, 0, 0);
    }
    if (ST == 2 && kt == NK - 1 && Pn != nullptr) {
      const char* Pnc = (const char*)Pn; const char* Qnc = (const char*)Qn;
#pragma unroll
      for (int i = 0; i < MT; i++) __builtin_amdgcn_global_load_lds((const unsigned*)(Pnc + (i * 64 * D * 2) + voff), (unsigned*)(dp + i * 8192), 16, 0, 0);
#pragma unroll
      for (int i = 0; i < NQI; i++) __builtin_amdgcn_global_load_lds((const unsigned*)(Qnc + (i * 64 * D * 2) + voff), (unsigned*)(dq + i * 8192), 16, 0, 0);
    }
    const char* pb = pa + cur * PROWS * 128;
    const char* qb = qa + cur * QROWS * 128;
    if constexpr (NT == 99) {
      bf16x8 af[MT], b0[NT], b1[NT];
#pragma unroll
      for (int j = 0; j < NT; j++) b0[j] = *(const bf16x8*)(qb + j * 2048 + o0);
#pragma unroll
      for (int i = 0; i < MT; i++) af[i] = *(const bf16x8*)(pb + i * 2048 + o0);
      __builtin_amdgcn_s_setprio(1);
#pragma unroll
      for (int i = 0; i < MT; i++) {
#pragma unroll
        for (int j = 0; j < NT; j++) acc[i][j] = mfma16(af[i], b0[j], acc[i][j]);
        b1[i] = *(const bf16x8*)(qb + i * 2048 + o1);
        af[i] = *(const bf16x8*)(pb + i * 2048 + o1);
      }
#pragma unroll
      for (int j = MT; j < NT; j++) b1[j] = *(const bf16x8*)(qb + j * 2048 + o1);
#pragma unroll
      for (int i = 0; i < MT; i++)
#pragma unroll
        for (int j = 0; j < NT; j++) acc[i][j] = mfma16(af[i], b1[j], acc[i][j]);
      __builtin_amdgcn_sched_group_barrier(0x100, NT + MT, 0);
#pragma unroll
      for (int r = 0; r < MT; r++) {
        __builtin_amdgcn_sched_group_barrier(0x008, 4, 0);
        __builtin_amdgcn_sched_group_barrier(0x100, 1, 0);
        __builtin_amdgcn_sched_group_barrier(0x008, 4, 0);
        __builtin_amdgcn_sched_group_barrier(0x100, 1, 0);
      }
      __builtin_amdgcn_sched_group_barrier(0x100, NT - MT, 0);
      __builtin_amdgcn_sched_group_barrier(0x008, MT * NT, 0);
      __builtin_amdgcn_s_setprio(0);
    } else {
#pragma unroll
      for (int ks = 0; ks < 2; ++ks) {
        const int oo = ks ? o1 : o0;
        bf16x8 a[MT], b[NT];
#pragma unroll
        for (int i = 0; i < MT; i++) a[i] = *(const bf16x8*)(pb + i * 2048 + oo);
#pragma unroll
        for (int j = 0; j < NT; j++) b[j] = *(const bf16x8*)(qb + j * 2048 + oo);
        __builtin_amdgcn_s_setprio(1);
#pragma unroll
        for (int i = 0; i < MT; i++)
#pragma unroll
          for (int j = 0; j < NT; j++) acc[i][j] = mfma16(a[i], b[j], acc[i][j]);
        __builtin_amdgcn_s_setprio(0);
      }
    }
    if (kt + ST - 1 < NK) asm volatile("s_waitcnt vmcnt(%0)" :: "n"((ST - 2) * NDMA) : "memory");
    else if (!(ST == 2 && Pn != nullptr)) asm volatile("s_waitcnt vmcnt(0)" ::: "memory");
    __builtin_amdgcn_s_barrier();
    asm volatile("" ::: "memory");
    cur = (cur == ST - 1) ? 0 : cur + 1;
    nxs = (nxs == ST - 1) ? 0 : nxs + 1;
  }
}

template <class PT> DI void wsrc(const PT& p, int l, int n, const float*& src, int& ld, int& col, float& scale) {
  scale = 1.f;
  src = p.w_in + (long)l * D * DIN; ld = DIN;
  if (n < W_C) {
    if (n < 1024) col = 4096 + n;
    else if (n < 2048) { col = 5120 + (n - 1024); scale = 0.0625f; }
    else if (n < 3072) col = 6144 + (n - 2048);
    else if (n < 3088) col = 9216 + (n - 3072);
    else col = -1;
  } else if (n < W_G) {
    int n2 = n - W_C;
    if (n2 < 4096) { int blk = n2 >> 6, sl = (n2 >> 4) & 3, cl = n2 & 15; col = sl * 1024 + blk * 16 + cl; }
    else { int n3 = n2 - 4096; int blk = n3 >> 5, sl = (n3 >> 4) & 1, cl = n3 & 15; col = (sl ? 8192 : 7168) + blk * 16 + cl; }
  } else if (n < W_PC) {
    int n4 = n - W_G; int mtb = n4 >> 9, r5 = n4 & 511; int cc5 = r5 >> 8, wm5 = (r5 >> 6) & 3, a5 = (r5 >> 5) & 1, sl = (r5 >> 4) & 1, cl = r5 & 15;
    col = 9232 + sl * 1024 + (256 * mtb + 64 * wm5 + 32 * cc5 + 16 * a5 + cl);
  } else if (n < W_PM) { src = p.w_pc + (long)l * D * D; ld = D; col = n - W_PC; }
  else if (n < W_O)  { src = p.w_pm + (long)l * D * D; ld = D; col = n - W_PM; }
  else               { src = p.w_out + (long)l * D * D; ld = D; col = n - W_O; }
}

template <class PT> DI void phase_prep(const PT& p, const Ctx& c, float* ldsf) {
  const int tid = opaque_tid();
  if (blockIdx.x == 0 && tid < 256) c.ctr[tid] = 0;
  const int nItems = DEPTH * (WROWS / 64) * 16;
  for (int it = blockIdx.x; it < nItems; it += gridDim.x) {
    const int kb = (it & 15) * 64; const int rb = it >> 4;
    const int l = rb / (WROWS / 64); const int nb = (rb % (WROWS / 64)) * 64;
    const float* src; int ld, col; float scale;
    const int nl = tid & 63;
    wsrc(p, l, nb + nl, src, ld, col, scale);
#pragma unroll
    for (int i = 0; i < 8; i++) {
      const int kl = (tid >> 6) + 8 * i;
      float v = (col >= 0) ? src[(long)(kb + kl) * ld + col] * scale : 0.f;
      ldsf[kl * 65 + nl] = v;
    }
    __syncthreads();
    {
      const int nl2 = tid >> 3, kc = tid & 7;
      float v[8];
#pragma unroll
      for (int j = 0; j < 8; j++) v[j] = ldsf[(kc * 8 + j) * 65 + nl2];
      uint4 o; o.x = pack2(v[0], v[1]); o.y = pack2(v[2], v[3]); o.z = pack2(v[4], v[5]); o.w = pack2(v[6], v[7]);
      *(uint4*)(c.W + ((long)l * WROWS + nb + nl2) * D + kb + kc * 8) = o;
    }
    __syncthreads();
  }
  const int nMod = DEPTH * 48;
  for (int it = blockIdx.x; it < nMod; it += gridDim.x) {
    const int l = it / 48, jb = (it % 48) * 64;
    const int cl = tid & 63, kc = tid >> 6;
    float acc[40];
#pragma unroll
    for (int b = 0; b < 40; b++) acc[b] = 0.f;
    const float* wa = p.w_ada + (long)l * D * 3072 + jb + cl;
    for (int k = kc * 128; k < kc * 128 + 128; ++k) {
      const float wv = wa[(long)k * 3072];
#pragma unroll
      for (int b = 0; b < 40; b++) {
        const float cv = (b < 8) ? p.c_prompt[b * D + k] : p.c_sample[(b - 8) * D + k];
        acc[b] += cv * wv;
      }
    }
#pragma unroll
    for (int b = 0; b < 40; b++) ldsf[(kc * 40 + b) * 64 + cl] = acc[b];
    __syncthreads();
    for (int idx = tid; idx < 40 * 64; idx += NT) {
      const int b = idx >> 6, cc = idx & 63;
      float s = p.b_ada[l * 3072 + jb + cc];
#pragma unroll
      for (int q = 0; q < 8; q++) s += ldsf[(q * 40 + b) * 64 + cc];
      c.mod[((long)l * 40 + b) * 3072 + jb + cc] = s;
    }
    __syncthreads();
  }
}

template <class PT> DI void phase_rows(const PT& p, const Ctx& c, int l, int g, bool fin) {
  const int tid_ = opaque_tid(); const int lane = tid_ & 63, w = tid_ >> 6;
  const int stride = gridDim.x * 8;
  float4 gv[4];
#pragma unroll
  for (int i = 0; i < 4; i++) gv[i] = *(const float4*)((fin ? p.final_g : p.norm_g + l * D) + 4 * lane + 256 * i);
  for (int lt0 = blockIdx.x * 8 + w; lt0 < c.Tg; lt0 += 2 * stride) {
    const bool has1 = lt0 + stride < c.Tg;
    const int lt1 = has1 ? lt0 + stride : lt0;
    const int tok0 = gtok(c, g, lt0), tok1 = gtok(c, g, lt1);
    const float* xr0 = (l == 0) ? xin_row(p, tok0) : p.out + (long)tok0 * D;
    const float* xr1 = (l == 0) ? xin_row(p, tok1) : p.out + (long)tok1 * D;
    float4 v0[4], v1[4]; float ss0 = 0.f, ss1 = 0.f;
#pragma unroll
    for (int i = 0; i < 4; i++) { v0[i] = *(const float4*)(xr0 + 4 * lane + 256 * i); v1[i] = *(const float4*)(xr1 + 4 * lane + 256 * i); }
    const float* mp0 = c.mod + ((long)(fin ? 0 : l) * 40 + batch_of(tok0)) * 3072;
    const float* mp1 = c.mod + ((long)(fin ? 0 : l) * 40 + batch_of(tok1)) * 3072;
    float4 sc0[4], sh0[4], sc1[4], sh1[4];
    if (!fin) {
#pragma unroll
      for (int i = 0; i < 4; i++) {
        const int k = 4 * lane + 256 * i;
        sc0[i] = *(const float4*)(mp0 + 1024 + k); sh0[i] = *(const float4*)(mp0 + k);
        sc1[i] = *(const float4*)(mp1 + 1024 + k); sh1[i] = *(const float4*)(mp1 + k);
      }
    }
#pragma unroll
    for (int i = 0; i < 4; i++) {
      ss0 += v0[i].x * v0[i].x + v0[i].y * v0[i].y + v0[i].z * v0[i].z + v0[i].w * v0[i].w;
      ss1 += v1[i].x * v1[i].x + v1[i].y * v1[i].y + v1[i].z * v1[i].z + v1[i].w * v1[i].w;
    }
    ss0 = wave_sum(ss0); ss1 = wave_sum(ss1);
    const float r0 = rsqrtf(ss0 * (1.f / 1024.f) + 1e-6f), r1 = rsqrtf(ss1 * (1.f / 1024.f) + 1e-6f);
    if (fin) {
#pragma unroll
      for (int i = 0; i < 4; i++) {
        const int k = 4 * lane + 256 * i;
        float4 o; o.x = v0[i].x * r0 * gv[i].x; o.y = v0[i].y * r0 * gv[i].y; o.z = v0[i].z * r0 * gv[i].z; o.w = v0[i].w * r0 * gv[i].w;
        *(float4*)(p.out + (long)tok0 * D + k) = o;
      }
      if (has1) {
#pragma unroll
        for (int i = 0; i < 4; i++) {
          const int k = 4 * lane + 256 * i;
          float4 o; o.x = v1[i].x * r1 * gv[i].x; o.y = v1[i].y * r1 * gv[i].y; o.z = v1[i].z * r1 * gv[i].z; o.w = v1[i].w * r1 * gv[i].w;
          *(float4*)(p.out + (long)tok1 * D + k) = o;
        }
      }
    } else {
#pragma unroll
      for (int i = 0; i < 4; i++) {
        const int k = 4 * lane + 256 * i;
        *(uint2*)(c.Rh + (long)lt0 * D + k) = pack4(v0[i].x * r0 * gv[i].x * (1.f + sc0[i].x) + sh0[i].x, v0[i].y * r0 * gv[i].y * (1.f + sc0[i].y) + sh0[i].y,
                                                    v0[i].z * r0 * gv[i].z * (1.f + sc0[i].z) + sh0[i].z, v0[i].w * r0 * gv[i].w * (1.f + sc0[i].w) + sh0[i].w);
      }
      if (has1) {
#pragma unroll
        for (int i = 0; i < 4; i++) {
          const int k = 4 * lane + 256 * i;
          *(uint2*)(c.Rh + (long)lt1 * D + k) = pack4(v1[i].x * r1 * gv[i].x * (1.f + sc1[i].x) + sh1[i].x, v1[i].y * r1 * gv[i].y * (1.f + sc1[i].y) + sh1[i].y,
                                                      v1[i].z * r1 * gv[i].z * (1.f + sc1[i].z) + sh1[i].z, v1[i].w * r1 * gv[i].w * (1.f + sc1[i].w) + sh1[i].w);
        }
      }
    }
  }
}

template <class PT> DI void phase_A(const PT& p, const Ctx& c, int l, u16* lds) {
  const int tid = opaque_tid(), lane = tid & 63, wave = tid >> 6, wm = wave & 3, wn = wave >> 2, lr = lane & 15, lg = lane >> 4;
  const u16* W = c.W + (long)l * WROWS * D;
  u16* Rq = c.R1; u16* Rk = c.R2; u16* RvT = c.R4;
  const int nTiles = (c.Tg / 256) * 13;
  auto ptrsA = [&](int tl, const u16*& Pp, const u16*& Qp) {
    const int tb_ = tl / 13, j_ = tl % 13;
    const u16* hp = c.Rh + (long)tb_ * 256 * D;
    if (j_ < 8) { Pp = W + (long)((j_ >> 2) * 1024 + (j_ & 3) * 256) * D; Qp = hp; }
    else if (j_ < 12) { Pp = hp; Qp = W + (long)(2048 + (j_ - 8) * 256) * D; }
    else { Pp = W + (long)3072 * D; Qp = hp; }
  };
  bool primed = false;
  for (int tile = blockIdx.x; tile < nTiles; tile += gridDim.x) {
    const int tb = tile / 13, j = tile % 13;
    f32x4 acc[4][8];
    const u16 *P0, *Q0, *P1 = nullptr, *Q1 = nullptr;
    ptrsA(tile, P0, Q0);
    if (tile + (int)gridDim.x < nTiles && j != 12 && (tile + (int)gridDim.x) % 13 != 12) ptrsA(tile + gridDim.x, P1, Q1);
    const bool pr = primed; primed = (P1 != nullptr);
    if (j < 8) {
      const int isk = j >> 2, head = j & 3;
      gemm_tile<4, 8, 2>(P0, Q0, acc, lds, P1, Q1, pr);
      u16* dst = isk ? Rk : Rq;
#pragma unroll
      for (int i = 0; i < 4; i++)
#pragma unroll
        for (int jn = 0; jn < 8; jn++) {
          const int d = 64 * wm + 16 * i + 4 * lg, t = 128 * wn + 16 * jn + lr;
          *(uint2*)(dst + (long)(tb * 256 + t) * D + head * 256 + d) = pack4v(acc[i][jn]);
        }
    } else if (j < 12) {
      const int head = j - 8;
      gemm_tile<4, 8, 2>(P0, Q0, acc, lds, P1, Q1, pr);
#pragma unroll
      for (int i = 0; i < 4; i++)
#pragma unroll
        for (int jn = 0; jn < 8; jn++) {
          const int tokl = 64 * wm + 16 * i + 4 * lg, e = 128 * wn + 16 * jn + lr;
          const int ch = tb * 2 + (tokl >> 7), sidx = tokl & 127;
          *(uint2*)(RvT + ((long)(ch * 4 + head) * 256 + e) * 128 + sidx) = pack4v(acc[i][jn]);
        }
    } else {
      f32x4 accg[1][8];
      gemm_tile<1, 8, 2>(P0, Q0, accg, lds);
      float* gl = (float*)lds;
      if (wm == 0) {
#pragma unroll
        for (int jn = 0; jn < 8; jn++) {
          const int t = 128 * wn + 16 * jn + lr;
#pragma unroll
          for (int r = 0; r < 4; r++) {
            float v = accg[0][jn][r] + p.b_gates[l * 16 + lg * 4 + r];
            if (lg & 1) v = fminf(v, 0.f) - log1pf(expf(-fabsf(v)));
            gl[t * 16 + lg * 4 + r] = v;
          }
        }
      }
      __syncthreads();
      if (tid < 16) {
        const int head = tid & 3, dir = (tid >> 2) & 1, cl = tid >> 3;
        const int ch = tb * 2 + cl;
        float* o = c.sc + (((long)(ch * 4 + head) * 2 + dir) * 3) * 128;
        const float* glc = gl + cl * 128 * 16;
        float bs = 0.f, pm = -3.0e38f;
        for (int q = 0; q < 128; ++q) {
          const int t = dir ? 127 - q : q;
          const float iv = glc[t * 16 + dir * 8 + head], lf = glc[t * 16 + dir * 8 + 4 + head];
          bs += lf; const float gg = iv - bs; pm = fmaxf(pm, gg);
          o[t] = bs; o[128 + t] = gg; o[256 + t] = pm;
        }
      }
      __syncthreads();
    }
  }
}

template <class PT> DI void phase_scan(const PT& p, const Ctx& c, int ctrIdx, char* smem) {
  __shared__ int s_task;
  const int tid = opaque_tid(), lane = tid & 63, w0 = __builtin_amdgcn_readfirstlane(tid >> 6), lr = lane & 15, lg = lane >> 4;
  u16* Kb = (u16*)smem;
  u16* Vt = Kb + 128 * KS;
  u16* Vw = Vt + 80 * VS;
  u16* Ct = Vw + 80 * VS;
  float* scg = (float*)(Ct + 80 * KS); float* scmu = scg + 128; float* sciw = scmu + 128; float* scfl = sciw + 128;
  const u16* Rq = c.R1; const u16* Rk = c.R2; const u16* RvT = c.R4;
  const int nLong = (8 / c.G) * 32;
  const int nLongQ8 = (8 / c.G), nShortQ8 = (32 / c.G);
  const int perQueue = (nLongQ8 + nShortQ8) * 4;
  int* ctr = c.ctr + ctrIdx * 8;
  const int myq = (int)(xb_xcc_id() & 7u);
  int qoff = 0;
  while (true) {
    __syncthreads();
    if (tid == 0) {
      int t = -1;
      while (qoff < 8) {
        const int qi = (myq + qoff) & 7;
        const int n = atomicAdd(ctr + qi, 1);
        if (n < perQueue) {
          const int quad = (n < nLongQ8 * 4) ? qi + 8 * (n >> 2) : nLongQ8 * 8 + qi + 8 * ((n - nLongQ8 * 4) >> 2);
          t = quad * 4 + (n & 3);
          break;
        }
        ++qoff;
      }
      s_task = t;
    }
    __syncthreads();
    const int task = s_task;
    if (task < 0) break;
    int seq, r, chunk0, nc;
    if (task < nLong) { seq = task >> 5; r = task & 31; chunk0 = seq * 64; nc = 64; }
    else { const int t2 = task - nLong; seq = t2 >> 5; r = t2 & 31; chunk0 = (c.half >> 7) + seq * 16; nc = 16; }
    const int head = r >> 3, dir = (r >> 2) & 1, es = r & 3;
    const int last = dir ? 0 : 127;
    u16* Rho = dir ? c.Rhb : c.Rhf;
    for (int idx = tid; idx < 80 * KS / 2; idx += NT) ((unsigned*)Ct)[idx] = 0u;
    for (int idx = tid; idx < 16 * VS / 2; idx += NT) { ((unsigned*)(Vt + 64 * VS))[idx] = 0u; ((unsigned*)(Vw + 64 * VS))[idx] = 0u; }
    __syncthreads();
    if (tid < 128) Vt[64 * VS + tid] = (u16)0x3F80;
    f32x4 st[2][5];
#pragma unroll
    for (int i = 0; i < 2; i++)
#pragma unroll
      for (int jn = 0; jn < 5; jn++) st[i][jn] = (f32x4){0.f, 0.f, 0.f, 0.f};
    float m = 0.f;
    const int vrow = tid >> 4, vsc = tid & 15;
    const int krow = tid >> 5, kkc = (tid & 31) * 8;
    u32x4 kpre[8], vpre[2]; float4 g8a, g8b; float bLn, gmaxn, myb, myg, mypm;
    bf16x8 qf[8];
    auto scan_load = [&](int cq) {
#pragma unroll
      for (int ks = 0; ks < 8; ks++)
        qf[ks] = *(const bf16x8*)(Rq + (long)(cq * 128 + 16 * w0 + lr) * D + head * 256 + 32 * ks + 8 * lg);
#pragma unroll
      for (int i = 0; i < 8; i++) kpre[i] = *(const u32x4*)(Rk + (long)(cq * 128 + krow + 16 * i) * D + head * 256 + kkc);
#pragma unroll
      for (int i = 0; i < 2; i++) vpre[i] = *(const u32x4*)(RvT + ((long)(cq * 4 + head) * 256 + es * 64 + vrow + 32 * i) * 128 + vsc * 8);
      const float* scb = c.sc + ((long)(cq * 4 + head) * 2 + dir) * 384;
      g8a = *(const float4*)(scb + 128 + vsc * 8); g8b = *(const float4*)(scb + 128 + vsc * 8 + 4);
      bLn = scb[last]; gmaxn = scb[256 + last];
      myb = scb[tid & 127]; myg = scb[128 + (tid & 127)]; mypm = scb[256 + (tid & 127)];
    };
    scan_load(chunk0 + (dir ? nc - 1 : 0));
    for (int j = 0; j < nc; ++j) {
      const int cc = chunk0 + (dir ? nc - 1 - j : j);
      int w = w0; asm volatile("" : "+s"(w));
      __syncthreads();
      const float muL = fmaxf(m, gmaxn);
      const float decay = __expf(m - muL);
      const float mnext = bLn + muL;
#pragma unroll
      for (int i = 0; i < 2; i++)
#pragma unroll
        for (int jn = 0; jn < 5; jn++)
          *(uint2*)(Ct + (16 * jn + lr) * KS + 32 * w + 16 * i + 4 * lg) = pack4v(st[i][jn]);
#pragma unroll
      for (int i = 0; i < 8; i++) *(u32x4*)(Kb + (krow + 16 * i) * KS + kkc) = kpre[i];
      {
        float w8[8];
        w8[0] = __expf(g8a.x - muL); w8[1] = __expf(g8a.y - muL); w8[2] = __expf(g8a.z - muL); w8[3] = __expf(g8a.w - muL);
        w8[4] = __expf(g8b.x - muL); w8[5] = __expf(g8b.y - muL); w8[6] = __expf(g8b.z - muL); w8[7] = __expf(g8b.w - muL);
#pragma unroll
        for (int i = 0; i < 2; i++) {
          const u32x4 vv = vpre[i];
          *(u32x4*)(Vt + (vrow + 32 * i) * VS + vsc * 8) = vv;
          uint4 v; v.x = vv[0]; v.y = vv[1]; v.z = vv[2]; v.w = vv[3];
          uint4 o;
          o.x = pack2(bf2f(v.x & 0xffffu) * w8[0], bf2f(v.x >> 16) * w8[1]);
          o.y = pack2(bf2f(v.y & 0xffffu) * w8[2], bf2f(v.y >> 16) * w8[3]);
          o.z = pack2(bf2f(v.z & 0xffffu) * w8[4], bf2f(v.z >> 16) * w8[5]);
          o.w = pack2(bf2f(v.w & 0xffffu) * w8[6], bf2f(v.w >> 16) * w8[7]);
          *(uint4*)(Vw + (vrow + 32 * i) * VS + vsc * 8) = o;
        }
        if (tid < 16) {
          uint4 o; o.x = pack2(w8[0], w8[1]); o.y = pack2(w8[2], w8[3]); o.z = pack2(w8[4], w8[5]); o.w = pack2(w8[6], w8[7]);
          *(uint4*)(Vw + 64 * VS + vsc * 8) = o;
        }
      }
      if (tid < 128) {
        const float mu = fmaxf(m, mypm);
        scg[tid] = myg; scmu[tid] = mu; sciw[tid] = __expf(m - mu); scfl[tid] = __expf(-(mu + myb));
      }
      __syncthreads();
      const int t = 16 * w + lr;
      bf16x8 spk[4];
      {
        f32x4 sacc[8];
#pragma unroll
        for (int i = 0; i < 8; i++) sacc[i] = (f32x4){0.f, 0.f, 0.f, 0.f};
#pragma unroll
        for (int i = 0; i < 8; i++) {
          const bool need = dir ? (i >= w) : (i <= w);
          if (need) {
#pragma unroll
            for (int ks = 0; ks < 8; ks++) {
              const bf16x8 a = *(const bf16x8*)(Kb + (16 * i + lr) * KS + 32 * ks + 8 * lg);
              sacc[i] = mfma16(a, qf[ks], sacc[i]);
            }
          }
        }
        const float mu_t = scmu[t];
        int tt = t; asm volatile("" : "+v"(tt));
        const int sgn = dir ? -1 : 1;
#pragma unroll
        for (int ks = 0; ks < 4; ks++) {
          float sv[8];
#pragma unroll
          for (int hh = 0; hh < 2; hh++) {
            const int i = 2 * ks + hh;
            const float4 gs = *(const float4*)(scg + 16 * i + 4 * lg);
            const float gv[4] = {gs.x, gs.y, gs.z, gs.w};
#pragma unroll
            for (int r2 = 0; r2 < 4; r2++) {
              const int s = 16 * i + 4 * lg + r2;
              const bool valid = (s - tt) * sgn <= 0;
              sv[hh * 4 + r2] = valid ? sacc[i][r2] * __expf(gv[r2] - mu_t) : 0.f;
            }
          }
          uint4 o; o.x = pack2(sv[0], sv[1]); o.y = pack2(sv[2], sv[3]); o.z = pack2(sv[4], sv[5]); o.w = pack2(sv[6], sv[7]);
          spk[ks] = __builtin_bit_cast(bf16x8, o);
        }
      }
      f32x4 num[5];
#pragma unroll
      for (int i = 0; i < 5; i++) num[i] = (f32x4){0.f, 0.f, 0.f, 0.f};
#pragma unroll
      for (int ks = 0; ks < 8; ks++)
#pragma unroll
        for (int i = 0; i < 5; i++) {
          const bf16x8 a = *(const bf16x8*)(Ct + (16 * i + lr) * KS + 32 * ks + 8 * lg);
          num[i] = mfma16(a, qf[ks], num[i]);
        }
      {
        const float iw = sciw[t];
#pragma unroll
        for (int i = 0; i < 5; i++) num[i] *= iw;
      }
#pragma unroll
      for (int ks = 0; ks < 4; ks++) {
        const bool need = dir ? (2 * ks + 1 >= w) : (2 * ks <= w);
        if (need) {
#pragma unroll
          for (int i = 0; i < 5; i++) {
            const uint2 lo = *(const uint2*)(Vt + (16 * i + lr) * VS + 32 * ks + 4 * lg);
            const uint2 hi = *(const uint2*)(Vt + (16 * i + lr) * VS + 32 * ks + 16 + 4 * lg);
            uint4 av; av.x = lo.x; av.y = lo.y; av.z = hi.x; av.w = hi.y;
            num[i] = mfma16(__builtin_bit_cast(bf16x8, av), spk[ks], num[i]);
          }
        }
      }
      {
        const float fl = scfl[t];
        const float dr = __shfl(num[4][0], lr);
        const float inv = 1.f / fmaxf(fabsf(dr), fl);
        u16* dst = Rho + (long)(cc * 128 + t) * D + head * 256 + es * 64 + 4 * lg;
#pragma unroll
        for (int i = 0; i < 4; i++)
          *(uint2*)(dst + 16 * i) = pack4(num[i][0] * inv, num[i][1] * inv, num[i][2] * inv, num[i][3] * inv);
      }
      __builtin_amdgcn_sched_barrier(0);
      { const int jn1 = (j + 1 < nc) ? j + 1 : j; scan_load(chunk0 + (dir ? nc - 1 - jn1 : jn1)); }
      __builtin_amdgcn_sched_barrier(0);
#pragma unroll
      for (int i = 0; i < 2; i++)
#pragma unroll
        for (int jn = 0; jn < 5; jn++) st[i][jn] *= decay;
#pragma unroll
      for (int ks = 0; ks < 4; ks++) {
        bf16x8 kTf[2];
#pragma unroll
        for (int i = 0; i < 2; i++) {
          const u16* ap = Kb + (32 * ks + 8 * lg + (lr >> 2)) * KS + 32 * w + 16 * i + 4 * (lr & 3);
          const s16x4 lo = __builtin_amdgcn_ds_read_tr16_b64_v4i16((s16x4 __attribute__((address_space(3)))*)ap);
          const s16x4 hi = __builtin_amdgcn_ds_read_tr16_b64_v4i16((s16x4 __attribute__((address_space(3)))*)(ap + 4 * KS));
          kTf[i] = __builtin_shufflevector(lo, hi, 0, 1, 2, 3, 4, 5, 6, 7);
        }
#pragma unroll
        for (int jn = 0; jn < 5; jn++) {
          const bf16x8 b = *(const bf16x8*)(Vw + (16 * jn + lr) * VS + 32 * ks + 8 * lg);
#pragma unroll
          for (int i = 0; i < 2; i++) st[i][jn] = mfma16(kTf[i], b, st[i][jn]);
        }
      }
      m = mnext;
    }
  }
}

template <class PT> DI void phase_C(const PT& p, const Ctx& c, int l, u16* lds) {
  const int tid = opaque_tid(), lane = tid & 63, wave = tid >> 6, wm = wave & 3, wn = wave >> 2, lr = lane & 15, lg = lane >> 4;
  const u16* W = c.W + ((long)l * WROWS + W_C) * D;
  u16* Ru = c.R1; u16* Ryp = c.R2; u16* Rog = c.R3;
  const int nTiles = (c.Tg / 256) * 24;
  for (int tile = blockIdx.x; tile < nTiles; tile += gridDim.x) {
    const int tb = tile / 24, pt = tile % 24;
    f32x4 acc[4][8];
    {
      const int tn = tile + gridDim.x;
      const bool has = tn < nTiles;
      gemm_tile<4, 8, 2>(W + (long)pt * 256 * D, c.Rh + (long)tb * 256 * D, acc, lds,
                         has ? W + (long)(tn % 24) * 256 * D : nullptr, has ? c.Rh + (long)(tn / 24) * 256 * D : nullptr, tile != (int)blockIdx.x);
    }
    if (pt < 16) {
      const int chn = pt * 64 + wm * 16 + 4 * lg;
#pragma unroll
      for (int jn = 0; jn < 8; jn++) {
        const long lt = tb * 256 + 128 * wn + 16 * jn + lr;
        float u[4], y[4];
#pragma unroll
        for (int r = 0; r < 4; r++) { u[r] = acc[1][jn][r] * acc[2][jn][r]; y[r] = acc[0][jn][r] * siluf_(acc[3][jn][r]); }
        *(uint2*)(Ru + lt * D + chn) = pack4(u[0], u[1], u[2], u[3]);
        *(uint2*)(Ryp + lt * D + chn) = pack4(y[0], y[1], y[2], y[3]);
      }
    } else {
      const int chn = (pt - 16) * 128 + wm * 32 + 4 * lg;
#pragma unroll
      for (int jn = 0; jn < 8; jn++) {
        const long lt = tb * 256 + 128 * wn + 16 * jn + lr;
#pragma unroll
        for (int hh = 0; hh < 2; hh++) {
          float o[4];
#pragma unroll
          for (int r = 0; r < 4; r++) o[r] = sigmoidf_(acc[2 * hh][jn][r]) * siluf_(acc[2 * hh + 1][jn][r]);
          *(uint2*)(Rog + lt * D + chn + 16 * hh) = pack4(o[0], o[1], o[2], o[3]);
        }
      }
    }
  }
}

template <class PT> DI void phase_E(const PT& p, const Ctx& c, int l) {
  const int tid_ = opaque_tid(); const int lane = tid_ & 63, w = tid_ >> 6;
  const u16* Ru = c.R1; u16* Ryp = c.R2; u16* Rog = c.R3;
  const float* cw = p.conv_w + (long)l * 3 * D; const float* cb = p.conv_b + (long)l * D; const float* mg = p.mh_norm_g + (long)l * D;
  float4 w0[4], w1[4], w2[4], bb[4], gg[4];
#pragma unroll
  for (int i = 0; i < 4; i++) {
    const int k = 4 * lane + 256 * i;
    w0[i] = *(const float4*)(cw + k); w1[i] = *(const float4*)(cw + D + k); w2[i] = *(const float4*)(cw + 2 * D + k);
    bb[i] = *(const float4*)(cb + k); gg[i] = *(const float4*)(mg + k);
  }
  for (int lt = blockIdx.x * 8 + w; lt < c.Tg; lt += gridDim.x * 8) {
    const int sl = lt < c.half ? 8192 : 2048;
    const int pos = (lt < c.half ? lt : lt - c.half) & (sl - 1);
    const bool first = pos == 0, lastp = pos == sl - 1;
    uint2 U0[4], U1[4], U2[4], YP[4], OG[4], HF[4], HB[4];
#pragma unroll
    for (int i = 0; i < 4; i++) {
      const int k = 4 * lane + 256 * i;
      U0[i] = *(const uint2*)(Ru + (long)(first ? lt : lt - 1) * D + k);
      U1[i] = *(const uint2*)(Ru + (long)lt * D + k);
      U2[i] = *(const uint2*)(Ru + (long)(lastp ? lt : lt + 1) * D + k);
      if (first) { U0[i].x = 0u; U0[i].y = 0u; }
      if (lastp) { U2[i].x = 0u; U2[i].y = 0u; }
      YP[i] = *(const uint2*)(Ryp + (long)lt * D + k);
      OG[i] = *(const uint2*)(Rog + (long)lt * D + k);
      HF[i] = *(const uint2*)(c.Rhf + (long)lt * D + k);
      HB[i] = *(const uint2*)(c.Rhb + (long)lt * D + k);
    }
#pragma unroll
    for (int i = 0; i < 4; i++) {
      const int k = 4 * lane + 256 * i;
      const float4 a0 = unpack4(U0[i]), a1 = unpack4(U1[i]), a2 = unpack4(U2[i]), yp = unpack4(YP[i]);
      const float y0 = yp.x * (w0[i].x * a0.x + w1[i].x * a1.x + w2[i].x * a2.x + bb[i].x);
      const float y1 = yp.y * (w0[i].y * a0.y + w1[i].y * a1.y + w2[i].y * a2.y + bb[i].y);
      const float y2 = yp.z * (w0[i].z * a0.z + w1[i].z * a1.z + w2[i].z * a2.z + bb[i].z);
      const float y3 = yp.w * (w0[i].w * a0.w + w1[i].w * a1.w + w2[i].w * a2.w + bb[i].w);
      *(uint2*)(Ryp + (long)lt * D + k) = pack4(y0, y1, y2, y3);
      const float4 hf = unpack4(HF[i]), hb = unpack4(HB[i]), og = unpack4(OG[i]);
      const float s0 = hf.x + hb.x, s1 = hf.y + hb.y, s2 = hf.z + hb.z, s3 = hf.w + hb.w;
      const float ss = wave_sum(s0 * s0 + s1 * s1 + s2 * s2 + s3 * s3);
      const float rstd = rsqrtf(ss * (1.f / 256.f) + 1e-6f);
      *(uint2*)(Rog + (long)lt * D + k) = pack4(og.x * s0 * rstd * gg[i].x, og.y * s1 * rstd * gg[i].y, og.z * s2 * rstd * gg[i].z, og.w * s3 * rstd * gg[i].w);
    }
  }
}

template <class PT> DI void phase_D1(const PT& p, const Ctx& c, int l, u16* lds) {
  const int tid = opaque_tid(), lane = tid & 63, wave = tid >> 6, wm = wave & 3, wn = wave >> 2, lr = lane & 15, lg = lane >> 4;
  const u16* W = c.W + (long)l * WROWS * D;
  const u16* Ryc = c.R2; const u16* Rym = c.R3; u16* Rmg = c.R4;
  const int nTiles = (c.Tg / 128) * 4;
  for (int tile = blockIdx.x; tile < nTiles; tile += gridDim.x) {
    const int ch = tile >> 2, mt = tile & 3;
    u32x2 gk[2][4][4], Mk[4][4];
#pragma unroll
    for (int cc = 0; cc < 2; cc++) {
      f32x4 a1[4][4];
      gemm_tile<4, 4, 3>(W + (long)(W_G + mt * 512 + cc * 256) * D, c.Rh + (long)ch * 128 * D, a1, lds);
#pragma unroll
      for (int i = 0; i < 4; i++)
#pragma unroll
        for (int jn = 0; jn < 4; jn++) {
          const uint2 t_ = pack4(sigmoidf_(a1[i][jn][0]), sigmoidf_(a1[i][jn][1]), sigmoidf_(a1[i][jn][2]), sigmoidf_(a1[i][jn][3]));
          gk[cc][i][jn] = (u32x2){t_.x, t_.y}; asm volatile("" : "+v"(gk[cc][i][jn]));
        }
    }
    {
      f32x4 a2[4][4];
      gemm_tile<4, 4, 3>(W + (long)(W_PC + mt * 256) * D, Ryc + (long)ch * 128 * D, a2, lds);
#pragma unroll
      for (int i = 0; i < 4; i++)
#pragma unroll
        for (int jn = 0; jn < 4; jn++) {
          uint2 g_; g_.x = gk[i >> 1][2 * (i & 1)][jn][0]; g_.y = gk[i >> 1][2 * (i & 1)][jn][1];
          const float4 gg = unpack4(g_);
          const uint2 t_ = pack4(gg.x * a2[i][jn][0], gg.y * a2[i][jn][1], gg.z * a2[i][jn][2], gg.w * a2[i][jn][3]);
          Mk[i][jn] = (u32x2){t_.x, t_.y}; asm volatile("" : "+v"(Mk[i][jn]));
        }
    }
    {
      f32x4 a2[4][4];
      gemm_tile<4, 4, 3>(W + (long)(W_PM + mt * 256) * D, Rym + (long)ch * 128 * D, a2, lds);
#pragma unroll
      for (int i = 0; i < 4; i++)
#pragma unroll
        for (int jn = 0; jn < 4; jn++) {
          uint2 g_; g_.x = gk[i >> 1][2 * (i & 1) + 1][jn][0]; g_.y = gk[i >> 1][2 * (i & 1) + 1][jn][1];
          uint2 m_; m_.x = Mk[i][jn][0]; m_.y = Mk[i][jn][1];
          const float4 gg = unpack4(g_);
          const float4 mm = unpack4(m_);
          const int col = mt * 256 + 64 * wm + 16 * i + 4 * lg;
          const long lt = ch * 128 + 64 * wn + 16 * jn + lr;
          *(uint2*)(Rmg + lt * D + col) = pack4(mm.x + gg.x * a2[i][jn][0], mm.y + gg.y * a2[i][jn][1],
                                                mm.z + gg.z * a2[i][jn][2], mm.w + gg.w * a2[i][jn][3]);
        }
    }
  }
}

template <class PT> DI void phase_D2(const PT& p, const Ctx& c, int l, int g, u16* lds) {
  const int tid = opaque_tid(), lane = tid & 63, wave = tid >> 6, wm = wave & 3, wn = wave >> 2, lr = lane & 15, lg = lane >> 4;
  const u16* W = c.W + ((long)l * WROWS + W_O) * D;
  const u16* Rmg = c.R4;
  const int nTiles = (c.Tg / 256) * 4;
  for (int tile = blockIdx.x; tile < nTiles; tile += gridDim.x) {
    const int tb = tile >> 2, pt = tile & 3;
    f32x4 acc[4][8];
    {
      const int tn = tile + gridDim.x;
      const bool has = tn < nTiles;
      gemm_tile<4, 8, 2>(W + (long)pt * 256 * D, Rmg + (long)tb * 256 * D, acc, lds,
                         has ? W + (long)(tn & 3) * 256 * D : nullptr, has ? Rmg + (long)(tn >> 2) * 256 * D : nullptr, tile != (int)blockIdx.x);
    }
    const int tok0 = gtok(c, g, tb * 256);
    const float* gp = c.mod + ((long)l * 40 + batch_of(tok0)) * 3072 + 2048;
#pragma unroll
    for (int i = 0; i < 4; i++) {
      const int col = pt * 256 + 64 * wm + 16 * i + 4 * lg;
      const float4 gt = *(const float4*)(gp + col);
      float4 xv[8];
#pragma unroll
      for (int jn = 0; jn < 8; jn++) {
        const int tok = tok0 + 128 * wn + 16 * jn + lr;
        const float* xr = (l == 0) ? xin_row(p, tok) : p.out + (long)tok * D;
        xv[jn] = *(const float4*)(xr + col);
      }
#pragma unroll
      for (int jn = 0; jn < 8; jn++) {
        const int tok = tok0 + 128 * wn + 16 * jn + lr;
        float4 o;
        o.x = xv[jn].x + gt.x * acc[i][jn][0]; o.y = xv[jn].y + gt.y * acc[i][jn][1];
        o.z = xv[jn].z + gt.z * acc[i][jn][2]; o.w = xv[jn].w + gt.w * acc[i][jn][3];
        *(float4*)(p.out + (long)tok * D + col) = o;
      }
    }
  }
}

__global__ void __launch_bounds__(NT) mega(Params p) {
  extern __shared__ __attribute__((aligned(16))) char smem[];
  cg::grid_group grid = cg::this_grid();
  const int nG = p.G;
  __shared__ uint4 xb_words;
  volatile LAS unsigned* xb_st = (volatile LAS unsigned*)&xb_words;
  Params* pg;
  unsigned* xbar;
  {
    const Ctx c0 = make_ctx(p);
    unsigned char* q = (unsigned char*)c0.ctr + 4096;
    xbar = (unsigned*)q; q += XCD_BAR_WORDS * 4;
    pg = (Params*)q;
    if (blockIdx.x == 0 && threadIdx.x == 0) *pg = p;
    if (threadIdx.x == 0) xb_words = make_uint4(0u, 0u, 0u, 0u);
    __syncthreads();
    XcdBarrier xb0 = xcd_barrier_post(xbar, xb_st);
    (void)xb0;
    phase_prep(p, c0, (float*)smem);
  }
  grid.sync();
#define PH(call) { const CParams* q_ = launder_params(pg); const CParams& P_ = *q_; const Ctx c = make_ctx(P_); call; }
#define BAR() { const CParams* q_ = launder_params(pg); const Ctx c = make_ctx(*q_); XcdBarrier xb; xb.bar = (unsigned*)((unsigned char*)c.ctr + 4096); xb.x = xb_xcc_id(); xb.st = xb_st; xcd_barrier(xb); }
  for (int g = 0; g < nG; ++g) {
    for (int l = 0; l < DEPTH; ++l) {
      PH(phase_rows(P_, c, l, g, false)); BAR();
      PH(phase_A(P_, c, l, (u16*)smem)); BAR();
      PH(phase_scan(P_, c, g * DEPTH + l, smem)); BAR();
      PH(phase_C(P_, c, l, (u16*)smem)); BAR();
      PH(phase_E(P_, c, l)); BAR();
      PH(phase_D1(P_, c, l, (u16*)smem)); BAR();
      PH(phase_D2(P_, c, l, g, (u16*)smem)); BAR();
    }
    PH(phase_rows(P_, c, DEPTH, g, true));
  }
}

extern "C" void kernel_launch(void* const* d_in, const int* in_sizes, int n_in, void* d_out, int out_size,
                              void* d_ws, size_t ws_size, hipStream_t stream) {
  static int grid_blocks = 0;
  static int Gsel = 2;
  if (!grid_blocks) {
    int dev = 0, cus = 0, per_cu = 0;
    hipGetDevice(&dev);
    hipDeviceGetAttribute(&cus, hipDeviceAttributeMultiprocessorCount, dev);
    hipFuncSetAttribute((const void*)mega, hipFuncAttributeMaxDynamicSharedMemorySize, LDS_BYTES);
    hipOccupancyMaxActiveBlocksPerMultiprocessor(&per_cu, (const void*)mega, NT, LDS_BYTES);
    if (per_cu < 1) per_cu = 1;
    grid_blocks = cus * per_cu;
    const size_t fixed = (size_t)DEPTH * WROWS * D * 2 + (size_t)DEPTH * 40 * 3072 * 4 + 4096 + XCD_BAR_WORDS * 4 + 1024;
    Gsel = 2;
    while (Gsel < 8 && 7 * ((size_t)(131072 / Gsel) * D * 2) + fixed + (size_t)(131072 / Gsel) * 96 > ws_size) Gsel *= 2;
  }
  Params p{};
  p.x_prompt = (const float*)d_in[0]; p.x_sample = (const float*)d_in[1]; p.c_prompt = (const float*)d_in[2]; p.c_sample = (const float*)d_in[3];
  p.w_ada = (const float*)d_in[4]; p.b_ada = (const float*)d_in[5]; p.norm_g = (const float*)d_in[6]; p.w_in = (const float*)d_in[7];
  p.b_gates = (const float*)d_in[8]; p.conv_w = (const float*)d_in[9]; p.conv_b = (const float*)d_in[10]; p.mh_norm_g = (const float*)d_in[11];
  p.w_pc = (const float*)d_in[12]; p.w_pm = (const float*)d_in[13]; p.w_out = (const float*)d_in[14]; p.final_g = (const float*)d_in[15];
  p.out = (float*)d_out; p.ws = (unsigned char*)d_ws; p.G = Gsel; p.pad = 0;
  {
    const size_t Tg = 131072 / Gsel;
    const size_t off = 7 * (Tg * D * 2) + (size_t)DEPTH * WROWS * D * 2 + (size_t)DEPTH * 40 * 3072 * 4 + Tg * 96 + 4096;
    (void)hipMemsetAsync((unsigned char*)d_ws + off, 0, XCD_BAR_WORDS * 4, stream);
  }
  void* args[] = {&p};
  hipError_t e = hipLaunchCooperativeKernel((const void*)mega, dim3(grid_blocks), dim3(NT), args, LDS_BYTES, stream);
  if (e != hipSuccess) fprintf(stderr, "cooperative launch failed: %s (grid %d)\n", hipGetErrorString(e), grid_blocks);
}
```

```cpp
#include <hip/hip_runtime.h>
#include <hip/hip_cooperative_groups.h>
#include <cstdio>
namespace cg = cooperative_groups;

typedef unsigned short u16;
using bf16x8 = __attribute__((ext_vector_type(8))) short;
using f32x4  = __attribute__((ext_vector_type(4))) float;
using s16x4  = __attribute__((ext_vector_type(4))) short;
using u32x4  = __attribute__((ext_vector_type(4))) unsigned;
using u32x2  = __attribute__((ext_vector_type(2))) unsigned;
#define DI __device__ __forceinline__

constexpr int D = 1024, DIN = 11280, DEPTH = 4;
constexpr int NT = 512;
constexpr int W_QKV = 0, W_C = 3328, W_G = 9472, W_PC = 11520, W_PM = 12544, W_O = 13568, WROWS = 14592;
constexpr int LDT = 72;
constexpr int KS = 264, VS = 136;
constexpr int LDS_BYTES = (128 * KS + 2 * 80 * VS + 80 * KS) * 2 + 4 * 128 * 4;

struct Params {
  const float* x_prompt; const float* x_sample; const float* c_prompt; const float* c_sample;
  const float* w_ada; const float* b_ada; const float* norm_g; const float* w_in; const float* b_gates;
  const float* conv_w; const float* conv_b; const float* mh_norm_g; const float* w_pc; const float* w_pm;
  const float* w_out; const float* final_g;
  float* out; unsigned char* ws;
  int G; int pad;
};

struct Ctx {
  int G, Tg, half;
  u16 *Rh, *R1, *R2, *R3, *R4, *Rhf, *Rhb;
  u16* W; float* mod; float* sc; int* ctr;
};

DI u16 f2bf(float x) { unsigned u = __float_as_uint(x); u += 0x7fffu + ((u >> 16) & 1u); return (u16)(u >> 16); }
DI float bf2f(unsigned h) { return __uint_as_float(h << 16); }
typedef __bf16 bf16x2_t __attribute__((ext_vector_type(2)));
typedef float f32x2_t __attribute__((ext_vector_type(2)));
DI unsigned pack2(float a, float b) { const f32x2_t v = {a, b}; return __builtin_bit_cast(unsigned, __builtin_convertvector(v, bf16x2_t)); }
DI uint2 pack4(float a, float b, float c, float d) { uint2 r; r.x = pack2(a, b); r.y = pack2(c, d); return r; }
DI uint2 pack4v(f32x4 v) { return pack4(v[0], v[1], v[2], v[3]); }
DI float4 unpack4(uint2 v) { float4 r; r.x = bf2f(v.x & 0xffffu); r.y = bf2f(v.x >> 16); r.z = bf2f(v.y & 0xffffu); r.w = bf2f(v.y >> 16); return r; }
DI float sigmoidf_(float x) { return __builtin_amdgcn_rcpf(1.f + __expf(-x)); }
DI float siluf_(float x) { return x * sigmoidf_(x); }
DI float wave_sum(float v) {
#pragma unroll
  for (int o = 32; o >= 1; o >>= 1) v += __shfl_xor(v, o);
  return v;
}
DI int opaque_tid() { int t = threadIdx.x; asm volatile("" : "+v"(t)); return t; }
DI f32x4 mfma16(bf16x8 a, bf16x8 b, f32x4 c) { return __builtin_amdgcn_mfma_f32_16x16x32_bf16(a, b, c, 0, 0, 0); }


typedef const Params __attribute__((address_space(4))) CParams;
template <class PT> DI Ctx make_ctx(const PT& p) {
  Ctx c;
  c.G = p.G; c.Tg = 131072 / p.G; c.half = c.Tg >> 1;
  const size_t REG = (size_t)c.Tg * D * 2;
  unsigned char* ws = p.ws;
  c.Rh = (u16*)(ws); c.R1 = (u16*)(ws + REG); c.R2 = (u16*)(ws + 2 * REG); c.R3 = (u16*)(ws + 3 * REG);
  c.R4 = (u16*)(ws + 4 * REG); c.Rhf = (u16*)(ws + 5 * REG); c.Rhb = (u16*)(ws + 6 * REG);
  unsigned char* q = ws + 7 * REG;
  c.W = (u16*)q; q += (size_t)DEPTH * WROWS * D * 2;
  c.mod = (float*)q; q += (size_t)DEPTH * 40 * 3072 * 4;
  c.sc = (float*)q; q += (size_t)c.Tg * 96;
  c.ctr = (int*)q;
  return c;
}
DI const CParams* launder_params(const Params* g) { asm volatile("" : "+s"(g)); return (const CParams*)(unsigned long long)g; }
DI int gtok(const Ctx& c, int g, int lt) { return lt < c.half ? g * c.half + lt : 65536 + g * c.half + (lt - c.half); }
DI int batch_of(int tok) { return tok < 65536 ? (tok >> 13) : 8 + ((tok - 65536) >> 11); }
template <class PT> DI const float* xin_row(const PT& p, int tok) {
  return tok < 65536 ? p.x_prompt + (long)tok * D : p.x_sample + (long)(tok - 65536) * D;
}


#define XB_TMO      128
#define XB_XCNT(j)  (256  + 64 * (j))
#define XB_XSUB(j)  (1280 + 64 * (j))
#define XB_XGEN(j)  (2304 + 64 * (j))
#define XB_TOP      3328
#define XB_TOPGEN   3392
#define XCD_BAR_WORDS 3456
#define XB_SPIN_CAP (1u << 18)
#define LAS __attribute__((address_space(3)))
DI unsigned xb_ld(unsigned* p)              { return __hip_atomic_load(p, __ATOMIC_RELAXED, __HIP_MEMORY_SCOPE_AGENT); }
DI unsigned xb_add(unsigned* p, unsigned v) { return __hip_atomic_fetch_add(p, v, __ATOMIC_RELAXED, __HIP_MEMORY_SCOPE_AGENT); }
DI unsigned xb_xcc_id() { return (unsigned)__builtin_amdgcn_s_getreg((3 << 11) | 20) & 0xFu; }
#define XB_SPIN(cond, bar) do { unsigned _sp = 0; while (cond) { __builtin_amdgcn_s_sleep(1); \
    if ((++_sp & 255u) == 0u) { if (xb_ld(&(bar)[XB_TMO])) break; if (_sp > XB_SPIN_CAP) { atomicAdd(&(bar)[XB_TMO], 1u); break; } } } } while (0)
struct XcdBarrier { unsigned* bar; unsigned x; volatile LAS unsigned* st; };
DI XcdBarrier xcd_barrier_post(unsigned* bar, volatile LAS unsigned* st) {
  XcdBarrier b; b.bar = bar; b.x = xb_xcc_id(); b.st = st;
  if (threadIdx.x == 0) (void)xb_add(&bar[XB_XCNT(b.x)], 1u);
  return b;
}
DI void xcd_barrier_complete(unsigned* bar, unsigned x, unsigned& nloc, unsigned& nx) {
  const unsigned G = gridDim.x * gridDim.y * gridDim.z;
  unsigned sum, cnt, mine, sp = 0u;
  for (;;) {
    sum = 0u; cnt = 0u; mine = 0u;
#pragma unroll
    for (unsigned j = 0; j < 16; ++j) { const unsigned c = xb_ld(&bar[XB_XCNT(j)]); sum += c; cnt += (c > 0u) ? 1u : 0u; }
    mine = xb_ld(&bar[XB_XCNT(x)]);
    if (sum == G) break;
    __builtin_amdgcn_s_sleep(1);
    if ((++sp & 255u) == 0u) { if (xb_ld(&bar[XB_TMO])) break; if (sp > XB_SPIN_CAP) { atomicAdd(&bar[XB_TMO], 1u); break; } }
  }
  nloc = mine > 0u ? mine : 1u; nx = cnt > 0u ? cnt : 1u;
}
DI void xcd_barrier(const XcdBarrier& b) {
  asm volatile("s_waitcnt vmcnt(0)" ::: "memory");
  __syncthreads();
  if (threadIdx.x == 0) {
    unsigned* bar = b.bar;
    asm volatile("" : "+s"(bar));
    __builtin_amdgcn_s_waitcnt(0);
    unsigned nloc = b.st[0], nx = b.st[1];
    if (nloc == 0u) { xcd_barrier_complete(bar, b.x, nloc, nx); b.st[0] = nloc; b.st[1] = nx; }
    const unsigned old = xb_add(&bar[XB_XSUB(b.x)], 1u);
    const unsigned gen = old / nloc;
    if (old + 1u == (gen + 1u) * nloc) {
      __builtin_amdgcn_fence(__ATOMIC_RELEASE, "agent");
      asm volatile("s_waitcnt vmcnt(0)" ::: "memory");
      const unsigned og = xb_add(&bar[XB_TOP], 1u);
      const unsigned tg = og / nx;
      if (og + 1u == (tg + 1u) * nx) xb_add(&bar[XB_TOPGEN], 1u);
      else XB_SPIN(xb_ld(&bar[XB_TOPGEN]) == tg, bar);
      __builtin_amdgcn_fence(__ATOMIC_ACQUIRE, "agent");
      xb_add(&bar[XB_XGEN(b.x)], 1u);
      asm volatile("s_waitcnt vmcnt(0)" ::: "memory");
    } else {
      XB_SPIN(xb_ld(&bar[XB_XGEN(b.x)]) == gen, bar);
      __builtin_amdgcn_fence(__ATOMIC_ACQUIRE, "agent");
      asm volatile("s_waitcnt vmcnt(0)" ::: "memory");
    }
  }
  __syncthreads();
}

template <int MT, int NT, int ST>
DI void gemm_tile(const u16* __restrict__ P, const u16* __restrict__ Q, f32x4 (&acc)[MT][NT], u16* lds,
                  const u16* Pn = nullptr, const u16* Qn = nullptr, bool primed = false, int* ringp = nullptr) {
  const int tid = opaque_tid(), lane = tid & 63, wave = __builtin_amdgcn_readfirstlane(tid >> 6), wm = wave & 3, wn = wave >> 2;
  const int lr = lane & 15, lg = lane >> 4;
  constexpr int PROWS = 64 * MT, QROWS = 32 * NT, NQI = NT / 2, NDMA = MT + NQI;
  char* pbase = (char*)lds;
  char* qbase = pbase + ST * PROWS * 128;
  const int drow = lane >> 3, dpos = lane & 7;
  const int r0 = 8 * wave + drow;
  const unsigned voff = (unsigned)(r0 * D + ((dpos ^ ((r0 >> 1) & 7)) << 3)) * 2u;
  const char* Pc = (const char*)P; const char* Qc = (const char*)Q;
  char* dp = pbase + wave * 1024 + lane * 16;
  char* dq = qbase + wave * 1024 + lane * 16;
#pragma unroll
  for (int i = 0; i < MT; i++)
#pragma unroll
    for (int j = 0; j < NT; j++) acc[i][j] = (f32x4){0.f, 0.f, 0.f, 0.f};
  const int ring0 = (ST == 3 && ringp) ? *ringp : 0;
  if (!primed) {
#pragma unroll
    for (int t0 = 0; t0 < ST - 1; t0++) {
      int bi = ring0 + t0; if (bi >= ST) bi -= ST;
#pragma unroll
      for (int i = 0; i < MT; i++) __builtin_amdgcn_global_load_lds((const unsigned*)(Pc + (i * 64 * D * 2 + t0 * 128) + voff), (unsigned*)(dp + bi * PROWS * 128 + i * 8192), 16, 0, 0);
#pragma unroll
      for (int i = 0; i < NQI; i++) __builtin_amdgcn_global_load_lds((const unsigned*)(Qc + (i * 64 * D * 2 + t0 * 128) + voff), (unsigned*)(dq + bi * QROWS * 128 + i * 8192), 16, 0, 0);
    }
  }
  if (primed) asm volatile("s_waitcnt vmcnt(0)" ::: "memory");
  else asm volatile("s_waitcnt vmcnt(%0)" :: "n"((ST - 2) * NDMA) : "memory");
  __builtin_amdgcn_s_barrier();
  asm volatile("" ::: "memory");
  const int swz = (lr >> 1) & 7;
  const int o0 = (lg ^ swz) << 4, o1 = ((4 + lg) ^ swz) << 4;
  const char* pa = pbase + (wm * 16 * MT + lr) * 128;
  const char* qa = qbase + (wn * 16 * NT + lr) * 128;
  constexpr int NK = D / 64;
  int cur = ring0, nxs = ring0 + ST - 1; if (nxs >= ST) nxs -= ST;
  for (int kt = 0; kt < NK; ++kt) {
    if (kt + ST - 1 < NK) {
#pragma unroll
      for (int i = 0; i < MT; i++) __builtin_amdgcn_global_load_lds((const unsigned*)(Pc + (i * 64 * D * 2 + (kt + ST - 1) * 128) + voff), (unsigned*)(dp + nxs * PROWS * 128 + i * 8192), 16, 0, 0);
#pragma unroll
      for (int i = 0; i < NQI; i++) __builtin_amdgcn_global_load_lds((const unsigned*)(Qc + (i * 64 * D * 2 + (kt + ST - 1) * 128) + voff), (unsigned*)(dq + nxs * QROWS * 128 + i * 8192), 16, 0, 0);
    }
    if (ST == 3 && kt >= NK - 2 && Pn != nullptr) {
      const char* Pnc = (const char*)Pn + (kt - (NK - 2)) * 128; const char* Qnc = (const char*)Qn + (kt - (NK - 2)) * 128;
#pragma unroll
      for (int i = 0; i < MT; i++) __builtin_amdgcn_global_load_lds((const unsigned*)(Pnc + (i * 64 * D * 2) + voff), (unsigned*)(dp + nxs * PROWS * 128 + i * 8192), 16, 0, 0);
#pragma unroll
      for (int i = 0; i < NQI; i++) __builtin_amdgcn_global_load_lds((const unsigned*)(Qnc + (i * 64 * D * 2) + voff), (unsigned*)(dq + nxs * QROWS * 128 + i * 8192), 16, 0, 0);
    }
    if (ST == 2 && kt == NK - 1 && Pn != nullptr) {
      const char* Pnc = (const char*)Pn; const char* Qnc = (const char*)Qn;
#pragma unroll
      for (int i = 0; i < MT; i++) __builtin_amdgcn_global_load_lds((const unsigned*)(Pnc + (i * 64 * D * 2) + voff), (unsigned*)(dp + i * 8192), 16, 0, 0);
#pragma unroll
      for (int i = 0; i < NQI; i++) __builtin_amdgcn_global_load_lds((const unsigned*)(Qnc + (i * 64 * D * 2) + voff), (unsigned*)(dq + i * 8192), 16, 0, 0);
    }
    const char* pb = pa + cur * PROWS * 128;
    const char* qb = qa + cur * QROWS * 128;
    if constexpr (NT == 99) {
      bf16x8 af[MT], b0[NT], b1[NT];
#pragma unroll
      for (int j = 0; j < NT; j++) b0[j] = *(const bf16x8*)(qb + j * 2048 + o0);
#pragma unroll
      for (int i = 0; i < MT; i++) af[i] = *(const bf16x8*)(pb + i * 2048 + o0);
      __builtin_amdgcn_s_setprio(1);
#pragma unroll
      for (int i = 0; i < MT; i++) {
#pragma unroll
        for (int j = 0; j < NT; j++) acc[i][j] = mfma16(af[i], b0[j], acc[i][j]);
        b1[i] = *(const bf16x8*)(qb + i * 2048 + o1);
        af[i] = *(const bf16x8*)(pb + i * 2048 + o1);
      }
#pragma unroll
      for (int j = MT; j < NT; j++) b1[j] = *(const bf16x8*)(qb + j * 2048 + o1);
#pragma unroll
      for (int i = 0; i < MT; i++)
#pragma unroll
        for (int j = 0; j < NT; j++) acc[i][j] = mfma16(af[i], b1[j], acc[i][j]);
      __builtin_amdgcn_sched_group_barrier(0x100, NT + MT, 0);
#pragma unroll
      for (int r = 0; r < MT; r++) {
        __builtin_amdgcn_sched_group_barrier(0x008, 4, 0);
        __builtin_amdgcn_sched_group_barrier(0x100, 1, 0);
        __builtin_amdgcn_sched_group_barrier(0x008, 4, 0);
        __builtin_amdgcn_sched_group_barrier(0x100, 1, 0);
      }
      __builtin_amdgcn_sched_group_barrier(0x100, NT - MT, 0);
      __builtin_amdgcn_sched_group_barrier(0x008, MT * NT, 0);
      __builtin_amdgcn_s_setprio(0);
    } else {
#pragma unroll
      for (int ks = 0; ks < 2; ++ks) {
        const int oo = ks ? o1 : o0;
        bf16x8 a[MT], b[NT];
#pragma unroll
        for (int i = 0; i < MT; i++) a[i] = *(const bf16x8*)(pb + i * 2048 + oo);
#pragma unroll
        for (int j = 0; j < NT; j++) b[j] = *(const bf16x8*)(qb + j * 2048 + oo);
        __builtin_amdgcn_s_setprio(1);
#pragma unroll
        for (int i = 0; i < MT; i++)
#pragma unroll
          for (int j = 0; j < NT; j++) acc[i][j] = mfma16(a[i], b[j], acc[i][j]);
        __builtin_amdgcn_s_setprio(0);
      }
    }
    if (kt + ST - 1 < NK) asm volatile("s_waitcnt vmcnt(%0)" :: "n"((ST - 2) * NDMA) : "memory");
    else if (ST == 3 && Pn != nullptr) { if (kt == NK - 2) asm volatile("s_waitcnt vmcnt(%0)" :: "n"(NDMA) : "memory"); }
    else if (!(ST == 2 && Pn != nullptr)) asm volatile("s_waitcnt vmcnt(0)" ::: "memory");
    __builtin_amdgcn_s_barrier();
    asm volatile("" ::: "memory");
    cur = (cur == ST - 1) ? 0 : cur + 1;
    nxs = (nxs == ST - 1) ? 0 : nxs + 1;
  }
  if (ST == 3 && ringp) *ringp = cur;
}

template <class PT> DI void wsrc(const PT& p, int l, int n, const float*& src, int& ld, int& col, float& scale) {
  scale = 1.f;
  src = p.w_in + (long)l * D * DIN; ld = DIN;
  if (n < W_C) {
    if (n < 1024) col = 4096 + n;
    else if (n < 2048) { col = 5120 + (n - 1024); scale = 0.0625f; }
    else if (n < 3072) col = 6144 + (n - 2048);
    else if (n < 3088) col = 9216 + (n - 3072);
    else col = -1;
  } else if (n < W_G) {
    int n2 = n - W_C;
    if (n2 < 4096) { int blk = n2 >> 6, sl = (n2 >> 4) & 3, cl = n2 & 15; col = sl * 1024 + blk * 16 + cl; }
    else { int n3 = n2 - 4096; int blk = n3 >> 5, sl = (n3 >> 4) & 1, cl = n3 & 15; col = (sl ? 8192 : 7168) + blk * 16 + cl; }
  } else if (n < W_PC) {
    int n4 = n - W_G; int mtb = n4 >> 9, r5 = n4 & 511; int cc5 = r5 >> 8, wm5 = (r5 >> 6) & 3, a5 = (r5 >> 5) & 1, sl = (r5 >> 4) & 1, cl = r5 & 15;
    col = 9232 + sl * 1024 + (256 * mtb + 64 * wm5 + 32 * cc5 + 16 * a5 + cl);
  } else if (n < W_PM) { src = p.w_pc + (long)l * D * D; ld = D; col = n - W_PC; }
  else if (n < W_O)  { src = p.w_pm + (long)l * D * D; ld = D; col = n - W_PM; }
  else               { src = p.w_out + (long)l * D * D; ld = D; col = n - W_O; }
}

template <class PT> DI void phase_prep(const PT& p, const Ctx& c, float* ldsf) {
  const int tid = opaque_tid();
  if (blockIdx.x == 0 && tid < 256) c.ctr[tid] = 0;
  const int nItems = DEPTH * (WROWS / 64) * 16;
  for (int it = blockIdx.x; it < nItems; it += gridDim.x) {
    const int kb = (it & 15) * 64; const int rb = it >> 4;
    const int l = rb / (WROWS / 64); const int nb = (rb % (WROWS / 64)) * 64;
    const float* src; int ld, col; float scale;
    const int nl = tid & 63;
    wsrc(p, l, nb + nl, src, ld, col, scale);
#pragma unroll
    for (int i = 0; i < 8; i++) {
      const int kl = (tid >> 6) + 8 * i;
      float v = (col >= 0) ? src[(long)(kb + kl) * ld + col] * scale : 0.f;
      ldsf[kl * 65 + nl] = v;
    }
    __syncthreads();
    {
      const int nl2 = tid >> 3, kc = tid & 7;
      float v[8];
#pragma unroll
      for (int j = 0; j < 8; j++) v[j] = ldsf[(kc * 8 + j) * 65 + nl2];
      uint4 o; o.x = pack2(v[0], v[1]); o.y = pack2(v[2], v[3]); o.z = pack2(v[4], v[5]); o.w = pack2(v[6], v[7]);
      *(uint4*)(c.W + ((long)l * WROWS + nb + nl2) * D + kb + kc * 8) = o;
    }
    __syncthreads();
  }
  const int nMod = DEPTH * 48;
  for (int it = blockIdx.x; it < nMod; it += gridDim.x) {
    const int l = it / 48, jb = (it % 48) * 64;
    const int cl = tid & 63, kc = tid >> 6;
    float acc[40];
#pragma unroll
    for (int b = 0; b < 40; b++) acc[b] = 0.f;
    const float* wa = p.w_ada + (long)l * D * 3072 + jb + cl;
    for (int k = kc * 128; k < kc * 128 + 128; ++k) {
      const float wv = wa[(long)k * 3072];
#pragma unroll
      for (int b = 0; b < 40; b++) {
        const float cv = (b < 8) ? p.c_prompt[b * D + k] : p.c_sample[(b - 8) * D + k];
        acc[b] += cv * wv;
      }
    }
#pragma unroll
    for (int b = 0; b < 40; b++) ldsf[(kc * 40 + b) * 64 + cl] = acc[b];
    __syncthreads();
    for (int idx = tid; idx < 40 * 64; idx += NT) {
      const int b = idx >> 6, cc = idx & 63;
      float s = p.b_ada[l * 3072 + jb + cc];
#pragma unroll
      for (int q = 0; q < 8; q++) s += ldsf[(q * 40 + b) * 64 + cc];
      c.mod[((long)l * 40 + b) * 3072 + jb + cc] = s;
    }
    __syncthreads();
  }
}

template <class PT> DI void phase_rows(const PT& p, const Ctx& c, int l, int g, bool fin) {
  const int tid_ = opaque_tid(); const int lane = tid_ & 63, w = tid_ >> 6;
  const int stride = gridDim.x * 8;
  float4 gv[4];
#pragma unroll
  for (int i = 0; i < 4; i++) gv[i] = *(const float4*)((fin ? p.final_g : p.norm_g + l * D) + 4 * lane + 256 * i);
  for (int lt0 = blockIdx.x * 8 + w; lt0 < c.Tg; lt0 += 2 * stride) {
    const bool has1 = lt0 + stride < c.Tg;
    const int lt1 = has1 ? lt0 + stride : lt0;
    const int tok0 = gtok(c, g, lt0), tok1 = gtok(c, g, lt1);
    const float* xr0 = (l == 0) ? xin_row(p, tok0) : p.out + (long)tok0 * D;
    const float* xr1 = (l == 0) ? xin_row(p, tok1) : p.out + (long)tok1 * D;
    float4 v0[4], v1[4]; float ss0 = 0.f, ss1 = 0.f;
#pragma unroll
    for (int i = 0; i < 4; i++) { v0[i] = *(const float4*)(xr0 + 4 * lane + 256 * i); v1[i] = *(const float4*)(xr1 + 4 * lane + 256 * i); }
    const float* mp0 = c.mod + ((long)(fin ? 0 : l) * 40 + batch_of(tok0)) * 3072;
    const float* mp1 = c.mod + ((long)(fin ? 0 : l) * 40 + batch_of(tok1)) * 3072;
    float4 sc0[4], sh0[4], sc1[4], sh1[4];
    if (!fin) {
#pragma unroll
      for (int i = 0; i < 4; i++) {
        const int k = 4 * lane + 256 * i;
        sc0[i] = *(const float4*)(mp0 + 1024 + k); sh0[i] = *(const float4*)(mp0 + k);
        sc1[i] = *(const float4*)(mp1 + 1024 + k); sh1[i] = *(const float4*)(mp1 + k);
      }
    }
#pragma unroll
    for (int i = 0; i < 4; i++) {
      ss0 += v0[i].x * v0[i].x + v0[i].y * v0[i].y + v0[i].z * v0[i].z + v0[i].w * v0[i].w;
      ss1 += v1[i].x * v1[i].x + v1[i].y * v1[i].y + v1[i].z * v1[i].z + v1[i].w * v1[i].w;
    }
    ss0 = wave_sum(ss0); ss1 = wave_sum(ss1);
    const float r0 = rsqrtf(ss0 * (1.f / 1024.f) + 1e-6f), r1 = rsqrtf(ss1 * (1.f / 1024.f) + 1e-6f);
    if (fin) {
#pragma unroll
      for (int i = 0; i < 4; i++) {
        const int k = 4 * lane + 256 * i;
        float4 o; o.x = v0[i].x * r0 * gv[i].x; o.y = v0[i].y * r0 * gv[i].y; o.z = v0[i].z * r0 * gv[i].z; o.w = v0[i].w * r0 * gv[i].w;
        *(float4*)(p.out + (long)tok0 * D + k) = o;
      }
      if (has1) {
#pragma unroll
        for (int i = 0; i < 4; i++) {
          const int k = 4 * lane + 256 * i;
          float4 o; o.x = v1[i].x * r1 * gv[i].x; o.y = v1[i].y * r1 * gv[i].y; o.z = v1[i].z * r1 * gv[i].z; o.w = v1[i].w * r1 * gv[i].w;
          *(float4*)(p.out + (long)tok1 * D + k) = o;
        }
      }
    } else {
#pragma unroll
      for (int i = 0; i < 4; i++) {
        const int k = 4 * lane + 256 * i;
        *(uint2*)(c.Rh + (long)lt0 * D + k) = pack4(v0[i].x * r0 * gv[i].x * (1.f + sc0[i].x) + sh0[i].x, v0[i].y * r0 * gv[i].y * (1.f + sc0[i].y) + sh0[i].y,
                                                    v0[i].z * r0 * gv[i].z * (1.f + sc0[i].z) + sh0[i].z, v0[i].w * r0 * gv[i].w * (1.f + sc0[i].w) + sh0[i].w);
      }
      if (has1) {
#pragma unroll
        for (int i = 0; i < 4; i++) {
          const int k = 4 * lane + 256 * i;
          *(uint2*)(c.Rh + (long)lt1 * D + k) = pack4(v1[i].x * r1 * gv[i].x * (1.f + sc1[i].x) + sh1[i].x, v1[i].y * r1 * gv[i].y * (1.f + sc1[i].y) + sh1[i].y,
                                                      v1[i].z * r1 * gv[i].z * (1.f + sc1[i].z) + sh1[i].z, v1[i].w * r1 * gv[i].w * (1.f + sc1[i].w) + sh1[i].w);
        }
      }
    }
  }
}

template <class PT> DI void phase_A(const PT& p, const Ctx& c, int l, u16* lds) {
  const int tid = opaque_tid(), lane = tid & 63, wave = tid >> 6, wm = wave & 3, wn = wave >> 2, lr = lane & 15, lg = lane >> 4;
  const u16* W = c.W + (long)l * WROWS * D;
  u16* Rq = c.R1; u16* Rk = c.R2; u16* RvT = c.R4;
  const int nTiles = (c.Tg / 256) * 13;
  auto ptrsA = [&](int tl, const u16*& Pp, const u16*& Qp) {
    const int tb_ = tl / 13, j_ = tl % 13;
    const u16* hp = c.Rh + (long)tb_ * 256 * D;
    if (j_ < 8) { Pp = W + (long)((j_ >> 2) * 1024 + (j_ & 3) * 256) * D; Qp = hp; }
    else if (j_ < 12) { Pp = hp; Qp = W + (long)(2048 + (j_ - 8) * 256) * D; }
    else { Pp = W + (long)3072 * D; Qp = hp; }
  };
  bool primed = false;
  for (int tile = blockIdx.x; tile < nTiles; tile += gridDim.x) {
    const int tb = tile / 13, j = tile % 13;
    f32x4 acc[4][8];
    const u16 *P0, *Q0, *P1 = nullptr, *Q1 = nullptr;
    ptrsA(tile, P0, Q0);
    if (tile + (int)gridDim.x < nTiles && j != 12 && (tile + (int)gridDim.x) % 13 != 12) ptrsA(tile + gridDim.x, P1, Q1);
    const bool pr = primed; primed = (P1 != nullptr);
    if (j < 8) {
      const int isk = j >> 2, head = j & 3;
      gemm_tile<4, 8, 2>(P0, Q0, acc, lds, P1, Q1, pr);
      u16* dst = isk ? Rk : Rq;
#pragma unroll
      for (int i = 0; i < 4; i++)
#pragma unroll
        for (int jn = 0; jn < 8; jn++) {
          const int d = 64 * wm + 16 * i + 4 * lg, t = 128 * wn + 16 * jn + lr;
          *(uint2*)(dst + (long)(tb * 256 + t) * D + head * 256 + d) = pack4v(acc[i][jn]);
        }
    } else if (j < 12) {
      const int head = j - 8;
      gemm_tile<4, 8, 2>(P0, Q0, acc, lds, P1, Q1, pr);
#pragma unroll
      for (int i = 0; i < 4; i++)
#pragma unroll
        for (int jn = 0; jn < 8; jn++) {
          const int tokl = 64 * wm + 16 * i + 4 * lg, e = 128 * wn + 16 * jn + lr;
          const int ch = tb * 2 + (tokl >> 7), sidx = tokl & 127;
          *(uint2*)(RvT + ((long)(ch * 4 + head) * 256 + e) * 128 + sidx) = pack4v(acc[i][jn]);
        }
    } else {
      f32x4 accg[1][8];
      gemm_tile<1, 8, 2>(P0, Q0, accg, lds);
      float* gl = (float*)lds;
      if (wm == 0) {
#pragma unroll
        for (int jn = 0; jn < 8; jn++) {
          const int t = 128 * wn + 16 * jn + lr;
#pragma unroll
          for (int r = 0; r < 4; r++) {
            float v = accg[0][jn][r] + p.b_gates[l * 16 + lg * 4 + r];
            if (lg & 1) v = fminf(v, 0.f) - log1pf(expf(-fabsf(v)));
            gl[t * 16 + lg * 4 + r] = v;
          }
        }
      }
      __syncthreads();
      if (tid < 16) {
        const int head = tid & 3, dir = (tid >> 2) & 1, cl = tid >> 3;
        const int ch = tb * 2 + cl;
        float* o = c.sc + (((long)(ch * 4 + head) * 2 + dir) * 3) * 128;
        const float* glc = gl + cl * 128 * 16;
        float bs = 0.f, pm = -3.0e38f;
        for (int q = 0; q < 128; ++q) {
          const int t = dir ? 127 - q : q;
          const float iv = glc[t * 16 + dir * 8 + head], lf = glc[t * 16 + dir * 8 + 4 + head];
          bs += lf; const float gg = iv - bs; pm = fmaxf(pm, gg);
          o[t] = bs; o[128 + t] = gg; o[256 + t] = pm;
        }
      }
      __syncthreads();
    }
  }
}

template <class PT> DI void phase_scan(const PT& p, const Ctx& c, int ctrIdx, char* smem) {
  __shared__ int s_task;
  const int tid = opaque_tid(), lane = tid & 63, w0 = __builtin_amdgcn_readfirstlane(tid >> 6), lr = lane & 15, lg = lane >> 4;
  u16* Kb = (u16*)smem;
  u16* Vt = Kb + 128 * KS;
  u16* Vw = Vt + 80 * VS;
  u16* Ct = Vw + 80 * VS;
  float* scg = (float*)(Ct + 80 * KS); float* scmu = scg + 128; float* sciw = scmu + 128; float* scfl = sciw + 128;
  const u16* Rq = c.R1; const u16* Rk = c.R2; const u16* RvT = c.R4;
  const int nLong = (8 / c.G) * 32;
  const int nLongQ8 = (8 / c.G), nShortQ8 = (32 / c.G);
  const int perQueue = (nLongQ8 + nShortQ8) * 4;
  int* ctr = c.ctr + ctrIdx * 8;
  const int myq = (int)(xb_xcc_id() & 7u);
  int qoff = 0;
  while (true) {
    __syncthreads();
    if (tid == 0) {
      int t = -1;
      while (qoff < 8) {
        const int qi = (myq + qoff) & 7;
        const int n = atomicAdd(ctr + qi, 1);
        if (n < perQueue) {
          const int quad = (n < nLongQ8 * 4) ? qi + 8 * (n >> 2) : nLongQ8 * 8 + qi + 8 * ((n - nLongQ8 * 4) >> 2);
          t = quad * 4 + (n & 3);
          break;
        }
        ++qoff;
      }
      s_task = t;
    }
    __syncthreads();
    const int task = s_task;
    if (task < 0) break;
    int seq, r, chunk0, nc;
    if (task < nLong) { seq = task >> 5; r = task & 31; chunk0 = seq * 64; nc = 64; }
    else { const int t2 = task - nLong; seq = t2 >> 5; r = t2 & 31; chunk0 = (c.half >> 7) + seq * 16; nc = 16; }
    const int head = r >> 3, dir = (r >> 2) & 1, es = r & 3;
    const int last = dir ? 0 : 127;
    u16* Rho = dir ? c.Rhb : c.Rhf;
    for (int idx = tid; idx < 80 * KS / 2; idx += NT) ((unsigned*)Ct)[idx] = 0u;
    for (int idx = tid; idx < 16 * VS / 2; idx += NT) { ((unsigned*)(Vt + 64 * VS))[idx] = 0u; ((unsigned*)(Vw + 64 * VS))[idx] = 0u; }
    __syncthreads();
    if (tid < 128) Vt[64 * VS + tid] = (u16)0x3F80;
    f32x4 st[2][5];
#pragma unroll
    for (int i = 0; i < 2; i++)
#pragma unroll
      for (int jn = 0; jn < 5; jn++) st[i][jn] = (f32x4){0.f, 0.f, 0.f, 0.f};
    float m = 0.f;
    const int vrow = tid >> 4, vsc = tid & 15;
    const int krow = tid >> 5, kkc = (tid & 31) * 8;
    u32x4 kpre[8], vpre[2]; float4 g8a, g8b; float bLn, gmaxn, myb, myg, mypm;
    bf16x8 qf[8];
    auto scan_load = [&](int cq) {
#pragma unroll
      for (int ks = 0; ks < 8; ks++)
        qf[ks] = *(const bf16x8*)(Rq + (long)(cq * 128 + 16 * w0 + lr) * D + head * 256 + 32 * ks + 8 * lg);
#pragma unroll
      for (int i = 0; i < 8; i++) kpre[i] = *(const u32x4*)(Rk + (long)(cq * 128 + krow + 16 * i) * D + head * 256 + kkc);
#pragma unroll
      for (int i = 0; i < 2; i++) vpre[i] = *(const u32x4*)(RvT + ((long)(cq * 4 + head) * 256 + es * 64 + vrow + 32 * i) * 128 + vsc * 8);
      const float* scb = c.sc + ((long)(cq * 4 + head) * 2 + dir) * 384;
      g8a = *(const float4*)(scb + 128 + vsc * 8); g8b = *(const float4*)(scb + 128 + vsc * 8 + 4);
      bLn = scb[last]; gmaxn = scb[256 + last];
      myb = scb[tid & 127]; myg = scb[128 + (tid & 127)]; mypm = scb[256 + (tid & 127)];
    };
    scan_load(chunk0 + (dir ? nc - 1 : 0));
    for (int j = 0; j < nc; ++j) {
      const int cc = chunk0 + (dir ? nc - 1 - j : j);
      int w = w0; asm volatile("" : "+s"(w));
      __syncthreads();
      const float muL = fmaxf(m, gmaxn);
      const float decay = __expf(m - muL);
      const float mnext = bLn + muL;
#pragma unroll
      for (int i = 0; i < 2; i++)
#pragma unroll
        for (int jn = 0; jn < 5; jn++)
          *(uint2*)(Ct + (16 * jn + lr) * KS + 32 * w + 16 * i + 4 * lg) = pack4v(st[i][jn]);
#pragma unroll
      for (int i = 0; i < 8; i++) *(u32x4*)(Kb + (krow + 16 * i) * KS + kkc) = kpre[i];
      {
        float w8[8];
        w8[0] = __expf(g8a.x - muL); w8[1] = __expf(g8a.y - muL); w8[2] = __expf(g8a.z - muL); w8[3] = __expf(g8a.w - muL);
        w8[4] = __expf(g8b.x - muL); w8[5] = __expf(g8b.y - muL); w8[6] = __expf(g8b.z - muL); w8[7] = __expf(g8b.w - muL);
#pragma unroll
        for (int i = 0; i < 2; i++) {
          const u32x4 vv = vpre[i];
          *(u32x4*)(Vt + (vrow + 32 * i) * VS + vsc * 8) = vv;
          uint4 v; v.x = vv[0]; v.y = vv[1]; v.z = vv[2]; v.w = vv[3];
          uint4 o;
          o.x = pack2(bf2f(v.x & 0xffffu) * w8[0], bf2f(v.x >> 16) * w8[1]);
          o.y = pack2(bf2f(v.y & 0xffffu) * w8[2], bf2f(v.y >> 16) * w8[3]);
          o.z = pack2(bf2f(v.z & 0xffffu) * w8[4], bf2f(v.z >> 16) * w8[5]);
          o.w = pack2(bf2f(v.w & 0xffffu) * w8[6], bf2f(v.w >> 16) * w8[7]);
          *(uint4*)(Vw + (vrow + 32 * i) * VS + vsc * 8) = o;
        }
        if (tid < 16) {
          uint4 o; o.x = pack2(w8[0], w8[1]); o.y = pack2(w8[2], w8[3]); o.z = pack2(w8[4], w8[5]); o.w = pack2(w8[6], w8[7]);
          *(uint4*)(Vw + 64 * VS + vsc * 8) = o;
        }
      }
      if (tid < 128) {
        const float mu = fmaxf(m, mypm);
        scg[tid] = myg; scmu[tid] = mu; sciw[tid] = __expf(m - mu); scfl[tid] = __expf(-(mu + myb));
      }
      __syncthreads();
      const int t = 16 * w + lr;
      bf16x8 spk[4];
      {
        f32x4 sacc[8];
#pragma unroll
        for (int i = 0; i < 8; i++) sacc[i] = (f32x4){0.f, 0.f, 0.f, 0.f};
#pragma unroll
        for (int i = 0; i < 8; i++) {
          const bool need = dir ? (i >= w) : (i <= w);
          if (need) {
#pragma unroll
            for (int ks = 0; ks < 8; ks++) {
              const bf16x8 a = *(const bf16x8*)(Kb + (16 * i + lr) * KS + 32 * ks + 8 * lg);
              sacc[i] = mfma16(a, qf[ks], sacc[i]);
            }
          }
        }
        const float mu_t = scmu[t];
        int tt = t; asm volatile("" : "+v"(tt));
        const int sgn = dir ? -1 : 1;
#pragma unroll
        for (int ks = 0; ks < 4; ks++) {
          float sv[8];
#pragma unroll
          for (int hh = 0; hh < 2; hh++) {
            const int i = 2 * ks + hh;
            const float4 gs = *(const float4*)(scg + 16 * i + 4 * lg);
            const float gv[4] = {gs.x, gs.y, gs.z, gs.w};
#pragma unroll
            for (int r2 = 0; r2 < 4; r2++) {
              const int s = 16 * i + 4 * lg + r2;
              const bool valid = (s - tt) * sgn <= 0;
              sv[hh * 4 + r2] = valid ? sacc[i][r2] * __expf(gv[r2] - mu_t) : 0.f;
            }
          }
          uint4 o; o.x = pack2(sv[0], sv[1]); o.y = pack2(sv[2], sv[3]); o.z = pack2(sv[4], sv[5]); o.w = pack2(sv[6], sv[7]);
          spk[ks] = __builtin_bit_cast(bf16x8, o);
        }
      }
      f32x4 num[5];
#pragma unroll
      for (int i = 0; i < 5; i++) num[i] = (f32x4){0.f, 0.f, 0.f, 0.f};
#pragma unroll
      for (int ks = 0; ks < 8; ks++)
#pragma unroll
        for (int i = 0; i < 5; i++) {
          const bf16x8 a = *(const bf16x8*)(Ct + (16 * i + lr) * KS + 32 * ks + 8 * lg);
          num[i] = mfma16(a, qf[ks], num[i]);
        }
      {
        const float iw = sciw[t];
#pragma unroll
        for (int i = 0; i < 5; i++) num[i] *= iw;
      }
#pragma unroll
      for (int ks = 0; ks < 4; ks++) {
        const bool need = dir ? (2 * ks + 1 >= w) : (2 * ks <= w);
        if (need) {
#pragma unroll
          for (int i = 0; i < 5; i++) {
            const uint2 lo = *(const uint2*)(Vt + (16 * i + lr) * VS + 32 * ks + 4 * lg);
            const uint2 hi = *(const uint2*)(Vt + (16 * i + lr) * VS + 32 * ks + 16 + 4 * lg);
            uint4 av; av.x = lo.x; av.y = lo.y; av.z = hi.x; av.w = hi.y;
            num[i] = mfma16(__builtin_bit_cast(bf16x8, av), spk[ks], num[i]);
          }
        }
      }
      {
        const float fl = scfl[t];
        const float dr = __shfl(num[4][0], lr);
        const float inv = 1.f / fmaxf(fabsf(dr), fl);
        u16* dst = Rho + (long)(cc * 128 + t) * D + head * 256 + es * 64 + 4 * lg;
#pragma unroll
        for (int i = 0; i < 4; i++)
          *(uint2*)(dst + 16 * i) = pack4(num[i][0] * inv, num[i][1] * inv, num[i][2] * inv, num[i][3] * inv);
      }
      __builtin_amdgcn_sched_barrier(0);
      { const int jn1 = (j + 1 < nc) ? j + 1 : j; scan_load(chunk0 + (dir ? nc - 1 - jn1 : jn1)); }
      __builtin_amdgcn_sched_barrier(0);
#pragma unroll
      for (int i = 0; i < 2; i++)
#pragma unroll
        for (int jn = 0; jn < 5; jn++) st[i][jn] *= decay;
#pragma unroll
      for (int ks = 0; ks < 4; ks++) {
        bf16x8 kTf[2];
#pragma unroll
        for (int i = 0; i < 2; i++) {
          const u16* ap = Kb + (32 * ks + 8 * lg + (lr >> 2)) * KS + 32 * w + 16 * i + 4 * (lr & 3);
          const s16x4 lo = __builtin_amdgcn_ds_read_tr16_b64_v4i16((s16x4 __attribute__((address_space(3)))*)ap);
          const s16x4 hi = __builtin_amdgcn_ds_read_tr16_b64_v4i16((s16x4 __attribute__((address_space(3)))*)(ap + 4 * KS));
          kTf[i] = __builtin_shufflevector(lo, hi, 0, 1, 2, 3, 4, 5, 6, 7);
        }
#pragma unroll
        for (int jn = 0; jn < 5; jn++) {
          const bf16x8 b = *(const bf16x8*)(Vw + (16 * jn + lr) * VS + 32 * ks + 8 * lg);
#pragma unroll
          for (int i = 0; i < 2; i++) st[i][jn] = mfma16(kTf[i], b, st[i][jn]);
        }
      }
      m = mnext;
    }
  }
}

template <class PT> DI void phase_C(const PT& p, const Ctx& c, int l, u16* lds) {
  const int tid = opaque_tid(), lane = tid & 63, wave = tid >> 6, wm = wave & 3, wn = wave >> 2, lr = lane & 15, lg = lane >> 4;
  const u16* W = c.W + ((long)l * WROWS + W_C) * D;
  u16* Ru = c.R1; u16* Ryp = c.R2; u16* Rog = c.R3;
  const int nTiles = (c.Tg / 256) * 24;
  for (int tile = blockIdx.x; tile < nTiles; tile += gridDim.x) {
    const int tb = tile / 24, pt = tile % 24;
    f32x4 acc[4][8];
    {
      const int tn = tile + gridDim.x;
      const bool has = tn < nTiles;
      gemm_tile<4, 8, 2>(W + (long)pt * 256 * D, c.Rh + (long)tb * 256 * D, acc, lds,
                         has ? W + (long)(tn % 24) * 256 * D : nullptr, has ? c.Rh + (long)(tn / 24) * 256 * D : nullptr, tile != (int)blockIdx.x);
    }
    if (pt < 16) {
      const int chn = pt * 64 + wm * 16 + 4 * lg;
#pragma unroll
      for (int jn = 0; jn < 8; jn++) {
        const long lt = tb * 256 + 128 * wn + 16 * jn + lr;
        float u[4], y[4];
#pragma unroll
        for (int r = 0; r < 4; r++) { u[r] = acc[1][jn][r] * acc[2][jn][r]; y[r] = acc[0][jn][r] * siluf_(acc[3][jn][r]); }
        *(uint2*)(Ru + lt * D + chn) = pack4(u[0], u[1], u[2], u[3]);
        *(uint2*)(Ryp + lt * D + chn) = pack4(y[0], y[1], y[2], y[3]);
      }
    } else {
      const int chn = (pt - 16) * 128 + wm * 32 + 4 * lg;
#pragma unroll
      for (int jn = 0; jn < 8; jn++) {
        const long lt = tb * 256 + 128 * wn + 16 * jn + lr;
#pragma unroll
        for (int hh = 0; hh < 2; hh++) {
          float o[4];
#pragma unroll
          for (int r = 0; r < 4; r++) o[r] = sigmoidf_(acc[2 * hh][jn][r]) * siluf_(acc[2 * hh + 1][jn][r]);
          *(uint2*)(Rog + lt * D + chn + 16 * hh) = pack4(o[0], o[1], o[2], o[3]);
        }
      }
    }
  }
}

template <class PT> DI void phase_E(const PT& p, const Ctx& c, int l) {
  const int tid_ = opaque_tid(); const int lane = tid_ & 63, w = tid_ >> 6;
  const u16* Ru = c.R1; u16* Ryp = c.R2; u16* Rog = c.R3;
  const float* cw = p.conv_w + (long)l * 3 * D; const float* cb = p.conv_b + (long)l * D; const float* mg = p.mh_norm_g + (long)l * D;
  float4 w0[4], w1[4], w2[4], bb[4], gg[4];
#pragma unroll
  for (int i = 0; i < 4; i++) {
    const int k = 4 * lane + 256 * i;
    w0[i] = *(const float4*)(cw + k); w1[i] = *(const float4*)(cw + D + k); w2[i] = *(const float4*)(cw + 2 * D + k);
    bb[i] = *(const float4*)(cb + k); gg[i] = *(const float4*)(mg + k);
  }
  for (int lt = blockIdx.x * 8 + w; lt < c.Tg; lt += gridDim.x * 8) {
    const int sl = lt < c.half ? 8192 : 2048;
    const int pos = (lt < c.half ? lt : lt - c.half) & (sl - 1);
    const bool first = pos == 0, lastp = pos == sl - 1;
    uint2 U0[4], U1[4], U2[4], YP[4], OG[4], HF[4], HB[4];
#pragma unroll
    for (int i = 0; i < 4; i++) {
      const int k = 4 * lane + 256 * i;
      U0[i] = *(const uint2*)(Ru + (long)(first ? lt : lt - 1) * D + k);
      U1[i] = *(const uint2*)(Ru + (long)lt * D + k);
      U2[i] = *(const uint2*)(Ru + (long)(lastp ? lt : lt + 1) * D + k);
      if (first) { U0[i].x = 0u; U0[i].y = 0u; }
      if (lastp) { U2[i].x = 0u; U2[i].y = 0u; }
      YP[i] = *(const uint2*)(Ryp + (long)lt * D + k);
      OG[i] = *(const uint2*)(Rog + (long)lt * D + k);
      HF[i] = *(const uint2*)(c.Rhf + (long)lt * D + k);
      HB[i] = *(const uint2*)(c.Rhb + (long)lt * D + k);
    }
#pragma unroll
    for (int i = 0; i < 4; i++) {
      const int k = 4 * lane + 256 * i;
      const float4 a0 = unpack4(U0[i]), a1 = unpack4(U1[i]), a2 = unpack4(U2[i]), yp = unpack4(YP[i]);
      const float y0 = yp.x * (w0[i].x * a0.x + w1[i].x * a1.x + w2[i].x * a2.x + bb[i].x);
      const float y1 = yp.y * (w0[i].y * a0.y + w1[i].y * a1.y + w2[i].y * a2.y + bb[i].y);
      const float y2 = yp.z * (w0[i].z * a0.z + w1[i].z * a1.z + w2[i].z * a2.z + bb[i].z);
      const float y3 = yp.w * (w0[i].w * a0.w + w1[i].w * a1.w + w2[i].w * a2.w + bb[i].w);
      *(uint2*)(Ryp + (long)lt * D + k) = pack4(y0, y1, y2, y3);
      const float4 hf = unpack4(HF[i]), hb = unpack4(HB[i]), og = unpack4(OG[i]);
      const float s0 = hf.x + hb.x, s1 = hf.y + hb.y, s2 = hf.z + hb.z, s3 = hf.w + hb.w;
      const float ss = wave_sum(s0 * s0 + s1 * s1 + s2 * s2 + s3 * s3);
      const float rstd = rsqrtf(ss * (1.f / 256.f) + 1e-6f);
      *(uint2*)(Rog + (long)lt * D + k) = pack4(og.x * s0 * rstd * gg[i].x, og.y * s1 * rstd * gg[i].y, og.z * s2 * rstd * gg[i].z, og.w * s3 * rstd * gg[i].w);
    }
  }
}

template <class PT> DI void phase_D1(const PT& p, const Ctx& c, int l, u16* lds) {
  const int tid = opaque_tid(), lane = tid & 63, wave = tid >> 6, wm = wave & 3, wn = wave >> 2, lr = lane & 15, lg = lane >> 4;
  const u16* W = c.W + (long)l * WROWS * D;
  const u16* Ryc = c.R2; const u16* Rym = c.R3; u16* Rmg = c.R4;
  const int nTiles = (c.Tg / 128) * 4;
  int ring = 0;
  for (int tile = blockIdx.x; tile < nTiles; tile += gridDim.x) {
    const int ch = tile >> 2, mt = tile & 3;
    const u16* Pg = W + (long)(W_G + mt * 512) * D; const u16* Qh = c.Rh + (long)ch * 128 * D;
    const u16* Pc_ = W + (long)(W_PC + mt * 256) * D; const u16* Qc_ = Ryc + (long)ch * 128 * D;
    const u16* Pm_ = W + (long)(W_PM + mt * 256) * D; const u16* Qm_ = Rym + (long)ch * 128 * D;
    const int tn = tile + gridDim.x; const bool hasn = tn < nTiles;
    const u16* Pnx = hasn ? W + (long)(W_G + (tn & 3) * 512) * D : nullptr; const u16* Qnx = hasn ? c.Rh + (long)(tn >> 2) * 128 * D : nullptr;
    u32x2 gk[2][4][4], Mk[4][4];
#pragma unroll
    for (int cc = 0; cc < 2; cc++) {
      f32x4 a1[4][4];
      if (cc == 0) gemm_tile<4, 4, 3>(Pg, Qh, a1, lds, Pg + (long)256 * D, Qh, tile != (int)blockIdx.x, &ring);
      else gemm_tile<4, 4, 3>(Pg + (long)256 * D, Qh, a1, lds, Pc_, Qc_, true, &ring);
#pragma unroll
      for (int i = 0; i < 4; i++)
#pragma unroll
        for (int jn = 0; jn < 4; jn++) {
          const uint2 t_ = pack4(sigmoidf_(a1[i][jn][0]), sigmoidf_(a1[i][jn][1]), sigmoidf_(a1[i][jn][2]), sigmoidf_(a1[i][jn][3]));
          gk[cc][i][jn] = (u32x2){t_.x, t_.y}; asm volatile("" : "+v"(gk[cc][i][jn]));
        }
    }
    {
      f32x4 a2[4][4];
      gemm_tile<4, 4, 3>(Pc_, Qc_, a2, lds, Pm_, Qm_, true, &ring);
#pragma unroll
      for (int i = 0; i < 4; i++)
#pragma unroll
        for (int jn = 0; jn < 4; jn++) {
          uint2 g_; g_.x = gk[i >> 1][2 * (i & 1)][jn][0]; g_.y = gk[i >> 1][2 * (i & 1)][jn][1];
          const float4 gg = unpack4(g_);
          const uint2 t_ = pack4(gg.x * a2[i][jn][0], gg.y * a2[i][jn][1], gg.z * a2[i][jn][2], gg.w * a2[i][jn][3]);
          Mk[i][jn] = (u32x2){t_.x, t_.y}; asm volatile("" : "+v"(Mk[i][jn]));
        }
    }
    {
      f32x4 a2[4][4];
      gemm_tile<4, 4, 3>(Pm_, Qm_, a2, lds, Pnx, Qnx, true, &ring);
#pragma unroll
      for (int i = 0; i < 4; i++)
#pragma unroll
        for (int jn = 0; jn < 4; jn++) {
          uint2 g_; g_.x = gk[i >> 1][2 * (i & 1) + 1][jn][0]; g_.y = gk[i >> 1][2 * (i & 1) + 1][jn][1];
          uint2 m_; m_.x = Mk[i][jn][0]; m_.y = Mk[i][jn][1];
          const float4 gg = unpack4(g_);
          const float4 mm = unpack4(m_);
          const int col = mt * 256 + 64 * wm + 16 * i + 4 * lg;
          const long lt = ch * 128 + 64 * wn + 16 * jn + lr;
          *(uint2*)(Rmg + lt * D + col) = pack4(mm.x + gg.x * a2[i][jn][0], mm.y + gg.y * a2[i][jn][1],
                                                mm.z + gg.z * a2[i][jn][2], mm.w + gg.w * a2[i][jn][3]);
        }
    }
  }
}

template <class PT> DI void phase_D2(const PT& p, const Ctx& c, int l, int g, u16* lds) {
  const int tid = opaque_tid(), lane = tid & 63, wave = tid >> 6, wm = wave & 3, wn = wave >> 2, lr = lane & 15, lg = lane >> 4;
  const u16* W = c.W + ((long)l * WROWS + W_O) * D;
  const u16* Rmg = c.R4;
  const int nTiles = (c.Tg / 256) * 4;
  for (int tile = blockIdx.x; tile < nTiles; tile += gridDim.x) {
    const int tb = tile >> 2, pt = tile & 3;
    f32x4 acc[4][8];
    {
      const int tn = tile + gridDim.x;
      const bool has = tn < nTiles;
      gemm_tile<4, 8, 2>(W + (long)pt * 256 * D, Rmg + (long)tb * 256 * D, acc, lds,
                         has ? W + (long)(tn & 3) * 256 * D : nullptr, has ? Rmg + (long)(tn >> 2) * 256 * D : nullptr, tile != (int)blockIdx.x);
    }
    const int tok0 = gtok(c, g, tb * 256);
    const float* gp = c.mod + ((long)l * 40 + batch_of(tok0)) * 3072 + 2048;
#pragma unroll
    for (int i = 0; i < 4; i++) {
      const int col = pt * 256 + 64 * wm + 16 * i + 4 * lg;
      const float4 gt = *(const float4*)(gp + col);
      float4 xv[8];
#pragma unroll
      for (int jn = 0; jn < 8; jn++) {
        const int tok = tok0 + 128 * wn + 16 * jn + lr;
        const float* xr = (l == 0) ? xin_row(p, tok) : p.out + (long)tok * D;
        xv[jn] = *(const float4*)(xr + col);
      }
#pragma unroll
      for (int jn = 0; jn < 8; jn++) {
        const int tok = tok0 + 128 * wn + 16 * jn + lr;
        float4 o;
        o.x = xv[jn].x + gt.x * acc[i][jn][0]; o.y = xv[jn].y + gt.y * acc[i][jn][1];
        o.z = xv[jn].z + gt.z * acc[i][jn][2]; o.w = xv[jn].w + gt.w * acc[i][jn][3];
        *(float4*)(p.out + (long)tok * D + col) = o;
      }
    }
  }
}

__global__ void __launch_bounds__(NT) mega(Params p) {
  extern __shared__ __attribute__((aligned(16))) char smem[];
  cg::grid_group grid = cg::this_grid();
  const int nG = p.G;
  __shared__ uint4 xb_words;
  volatile LAS unsigned* xb_st = (volatile LAS unsigned*)&xb_words;
  Params* pg;
  unsigned* xbar;
  {
    const Ctx c0 = make_ctx(p);
    unsigned char* q = (unsigned char*)c0.ctr + 4096;
    xbar = (unsigned*)q; q += XCD_BAR_WORDS * 4;
    pg = (Params*)q;
    if (blockIdx.x == 0 && threadIdx.x == 0) *pg = p;
    if (threadIdx.x == 0) xb_words = make_uint4(0u, 0u, 0u, 0u);
    __syncthreads();
    XcdBarrier xb0 = xcd_barrier_post(xbar, xb_st);
    (void)xb0;
    phase_prep(p, c0, (float*)smem);
  }
  grid.sync();
#define PH(call) { const CParams* q_ = launder_params(pg); const CParams& P_ = *q_; const Ctx c = make_ctx(P_); call; }
#define BAR() { const CParams* q_ = launder_params(pg); const Ctx c = make_ctx(*q_); XcdBarrier xb; xb.bar = (unsigned*)((unsigned char*)c.ctr + 4096); xb.x = xb_xcc_id(); xb.st = xb_st; xcd_barrier(xb); }
  for (int g = 0; g < nG; ++g) {
    for (int l = 0; l < DEPTH; ++l) {
      PH(phase_rows(P_, c, l, g, false)); BAR();
      PH(phase_A(P_, c, l, (u16*)smem)); BAR();
      PH(phase_scan(P_, c, g * DEPTH + l, smem)); BAR();
      PH(phase_C(P_, c, l, (u16*)smem)); BAR();
      PH(phase_E(P_, c, l)); BAR();
      PH(phase_D1(P_, c, l, (u16*)smem)); BAR();
      PH(phase_D2(P_, c, l, g, (u16*)smem)); BAR();
    }
    PH(phase_rows(P_, c, DEPTH, g, true));
  }
}

extern "C" void kernel_launch(void* const* d_in, const int* in_sizes, int n_in, void* d_out, int out_size,
                              void* d_ws, size_t ws_size, hipStream_t stream) {
  static int grid_blocks = 0;
  static int Gsel = 2;
  if (!grid_blocks) {
    int dev = 0, cus = 0, per_cu = 0;
    hipGetDevice(&dev);
    hipDeviceGetAttribute(&cus, hipDeviceAttributeMultiprocessorCount, dev);
    hipFuncSetAttribute((const void*)mega, hipFuncAttributeMaxDynamicSharedMemorySize, LDS_BYTES);
    hipOccupancyMaxActiveBlocksPerMultiprocessor(&per_cu, (const void*)mega, NT, LDS_BYTES);
    if (per_cu < 1) per_cu = 1;
    grid_blocks = cus * per_cu;
    const size_t fixed = (size_t)DEPTH * WROWS * D * 2 + (size_t)DEPTH * 40 * 3072 * 4 + 4096 + XCD_BAR_WORDS * 4 + 1024;
    Gsel = 2;
    while (Gsel < 8 && 7 * ((size_t)(131072 / Gsel) * D * 2) + fixed + (size_t)(131072 / Gsel) * 96 > ws_size) Gsel *= 2;
  }
  Params p{};
  p.x_prompt = (const float*)d_in[0]; p.x_sample = (const float*)d_in[1]; p.c_prompt = (const float*)d_in[2]; p.c_sample = (const float*)d_in[3];
  p.w_ada = (const float*)d_in[4]; p.b_ada = (const float*)d_in[5]; p.norm_g = (const float*)d_in[6]; p.w_in = (const float*)d_in[7];
  p.b_gates = (const float*)d_in[8]; p.conv_w = (const float*)d_in[9]; p.conv_b = (const float*)d_in[10]; p.mh_norm_g = (const float*)d_in[11];
  p.w_pc = (const float*)d_in[12]; p.w_pm = (const float*)d_in[13]; p.w_out = (const float*)d_in[14]; p.final_g = (const float*)d_in[15];
  p.out = (float*)d_out; p.ws = (unsigned char*)d_ws; p.G = Gsel; p.pad = 0;
  {
    const size_t Tg = 131072 / Gsel;
    const size_t off = 7 * (Tg * D * 2) + (size_t)DEPTH * WROWS * D * 2 + (size_t)DEPTH * 40 * 3072 * 4 + Tg * 96 + 4096;
    (void)hipMemsetAsync((unsigned char*)d_ws + off, 0, XCD_BAR_WORDS * 4, stream);
  }
  void* args[] = {&p};
  hipError_t e = hipLaunchCooperativeKernel((const void*)mega, dim3(grid_blocks), dim3(NT), args, LDS_BYTES, stream);
  if (e != hipSuccess) fprintf(stderr, "cooperative launch failed: %s (grid %d)\n", hipGetErrorString(e), grid_blocks);
}
```

```cpp
#include <hip/hip_runtime.h>
#include <hip/hip_cooperative_groups.h>
#include <cstdio>
namespace cg = cooperative_groups;

typedef unsigned short u16;
using bf16x8 = __attribute__((ext_vector_type(8))) short;
using f32x4  = __attribute__((ext_vector_type(4))) float;
using s16x4  = __attribute__((ext_vector_type(4))) short;
using u32x4  = __attribute__((ext_vector_type(4))) unsigned;
using u32x2  = __attribute__((ext_vector_type(2))) unsigned;
#define DI __device__ __forceinline__

constexpr int D = 1024, DIN = 11280, DEPTH = 4;
constexpr int NT = 512;
constexpr int W_QKV = 0, W_C = 3328, W_G = 9472, W_PC = 11520, W_PM = 12544, W_O = 13568, WROWS = 14592;
constexpr int LDT = 72;
constexpr int KS = 264, VS = 136;
constexpr int LDS_BYTES = (128 * KS + 2 * 80 * VS + 80 * KS) * 2 + 4 * 128 * 4;

struct Params {
  const float* x_prompt; const float* x_sample; const float* c_prompt; const float* c_sample;
  const float* w_ada; const float* b_ada; const float* norm_g; const float* w_in; const float* b_gates;
  const float* conv_w; const float* conv_b; const float* mh_norm_g; const float* w_pc; const float* w_pm;
  const float* w_out; const float* final_g;
  float* out; unsigned char* ws;
  int G; int pad;
};

struct Ctx {
  int G, Tg, half;
  u16 *Rh, *R1, *R2, *R3, *R4, *Rhf, *Rhb;
  u16* W; float* mod; float* sc; int* ctr;
};

DI u16 f2bf(float x) { unsigned u = __float_as_uint(x); u += 0x7fffu + ((u >> 16) & 1u); return (u16)(u >> 16); }
DI float bf2f(unsigned h) { return __uint_as_float(h << 16); }
typedef __bf16 bf16x2_t __attribute__((ext_vector_type(2)));
typedef float f32x2_t __attribute__((ext_vector_type(2)));
DI unsigned pack2(float a, float b) { const f32x2_t v = {a, b}; return __builtin_bit_cast(unsigned, __builtin_convertvector(v, bf16x2_t)); }
DI uint2 pack4(float a, float b, float c, float d) { uint2 r; r.x = pack2(a, b); r.y = pack2(c, d); return r; }
DI uint2 pack4v(f32x4 v) { return pack4(v[0], v[1], v[2], v[3]); }
DI float4 unpack4(uint2 v) { float4 r; r.x = bf2f(v.x & 0xffffu); r.y = bf2f(v.x >> 16); r.z = bf2f(v.y & 0xffffu); r.w = bf2f(v.y >> 16); return r; }
DI float sigmoidf_(float x) { return __builtin_amdgcn_rcpf(1.f + __expf(-x)); }
DI float siluf_(float x) { return x * sigmoidf_(x); }
DI float wave_sum(float v) {
#pragma unroll
  for (int o = 32; o >= 1; o >>= 1) v += __shfl_xor(v, o);
  return v;
}
DI int opaque_tid() { int t = threadIdx.x; asm volatile("" : "+v"(t)); return t; }
DI f32x4 mfma16(bf16x8 a, bf16x8 b, f32x4 c) { return __builtin_amdgcn_mfma_f32_16x16x32_bf16(a, b, c, 0, 0, 0); }


typedef const Params __attribute__((address_space(4))) CParams;
template <class PT> DI Ctx make_ctx(const PT& p) {
  Ctx c;
  c.G = p.G; c.Tg = 131072 / p.G; c.half = c.Tg >> 1;
  const size_t REG = (size_t)c.Tg * D * 2;
  unsigned char* ws = p.ws;
  c.Rh = (u16*)(ws); c.R1 = (u16*)(ws + REG); c.R2 = (u16*)(ws + 2 * REG); c.R3 = (u16*)(ws + 3 * REG);
  c.R4 = (u16*)(ws + 4 * REG); c.Rhf = (u16*)(ws + 5 * REG); c.Rhb = (u16*)(ws + 6 * REG);
  unsigned char* q = ws + 7 * REG;
  c.W = (u16*)q; q += (size_t)DEPTH * WROWS * D * 2;
  c.mod = (float*)q; q += (size_t)DEPTH * 40 * 3072 * 4;
  c.sc = (float*)q; q += (size_t)c.Tg * 96;
  c.ctr = (int*)q;
  return c;
}
DI const CParams* launder_params(const Params* g) { asm volatile("" : "+s"(g)); return (const CParams*)(unsigned long long)g; }
DI int gtok(const Ctx& c, int g, int lt) { return lt < c.half ? g * c.half + lt : 65536 + g * c.half + (lt - c.half); }
DI int batch_of(int tok) { return tok < 65536 ? (tok >> 13) : 8 + ((tok - 65536) >> 11); }
template <class PT> DI const float* xin_row(const PT& p, int tok) {
  return tok < 65536 ? p.x_prompt + (long)tok * D : p.x_sample + (long)(tok - 65536) * D;
}


#define XB_TMO      128
#define XB_XCNT(j)  (256  + 64 * (j))
#define XB_XSUB(j)  (1280 + 64 * (j))
#define XB_XGEN(j)  (2304 + 64 * (j))
#define XB_TOP      3328
#define XB_TOPGEN   3392
#define XCD_BAR_WORDS 3456
#define XB_SPIN_CAP (1u << 18)
#define LAS __attribute__((address_space(3)))
DI unsigned xb_ld(unsigned* p)              { return __hip_atomic_load(p, __ATOMIC_RELAXED, __HIP_MEMORY_SCOPE_AGENT); }
DI unsigned xb_add(unsigned* p, unsigned v) { return __hip_atomic_fetch_add(p, v, __ATOMIC_RELAXED, __HIP_MEMORY_SCOPE_AGENT); }
DI unsigned xb_xcc_id() { return (unsigned)__builtin_amdgcn_s_getreg((3 << 11) | 20) & 0xFu; }
#define XB_SPIN(cond, bar) do { unsigned _sp = 0; while (cond) { __builtin_amdgcn_s_sleep(1); \
    if ((++_sp & 255u) == 0u) { if (xb_ld(&(bar)[XB_TMO])) break; if (_sp > XB_SPIN_CAP) { atomicAdd(&(bar)[XB_TMO], 1u); break; } } } } while (0)
struct XcdBarrier { unsigned* bar; unsigned x; volatile LAS unsigned* st; };
DI XcdBarrier xcd_barrier_post(unsigned* bar, volatile LAS unsigned* st) {
  XcdBarrier b; b.bar = bar; b.x = xb_xcc_id(); b.st = st;
  if (threadIdx.x == 0) (void)xb_add(&bar[XB_XCNT(b.x)], 1u);
  return b;
}
DI void xcd_barrier_complete(unsigned* bar, unsigned x, unsigned& nloc, unsigned& nx) {
  const unsigned G = gridDim.x * gridDim.y * gridDim.z;
  unsigned sum, cnt, mine, sp = 0u;
  for (;;) {
    sum = 0u; cnt = 0u; mine = 0u;
#pragma unroll
    for (unsigned j = 0; j < 16; ++j) { const unsigned c = xb_ld(&bar[XB_XCNT(j)]); sum += c; cnt += (c > 0u) ? 1u : 0u; }
    mine = xb_ld(&bar[XB_XCNT(x)]);
    if (sum == G) break;
    __builtin_amdgcn_s_sleep(1);
    if ((++sp & 255u) == 0u) { if (xb_ld(&bar[XB_TMO])) break; if (sp > XB_SPIN_CAP) { atomicAdd(&bar[XB_TMO], 1u); break; } }
  }
  nloc = mine > 0u ? mine : 1u; nx = cnt > 0u ? cnt : 1u;
}
DI void xcd_barrier(const XcdBarrier& b) {
  asm volatile("s_waitcnt vmcnt(0)" ::: "memory");
  __syncthreads();
  if (threadIdx.x == 0) {
    unsigned* bar = b.bar;
    asm volatile("" : "+s"(bar));
    __builtin_amdgcn_s_waitcnt(0);
    unsigned nloc = b.st[0], nx = b.st[1];
    if (nloc == 0u) { xcd_barrier_complete(bar, b.x, nloc, nx); b.st[0] = nloc; b.st[1] = nx; }
    const unsigned old = xb_add(&bar[XB_XSUB(b.x)], 1u);
    const unsigned gen = old / nloc;
    if (old + 1u == (gen + 1u) * nloc) {
      __builtin_amdgcn_fence(__ATOMIC_RELEASE, "agent");
      asm volatile("s_waitcnt vmcnt(0)" ::: "memory");
      const unsigned og = xb_add(&bar[XB_TOP], 1u);
      const unsigned tg = og / nx;
      if (og + 1u == (tg + 1u) * nx) xb_add(&bar[XB_TOPGEN], 1u);
      else XB_SPIN(xb_ld(&bar[XB_TOPGEN]) == tg, bar);
      __builtin_amdgcn_fence(__ATOMIC_ACQUIRE, "agent");
      xb_add(&bar[XB_XGEN(b.x)], 1u);
      asm volatile("s_waitcnt vmcnt(0)" ::: "memory");
    } else {
      XB_SPIN(xb_ld(&bar[XB_XGEN(b.x)]) == gen, bar);
      __builtin_amdgcn_fence(__ATOMIC_ACQUIRE, "agent");
      asm volatile("s_waitcnt vmcnt(0)" ::: "memory");
    }
  }
  __syncthreads();
}

template <int MT, int NT, int ST>
DI void gemm_tile(const u16* __restrict__ P, const u16* __restrict__ Q, f32x4 (&acc)[MT][NT], u16* lds,
                  const u16* Pn = nullptr, const u16* Qn = nullptr, bool primed = false, int* ringp = nullptr) {
  const int tid = opaque_tid(), lane = tid & 63, wave = __builtin_amdgcn_readfirstlane(tid >> 6), wm = wave & 3, wn = wave >> 2;
  const int lr = lane & 15, lg = lane >> 4;
  constexpr int PROWS = 64 * MT, QROWS = 32 * NT, NQI = NT / 2, NDMA = MT + NQI;
  char* pbase = (char*)lds;
  char* qbase = pbase + ST * PROWS * 128;
  const int drow = lane >> 3, dpos = lane & 7;
  const int r0 = 8 * wave + drow;
  const unsigned voff = (unsigned)(r0 * D + ((dpos ^ ((r0 >> 1) & 7)) << 3)) * 2u;
  const char* Pc = (const char*)P; const char* Qc = (const char*)Q;
  char* dp = pbase + wave * 1024 + lane * 16;
  char* dq = qbase + wave * 1024 + lane * 16;
#pragma unroll
  for (int i = 0; i < MT; i++)
#pragma unroll
    for (int j = 0; j < NT; j++) acc[i][j] = (f32x4){0.f, 0.f, 0.f, 0.f};
  const int ring0 = (ST == 3 && ringp) ? *ringp : 0;
  if (!primed) {
#pragma unroll
    for (int t0 = 0; t0 < ST - 1; t0++) {
      int bi = ring0 + t0; if (bi >= ST) bi -= ST;
#pragma unroll
      for (int i = 0; i < MT; i++) __builtin_amdgcn_global_load_lds((const unsigned*)(Pc + (i * 64 * D * 2 + t0 * 128) + voff), (unsigned*)(dp + bi * PROWS * 128 + i * 8192), 16, 0, 0);
#pragma unroll
      for (int i = 0; i < NQI; i++) __builtin_amdgcn_global_load_lds((const unsigned*)(Qc + (i * 64 * D * 2 + t0 * 128) + voff), (unsigned*)(dq + bi * QROWS * 128 + i * 8192), 16, 0, 0);
    }
  }
  if (primed) asm volatile("s_waitcnt vmcnt(0)" ::: "memory");
  else asm volatile("s_waitcnt vmcnt(%0)" :: "n"((ST - 2) * NDMA) : "memory");
  __builtin_amdgcn_s_barrier();
  asm volatile("" ::: "memory");
  const int swz = (lr >> 1) & 7;
  const int o0 = (lg ^ swz) << 4, o1 = ((4 + lg) ^ swz) << 4;
  const char* pa = pbase + (wm * 16 * MT + lr) * 128;
  const char* qa = qbase + (wn * 16 * NT + lr) * 128;
  constexpr int NK = D / 64;
  int cur = ring0, nxs = ring0 + ST - 1; if (nxs >= ST) nxs -= ST;
  for (int kt = 0; kt < NK; ++kt) {
    if (kt + ST - 1 < NK) {
#pragma unroll
      for (int i = 0; i < MT; i++) __builtin_amdgcn_global_load_lds((const unsigned*)(Pc + (i * 64 * D * 2 + (kt + ST - 1) * 128) + voff), (unsigned*)(dp + nxs * PROWS * 128 + i * 8192), 16, 0, 0);
#pragma unroll
      for (int i = 0; i < NQI; i++) __builtin_amdgcn_global_load_lds((const unsigned*)(Qc + (i * 64 * D * 2 + (kt + ST - 1) * 128) + voff), (unsigned*)(dq + nxs * QROWS * 128 + i * 8192), 16, 0, 0);
    }
    if (ST == 3 && kt >= NK - 2 && Pn != nullptr) {
      const char* Pnc = (const char*)Pn + (kt - (NK - 2)) * 128; const char* Qnc = (const char*)Qn + (kt - (NK - 2)) * 128;
#pragma unroll
      for (int i = 0; i < MT; i++) __builtin_amdgcn_global_load_lds((const unsigned*)(Pnc + (i * 64 * D * 2) + voff), (unsigned*)(dp + nxs * PROWS * 128 + i * 8192), 16, 0, 0);
#pragma unroll
      for (int i = 0; i < NQI; i++) __builtin_amdgcn_global_load_lds((const unsigned*)(Qnc + (i * 64 * D * 2) + voff), (unsigned*)(dq + nxs * QROWS * 128 + i * 8192), 16, 0, 0);
    }
    if (ST == 2 && kt == NK - 1 && Pn != nullptr) {
      const char* Pnc = (const char*)Pn; const char* Qnc = (const char*)Qn;
#pragma unroll
      for (int i = 0; i < MT; i++) __builtin_amdgcn_global_load_lds((const unsigned*)(Pnc + (i * 64 * D * 2) + voff), (unsigned*)(dp + i * 8192), 16, 0, 0);
#pragma unroll
      for (int i = 0; i < NQI; i++) __builtin_amdgcn_global_load_lds((const unsigned*)(Qnc + (i * 64 * D * 2) + voff), (unsigned*)(dq + i * 8192), 16, 0, 0);
    }
    const char* pb = pa + cur * PROWS * 128;
    const char* qb = qa + cur * QROWS * 128;
    if constexpr (NT == 99) {
      bf16x8 af[MT], b0[NT], b1[NT];
#pragma unroll
      for (int j = 0; j < NT; j++) b0[j] = *(const bf16x8*)(qb + j * 2048 + o0);
#pragma unroll
      for (int i = 0; i < MT; i++) af[i] = *(const bf16x8*)(pb + i * 2048 + o0);
      __builtin_amdgcn_s_setprio(1);
#pragma unroll
      for (int i = 0; i < MT; i++) {
#pragma unroll
        for (int j = 0; j < NT; j++) acc[i][j] = mfma16(af[i], b0[j], acc[i][j]);
        b1[i] = *(const bf16x8*)(qb + i * 2048 + o1);
        af[i] = *(const bf16x8*)(pb + i * 2048 + o1);
      }
#pragma unroll
      for (int j = MT; j < NT; j++) b1[j] = *(const bf16x8*)(qb + j * 2048 + o1);
#pragma unroll
      for (int i = 0; i < MT; i++)
#pragma unroll
        for (int j = 0; j < NT; j++) acc[i][j] = mfma16(af[i], b1[j], acc[i][j]);
      __builtin_amdgcn_sched_group_barrier(0x100, NT + MT, 0);
#pragma unroll
      for (int r = 0; r < MT; r++) {
        __builtin_amdgcn_sched_group_barrier(0x008, 4, 0);
        __builtin_amdgcn_sched_group_barrier(0x100, 1, 0);
        __builtin_amdgcn_sched_group_barrier(0x008, 4, 0);
        __builtin_amdgcn_sched_group_barrier(0x100, 1, 0);
      }
      __builtin_amdgcn_sched_group_barrier(0x100, NT - MT, 0);
      __builtin_amdgcn_sched_group_barrier(0x008, MT * NT, 0);
      __builtin_amdgcn_s_setprio(0);
    } else {
#pragma unroll
      for (int ks = 0; ks < 2; ++ks) {
        const int oo = ks ? o1 : o0;
        bf16x8 a[MT], b[NT];
#pragma unroll
        for (int i = 0; i < MT; i++) a[i] = *(const bf16x8*)(pb + i * 2048 + oo);
#pragma unroll
        for (int j = 0; j < NT; j++) b[j] = *(const bf16x8*)(qb + j * 2048 + oo);
        __builtin_amdgcn_s_setprio(1);
#pragma unroll
        for (int i = 0; i < MT; i++)
#pragma unroll
          for (int j = 0; j < NT; j++) acc[i][j] = mfma16(a[i], b[j], acc[i][j]);
        __builtin_amdgcn_s_setprio(0);
      }
    }
    if (kt + ST - 1 < NK) asm volatile("s_waitcnt vmcnt(%0)" :: "n"((ST - 2) * NDMA) : "memory");
    else if (ST == 3 && Pn != nullptr) { if (kt == NK - 2) asm volatile("s_waitcnt vmcnt(%0)" :: "n"(NDMA) : "memory"); }
    else if (!(ST == 2 && Pn != nullptr)) asm volatile("s_waitcnt vmcnt(0)" ::: "memory");
    __builtin_amdgcn_s_barrier();
    asm volatile("" ::: "memory");
    cur = (cur == ST - 1) ? 0 : cur + 1;
    nxs = (nxs == ST - 1) ? 0 : nxs + 1;
  }
  if (ST == 3 && ringp) *ringp = cur;
}

template <class PT> DI void wsrc(const PT& p, int l, int n, const float*& src, int& ld, int& col, float& scale) {
  scale = 1.f;
  src = p.w_in + (long)l * D * DIN; ld = DIN;
  if (n < W_C) {
    if (n < 1024) col = 4096 + n;
    else if (n < 2048) { col = 5120 + (n - 1024); scale = 0.0625f; }
    else if (n < 3072) col = 6144 + (n - 2048);
    else if (n < 3088) col = 9216 + (n - 3072);
    else col = -1;
  } else if (n < W_G) {
    int n2 = n - W_C;
    if (n2 < 4096) { int blk = n2 >> 6, sl = (n2 >> 4) & 3, cl = n2 & 15; col = sl * 1024 + blk * 16 + cl; }
    else { int n3 = n2 - 4096; int blk = n3 >> 5, sl = (n3 >> 4) & 1, cl = n3 & 15; col = (sl ? 8192 : 7168) + blk * 16 + cl; }
  } else if (n < W_PC) {
    int n4 = n - W_G; int mtb = n4 >> 9, r5 = n4 & 511; int cc5 = r5 >> 8, wm5 = (r5 >> 6) & 3, a5 = (r5 >> 5) & 1, sl = (r5 >> 4) & 1, cl = r5 & 15;
    col = 9232 + sl * 1024 + (256 * mtb + 64 * wm5 + 32 * cc5 + 16 * a5 + cl);
  } else if (n < W_PM) { src = p.w_pc + (long)l * D * D; ld = D; col = n - W_PC; }
  else if (n < W_O)  { src = p.w_pm + (long)l * D * D; ld = D; col = n - W_PM; }
  else               { src = p.w_out + (long)l * D * D; ld = D; col = n - W_O; }
}

template <class PT> DI void phase_prep(const PT& p, const Ctx& c, float* ldsf) {
  const int tid = opaque_tid();
  if (blockIdx.x == 0 && tid < 256) c.ctr[tid] = 0;
  const int nItems = DEPTH * (WROWS / 64) * 16;
  for (int it = blockIdx.x; it < nItems; it += gridDim.x) {
    const int kb = (it & 15) * 64; const int rb = it >> 4;
    const int l = rb / (WROWS / 64); const int nb = (rb % (WROWS / 64)) * 64;
    const float* src; int ld, col; float scale;
    const int nl = tid & 63;
    wsrc(p, l, nb + nl, src, ld, col, scale);
#pragma unroll
    for (int i = 0; i < 8; i++) {
      const int kl = (tid >> 6) + 8 * i;
      float v = (col >= 0) ? src[(long)(kb + kl) * ld + col] * scale : 0.f;
      ldsf[kl * 65 + nl] = v;
    }
    __syncthreads();
    {
      const int nl2 = tid >> 3, kc = tid & 7;
      float v[8];
#pragma unroll
      for (int j = 0; j < 8; j++) v[j] = ldsf[(kc * 8 + j) * 65 + nl2];
      uint4 o; o.x = pack2(v[0], v[1]); o.y = pack2(v[2], v[3]); o.z = pack2(v[4], v[5]); o.w = pack2(v[6], v[7]);
      *(uint4*)(c.W + ((long)l * WROWS + nb + nl2) * D + kb + kc * 8) = o;
    }
    __syncthreads();
  }
  const int nMod = DEPTH * 48;
  for (int it = blockIdx.x; it < nMod; it += gridDim.x) {
    const int l = it / 48, jb = (it % 48) * 64;
    const int cl = tid & 63, kc = tid >> 6;
    float acc[40];
#pragma unroll
    for (int b = 0; b < 40; b++) acc[b] = 0.f;
    const float* wa = p.w_ada + (long)l * D * 3072 + jb + cl;
    for (int k = kc * 128; k < kc * 128 + 128; ++k) {
      const float wv = wa[(long)k * 3072];
#pragma unroll
      for (int b = 0; b < 40; b++) {
        const float cv = (b < 8) ? p.c_prompt[b * D + k] : p.c_sample[(b - 8) * D + k];
        acc[b] += cv * wv;
      }
    }
#pragma unroll
    for (int b = 0; b < 40; b++) ldsf[(kc * 40 + b) * 64 + cl] = acc[b];
    __syncthreads();
    for (int idx = tid; idx < 40 * 64; idx += NT) {
      const int b = idx >> 6, cc = idx & 63;
      float s = p.b_ada[l * 3072 + jb + cc];
#pragma unroll
      for (int q = 0; q < 8; q++) s += ldsf[(q * 40 + b) * 64 + cc];
      c.mod[((long)l * 40 + b) * 3072 + jb + cc] = s;
    }
    __syncthreads();
  }
}

template <class PT> DI void phase_rows(const PT& p, const Ctx& c, int l, int g, bool fin) {
  const int tid_ = opaque_tid(); const int lane = tid_ & 63, w = tid_ >> 6;
  const int stride = gridDim.x * 8;
  float4 gv[4];
#pragma unroll
  for (int i = 0; i < 4; i++) gv[i] = *(const float4*)((fin ? p.final_g : p.norm_g + l * D) + 4 * lane + 256 * i);
  for (int lt0 = blockIdx.x * 8 + w; lt0 < c.Tg; lt0 += 2 * stride) {
    const bool has1 = lt0 + stride < c.Tg;
    const int lt1 = has1 ? lt0 + stride : lt0;
    const int tok0 = gtok(c, g, lt0), tok1 = gtok(c, g, lt1);
    const float* xr0 = (l == 0) ? xin_row(p, tok0) : p.out + (long)tok0 * D;
    const float* xr1 = (l == 0) ? xin_row(p, tok1) : p.out + (long)tok1 * D;
    float4 v0[4], v1[4]; float ss0 = 0.f, ss1 = 0.f;
#pragma unroll
    for (int i = 0; i < 4; i++) { v0[i] = *(const float4*)(xr0 + 4 * lane + 256 * i); v1[i] = *(const float4*)(xr1 + 4 * lane + 256 * i); }
    const float* mp0 = c.mod + ((long)(fin ? 0 : l) * 40 + batch_of(tok0)) * 3072;
    const float* mp1 = c.mod + ((long)(fin ? 0 : l) * 40 + batch_of(tok1)) * 3072;
    float4 sc0[4], sh0[4], sc1[4], sh1[4];
    if (!fin) {
#pragma unroll
      for (int i = 0; i < 4; i++) {
        const int k = 4 * lane + 256 * i;
        sc0[i] = *(const float4*)(mp0 + 1024 + k); sh0[i] = *(const float4*)(mp0 + k);
        sc1[i] = *(const float4*)(mp1 + 1024 + k); sh1[i] = *(const float4*)(mp1 + k);
      }
    }
#pragma unroll
    for (int i = 0; i < 4; i++) {
      ss0 += v0[i].x * v0[i].x + v0[i].y * v0[i].y + v0[i].z * v0[i].z + v0[i].w * v0[i].w;
      ss1 += v1[i].x * v1[i].x + v1[i].y * v1[i].y + v1[i].z * v1[i].z + v1[i].w * v1[i].w;
    }
    ss0 = wave_sum(ss0); ss1 = wave_sum(ss1);
    const float r0 = rsqrtf(ss0 * (1.f / 1024.f) + 1e-6f), r1 = rsqrtf(ss1 * (1.f / 1024.f) + 1e-6f);
    if (fin) {
#pragma unroll
      for (int i = 0; i < 4; i++) {
        const int k = 4 * lane + 256 * i;
        float4 o; o.x = v0[i].x * r0 * gv[i].x; o.y = v0[i].y * r0 * gv[i].y; o.z = v0[i].z * r0 * gv[i].z; o.w = v0[i].w * r0 * gv[i].w;
        *(float4*)(p.out + (long)tok0 * D + k) = o;
      }
      if (has1) {
#pragma unroll
        for (int i = 0; i < 4; i++) {
          const int k = 4 * lane + 256 * i;
          float4 o; o.x = v1[i].x * r1 * gv[i].x; o.y = v1[i].y * r1 * gv[i].y; o.z = v1[i].z * r1 * gv[i].z; o.w = v1[i].w * r1 * gv[i].w;
          *(float4*)(p.out + (long)tok1 * D + k) = o;
        }
      }
    } else {
#pragma unroll
      for (int i = 0; i < 4; i++) {
        const int k = 4 * lane + 256 * i;
        *(uint2*)(c.Rh + (long)lt0 * D + k) = pack4(v0[i].x * r0 * gv[i].x * (1.f + sc0[i].x) + sh0[i].x, v0[i].y * r0 * gv[i].y * (1.f + sc0[i].y) + sh0[i].y,
                                                    v0[i].z * r0 * gv[i].z * (1.f + sc0[i].z) + sh0[i].z, v0[i].w * r0 * gv[i].w * (1.f + sc0[i].w) + sh0[i].w);
      }
      if (has1) {
#pragma unroll
        for (int i = 0; i < 4; i++) {
          const int k = 4 * lane + 256 * i;
          *(uint2*)(c.Rh + (long)lt1 * D + k) = pack4(v1[i].x * r1 * gv[i].x * (1.f + sc1[i].x) + sh1[i].x, v1[i].y * r1 * gv[i].y * (1.f + sc1[i].y) + sh1[i].y,
                                                      v1[i].z * r1 * gv[i].z * (1.f + sc1[i].z) + sh1[i].z, v1[i].w * r1 * gv[i].w * (1.f + sc1[i].w) + sh1[i].w);
        }
      }
    }
  }
}

template <class PT> DI void phase_A(const PT& p, const Ctx& c, int l, u16* lds) {
  const int tid = opaque_tid(), lane = tid & 63, wave = tid >> 6, wm = wave & 3, wn = wave >> 2, lr = lane & 15, lg = lane >> 4;
  const u16* W = c.W + (long)l * WROWS * D;
  u16* Rq = c.R1; u16* Rk = c.R2; u16* RvT = c.R4;
  const int nTiles = (c.Tg / 256) * 13;
  auto ptrsA = [&](int tl, const u16*& Pp, const u16*& Qp) {
    const int tb_ = (tl / 104) * 8 + (tl & 7), j_ = (tl % 104) >> 3;
    const u16* hp = c.Rh + (long)tb_ * 256 * D;
    if (j_ < 8) { Pp = W + (long)((j_ >> 2) * 1024 + (j_ & 3) * 256) * D; Qp = hp; }
    else if (j_ < 12) { Pp = hp; Qp = W + (long)(2048 + (j_ - 8) * 256) * D; }
    else { Pp = W + (long)3072 * D; Qp = hp; }
  };
  bool primed = false;
  for (int tile = blockIdx.x; tile < nTiles; tile += gridDim.x) {
    const int tb = (tile / 104) * 8 + (tile & 7), j = (tile % 104) >> 3;
    f32x4 acc[4][8];
    const u16 *P0, *Q0, *P1 = nullptr, *Q1 = nullptr;
    ptrsA(tile, P0, Q0);
    if (tile + (int)gridDim.x < nTiles && j != 12 && (((tile + (int)gridDim.x) % 104) >> 3) != 12) ptrsA(tile + gridDim.x, P1, Q1);
    const bool pr = primed; primed = (P1 != nullptr);
    if (j < 8) {
      const int isk = j >> 2, head = j & 3;
      gemm_tile<4, 8, 2>(P0, Q0, acc, lds, P1, Q1, pr);
      u16* dst = isk ? Rk : Rq;
#pragma unroll
      for (int i = 0; i < 4; i++)
#pragma unroll
        for (int jn = 0; jn < 8; jn++) {
          const int d = 64 * wm + 16 * i + 4 * lg, t = 128 * wn + 16 * jn + lr;
          *(uint2*)(dst + (long)(tb * 256 + t) * D + head * 256 + d) = pack4v(acc[i][jn]);
        }
    } else if (j < 12) {
      const int head = j - 8;
      gemm_tile<4, 8, 2>(P0, Q0, acc, lds, P1, Q1, pr);
#pragma unroll
      for (int i = 0; i < 4; i++)
#pragma unroll
        for (int jn = 0; jn < 8; jn++) {
          const int tokl = 64 * wm + 16 * i + 4 * lg, e = 128 * wn + 16 * jn + lr;
          const int ch = tb * 2 + (tokl >> 7), sidx = tokl & 127;
          *(uint2*)(RvT + ((long)(ch * 4 + head) * 256 + e) * 128 + sidx) = pack4v(acc[i][jn]);
        }
    } else {
      f32x4 accg[1][8];
      gemm_tile<1, 8, 2>(P0, Q0, accg, lds);
      float* gl = (float*)lds;
      if (wm == 0) {
#pragma unroll
        for (int jn = 0; jn < 8; jn++) {
          const int t = 128 * wn + 16 * jn + lr;
#pragma unroll
          for (int r = 0; r < 4; r++) {
            float v = accg[0][jn][r] + p.b_gates[l * 16 + lg * 4 + r];
            if (lg & 1) v = fminf(v, 0.f) - log1pf(expf(-fabsf(v)));
            gl[t * 16 + lg * 4 + r] = v;
          }
        }
      }
      __syncthreads();
      if (tid < 16) {
        const int head = tid & 3, dir = (tid >> 2) & 1, cl = tid >> 3;
        const int ch = tb * 2 + cl;
        float* o = c.sc + (((long)(ch * 4 + head) * 2 + dir) * 3) * 128;
        const float* glc = gl + cl * 128 * 16;
        float bs = 0.f, pm = -3.0e38f;
        for (int q = 0; q < 128; ++q) {
          const int t = dir ? 127 - q : q;
          const float iv = glc[t * 16 + dir * 8 + head], lf = glc[t * 16 + dir * 8 + 4 + head];
          bs += lf; const float gg = iv - bs; pm = fmaxf(pm, gg);
          o[t] = bs; o[128 + t] = gg; o[256 + t] = pm;
        }
      }
      __syncthreads();
    }
  }
}

template <class PT> DI void phase_scan(const PT& p, const Ctx& c, int ctrIdx, char* smem) {
  __shared__ int s_task;
  const int tid = opaque_tid(), lane = tid & 63, w0 = __builtin_amdgcn_readfirstlane(tid >> 6), lr = lane & 15, lg = lane >> 4;
  u16* Kb = (u16*)smem;
  u16* Vt = Kb + 128 * KS;
  u16* Vw = Vt + 80 * VS;
  u16* Ct = Vw + 80 * VS;
  float* scg = (float*)(Ct + 80 * KS); float* scmu = scg + 128; float* sciw = scmu + 128; float* scfl = sciw + 128;
  const u16* Rq = c.R1; const u16* Rk = c.R2; const u16* RvT = c.R4;
  const int nLong = (8 / c.G) * 32;
  const int nLongQ8 = (8 / c.G), nShortQ8 = (32 / c.G);
  const int perQueue = (nLongQ8 + nShortQ8) * 4;
  int* ctr = c.ctr + ctrIdx * 8;
  const int myq = (int)(xb_xcc_id() & 7u);
  int qoff = 0;
  while (true) {
    __syncthreads();
    if (tid == 0) {
      int t = -1;
      while (qoff < 8) {
        const int qi = (myq + qoff) & 7;
        const int n = atomicAdd(ctr + qi, 1);
        if (n < perQueue) {
          const int quad = (n < nLongQ8 * 4) ? qi + 8 * (n >> 2) : nLongQ8 * 8 + qi + 8 * ((n - nLongQ8 * 4) >> 2);
          t = quad * 4 + (n & 3);
          break;
        }
        ++qoff;
      }
      s_task = t;
    }
    __syncthreads();
    const int task = s_task;
    if (task < 0) break;
    int seq, r, chunk0, nc;
    if (task < nLong) { seq = task >> 5; r = task & 31; chunk0 = seq * 64; nc = 64; }
    else { const int t2 = task - nLong; seq = t2 >> 5; r = t2 & 31; chunk0 = (c.half >> 7) + seq * 16; nc = 16; }
    const int head = r >> 3, dir = (r >> 2) & 1, es = r & 3;
    const int last = dir ? 0 : 127;
    u16* Rho = dir ? c.Rhb : c.Rhf;
    for (int idx = tid; idx < 80 * KS / 2; idx += NT) ((unsigned*)Ct)[idx] = 0u;
    for (int idx = tid; idx < 16 * VS / 2; idx += NT) { ((unsigned*)(Vt + 64 * VS))[idx] = 0u; ((unsigned*)(Vw + 64 * VS))[idx] = 0u; }
    __syncthreads();
    if (tid < 128) Vt[64 * VS + tid] = (u16)0x3F80;
    f32x4 st[2][5];
#pragma unroll
    for (int i = 0; i < 2; i++)
#pragma unroll
      for (int jn = 0; jn < 5; jn++) st[i][jn] = (f32x4){0.f, 0.f, 0.f, 0.f};
    float m = 0.f;
    const int vrow = tid >> 4, vsc = tid & 15;
    const int krow = tid >> 5, kkc = (tid & 31) * 8;
    u32x4 kpre[8], vpre[2]; float4 g8a, g8b; float bLn, gmaxn, myb, myg, mypm;
    bf16x8 qf[8];
    auto scan_load = [&](int cq) {
#pragma unroll
      for (int ks = 0; ks < 8; ks++)
        qf[ks] = *(const bf16x8*)(Rq + (long)(cq * 128 + 16 * w0 + lr) * D + head * 256 + 32 * ks + 8 * lg);
#pragma unroll
      for (int i = 0; i < 8; i++) kpre[i] = *(const u32x4*)(Rk + (long)(cq * 128 + krow + 16 * i) * D + head * 256 + kkc);
#pragma unroll
      for (int i = 0; i < 2; i++) vpre[i] = *(const u32x4*)(RvT + ((long)(cq * 4 + head) * 256 + es * 64 + vrow + 32 * i) * 128 + vsc * 8);
      const float* scb = c.sc + ((long)(cq * 4 + head) * 2 + dir) * 384;
      g8a = *(const float4*)(scb + 128 + vsc * 8); g8b = *(const float4*)(scb + 128 + vsc * 8 + 4);
      bLn = scb[last]; gmaxn = scb[256 + last];
      myb = scb[tid & 127]; myg = scb[128 + (tid & 127)]; mypm = scb[256 + (tid & 127)];
    };
    scan_load(chunk0 + (dir ? nc - 1 : 0));
    for (int j = 0; j < nc; ++j) {
      const int cc = chunk0 + (dir ? nc - 1 - j : j);
      int w = w0; asm volatile("" : "+s"(w));
      __syncthreads();
      const float muL = fmaxf(m, gmaxn);
      const float decay = __expf(m - muL);
      const float mnext = bLn + muL;
#pragma unroll
      for (int i = 0; i < 2; i++)
#pragma unroll
        for (int jn = 0; jn < 5; jn++)
          *(uint2*)(Ct + (16 * jn + lr) * KS + 32 * w + 16 * i + 4 * lg) = pack4v(st[i][jn]);
#pragma unroll
      for (int i = 0; i < 8; i++) *(u32x4*)(Kb + (krow + 16 * i) * KS + kkc) = kpre[i];
      {
        float w8[8];
        w8[0] = __expf(g8a.x - muL); w8[1] = __expf(g8a.y - muL); w8[2] = __expf(g8a.z - muL); w8[3] = __expf(g8a.w - muL);
        w8[4] = __expf(g8b.x - muL); w8[5] = __expf(g8b.y - muL); w8[6] = __expf(g8b.z - muL); w8[7] = __expf(g8b.w - muL);
#pragma unroll
        for (int i = 0; i < 2; i++) {
          const u32x4 vv = vpre[i];
          *(u32x4*)(Vt + (vrow + 32 * i) * VS + vsc * 8) = vv;
          uint4 v; v.x = vv[0]; v.y = vv[1]; v.z = vv[2]; v.w = vv[3];
          uint4 o;
          o.x = pack2(bf2f(v.x & 0xffffu) * w8[0], bf2f(v.x >> 16) * w8[1]);
          o.y = pack2(bf2f(v.y & 0xffffu) * w8[2], bf2f(v.y >> 16) * w8[3]);
          o.z = pack2(bf2f(v.z & 0xffffu) * w8[4], bf2f(v.z >> 16) * w8[5]);
          o.w = pack2(bf2f(v.w & 0xffffu) * w8[6], bf2f(v.w >> 16) * w8[7]);
          *(uint4*)(Vw + (vrow + 32 * i) * VS + vsc * 8) = o;
        }
        if (tid < 16) {
          uint4 o; o.x = pack2(w8[0], w8[1]); o.y = pack2(w8[2], w8[3]); o.z = pack2(w8[4], w8[5]); o.w = pack2(w8[6], w8[7]);
          *(uint4*)(Vw + 64 * VS + vsc * 8) = o;
        }
      }
      if (tid < 128) {
        const float mu = fmaxf(m, mypm);
        scg[tid] = myg; scmu[tid] = mu; sciw[tid] = __expf(m - mu); scfl[tid] = __expf(-(mu + myb));
      }
      __syncthreads();
      const int t = 16 * w + lr;
      bf16x8 spk[4];
      {
        f32x4 sacc[8];
#pragma unroll
        for (int i = 0; i < 8; i++) sacc[i] = (f32x4){0.f, 0.f, 0.f, 0.f};
#pragma unroll
        for (int i = 0; i < 8; i++) {
          const bool need = dir ? (i >= w) : (i <= w);
          if (need) {
#pragma unroll
            for (int ks = 0; ks < 8; ks++) {
              const bf16x8 a = *(const bf16x8*)(Kb + (16 * i + lr) * KS + 32 * ks + 8 * lg);
              sacc[i] = mfma16(a, qf[ks], sacc[i]);
            }
          }
        }
        const float mu_t = scmu[t];
        int tt = t; asm volatile("" : "+v"(tt));
        const int sgn = dir ? -1 : 1;
#pragma unroll
        for (int ks = 0; ks < 4; ks++) {
          float sv[8];
#pragma unroll
          for (int hh = 0; hh < 2; hh++) {
            const int i = 2 * ks + hh;
            const float4 gs = *(const float4*)(scg + 16 * i + 4 * lg);
            const float gv[4] = {gs.x, gs.y, gs.z, gs.w};
#pragma unroll
            for (int r2 = 0; r2 < 4; r2++) {
              const int s = 16 * i + 4 * lg + r2;
              const bool valid = (s - tt) * sgn <= 0;
              sv[hh * 4 + r2] = valid ? sacc[i][r2] * __expf(gv[r2] - mu_t) : 0.f;
            }
          }
          uint4 o; o.x = pack2(sv[0], sv[1]); o.y = pack2(sv[2], sv[3]); o.z = pack2(sv[4], sv[5]); o.w = pack2(sv[6], sv[7]);
          spk[ks] = __builtin_bit_cast(bf16x8, o);
        }
      }
      f32x4 num[5];
#pragma unroll
      for (int i = 0; i < 5; i++) num[i] = (f32x4){0.f, 0.f, 0.f, 0.f};
#pragma unroll
      for (int ks = 0; ks < 8; ks++)
#pragma unroll
        for (int i = 0; i < 5; i++) {
          const bf16x8 a = *(const bf16x8*)(Ct + (16 * i + lr) * KS + 32 * ks + 8 * lg);
          num[i] = mfma16(a, qf[ks], num[i]);
        }
      {
        const float iw = sciw[t];
#pragma unroll
        for (int i = 0; i < 5; i++) num[i] *= iw;
      }
#pragma unroll
      for (int ks = 0; ks < 4; ks++) {
        const bool need = dir ? (2 * ks + 1 >= w) : (2 * ks <= w);
        if (need) {
#pragma unroll
          for (int i = 0; i < 5; i++) {
            const uint2 lo = *(const uint2*)(Vt + (16 * i + lr) * VS + 32 * ks + 4 * lg);
            const uint2 hi = *(const uint2*)(Vt + (16 * i + lr) * VS + 32 * ks + 16 + 4 * lg);
            uint4 av; av.x = lo.x; av.y = lo.y; av.z = hi.x; av.w = hi.y;
            num[i] = mfma16(__builtin_bit_cast(bf16x8, av), spk[ks], num[i]);
          }
        }
      }
      {
        const float fl = scfl[t];
        const float dr = __shfl(num[4][0], lr);
        const float inv = 1.f / fmaxf(fabsf(dr), fl);
        u16* dst = Rho + (long)(cc * 128 + t) * D + head * 256 + es * 64 + 4 * lg;
#pragma unroll
        for (int i = 0; i < 4; i++)
          *(uint2*)(dst + 16 * i) = pack4(num[i][0] * inv, num[i][1] * inv, num[i][2] * inv, num[i][3] * inv);
      }
      __builtin_amdgcn_sched_barrier(0);
      { const int jn1 = (j + 1 < nc) ? j + 1 : j; scan_load(chunk0 + (dir ? nc - 1 - jn1 : jn1)); }
      __builtin_amdgcn_sched_barrier(0);
#pragma unroll
      for (int i = 0; i < 2; i++)
#pragma unroll
        for (int jn = 0; jn < 5; jn++) st[i][jn] *= decay;
#pragma unroll
      for (int ks = 0; ks < 4; ks++) {
        bf16x8 kTf[2];
#pragma unroll
        for (int i = 0; i < 2; i++) {
          const u16* ap = Kb + (32 * ks + 8 * lg + (lr >> 2)) * KS + 32 * w + 16 * i + 4 * (lr & 3);
          const s16x4 lo = __builtin_amdgcn_ds_read_tr16_b64_v4i16((s16x4 __attribute__((address_space(3)))*)ap);
          const s16x4 hi = __builtin_amdgcn_ds_read_tr16_b64_v4i16((s16x4 __attribute__((address_space(3)))*)(ap + 4 * KS));
          kTf[i] = __builtin_shufflevector(lo, hi, 0, 1, 2, 3, 4, 5, 6, 7);
        }
#pragma unroll
        for (int jn = 0; jn < 5; jn++) {
          const bf16x8 b = *(const bf16x8*)(Vw + (16 * jn + lr) * VS + 32 * ks + 8 * lg);
#pragma unroll
          for (int i = 0; i < 2; i++) st[i][jn] = mfma16(kTf[i], b, st[i][jn]);
        }
      }
      m = mnext;
    }
  }
}

template <class PT> DI void phase_C(const PT& p, const Ctx& c, int l, u16* lds) {
  const int tid = opaque_tid(), lane = tid & 63, wave = tid >> 6, wm = wave & 3, wn = wave >> 2, lr = lane & 15, lg = lane >> 4;
  const u16* W = c.W + ((long)l * WROWS + W_C) * D;
  u16* Ru = c.R1; u16* Ryp = c.R2; u16* Rog = c.R3;
  const int nTiles = (c.Tg / 256) * 24;
  for (int tile = blockIdx.x; tile < nTiles; tile += gridDim.x) {
    const int tb = 2 * ((tile >> 3) / 6) + (tile & 1), pt = 6 * ((tile & 7) >> 1) + ((tile >> 3) % 6);
    f32x4 acc[4][8];
    {
      const int tn = tile + gridDim.x;
      const bool has = tn < nTiles;
      gemm_tile<4, 8, 2>(W + (long)pt * 256 * D, c.Rh + (long)tb * 256 * D, acc, lds,
                         has ? W + (long)(6 * ((tn & 7) >> 1) + ((tn >> 3) % 6)) * 256 * D : nullptr, has ? c.Rh + (long)(2 * ((tn >> 3) / 6) + (tn & 1)) * 256 * D : nullptr, tile != (int)blockIdx.x);
    }
    if (pt < 16) {
      const int chn = pt * 64 + wm * 16 + 4 * lg;
#pragma unroll
      for (int jn = 0; jn < 8; jn++) {
        const long lt = tb * 256 + 128 * wn + 16 * jn + lr;
        float u[4], y[4];
#pragma unroll
        for (int r = 0; r < 4; r++) { u[r] = acc[1][jn][r] * acc[2][jn][r]; y[r] = acc[0][jn][r] * siluf_(acc[3][jn][r]); }
        *(uint2*)(Ru + lt * D + chn) = pack4(u[0], u[1], u[2], u[3]);
        *(uint2*)(Ryp + lt * D + chn) = pack4(y[0], y[1], y[2], y[3]);
      }
    } else {
      const int chn = (pt - 16) * 128 + wm * 32 + 4 * lg;
#pragma unroll
      for (int jn = 0; jn < 8; jn++) {
        const long lt = tb * 256 + 128 * wn + 16 * jn + lr;
#pragma unroll
        for (int hh = 0; hh < 2; hh++) {
          float o[4];
#pragma unroll
          for (int r = 0; r < 4; r++) o[r] = sigmoidf_(acc[2 * hh][jn][r]) * siluf_(acc[2 * hh + 1][jn][r]);
          *(uint2*)(Rog + lt * D + chn + 16 * hh) = pack4(o[0], o[1], o[2], o[3]);
        }
      }
    }
  }
}

template <class PT> DI void phase_E(const PT& p, const Ctx& c, int l) {
  const int tid_ = opaque_tid(); const int lane = tid_ & 63, w = tid_ >> 6;
  const u16* Ru = c.R1; u16* Ryp = c.R2; u16* Rog = c.R3;
  const float* cw = p.conv_w + (long)l * 3 * D; const float* cb = p.conv_b + (long)l * D; const float* mg = p.mh_norm_g + (long)l * D;
  float4 w0[4], w1[4], w2[4], bb[4], gg[4];
#pragma unroll
  for (int i = 0; i < 4; i++) {
    const int k = 4 * lane + 256 * i;
    w0[i] = *(const float4*)(cw + k); w1[i] = *(const float4*)(cw + D + k); w2[i] = *(const float4*)(cw + 2 * D + k);
    bb[i] = *(const float4*)(cb + k); gg[i] = *(const float4*)(mg + k);
  }
  for (int lt = blockIdx.x * 8 + w; lt < c.Tg; lt += gridDim.x * 8) {
    const int sl = lt < c.half ? 8192 : 2048;
    const int pos = (lt < c.half ? lt : lt - c.half) & (sl - 1);
    const bool first = pos == 0, lastp = pos == sl - 1;
    uint2 U0[4], U1[4], U2[4], YP[4], OG[4], HF[4], HB[4];
#pragma unroll
    for (int i = 0; i < 4; i++) {
      const int k = 4 * lane + 256 * i;
      U0[i] = *(const uint2*)(Ru + (long)(first ? lt : lt - 1) * D + k);
      U1[i] = *(const uint2*)(Ru + (long)lt * D + k);
      U2[i] = *(const uint2*)(Ru + (long)(lastp ? lt : lt + 1) * D + k);
      if (first) { U0[i].x = 0u; U0[i].y = 0u; }
      if (lastp) { U2[i].x = 0u; U2[i].y = 0u; }
      YP[i] = *(const uint2*)(Ryp + (long)lt * D + k);
      OG[i] = *(const uint2*)(Rog + (long)lt * D + k);
      HF[i] = *(const uint2*)(c.Rhf + (long)lt * D + k);
      HB[i] = *(const uint2*)(c.Rhb + (long)lt * D + k);
    }
#pragma unroll
    for (int i = 0; i < 4; i++) {
      const int k = 4 * lane + 256 * i;
      const float4 a0 = unpack4(U0[i]), a1 = unpack4(U1[i]), a2 = unpack4(U2[i]), yp = unpack4(YP[i]);
      const float y0 = yp.x * (w0[i].x * a0.x + w1[i].x * a1.x + w2[i].x * a2.x + bb[i].x);
      const float y1 = yp.y * (w0[i].y * a0.y + w1[i].y * a1.y + w2[i].y * a2.y + bb[i].y);
      const float y2 = yp.z * (w0[i].z * a0.z + w1[i].z * a1.z + w2[i].z * a2.z + bb[i].z);
      const float y3 = yp.w * (w0[i].w * a0.w + w1[i].w * a1.w + w2[i].w * a2.w + bb[i].w);
      *(uint2*)(Ryp + (long)lt * D + k) = pack4(y0, y1, y2, y3);
      const float4 hf = unpack4(HF[i]), hb = unpack4(HB[i]), og = unpack4(OG[i]);
      const float s0 = hf.x + hb.x, s1 = hf.y + hb.y, s2 = hf.z + hb.z, s3 = hf.w + hb.w;
      const float ss = wave_sum(s0 * s0 + s1 * s1 + s2 * s2 + s3 * s3);
      const float rstd = rsqrtf(ss * (1.f / 256.f) + 1e-6f);
      *(uint2*)(Rog + (long)lt * D + k) = pack4(og.x * s0 * rstd * gg[i].x, og.y * s1 * rstd * gg[i].y, og.z * s2 * rstd * gg[i].z, og.w * s3 * rstd * gg[i].w);
    }
  }
}

template <class PT> DI void phase_D1(const PT& p, const Ctx& c, int l, u16* lds) {
  const int tid = opaque_tid(), lane = tid & 63, wave = tid >> 6, wm = wave & 3, wn = wave >> 2, lr = lane & 15, lg = lane >> 4;
  const u16* W = c.W + (long)l * WROWS * D;
  const u16* Ryc = c.R2; const u16* Rym = c.R3; u16* Rmg = c.R4;
  const int nTiles = (c.Tg / 128) * 4;
  int ring = 0;
  for (int tile = blockIdx.x; tile < nTiles; tile += gridDim.x) {
    const int ch = tile >> 2, mt = tile & 3;
    const u16* Pg = W + (long)(W_G + mt * 512) * D; const u16* Qh = c.Rh + (long)ch * 128 * D;
    const u16* Pc_ = W + (long)(W_PC + mt * 256) * D; const u16* Qc_ = Ryc + (long)ch * 128 * D;
    const u16* Pm_ = W + (long)(W_PM + mt * 256) * D; const u16* Qm_ = Rym + (long)ch * 128 * D;
    const int tn = tile + gridDim.x; const bool hasn = tn < nTiles;
    const u16* Pnx = hasn ? W + (long)(W_G + (tn & 3) * 512) * D : nullptr; const u16* Qnx = hasn ? c.Rh + (long)(tn >> 2) * 128 * D : nullptr;
    u32x2 gk[2][4][4], Mk[4][4];
#pragma unroll
    for (int cc = 0; cc < 2; cc++) {
      f32x4 a1[4][4];
      if (cc == 0) gemm_tile<4, 4, 3>(Pg, Qh, a1, lds, Pg + (long)256 * D, Qh, tile != (int)blockIdx.x, &ring);
      else gemm_tile<4, 4, 3>(Pg + (long)256 * D, Qh, a1, lds, Pc_, Qc_, true, &ring);
#pragma unroll
      for (int i = 0; i < 4; i++)
#pragma unroll
        for (int jn = 0; jn < 4; jn++) {
          const uint2 t_ = pack4(sigmoidf_(a1[i][jn][0]), sigmoidf_(a1[i][jn][1]), sigmoidf_(a1[i][jn][2]), sigmoidf_(a1[i][jn][3]));
          gk[cc][i][jn] = (u32x2){t_.x, t_.y}; asm volatile("" : "+v"(gk[cc][i][jn]));
        }
    }
    {
      f32x4 a2[4][4];
      gemm_tile<4, 4, 3>(Pc_, Qc_, a2, lds, Pm_, Qm_, true, &ring);
#pragma unroll
      for (int i = 0; i < 4; i++)
#pragma unroll
        for (int jn = 0; jn < 4; jn++) {
          uint2 g_; g_.x = gk[i >> 1][2 * (i & 1)][jn][0]; g_.y = gk[i >> 1][2 * (i & 1)][jn][1];
          const float4 gg = unpack4(g_);
          const uint2 t_ = pack4(gg.x * a2[i][jn][0], gg.y * a2[i][jn][1], gg.z * a2[i][jn][2], gg.w * a2[i][jn][3]);
          Mk[i][jn] = (u32x2){t_.x, t_.y}; asm volatile("" : "+v"(Mk[i][jn]));
        }
    }
    {
      f32x4 a2[4][4];
      gemm_tile<4, 4, 3>(Pm_, Qm_, a2, lds, Pnx, Qnx, true, &ring);
#pragma unroll
      for (int i = 0; i < 4; i++)
#pragma unroll
        for (int jn = 0; jn < 4; jn++) {
          uint2 g_; g_.x = gk[i >> 1][2 * (i & 1) + 1][jn][0]; g_.y = gk[i >> 1][2 * (i & 1) + 1][jn][1];
          uint2 m_; m_.x = Mk[i][jn][0]; m_.y = Mk[i][jn][1];
          const float4 gg = unpack4(g_);
          const float4 mm = unpack4(m_);
          const int col = mt * 256 + 64 * wm + 16 * i + 4 * lg;
          const long lt = ch * 128 + 64 * wn + 16 * jn + lr;
          *(uint2*)(Rmg + lt * D + col) = pack4(mm.x + gg.x * a2[i][jn][0], mm.y + gg.y * a2[i][jn][1],
                                                mm.z + gg.z * a2[i][jn][2], mm.w + gg.w * a2[i][jn][3]);
        }
    }
  }
}

template <class PT> DI void phase_D2(const PT& p, const Ctx& c, int l, int g, u16* lds) {
  const int tid = opaque_tid(), lane = tid & 63, wave = tid >> 6, wm = wave & 3, wn = wave >> 2, lr = lane & 15, lg = lane >> 4;
  const u16* W = c.W + ((long)l * WROWS + W_O) * D;
  const u16* Rmg = c.R4;
  const int nTiles = (c.Tg / 256) * 4;
  for (int tile = blockIdx.x; tile < nTiles; tile += gridDim.x) {
    const int tb = (tile >> 5) * 8 + (tile & 7), pt = (tile >> 3) & 3;
    f32x4 acc[4][8];
    {
      const int tn = tile + gridDim.x;
      const bool has = tn < nTiles;
      gemm_tile<4, 8, 2>(W + (long)pt * 256 * D, Rmg + (long)tb * 256 * D, acc, lds,
                         has ? W + (long)((tn >> 3) & 3) * 256 * D : nullptr, has ? Rmg + (long)((tn >> 5) * 8 + (tn & 7)) * 256 * D : nullptr, tile != (int)blockIdx.x);
    }
    const int tok0 = gtok(c, g, tb * 256);
    const float* gp = c.mod + ((long)l * 40 + batch_of(tok0)) * 3072 + 2048;
#pragma unroll
    for (int ip = 0; ip < 2; ip++) {
      float4 xv[2][8], gt[2];
#pragma unroll
      for (int h2 = 0; h2 < 2; h2++) {
        const int col = pt * 256 + 64 * wm + 16 * (2 * ip + h2) + 4 * lg;
        gt[h2] = *(const float4*)(gp + col);
#pragma unroll
        for (int jn = 0; jn < 8; jn++) {
          const int tok = tok0 + 128 * wn + 16 * jn + lr;
          const float* xr = (l == 0) ? xin_row(p, tok) : p.out + (long)tok * D;
          xv[h2][jn] = *(const float4*)(xr + col);
        }
      }
#pragma unroll
      for (int h2 = 0; h2 < 2; h2++) {
        const int i = 2 * ip + h2;
        const int col = pt * 256 + 64 * wm + 16 * i + 4 * lg;
#pragma unroll
        for (int jn = 0; jn < 8; jn++) {
          const int tok = tok0 + 128 * wn + 16 * jn + lr;
          float4 o;
          o.x = xv[h2][jn].x + gt[h2].x * acc[i][jn][0]; o.y = xv[h2][jn].y + gt[h2].y * acc[i][jn][1];
          o.z = xv[h2][jn].z + gt[h2].z * acc[i][jn][2]; o.w = xv[h2][jn].w + gt[h2].w * acc[i][jn][3];
          *(float4*)(p.out + (long)tok * D + col) = o;
        }
      }
    }
  }
}

__global__ void __launch_bounds__(NT) mega(Params p) {
  extern __shared__ __attribute__((aligned(16))) char smem[];
  cg::grid_group grid = cg::this_grid();
  const int nG = p.G;
  __shared__ uint4 xb_words;
  volatile LAS unsigned* xb_st = (volatile LAS unsigned*)&xb_words;
  Params* pg;
  unsigned* xbar;
  {
    const Ctx c0 = make_ctx(p);
    unsigned char* q = (unsigned char*)c0.ctr + 4096;
    xbar = (unsigned*)q; q += XCD_BAR_WORDS * 4;
    pg = (Params*)q;
    if (blockIdx.x == 0 && threadIdx.x == 0) *pg = p;
    if (threadIdx.x == 0) xb_words = make_uint4(0u, 0u, 0u, 0u);
    __syncthreads();
    XcdBarrier xb0 = xcd_barrier_post(xbar, xb_st);
    (void)xb0;
    phase_prep(p, c0, (float*)smem);
  }
  grid.sync();
#define PH(call) { const CParams* q_ = launder_params(pg); const CParams& P_ = *q_; const Ctx c = make_ctx(P_); call; }
#define BAR() { const CParams* q_ = launder_params(pg); const Ctx c = make_ctx(*q_); XcdBarrier xb; xb.bar = (unsigned*)((unsigned char*)c.ctr + 4096); xb.x = xb_xcc_id(); xb.st = xb_st; xcd_barrier(xb); }
  for (int g = 0; g < nG; ++g) {
    for (int l = 0; l < DEPTH; ++l) {
      PH(phase_rows(P_, c, l, g, false)); BAR();
      PH(phase_A(P_, c, l, (u16*)smem)); BAR();
      PH(phase_scan(P_, c, g * DEPTH + l, smem)); BAR();
      PH(phase_C(P_, c, l, (u16*)smem)); BAR();
      PH(phase_E(P_, c, l)); BAR();
      PH(phase_D1(P_, c, l, (u16*)smem)); BAR();
      PH(phase_D2(P_, c, l, g, (u16*)smem)); BAR();
    }
    PH(phase_rows(P_, c, DEPTH, g, true));
  }
}

extern "C" void kernel_launch(void* const* d_in, const int* in_sizes, int n_in, void* d_out, int out_size,
                              void* d_ws, size_t ws_size, hipStream_t stream) {
  static int grid_blocks = 0;
  static int Gsel = 2;
  if (!grid_blocks) {
    int dev = 0, cus = 0, per_cu = 0;
    hipGetDevice(&dev);
    hipDeviceGetAttribute(&cus, hipDeviceAttributeMultiprocessorCount, dev);
    hipFuncSetAttribute((const void*)mega, hipFuncAttributeMaxDynamicSharedMemorySize, LDS_BYTES);
    hipOccupancyMaxActiveBlocksPerMultiprocessor(&per_cu, (const void*)mega, NT, LDS_BYTES);
    if (per_cu < 1) per_cu = 1;
    grid_blocks = cus * per_cu;
    const size_t fixed = (size_t)DEPTH * WROWS * D * 2 + (size_t)DEPTH * 40 * 3072 * 4 + 4096 + XCD_BAR_WORDS * 4 + 1024;
    Gsel = 2;
    while (Gsel < 8 && 7 * ((size_t)(131072 / Gsel) * D * 2) + fixed + (size_t)(131072 / Gsel) * 96 > ws_size) Gsel *= 2;
  }
  Params p{};
  p.x_prompt = (const float*)d_in[0]; p.x_sample = (const float*)d_in[1]; p.c_prompt = (const float*)d_in[2]; p.c_sample = (const float*)d_in[3];
  p.w_ada = (const float*)d_in[4]; p.b_ada = (const float*)d_in[5]; p.norm_g = (const float*)d_in[6]; p.w_in = (const float*)d_in[7];
  p.b_gates = (const float*)d_in[8]; p.conv_w = (const float*)d_in[9]; p.conv_b = (const float*)d_in[10]; p.mh_norm_g = (const float*)d_in[11];
  p.w_pc = (const float*)d_in[12]; p.w_pm = (const float*)d_in[13]; p.w_out = (const float*)d_in[14]; p.final_g = (const float*)d_in[15];
  p.out = (float*)d_out; p.ws = (unsigned char*)d_ws; p.G = Gsel; p.pad = 0;
  {
    const size_t Tg = 131072 / Gsel;
    const size_t off = 7 * (Tg * D * 2) + (size_t)DEPTH * WROWS * D * 2 + (size_t)DEPTH * 40 * 3072 * 4 + Tg * 96 + 4096;
    (void)hipMemsetAsync((unsigned char*)d_ws + off, 0, XCD_BAR_WORDS * 4, stream);
  }
  void* args[] = {&p};
  hipError_t e = hipLaunchCooperativeKernel((const void*)mega, dim3(grid_blocks), dim3(NT), args, LDS_BYTES, stream);
  if (e != hipSuccess) fprintf(stderr, "cooperative launch failed: %s (grid %d)\n", hipGetErrorString(e), grid_blocks);
}
```

```cpp
#include <hip/hip_runtime.h>
#include <hip/hip_cooperative_groups.h>
#include <cstdio>
namespace cg = cooperative_groups;

typedef unsigned short u16;
using bf16x8 = __attribute__((ext_vector_type(8))) short;
using f32x4  = __attribute__((ext_vector_type(4))) float;
using s16x4  = __attribute__((ext_vector_type(4))) short;
using u32x4  = __attribute__((ext_vector_type(4))) unsigned;
using u32x2  = __attribute__((ext_vector_type(2))) unsigned;
#define DI __device__ __forceinline__

constexpr int D = 1024, DIN = 11280, DEPTH = 4;
constexpr int NT = 512;
constexpr int W_QKV = 0, W_C = 3328, W_G = 9472, W_PC = 11520, W_PM = 12544, W_O = 13568, WROWS = 14592;
constexpr int LDT = 72;
constexpr int KS = 264, VS = 136;
constexpr int LDS_BYTES = (128 * KS + 2 * 80 * VS + 80 * KS) * 2 + 4 * 128 * 4;

struct Params {
  const float* x_prompt; const float* x_sample; const float* c_prompt; const float* c_sample;
  const float* w_ada; const float* b_ada; const float* norm_g; const float* w_in; const float* b_gates;
  const float* conv_w; const float* conv_b; const float* mh_norm_g; const float* w_pc; const float* w_pm;
  const float* w_out; const float* final_g;
  float* out; unsigned char* ws;
  int G; int pad;
};

struct Ctx {
  int G, Tg, half;
  u16 *Rh, *R1, *R2, *R3, *R4, *Rhf, *Rhb;
  u16* W; float* mod; float* sc; int* ctr;
};

DI u16 f2bf(float x) { unsigned u = __float_as_uint(x); u += 0x7fffu + ((u >> 16) & 1u); return (u16)(u >> 16); }
DI float bf2f(unsigned h) { return __uint_as_float(h << 16); }
typedef __bf16 bf16x2_t __attribute__((ext_vector_type(2)));
typedef float f32x2_t __attribute__((ext_vector_type(2)));
DI unsigned pack2(float a, float b) { const f32x2_t v = {a, b}; return __builtin_bit_cast(unsigned, __builtin_convertvector(v, bf16x2_t)); }
DI uint2 pack4(float a, float b, float c, float d) { uint2 r; r.x = pack2(a, b); r.y = pack2(c, d); return r; }
DI uint2 pack4v(f32x4 v) { return pack4(v[0], v[1], v[2], v[3]); }
DI float4 unpack4(uint2 v) { float4 r; r.x = bf2f(v.x & 0xffffu); r.y = bf2f(v.x >> 16); r.z = bf2f(v.y & 0xffffu); r.w = bf2f(v.y >> 16); return r; }
DI float sigmoidf_(float x) { return __builtin_amdgcn_rcpf(1.f + __expf(-x)); }
DI float siluf_(float x) { return x * sigmoidf_(x); }
DI float wave_sum(float v) {
#pragma unroll
  for (int o = 32; o >= 1; o >>= 1) v += __shfl_xor(v, o);
  return v;
}
DI int opaque_tid() { int t = threadIdx.x; asm volatile("" : "+v"(t)); return t; }
DI f32x4 mfma16(bf16x8 a, bf16x8 b, f32x4 c) { return __builtin_amdgcn_mfma_f32_16x16x32_bf16(a, b, c, 0, 0, 0); }


typedef const Params __attribute__((address_space(4))) CParams;
template <class PT> DI Ctx make_ctx(const PT& p) {
  Ctx c;
  c.G = p.G; c.Tg = 131072 / p.G; c.half = c.Tg >> 1;
  const size_t REG = (size_t)c.Tg * D * 2;
  unsigned char* ws = p.ws;
  c.Rh = (u16*)(ws); c.R1 = (u16*)(ws + REG); c.R2 = (u16*)(ws + 2 * REG); c.R3 = (u16*)(ws + 3 * REG);
  c.R4 = (u16*)(ws + 4 * REG); c.Rhf = (u16*)(ws + 5 * REG); c.Rhb = (u16*)(ws + 6 * REG);
  unsigned char* q = ws + 7 * REG;
  c.W = (u16*)q; q += (size_t)DEPTH * WROWS * D * 2;
  c.mod = (float*)q; q += (size_t)DEPTH * 40 * 3072 * 4;
  c.sc = (float*)q; q += (size_t)c.Tg * 96;
  c.ctr = (int*)q;
  return c;
}
DI const CParams* launder_params(const Params* g) { asm volatile("" : "+s"(g)); return (const CParams*)(unsigned long long)g; }
DI int gtok(const Ctx& c, int g, int lt) { return lt < c.half ? g * c.half + lt : 65536 + g * c.half + (lt - c.half); }
DI int batch_of(int tok) { return tok < 65536 ? (tok >> 13) : 8 + ((tok - 65536) >> 11); }
template <class PT> DI const float* xin_row(const PT& p, int tok) {
  return tok < 65536 ? p.x_prompt + (long)tok * D : p.x_sample + (long)(tok - 65536) * D;
}


#define XB_TMO      128
#define XB_XCNT(j)  (256  + 64 * (j))
#define XB_XSUB(j)  (1280 + 64 * (j))
#define XB_XGEN(j)  (2304 + 64 * (j))
#define XB_TOP      3328
#define XB_TOPGEN   3392
#define XCD_BAR_WORDS 3456
#define XB_SPIN_CAP (1u << 18)
#define LAS __attribute__((address_space(3)))
DI unsigned xb_ld(unsigned* p)              { return __hip_atomic_load(p, __ATOMIC_RELAXED, __HIP_MEMORY_SCOPE_AGENT); }
DI unsigned xb_add(unsigned* p, unsigned v) { return __hip_atomic_fetch_add(p, v, __ATOMIC_RELAXED, __HIP_MEMORY_SCOPE_AGENT); }
DI unsigned xb_xcc_id() { return (unsigned)__builtin_amdgcn_s_getreg((3 << 11) | 20) & 0xFu; }
#define XB_SPIN(cond, bar) do { unsigned _sp = 0; while (cond) { __builtin_amdgcn_s_sleep(1); \
    if ((++_sp & 255u) == 0u) { if (xb_ld(&(bar)[XB_TMO])) break; if (_sp > XB_SPIN_CAP) { atomicAdd(&(bar)[XB_TMO], 1u); break; } } } } while (0)
struct XcdBarrier { unsigned* bar; unsigned x; volatile LAS unsigned* st; };
DI XcdBarrier xcd_barrier_post(unsigned* bar, volatile LAS unsigned* st) {
  XcdBarrier b; b.bar = bar; b.x = xb_xcc_id(); b.st = st;
  if (threadIdx.x == 0) (void)xb_add(&bar[XB_XCNT(b.x)], 1u);
  return b;
}
DI void xcd_barrier_complete(unsigned* bar, unsigned x, unsigned& nloc, unsigned& nx) {
  const unsigned G = gridDim.x * gridDim.y * gridDim.z;
  unsigned sum, cnt, mine, sp = 0u;
  for (;;) {
    sum = 0u; cnt = 0u; mine = 0u;
#pragma unroll
    for (unsigned j = 0; j < 16; ++j) { const unsigned c = xb_ld(&bar[XB_XCNT(j)]); sum += c; cnt += (c > 0u) ? 1u : 0u; }
    mine = xb_ld(&bar[XB_XCNT(x)]);
    if (sum == G) break;
    __builtin_amdgcn_s_sleep(1);
    if ((++sp & 255u) == 0u) { if (xb_ld(&bar[XB_TMO])) break; if (sp > XB_SPIN_CAP) { atomicAdd(&bar[XB_TMO], 1u); break; } }
  }
  nloc = mine > 0u ? mine : 1u; nx = cnt > 0u ? cnt : 1u;
}
DI void xcd_barrier(const XcdBarrier& b) {
  asm volatile("s_waitcnt vmcnt(0)" ::: "memory");
  __syncthreads();
  if (threadIdx.x == 0) {
    unsigned* bar = b.bar;
    asm volatile("" : "+s"(bar));
    __builtin_amdgcn_s_waitcnt(0);
    unsigned nloc = b.st[0], nx = b.st[1];
    if (nloc == 0u) { xcd_barrier_complete(bar, b.x, nloc, nx); b.st[0] = nloc; b.st[1] = nx; }
    const unsigned old = xb_add(&bar[XB_XSUB(b.x)], 1u);
    const unsigned gen = old / nloc;
    if (old + 1u == (gen + 1u) * nloc) {
      __builtin_amdgcn_fence(__ATOMIC_RELEASE, "agent");
      asm volatile("s_waitcnt vmcnt(0)" ::: "memory");
      const unsigned og = xb_add(&bar[XB_TOP], 1u);
      const unsigned tg = og / nx;
      if (og + 1u == (tg + 1u) * nx) xb_add(&bar[XB_TOPGEN], 1u);
      else XB_SPIN(xb_ld(&bar[XB_TOPGEN]) == tg, bar);
      __builtin_amdgcn_fence(__ATOMIC_ACQUIRE, "agent");
      xb_add(&bar[XB_XGEN(b.x)], 1u);
      asm volatile("s_waitcnt vmcnt(0)" ::: "memory");
    } else {
      XB_SPIN(xb_ld(&bar[XB_XGEN(b.x)]) == gen, bar);
      __builtin_amdgcn_fence(__ATOMIC_ACQUIRE, "agent");
      asm volatile("s_waitcnt vmcnt(0)" ::: "memory");
    }
  }
  __syncthreads();
}

template <int MT, int NT, int ST>
DI void gemm_tile(const u16* __restrict__ P, const u16* __restrict__ Q, f32x4 (&acc)[MT][NT], u16* lds,
                  const u16* Pn = nullptr, const u16* Qn = nullptr, bool primed = false, int* ringp = nullptr) {
  const int tid = opaque_tid(), lane = tid & 63, wave = __builtin_amdgcn_readfirstlane(tid >> 6), wm = wave & 3, wn = wave >> 2;
  const int lr = lane & 15, lg = lane >> 4;
  constexpr int PROWS = 64 * MT, QROWS = 32 * NT, NQI = NT / 2, NDMA = MT + NQI;
  char* pbase = (char*)lds;
  char* qbase = pbase + ST * PROWS * 128;
  const int drow = lane >> 3, dpos = lane & 7;
  const int r0 = 8 * wave + drow;
  const unsigned voff = (unsigned)(r0 * D + ((dpos ^ ((r0 >> 1) & 7)) << 3)) * 2u;
  const char* Pc = (const char*)P; const char* Qc = (const char*)Q;
  char* dp = pbase + wave * 1024 + lane * 16;
  char* dq = qbase + wave * 1024 + lane * 16;
#pragma unroll
  for (int i = 0; i < MT; i++)
#pragma unroll
    for (int j = 0; j < NT; j++) acc[i][j] = (f32x4){0.f, 0.f, 0.f, 0.f};
  const int ring0 = (ST == 3 && ringp) ? *ringp : 0;
  if (!primed) {
#pragma unroll
    for (int t0 = 0; t0 < ST - 1; t0++) {
      int bi = ring0 + t0; if (bi >= ST) bi -= ST;
#pragma unroll
      for (int i = 0; i < MT; i++) __builtin_amdgcn_global_load_lds((const unsigned*)(Pc + (i * 64 * D * 2 + t0 * 128) + voff), (unsigned*)(dp + bi * PROWS * 128 + i * 8192), 16, 0, 0);
#pragma unroll
      for (int i = 0; i < NQI; i++) __builtin_amdgcn_global_load_lds((const unsigned*)(Qc + (i * 64 * D * 2 + t0 * 128) + voff), (unsigned*)(dq + bi * QROWS * 128 + i * 8192), 16, 0, 0);
    }
  }
  if (primed) asm volatile("s_waitcnt vmcnt(0)" ::: "memory");
  else asm volatile("s_waitcnt vmcnt(%0)" :: "n"((ST - 2) * NDMA) : "memory");
  __builtin_amdgcn_s_barrier();
  asm volatile("" ::: "memory");
  const int swz = (lr >> 1) & 7;
  const int o0 = (lg ^ swz) << 4, o1 = ((4 + lg) ^ swz) << 4;
  const char* pa = pbase + (wm * 16 * MT + lr) * 128;
  const char* qa = qbase + (wn * 16 * NT + lr) * 128;
  constexpr int NK = D / 64;
  int cur = ring0, nxs = ring0 + ST - 1; if (nxs >= ST) nxs -= ST;
  for (int kt = 0; kt < NK; ++kt) {
    if (kt + ST - 1 < NK) {
#pragma unroll
      for (int i = 0; i < MT; i++) __builtin_amdgcn_global_load_lds((const unsigned*)(Pc + (i * 64 * D * 2 + (kt + ST - 1) * 128) + voff), (unsigned*)(dp + nxs * PROWS * 128 + i * 8192), 16, 0, 0);
#pragma unroll
      for (int i = 0; i < NQI; i++) __builtin_amdgcn_global_load_lds((const unsigned*)(Qc + (i * 64 * D * 2 + (kt + ST - 1) * 128) + voff), (unsigned*)(dq + nxs * QROWS * 128 + i * 8192), 16, 0, 0);
    }
    if (ST == 3 && kt >= NK - 2 && Pn != nullptr) {
      const char* Pnc = (const char*)Pn + (kt - (NK - 2)) * 128; const char* Qnc = (const char*)Qn + (kt - (NK - 2)) * 128;
#pragma unroll
      for (int i = 0; i < MT; i++) __builtin_amdgcn_global_load_lds((const unsigned*)(Pnc + (i * 64 * D * 2) + voff), (unsigned*)(dp + nxs * PROWS * 128 + i * 8192), 16, 0, 0);
#pragma unroll
      for (int i = 0; i < NQI; i++) __builtin_amdgcn_global_load_lds((const unsigned*)(Qnc + (i * 64 * D * 2) + voff), (unsigned*)(dq + nxs * QROWS * 128 + i * 8192), 16, 0, 0);
    }
    if (ST == 2 && kt == NK - 1 && Pn != nullptr) {
      const char* Pnc = (const char*)Pn; const char* Qnc = (const char*)Qn;
#pragma unroll
      for (int i = 0; i < MT; i++) __builtin_amdgcn_global_load_lds((const unsigned*)(Pnc + (i * 64 * D * 2) + voff), (unsigned*)(dp + i * 8192), 16, 0, 0);
#pragma unroll
      for (int i = 0; i < NQI; i++) __builtin_amdgcn_global_load_lds((const unsigned*)(Qnc + (i * 64 * D * 2) + voff), (unsigned*)(dq + i * 8192), 16, 0, 0);
    }
    const char* pb = pa + cur * PROWS * 128;
    const char* qb = qa + cur * QROWS * 128;
    if constexpr (NT == 99) {
      bf16x8 af[MT], b0[NT], b1[NT];
#pragma unroll
      for (int j = 0; j < NT; j++) b0[j] = *(const bf16x8*)(qb + j * 2048 + o0);
#pragma unroll
      for (int i = 0; i < MT; i++) af[i] = *(const bf16x8*)(pb + i * 2048 + o0);
      __builtin_amdgcn_s_setprio(1);
#pragma unroll
      for (int i = 0; i < MT; i++) {
#pragma unroll
        for (int j = 0; j < NT; j++) acc[i][j] = mfma16(af[i], b0[j], acc[i][j]);
        b1[i] = *(const bf16x8*)(qb + i * 2048 + o1);
        af[i] = *(const bf16x8*)(pb + i * 2048 + o1);
      }
#pragma unroll
      for (int j = MT; j < NT; j++) b1[j] = *(const bf16x8*)(qb + j * 2048 + o1);
#pragma unroll
      for (int i = 0; i < MT; i++)
#pragma unroll
        for (int j = 0; j < NT; j++) acc[i][j] = mfma16(af[i], b1[j], acc[i][j]);
      __builtin_amdgcn_sched_group_barrier(0x100, NT + MT, 0);
#pragma unroll
      for (int r = 0; r < MT; r++) {
        __builtin_amdgcn_sched_group_barrier(0x008, 4, 0);
        __builtin_amdgcn_sched_group_barrier(0x100, 1, 0);
        __builtin_amdgcn_sched_group_barrier(0x008, 4, 0);
        __builtin_amdgcn_sched_group_barrier(0x100, 1, 0);
      }
      __builtin_amdgcn_sched_group_barrier(0x100, NT - MT, 0);
      __builtin_amdgcn_sched_group_barrier(0x008, MT * NT, 0);
      __builtin_amdgcn_s_setprio(0);
    } else {
#pragma unroll
      for (int ks = 0; ks < 2; ++ks) {
        const int oo = ks ? o1 : o0;
        bf16x8 a[MT], b[NT];
#pragma unroll
        for (int i = 0; i < MT; i++) a[i] = *(const bf16x8*)(pb + i * 2048 + oo);
#pragma unroll
        for (int j = 0; j < NT; j++) b[j] = *(const bf16x8*)(qb + j * 2048 + oo);
        __builtin_amdgcn_s_setprio(1);
#pragma unroll
        for (int i = 0; i < MT; i++)
#pragma unroll
          for (int j = 0; j < NT; j++) acc[i][j] = mfma16(a[i], b[j], acc[i][j]);
        __builtin_amdgcn_s_setprio(0);
      }
    }
    if (kt + ST - 1 < NK) asm volatile("s_waitcnt vmcnt(%0)" :: "n"((ST - 2) * NDMA) : "memory");
    else if (ST == 3 && Pn != nullptr) { if (kt == NK - 2) asm volatile("s_waitcnt vmcnt(%0)" :: "n"(NDMA) : "memory"); }
    else if (!(ST == 2 && Pn != nullptr)) asm volatile("s_waitcnt vmcnt(0)" ::: "memory");
    __builtin_amdgcn_s_barrier();
    asm volatile("" ::: "memory");
    cur = (cur == ST - 1) ? 0 : cur + 1;
    nxs = (nxs == ST - 1) ? 0 : nxs + 1;
  }
  if (ST == 3 && ringp) *ringp = cur;
}

template <class PT> DI void wsrc(const PT& p, int l, int n, const float*& src, int& ld, int& col, float& scale) {
  scale = 1.f;
  src = p.w_in + (long)l * D * DIN; ld = DIN;
  if (n < W_C) {
    if (n < 1024) col = 4096 + n;
    else if (n < 2048) { col = 5120 + (n - 1024); scale = 0.0625f; }
    else if (n < 3072) col = 6144 + (n - 2048);
    else if (n < 3088) col = 9216 + (n - 3072);
    else col = -1;
  } else if (n < W_G) {
    int n2 = n - W_C;
    if (n2 < 4096) { int blk = n2 >> 6, sl = (n2 >> 4) & 3, cl = n2 & 15; col = sl * 1024 + blk * 16 + cl; }
    else { int n3 = n2 - 4096; int blk = n3 >> 5, sl = (n3 >> 4) & 1, cl = n3 & 15; col = (sl ? 8192 : 7168) + blk * 16 + cl; }
  } else if (n < W_PC) {
    int n4 = n - W_G; int mtb = n4 >> 9, r5 = n4 & 511; int cc5 = r5 >> 8, wm5 = (r5 >> 6) & 3, a5 = (r5 >> 5) & 1, sl = (r5 >> 4) & 1, cl = r5 & 15;
    col = 9232 + sl * 1024 + (256 * mtb + 64 * wm5 + 32 * cc5 + 16 * a5 + cl);
  } else if (n < W_PM) { src = p.w_pc + (long)l * D * D; ld = D; col = n - W_PC; }
  else if (n < W_O)  { src = p.w_pm + (long)l * D * D; ld = D; col = n - W_PM; }
  else               { src = p.w_out + (long)l * D * D; ld = D; col = n - W_O; }
}

template <class PT> DI void phase_prep(const PT& p, const Ctx& c, float* ldsf) {
  const int tid = opaque_tid();
  if (blockIdx.x == 0 && tid < 256) c.ctr[tid] = 0;
  const int nItems = DEPTH * (WROWS / 64) * 16;
  for (int it = blockIdx.x; it < nItems; it += gridDim.x) {
    const int kb = (it & 15) * 64; const int rb = it >> 4;
    const int l = rb / (WROWS / 64); const int nb = (rb % (WROWS / 64)) * 64;
    const float* src; int ld, col; float scale;
    const int nl = tid & 63;
    wsrc(p, l, nb + nl, src, ld, col, scale);
#pragma unroll
    for (int i = 0; i < 8; i++) {
      const int kl = (tid >> 6) + 8 * i;
      float v = (col >= 0) ? src[(long)(kb + kl) * ld + col] * scale : 0.f;
      ldsf[kl * 65 + nl] = v;
    }
    __syncthreads();
    {
      const int nl2 = tid >> 3, kc = tid & 7;
      float v[8];
#pragma unroll
      for (int j = 0; j < 8; j++) v[j] = ldsf[(kc * 8 + j) * 65 + nl2];
      uint4 o; o.x = pack2(v[0], v[1]); o.y = pack2(v[2], v[3]); o.z = pack2(v[4], v[5]); o.w = pack2(v[6], v[7]);
      *(uint4*)(c.W + ((long)l * WROWS + nb + nl2) * D + kb + kc * 8) = o;
    }
    __syncthreads();
  }
  const int nMod = DEPTH * 48;
  for (int it = blockIdx.x; it < nMod; it += gridDim.x) {
    const int l = it / 48, jb = (it % 48) * 64;
    const int cl = tid & 63, kc = tid >> 6;
    float acc[40];
#pragma unroll
    for (int b = 0; b < 40; b++) acc[b] = 0.f;
    const float* wa = p.w_ada + (long)l * D * 3072 + jb + cl;
    for (int k = kc * 128; k < kc * 128 + 128; ++k) {
      const float wv = wa[(long)k * 3072];
#pragma unroll
      for (int b = 0; b < 40; b++) {
        const float cv = (b < 8) ? p.c_prompt[b * D + k] : p.c_sample[(b - 8) * D + k];
        acc[b] += cv * wv;
      }
    }
#pragma unroll
    for (int b = 0; b < 40; b++) ldsf[(kc * 40 + b) * 64 + cl] = acc[b];
    __syncthreads();
    for (int idx = tid; idx < 40 * 64; idx += NT) {
      const int b = idx >> 6, cc = idx & 63;
      float s = p.b_ada[l * 3072 + jb + cc];
#pragma unroll
      for (int q = 0; q < 8; q++) s += ldsf[(q * 40 + b) * 64 + cc];
      c.mod[((long)l * 40 + b) * 3072 + jb + cc] = s;
    }
    __syncthreads();
  }
}

template <class PT> DI void phase_rows(const PT& p, const Ctx& c, int l, int g, bool fin) {
  const int tid_ = opaque_tid(); const int lane = tid_ & 63, w = tid_ >> 6;
  const int stride = gridDim.x * 8;
  float4 gv[4];
#pragma unroll
  for (int i = 0; i < 4; i++) gv[i] = *(const float4*)((fin ? p.final_g : p.norm_g + l * D) + 4 * lane + 256 * i);
  for (int lt0 = blockIdx.x * 8 + w; lt0 < c.Tg; lt0 += 2 * stride) {
    const bool has1 = lt0 + stride < c.Tg;
    const int lt1 = has1 ? lt0 + stride : lt0;
    const int tok0 = gtok(c, g, lt0), tok1 = gtok(c, g, lt1);
    const float* xr0 = (l == 0) ? xin_row(p, tok0) : p.out + (long)tok0 * D;
    const float* xr1 = (l == 0) ? xin_row(p, tok1) : p.out + (long)tok1 * D;
    float4 v0[4], v1[4]; float ss0 = 0.f, ss1 = 0.f;
#pragma unroll
    for (int i = 0; i < 4; i++) { v0[i] = *(const float4*)(xr0 + 4 * lane + 256 * i); v1[i] = *(const float4*)(xr1 + 4 * lane + 256 * i); }
    const float* mp0 = c.mod + ((long)(fin ? 0 : l) * 40 + batch_of(tok0)) * 3072;
    const float* mp1 = c.mod + ((long)(fin ? 0 : l) * 40 + batch_of(tok1)) * 3072;
    float4 sc0[4], sh0[4], sc1[4], sh1[4];
    if (!fin) {
#pragma unroll
      for (int i = 0; i < 4; i++) {
        const int k = 4 * lane + 256 * i;
        sc0[i] = *(const float4*)(mp0 + 1024 + k); sh0[i] = *(const float4*)(mp0 + k);
        sc1[i] = *(const float4*)(mp1 + 1024 + k); sh1[i] = *(const float4*)(mp1 + k);
      }
    }
#pragma unroll
    for (int i = 0; i < 4; i++) {
      ss0 += v0[i].x * v0[i].x + v0[i].y * v0[i].y + v0[i].z * v0[i].z + v0[i].w * v0[i].w;
      ss1 += v1[i].x * v1[i].x + v1[i].y * v1[i].y + v1[i].z * v1[i].z + v1[i].w * v1[i].w;
    }
    ss0 = wave_sum(ss0); ss1 = wave_sum(ss1);
    const float r0 = rsqrtf(ss0 * (1.f / 1024.f) + 1e-6f), r1 = rsqrtf(ss1 * (1.f / 1024.f) + 1e-6f);
    if (fin) {
#pragma unroll
      for (int i = 0; i < 4; i++) {
        const int k = 4 * lane + 256 * i;
        float4 o; o.x = v0[i].x * r0 * gv[i].x; o.y = v0[i].y * r0 * gv[i].y; o.z = v0[i].z * r0 * gv[i].z; o.w = v0[i].w * r0 * gv[i].w;
        *(float4*)(p.out + (long)tok0 * D + k) = o;
      }
      if (has1) {
#pragma unroll
        for (int i = 0; i < 4; i++) {
          const int k = 4 * lane + 256 * i;
          float4 o; o.x = v1[i].x * r1 * gv[i].x; o.y = v1[i].y * r1 * gv[i].y; o.z = v1[i].z * r1 * gv[i].z; o.w = v1[i].w * r1 * gv[i].w;
          *(float4*)(p.out + (long)tok1 * D + k) = o;
        }
      }
    } else {
#pragma unroll
      for (int i = 0; i < 4; i++) {
        const int k = 4 * lane + 256 * i;
        *(uint2*)(c.Rh + (long)lt0 * D + k) = pack4(v0[i].x * r0 * gv[i].x * (1.f + sc0[i].x) + sh0[i].x, v0[i].y * r0 * gv[i].y * (1.f + sc0[i].y) + sh0[i].y,
                                                    v0[i].z * r0 * gv[i].z * (1.f + sc0[i].z) + sh0[i].z, v0[i].w * r0 * gv[i].w * (1.f + sc0[i].w) + sh0[i].w);
      }
      if (has1) {
#pragma unroll
        for (int i = 0; i < 4; i++) {
          const int k = 4 * lane + 256 * i;
          *(uint2*)(c.Rh + (long)lt1 * D + k) = pack4(v1[i].x * r1 * gv[i].x * (1.f + sc1[i].x) + sh1[i].x, v1[i].y * r1 * gv[i].y * (1.f + sc1[i].y) + sh1[i].y,
                                                      v1[i].z * r1 * gv[i].z * (1.f + sc1[i].z) + sh1[i].z, v1[i].w * r1 * gv[i].w * (1.f + sc1[i].w) + sh1[i].w);
        }
      }
    }
  }
}

template <class PT> DI void phase_A(const PT& p, const Ctx& c, int l, u16* lds) {
  const int tid = opaque_tid(), lane = tid & 63, wave = tid >> 6, wm = wave & 3, wn = wave >> 2, lr = lane & 15, lg = lane >> 4;
  const u16* W = c.W + (long)l * WROWS * D;
  u16* Rq = c.R1; u16* Rk = c.R2; u16* RvT = c.R4;
  const int nTiles = (c.Tg / 256) * 13;
  auto ptrsA = [&](int tl, const u16*& Pp, const u16*& Qp) {
    const int tb_ = (tl / 104) * 8 + (tl & 7), j_ = (tl % 104) >> 3;
    const u16* hp = c.Rh + (long)tb_ * 256 * D;
    if (j_ < 8) { Pp = W + (long)((j_ >> 2) * 1024 + (j_ & 3) * 256) * D; Qp = hp; }
    else if (j_ < 12) { Pp = hp; Qp = W + (long)(2048 + (j_ - 8) * 256) * D; }
    else { Pp = W + (long)3072 * D; Qp = hp; }
  };
  bool primed = false;
  for (int tile = blockIdx.x; tile < nTiles; tile += gridDim.x) {
    const int tb = (tile / 104) * 8 + (tile & 7), j = (tile % 104) >> 3;
    f32x4 acc[4][8];
    const u16 *P0, *Q0, *P1 = nullptr, *Q1 = nullptr;
    ptrsA(tile, P0, Q0);
    if (tile + (int)gridDim.x < nTiles && j != 12 && (((tile + (int)gridDim.x) % 104) >> 3) != 12) ptrsA(tile + gridDim.x, P1, Q1);
    const bool pr = primed; primed = (P1 != nullptr);
    if (j < 8) {
      const int isk = j >> 2, head = j & 3;
      gemm_tile<4, 8, 2>(P0, Q0, acc, lds, P1, Q1, pr);
      u16* dst = isk ? Rk : Rq;
#pragma unroll
      for (int i = 0; i < 4; i++)
#pragma unroll
        for (int jn = 0; jn < 8; jn++) {
          const int d = 64 * wm + 16 * i + 4 * lg, t = 128 * wn + 16 * jn + lr;
          *(uint2*)(dst + (long)(tb * 256 + t) * D + head * 256 + d) = pack4v(acc[i][jn]);
        }
    } else if (j < 12) {
      const int head = j - 8;
      gemm_tile<4, 8, 2>(P0, Q0, acc, lds, P1, Q1, pr);
#pragma unroll
      for (int i = 0; i < 4; i++)
#pragma unroll
        for (int jn = 0; jn < 8; jn++) {
          const int tokl = 64 * wm + 16 * i + 4 * lg, e = 128 * wn + 16 * jn + lr;
          const int ch = tb * 2 + (tokl >> 7), sidx = tokl & 127;
          *(uint2*)(RvT + ((long)(ch * 4 + head) * 256 + e) * 128 + sidx) = pack4v(acc[i][jn]);
        }
    } else {
      f32x4 accg[1][8];
      gemm_tile<1, 8, 2>(P0, Q0, accg, lds);
      float* gl = (float*)lds;
      if (wm == 0) {
#pragma unroll
        for (int jn = 0; jn < 8; jn++) {
          const int t = 128 * wn + 16 * jn + lr;
#pragma unroll
          for (int r = 0; r < 4; r++) {
            float v = accg[0][jn][r] + p.b_gates[l * 16 + lg * 4 + r];
            if (lg & 1) v = fminf(v, 0.f) - log1pf(expf(-fabsf(v)));
            gl[t * 16 + lg * 4 + r] = v;
          }
        }
      }
      __syncthreads();
      if (tid < 16) {
        const int head = tid & 3, dir = (tid >> 2) & 1, cl = tid >> 3;
        const int ch = tb * 2 + cl;
        float* o = c.sc + (((long)(ch * 4 + head) * 2 + dir) * 3) * 128;
        const float* glc = gl + cl * 128 * 16;
        float bs = 0.f, pm = -3.0e38f;
        for (int q = 0; q < 128; ++q) {
          const int t = dir ? 127 - q : q;
          const float iv = glc[t * 16 + dir * 8 + head], lf = glc[t * 16 + dir * 8 + 4 + head];
          bs += lf; const float gg = iv - bs; pm = fmaxf(pm, gg);
          o[t] = bs; o[128 + t] = gg; o[256 + t] = pm;
        }
      }
      __syncthreads();
    }
  }
}

template <class PT> DI void phase_scan(const PT& p, const Ctx& c, int ctrIdx, char* smem) {
  __shared__ int s_task;
  const int tid = opaque_tid(), lane = tid & 63, w0 = __builtin_amdgcn_readfirstlane(tid >> 6), lr = lane & 15, lg = lane >> 4;
  u16* Kb = (u16*)smem;
  u16* Vt = Kb + 128 * KS;
  u16* Vw = Vt + 80 * VS;
  u16* Ct = Vw + 80 * VS;
  float* scg = (float*)(Ct + 80 * KS); float* scmu = scg + 128; float* sciw = scmu + 128; float* scfl = sciw + 128;
  const u16* Rq = c.R1; const u16* Rk = c.R2; const u16* RvT = c.R4;
  const int nLong = (8 / c.G) * 32;
  const int nLongQ8 = (8 / c.G), nShortQ8 = (32 / c.G);
  const int perQueue = (nLongQ8 + nShortQ8) * 4;
  int* ctr = c.ctr + ctrIdx * 8;
  const int myq = (int)(xb_xcc_id() & 7u);
  int qoff = 0;
  while (true) {
    __syncthreads();
    if (tid == 0) {
      int t = -1;
      while (qoff < 8) {
        const int qi = (myq + qoff) & 7;
        const int n = atomicAdd(ctr + qi, 1);
        if (n < perQueue) {
          const int quad = (n < nLongQ8 * 4) ? qi + 8 * (n >> 2) : nLongQ8 * 8 + qi + 8 * ((n - nLongQ8 * 4) >> 2);
          t = quad * 4 + (n & 3);
          break;
        }
        ++qoff;
      }
      s_task = t;
    }
    __syncthreads();
    const int task = s_task;
    if (task < 0) break;
    int seq, r, chunk0, nc;
    if (task < nLong) { seq = task >> 5; r = task & 31; chunk0 = seq * 64; nc = 64; }
    else { const int t2 = task - nLong; seq = t2 >> 5; r = t2 & 31; chunk0 = (c.half >> 7) + seq * 16; nc = 16; }
    const int head = r >> 3, dir = (r >> 2) & 1, es = r & 3;
    const int last = dir ? 0 : 127;
    u16* Rho = dir ? c.Rhb : c.Rhf;
    for (int idx = tid; idx < 80 * KS / 2; idx += NT) ((unsigned*)Ct)[idx] = 0u;
    for (int idx = tid; idx < 16 * VS / 2; idx += NT) { ((unsigned*)(Vt + 64 * VS))[idx] = 0u; ((unsigned*)(Vw + 64 * VS))[idx] = 0u; }
    __syncthreads();
    if (tid < 128) Vt[64 * VS + tid] = (u16)0x3F80;
    f32x4 st[2][5];
#pragma unroll
    for (int i = 0; i < 2; i++)
#pragma unroll
      for (int jn = 0; jn < 5; jn++) st[i][jn] = (f32x4){0.f, 0.f, 0.f, 0.f};
    float m = 0.f;
    const int vrow = tid >> 4, vsc = tid & 15;
    const int krow = tid >> 5, kkc = (tid & 31) * 8;
    u32x4 kpre[8], vpre[2]; float4 g8a, g8b; float bLn, gmaxn, myb, myg, mypm;
    bf16x8 qf[8];
    auto scan_load = [&](int cq) {
#pragma unroll
      for (int ks = 0; ks < 8; ks++)
        qf[ks] = *(const bf16x8*)(Rq + (long)(cq * 128 + 16 * w0 + lr) * D + head * 256 + 32 * ks + 8 * lg);
#pragma unroll
      for (int i = 0; i < 8; i++) kpre[i] = *(const u32x4*)(Rk + (long)(cq * 128 + krow + 16 * i) * D + head * 256 + kkc);
#pragma unroll
      for (int i = 0; i < 2; i++) vpre[i] = *(const u32x4*)(RvT + ((long)(cq * 4 + head) * 256 + es * 64 + vrow + 32 * i) * 128 + vsc * 8);
      const float* scb = c.sc + ((long)(cq * 4 + head) * 2 + dir) * 384;
      g8a = *(const float4*)(scb + 128 + vsc * 8); g8b = *(const float4*)(scb + 128 + vsc * 8 + 4);
      bLn = scb[last]; gmaxn = scb[256 + last];
      myb = scb[tid & 127]; myg = scb[128 + (tid & 127)]; mypm = scb[256 + (tid & 127)];
    };
    scan_load(chunk0 + (dir ? nc - 1 : 0));
    for (int j = 0; j < nc; ++j) {
      const int cc = chunk0 + (dir ? nc - 1 - j : j);
      int w = w0; asm volatile("" : "+s"(w));
      __syncthreads();
      const float muL = fmaxf(m, gmaxn);
      const float decay = __expf(m - muL);
      const float mnext = bLn + muL;
#pragma unroll
      for (int i = 0; i < 2; i++)
#pragma unroll
        for (int jn = 0; jn < 5; jn++)
          *(uint2*)(Ct + (16 * jn + lr) * KS + 32 * w + 16 * i + 4 * lg) = pack4v(st[i][jn]);
#pragma unroll
      for (int i = 0; i < 8; i++) *(u32x4*)(Kb + (krow + 16 * i) * KS + kkc) = kpre[i];
      {
        float w8[8];
        w8[0] = __expf(g8a.x - muL); w8[1] = __expf(g8a.y - muL); w8[2] = __expf(g8a.z - muL); w8[3] = __expf(g8a.w - muL);
        w8[4] = __expf(g8b.x - muL); w8[5] = __expf(g8b.y - muL); w8[6] = __expf(g8b.z - muL); w8[7] = __expf(g8b.w - muL);
#pragma unroll
        for (int i = 0; i < 2; i++) {
          const u32x4 vv = vpre[i];
          *(u32x4*)(Vt + (vrow + 32 * i) * VS + vsc * 8) = vv;
          uint4 v; v.x = vv[0]; v.y = vv[1]; v.z = vv[2]; v.w = vv[3];
          uint4 o;
          o.x = pack2(bf2f(v.x & 0xffffu) * w8[0], bf2f(v.x >> 16) * w8[1]);
          o.y = pack2(bf2f(v.y & 0xffffu) * w8[2], bf2f(v.y >> 16) * w8[3]);
          o.z = pack2(bf2f(v.z & 0xffffu) * w8[4], bf2f(v.z >> 16) * w8[5]);
          o.w = pack2(bf2f(v.w & 0xffffu) * w8[6], bf2f(v.w >> 16) * w8[7]);
          *(uint4*)(Vw + (vrow + 32 * i) * VS + vsc * 8) = o;
        }
        if (tid < 16) {
          uint4 o; o.x = pack2(w8[0], w8[1]); o.y = pack2(w8[2], w8[3]); o.z = pack2(w8[4], w8[5]); o.w = pack2(w8[6], w8[7]);
          *(uint4*)(Vw + 64 * VS + vsc * 8) = o;
        }
      }
      if (tid < 128) {
        const float mu = fmaxf(m, mypm);
        scg[tid] = myg; scmu[tid] = mu; sciw[tid] = __expf(m - mu); scfl[tid] = __expf(-(mu + myb));
      }
      __syncthreads();
      const int t = 16 * w + lr;
      bf16x8 spk[4];
      {
        f32x4 sacc[8];
#pragma unroll
        for (int i = 0; i < 8; i++) sacc[i] = (f32x4){0.f, 0.f, 0.f, 0.f};
#pragma unroll
        for (int i = 0; i < 8; i++) {
          const bool need = dir ? (i >= w) : (i <= w);
          if (need) {
#pragma unroll
            for (int ks = 0; ks < 8; ks++) {
              const bf16x8 a = *(const bf16x8*)(Kb + (16 * i + lr) * KS + 32 * ks + 8 * lg);
              sacc[i] = mfma16(a, qf[ks], sacc[i]);
            }
          }
        }
        const float mu_t = scmu[t];
        int tt = t; asm volatile("" : "+v"(tt));
        const int sgn = dir ? -1 : 1;
#pragma unroll
        for (int ks = 0; ks < 4; ks++) {
          float sv[8];
#pragma unroll
          for (int hh = 0; hh < 2; hh++) {
            const int i = 2 * ks + hh;
            const float4 gs = *(const float4*)(scg + 16 * i + 4 * lg);
            const float gv[4] = {gs.x, gs.y, gs.z, gs.w};
#pragma unroll
            for (int r2 = 0; r2 < 4; r2++) {
              const int s = 16 * i + 4 * lg + r2;
              const bool valid = (s - tt) * sgn <= 0;
              sv[hh * 4 + r2] = valid ? sacc[i][r2] * __expf(gv[r2] - mu_t) : 0.f;
            }
          }
          uint4 o; o.x = pack2(sv[0], sv[1]); o.y = pack2(sv[2], sv[3]); o.z = pack2(sv[4], sv[5]); o.w = pack2(sv[6], sv[7]);
          spk[ks] = __builtin_bit_cast(bf16x8, o);
        }
      }
      f32x4 num[5];
#pragma unroll
      for (int i = 0; i < 5; i++) num[i] = (f32x4){0.f, 0.f, 0.f, 0.f};
#pragma unroll
      for (int ks = 0; ks < 8; ks++)
#pragma unroll
        for (int i = 0; i < 5; i++) {
          const bf16x8 a = *(const bf16x8*)(Ct + (16 * i + lr) * KS + 32 * ks + 8 * lg);
          num[i] = mfma16(a, qf[ks], num[i]);
        }
      {
        const float iw = sciw[t];
#pragma unroll
        for (int i = 0; i < 5; i++) num[i] *= iw;
      }
#pragma unroll
      for (int ks = 0; ks < 4; ks++) {
        const bool need = dir ? (2 * ks + 1 >= w) : (2 * ks <= w);
        if (need) {
#pragma unroll
          for (int i = 0; i < 5; i++) {
            const uint2 lo = *(const uint2*)(Vt + (16 * i + lr) * VS + 32 * ks + 4 * lg);
            const uint2 hi = *(const uint2*)(Vt + (16 * i + lr) * VS + 32 * ks + 16 + 4 * lg);
            uint4 av; av.x = lo.x; av.y = lo.y; av.z = hi.x; av.w = hi.y;
            num[i] = mfma16(__builtin_bit_cast(bf16x8, av), spk[ks], num[i]);
          }
        }
      }
      {
        const float fl = scfl[t];
        const float dr = __shfl(num[4][0], lr);
        const float inv = 1.f / fmaxf(fabsf(dr), fl);
        u16* dst = Rho + (long)(cc * 128 + t) * D + head * 256 + es * 64 + 4 * lg;
#pragma unroll
        for (int i = 0; i < 4; i++)
          *(uint2*)(dst + 16 * i) = pack4(num[i][0] * inv, num[i][1] * inv, num[i][2] * inv, num[i][3] * inv);
      }
      __builtin_amdgcn_sched_barrier(0);
      { const int jn1 = (j + 1 < nc) ? j + 1 : j; scan_load(chunk0 + (dir ? nc - 1 - jn1 : jn1)); }
      __builtin_amdgcn_sched_barrier(0);
#pragma unroll
      for (int i = 0; i < 2; i++)
#pragma unroll
        for (int jn = 0; jn < 5; jn++) st[i][jn] *= decay;
#pragma unroll
      for (int ks = 0; ks < 4; ks++) {
        bf16x8 kTf[2];
#pragma unroll
        for (int i = 0; i < 2; i++) {
          const u16* ap = Kb + (32 * ks + 8 * lg + (lr >> 2)) * KS + 32 * w + 16 * i + 4 * (lr & 3);
          const s16x4 lo = __builtin_amdgcn_ds_read_tr16_b64_v4i16((s16x4 __attribute__((address_space(3)))*)ap);
          const s16x4 hi = __builtin_amdgcn_ds_read_tr16_b64_v4i16((s16x4 __attribute__((address_space(3)))*)(ap + 4 * KS));
          kTf[i] = __builtin_shufflevector(lo, hi, 0, 1, 2, 3, 4, 5, 6, 7);
        }
#pragma unroll
        for (int jn = 0; jn < 5; jn++) {
          const bf16x8 b = *(const bf16x8*)(Vw + (16 * jn + lr) * VS + 32 * ks + 8 * lg);
#pragma unroll
          for (int i = 0; i < 2; i++) st[i][jn] = mfma16(kTf[i], b, st[i][jn]);
        }
      }
      m = mnext;
    }
  }
}

template <class PT> DI void phase_C(const PT& p, const Ctx& c, int l, u16* lds) {
  const int tid = opaque_tid(), lane = tid & 63, wave = tid >> 6, wm = wave & 3, wn = wave >> 2, lr = lane & 15, lg = lane >> 4;
  const u16* W = c.W + ((long)l * WROWS + W_C) * D;
  u16* Ru = c.R1; u16* Ryp = c.R2; u16* Rog = c.R3;
  const int nTiles = (c.Tg / 256) * 24;
  for (int tile = blockIdx.x; tile < nTiles; tile += gridDim.x) {
    const int tb = 2 * ((tile >> 3) / 6) + (tile & 1), pt = 6 * ((tile & 7) >> 1) + ((tile >> 3) % 6);
    f32x4 acc[4][8];
    {
      const int tn = tile + gridDim.x;
      const bool has = tn < nTiles;
      gemm_tile<4, 8, 2>(W + (long)pt * 256 * D, c.Rh + (long)tb * 256 * D, acc, lds,
                         has ? W + (long)(6 * ((tn & 7) >> 1) + ((tn >> 3) % 6)) * 256 * D : nullptr, has ? c.Rh + (long)(2 * ((tn >> 3) / 6) + (tn & 1)) * 256 * D : nullptr, tile != (int)blockIdx.x);
    }
    if (pt < 16) {
      const int chn = pt * 64 + wm * 16 + 4 * lg;
#pragma unroll
      for (int jn = 0; jn < 8; jn++) {
        const long lt = tb * 256 + 128 * wn + 16 * jn + lr;
        float u[4], y[4];
#pragma unroll
        for (int r = 0; r < 4; r++) { u[r] = acc[1][jn][r] * acc[2][jn][r]; y[r] = acc[0][jn][r] * siluf_(acc[3][jn][r]); }
        *(uint2*)(Ru + lt * D + chn) = pack4(u[0], u[1], u[2], u[3]);
        *(uint2*)(Ryp + lt * D + chn) = pack4(y[0], y[1], y[2], y[3]);
      }
    } else {
      const int chn = (pt - 16) * 128 + wm * 32 + 4 * lg;
#pragma unroll
      for (int jn = 0; jn < 8; jn++) {
        const long lt = tb * 256 + 128 * wn + 16 * jn + lr;
#pragma unroll
        for (int hh = 0; hh < 2; hh++) {
          float o[4];
#pragma unroll
          for (int r = 0; r < 4; r++) o[r] = sigmoidf_(acc[2 * hh][jn][r]) * siluf_(acc[2 * hh + 1][jn][r]);
          *(uint2*)(Rog + lt * D + chn + 16 * hh) = pack4(o[0], o[1], o[2], o[3]);
        }
      }
    }
  }
}

template <class PT> DI void phase_E(const PT& p, const Ctx& c, int l) {
  const int tid_ = opaque_tid(); const int lane = tid_ & 63, w = tid_ >> 6;
  const u16* Ru = c.R1; u16* Ryp = c.R2; u16* Rog = c.R3;
  const float* cw = p.conv_w + (long)l * 3 * D; const float* cb = p.conv_b + (long)l * D; const float* mg = p.mh_norm_g + (long)l * D;
  float4 w0[4], w1[4], w2[4], bb[4], gg[4];
#pragma unroll
  for (int i = 0; i < 4; i++) {
    const int k = 4 * lane + 256 * i;
    w0[i] = *(const float4*)(cw + k); w1[i] = *(const float4*)(cw + D + k); w2[i] = *(const float4*)(cw + 2 * D + k);
    bb[i] = *(const float4*)(cb + k); gg[i] = *(const float4*)(mg + k);
  }
  for (int lt = blockIdx.x * 8 + w; lt < c.Tg; lt += gridDim.x * 8) {
    const int sl = lt < c.half ? 8192 : 2048;
    const int pos = (lt < c.half ? lt : lt - c.half) & (sl - 1);
    const bool first = pos == 0, lastp = pos == sl - 1;
    uint2 U0[4], U1[4], U2[4], YP[4], OG[4], HF[4], HB[4];
#pragma unroll
    for (int i = 0; i < 4; i++) {
      const int k = 4 * lane + 256 * i;
      U0[i] = *(const uint2*)(Ru + (long)(first ? lt : lt - 1) * D + k);
      U1[i] = *(const uint2*)(Ru + (long)lt * D + k);
      U2[i] = *(const uint2*)(Ru + (long)(lastp ? lt : lt + 1) * D + k);
      if (first) { U0[i].x = 0u; U0[i].y = 0u; }
      if (lastp) { U2[i].x = 0u; U2[i].y = 0u; }
      YP[i] = *(const uint2*)(Ryp + (long)lt * D + k);
      OG[i] = *(const uint2*)(Rog + (long)lt * D + k);
      HF[i] = *(const uint2*)(c.Rhf + (long)lt * D + k);
      HB[i] = *(const uint2*)(c.Rhb + (long)lt * D + k);
    }
#pragma unroll
    for (int i = 0; i < 4; i++) {
      const int k = 4 * lane + 256 * i;
      const float4 a0 = unpack4(U0[i]), a1 = unpack4(U1[i]), a2 = unpack4(U2[i]), yp = unpack4(YP[i]);
      const float y0 = yp.x * (w0[i].x * a0.x + w1[i].x * a1.x + w2[i].x * a2.x + bb[i].x);
      const float y1 = yp.y * (w0[i].y * a0.y + w1[i].y * a1.y + w2[i].y * a2.y + bb[i].y);
      const float y2 = yp.z * (w0[i].z * a0.z + w1[i].z * a1.z + w2[i].z * a2.z + bb[i].z);
      const float y3 = yp.w * (w0[i].w * a0.w + w1[i].w * a1.w + w2[i].w * a2.w + bb[i].w);
      *(uint2*)(Ryp + (long)lt * D + k) = pack4(y0, y1, y2, y3);
      const float4 hf = unpack4(HF[i]), hb = unpack4(HB[i]), og = unpack4(OG[i]);
      const float s0 = hf.x + hb.x, s1 = hf.y + hb.y, s2 = hf.z + hb.z, s3 = hf.w + hb.w;
      const float ss = wave_sum(s0 * s0 + s1 * s1 + s2 * s2 + s3 * s3);
      const float rstd = rsqrtf(ss * (1.f / 256.f) + 1e-6f);
      *(uint2*)(Rog + (long)lt * D + k) = pack4(og.x * s0 * rstd * gg[i].x, og.y * s1 * rstd * gg[i].y, og.z * s2 * rstd * gg[i].z, og.w * s3 * rstd * gg[i].w);
    }
  }
}

template <class PT> DI void phase_D1(const PT& p, const Ctx& c, int l, u16* lds) {
  const int tid = opaque_tid(), lane = tid & 63, wave = tid >> 6, wm = wave & 3, wn = wave >> 2, lr = lane & 15, lg = lane >> 4;
  const u16* W = c.W + (long)l * WROWS * D;
  const u16* Ryc = c.R2; const u16* Rym = c.R3; u16* Rmg = c.R4;
  const int nTiles = (c.Tg / 128) * 4;
  int ring = 0;
  for (int tile = blockIdx.x; tile < nTiles; tile += gridDim.x) {
    const int ch = ((tile >> 5) << 3) + (tile & 7), mt = (tile >> 3) & 3;
    const u16* Pg = W + (long)(W_G + mt * 512) * D; const u16* Qh = c.Rh + (long)ch * 128 * D;
    const u16* Pc_ = W + (long)(W_PC + mt * 256) * D; const u16* Qc_ = Ryc + (long)ch * 128 * D;
    const u16* Pm_ = W + (long)(W_PM + mt * 256) * D; const u16* Qm_ = Rym + (long)ch * 128 * D;
    const int tn = tile + gridDim.x; const bool hasn = tn < nTiles;
    const u16* Pnx = hasn ? W + (long)(W_G + ((tn >> 3) & 3) * 512) * D : nullptr; const u16* Qnx = hasn ? c.Rh + (long)(((tn >> 5) << 3) + (tn & 7)) * 128 * D : nullptr;
    u32x2 gk[2][4][4], Mk[4][4];
#pragma unroll
    for (int cc = 0; cc < 2; cc++) {
      f32x4 a1[4][4];
      if (cc == 0) gemm_tile<4, 4, 3>(Pg, Qh, a1, lds, Pg + (long)256 * D, Qh, tile != (int)blockIdx.x, &ring);
      else gemm_tile<4, 4, 3>(Pg + (long)256 * D, Qh, a1, lds, Pc_, Qc_, true, &ring);
#pragma unroll
      for (int i = 0; i < 4; i++)
#pragma unroll
        for (int jn = 0; jn < 4; jn++) {
          const uint2 t_ = pack4(sigmoidf_(a1[i][jn][0]), sigmoidf_(a1[i][jn][1]), sigmoidf_(a1[i][jn][2]), sigmoidf_(a1[i][jn][3]));
          gk[cc][i][jn] = (u32x2){t_.x, t_.y}; asm volatile("" : "+v"(gk[cc][i][jn]));
        }
    }
    {
      f32x4 a2[4][4];
      gemm_tile<4, 4, 3>(Pc_, Qc_, a2, lds, Pm_, Qm_, true, &ring);
#pragma unroll
      for (int i = 0; i < 4; i++)
#pragma unroll
        for (int jn = 0; jn < 4; jn++) {
          uint2 g_; g_.x = gk[i >> 1][2 * (i & 1)][jn][0]; g_.y = gk[i >> 1][2 * (i & 1)][jn][1];
          const float4 gg = unpack4(g_);
          const uint2 t_ = pack4(gg.x * a2[i][jn][0], gg.y * a2[i][jn][1], gg.z * a2[i][jn][2], gg.w * a2[i][jn][3]);
          Mk[i][jn] = (u32x2){t_.x, t_.y}; asm volatile("" : "+v"(Mk[i][jn]));
        }
    }
    {
      f32x4 a2[4][4];
      gemm_tile<4, 4, 3>(Pm_, Qm_, a2, lds, Pnx, Qnx, true, &ring);
#pragma unroll
      for (int i = 0; i < 4; i++)
#pragma unroll
        for (int jn = 0; jn < 4; jn++) {
          uint2 g_; g_.x = gk[i >> 1][2 * (i & 1) + 1][jn][0]; g_.y = gk[i >> 1][2 * (i & 1) + 1][jn][1];
          uint2 m_; m_.x = Mk[i][jn][0]; m_.y = Mk[i][jn][1];
          const float4 gg = unpack4(g_);
          const float4 mm = unpack4(m_);
          const int col = mt * 256 + 64 * wm + 16 * i + 4 * lg;
          const long lt = ch * 128 + 64 * wn + 16 * jn + lr;
          *(uint2*)(Rmg + lt * D + col) = pack4(mm.x + gg.x * a2[i][jn][0], mm.y + gg.y * a2[i][jn][1],
                                                mm.z + gg.z * a2[i][jn][2], mm.w + gg.w * a2[i][jn][3]);
        }
    }
  }
}

template <class PT> DI void phase_D2(const PT& p, const Ctx& c, int l, int g, u16* lds) {
  const int tid = opaque_tid(), lane = tid & 63, wave = tid >> 6, wm = wave & 3, wn = wave >> 2, lr = lane & 15, lg = lane >> 4;
  const u16* W = c.W + ((long)l * WROWS + W_O) * D;
  const u16* Rmg = c.R4;
  const int nTiles = (c.Tg / 256) * 4;
  for (int tile = blockIdx.x; tile < nTiles; tile += gridDim.x) {
    const int tb = (tile >> 5) * 8 + (tile & 7), pt = (tile >> 3) & 3;
    f32x4 acc[4][8];
    {
      const int tn = tile + gridDim.x;
      const bool has = tn < nTiles;
      gemm_tile<4, 8, 2>(W + (long)pt * 256 * D, Rmg + (long)tb * 256 * D, acc, lds,
                         has ? W + (long)((tn >> 3) & 3) * 256 * D : nullptr, has ? Rmg + (long)((tn >> 5) * 8 + (tn & 7)) * 256 * D : nullptr, tile != (int)blockIdx.x);
    }
    const int tok0 = gtok(c, g, tb * 256);
    const float* gp = c.mod + ((long)l * 40 + batch_of(tok0)) * 3072 + 2048;
#pragma unroll
    for (int ip = 0; ip < 2; ip++) {
      float4 xv[2][8], gt[2];
#pragma unroll
      for (int h2 = 0; h2 < 2; h2++) {
        const int col = pt * 256 + 64 * wm + 16 * (2 * ip + h2) + 4 * lg;
        gt[h2] = *(const float4*)(gp + col);
#pragma unroll
        for (int jn = 0; jn < 8; jn++) {
          const int tok = tok0 + 128 * wn + 16 * jn + lr;
          const float* xr = (l == 0) ? xin_row(p, tok) : p.out + (long)tok * D;
          xv[h2][jn] = *(const float4*)(xr + col);
        }
      }
#pragma unroll
      for (int h2 = 0; h2 < 2; h2++) {
        const int i = 2 * ip + h2;
        const int col = pt * 256 + 64 * wm + 16 * i + 4 * lg;
#pragma unroll
        for (int jn = 0; jn < 8; jn++) {
          const int tok = tok0 + 128 * wn + 16 * jn + lr;
          float4 o;
          o.x = xv[h2][jn].x + gt[h2].x * acc[i][jn][0]; o.y = xv[h2][jn].y + gt[h2].y * acc[i][jn][1];
          o.z = xv[h2][jn].z + gt[h2].z * acc[i][jn][2]; o.w = xv[h2][jn].w + gt[h2].w * acc[i][jn][3];
          *(float4*)(p.out + (long)tok * D + col) = o;
        }
      }
    }
  }
}

__global__ void __launch_bounds__(NT) mega(Params p) {
  extern __shared__ __attribute__((aligned(16))) char smem[];
  cg::grid_group grid = cg::this_grid();
  const int nG = p.G;
  __shared__ uint4 xb_words;
  volatile LAS unsigned* xb_st = (volatile LAS unsigned*)&xb_words;
  Params* pg;
  unsigned* xbar;
  {
    const Ctx c0 = make_ctx(p);
    unsigned char* q = (unsigned char*)c0.ctr + 4096;
    xbar = (unsigned*)q; q += XCD_BAR_WORDS * 4;
    pg = (Params*)q;
    if (blockIdx.x == 0 && threadIdx.x == 0) *pg = p;
    if (threadIdx.x == 0) xb_words = make_uint4(0u, 0u, 0u, 0u);
    __syncthreads();
    XcdBarrier xb0 = xcd_barrier_post(xbar, xb_st);
    (void)xb0;
    phase_prep(p, c0, (float*)smem);
  }
  grid.sync();
#define PH(call) { const CParams* q_ = launder_params(pg); const CParams& P_ = *q_; const Ctx c = make_ctx(P_); call; }
#define BAR() { const CParams* q_ = launder_params(pg); const Ctx c = make_ctx(*q_); XcdBarrier xb; xb.bar = (unsigned*)((unsigned char*)c.ctr + 4096); xb.x = xb_xcc_id(); xb.st = xb_st; xcd_barrier(xb); }
  for (int g = 0; g < nG; ++g) {
    for (int l = 0; l < DEPTH; ++l) {
      PH(phase_rows(P_, c, l, g, false)); BAR();
      PH(phase_A(P_, c, l, (u16*)smem)); BAR();
      PH(phase_scan(P_, c, g * DEPTH + l, smem)); BAR();
      PH(phase_C(P_, c, l, (u16*)smem)); BAR();
      PH(phase_E(P_, c, l)); BAR();
      PH(phase_D1(P_, c, l, (u16*)smem)); BAR();
      PH(phase_D2(P_, c, l, g, (u16*)smem)); BAR();
    }
    PH(phase_rows(P_, c, DEPTH, g, true));
  }
}

extern "C" void kernel_launch(void* const* d_in, const int* in_sizes, int n_in, void* d_out, int out_size,
                              void* d_ws, size_t ws_size, hipStream_t stream) {
  static int grid_blocks = 0;
  static int Gsel = 2;
  if (!grid_blocks) {
    int dev = 0, cus = 0, per_cu = 0;
    hipGetDevice(&dev);
    hipDeviceGetAttribute(&cus, hipDeviceAttributeMultiprocessorCount, dev);
    hipFuncSetAttribute((const void*)mega, hipFuncAttributeMaxDynamicSharedMemorySize, LDS_BYTES);
    hipOccupancyMaxActiveBlocksPerMultiprocessor(&per_cu, (const void*)mega, NT, LDS_BYTES);
    if (per_cu < 1) per_cu = 1;
    grid_blocks = cus * per_cu;
    const size_t fixed = (size_t)DEPTH * WROWS * D * 2 + (size_t)DEPTH * 40 * 3072 * 4 + 4096 + XCD_BAR_WORDS * 4 + 1024;
    Gsel = 2;
    while (Gsel < 8 && 7 * ((size_t)(131072 / Gsel) * D * 2) + fixed + (size_t)(131072 / Gsel) * 96 > ws_size) Gsel *= 2;
  }
  Params p{};
  p.x_prompt = (const float*)d_in[0]; p.x_sample = (const float*)d_in[1]; p.c_prompt = (const float*)d_in[2]; p.c_sample = (const float*)d_in[3];
  p.w_ada = (const float*)d_in[4]; p.b_ada = (const float*)d_in[5]; p.norm_g = (const float*)d_in[6]; p.w_in = (const float*)d_in[7];
  p.b_gates = (const float*)d_in[8]; p.conv_w = (const float*)d_in[9]; p.conv_b = (const float*)d_in[10]; p.mh_norm_g = (const float*)d_in[11];
  p.w_pc = (const float*)d_in[12]; p.w_pm = (const float*)d_in[13]; p.w_out = (const float*)d_in[14]; p.final_g = (const float*)d_in[15];
  p.out = (float*)d_out; p.ws = (unsigned char*)d_ws; p.G = Gsel; p.pad = 0;
  {
    const size_t Tg = 131072 / Gsel;
    const size_t off = 7 * (Tg * D * 2) + (size_t)DEPTH * WROWS * D * 2 + (size_t)DEPTH * 40 * 3072 * 4 + Tg * 96 + 4096;
    (void)hipMemsetAsync((unsigned char*)d_ws + off, 0, XCD_BAR_WORDS * 4, stream);
  }
  void* args[] = {&p};
  hipError_t e = hipLaunchCooperativeKernel((const void*)mega, dim3(grid_blocks), dim3(NT), args, LDS_BYTES, stream);
  if (e != hipSuccess) fprintf(stderr, "cooperative launch failed: %s (grid %d)\n", hipGetErrorString(e), grid_blocks);
}
```

```cpp
#include <hip/hip_runtime.h>
#include <hip/hip_cooperative_groups.h>
#include <cstdio>
namespace cg = cooperative_groups;

typedef unsigned short u16;
using bf16x8 = __attribute__((ext_vector_type(8))) short;
using f32x4  = __attribute__((ext_vector_type(4))) float;
using s16x4  = __attribute__((ext_vector_type(4))) short;
using u32x4  = __attribute__((ext_vector_type(4))) unsigned;
using u32x2  = __attribute__((ext_vector_type(2))) unsigned;
#define DI __device__ __forceinline__

constexpr int D = 1024, DIN = 11280, DEPTH = 4;
constexpr int NT = 512;
constexpr int W_QKV = 0, W_C = 3328, W_G = 9472, W_PC = 11520, W_PM = 12544, W_O = 13568, WROWS = 14592;
constexpr int LDT = 72;
constexpr int KS = 264, VS = 136;
constexpr int LDS_BYTES = (128 * KS + 2 * 80 * VS + 80 * KS) * 2 + 4 * 128 * 4;

struct Params {
  const float* x_prompt; const float* x_sample; const float* c_prompt; const float* c_sample;
  const float* w_ada; const float* b_ada; const float* norm_g; const float* w_in; const float* b_gates;
  const float* conv_w; const float* conv_b; const float* mh_norm_g; const float* w_pc; const float* w_pm;
  const float* w_out; const float* final_g;
  float* out; unsigned char* ws;
  int G; int pad;
};

struct Ctx {
  int G, Tg, half;
  u16 *Rh, *R1, *R2, *R3, *R4, *Rhf, *Rhb;
  u16* W; float* mod; float* sc; int* ctr;
};

DI u16 f2bf(float x) { unsigned u = __float_as_uint(x); u += 0x7fffu + ((u >> 16) & 1u); return (u16)(u >> 16); }
DI float bf2f(unsigned h) { return __uint_as_float(h << 16); }
typedef __bf16 bf16x2_t __attribute__((ext_vector_type(2)));
typedef float f32x2_t __attribute__((ext_vector_type(2)));
DI unsigned pack2(float a, float b) { const f32x2_t v = {a, b}; return __builtin_bit_cast(unsigned, __builtin_convertvector(v, bf16x2_t)); }
DI uint2 pack4(float a, float b, float c, float d) { uint2 r; r.x = pack2(a, b); r.y = pack2(c, d); return r; }
DI uint2 pack4v(f32x4 v) { return pack4(v[0], v[1], v[2], v[3]); }
DI float4 unpack4(uint2 v) { float4 r; r.x = bf2f(v.x & 0xffffu); r.y = bf2f(v.x >> 16); r.z = bf2f(v.y & 0xffffu); r.w = bf2f(v.y >> 16); return r; }
DI float sigmoidf_(float x) { return __builtin_amdgcn_rcpf(1.f + __expf(-x)); }
DI float siluf_(float x) { return x * sigmoidf_(x); }
DI float wave_sum(float v) {
#pragma unroll
  for (int o = 32; o >= 1; o >>= 1) v += __shfl_xor(v, o);
  return v;
}
DI int opaque_tid() { int t = threadIdx.x; asm volatile("" : "+v"(t)); return t; }
DI f32x4 mfma16(bf16x8 a, bf16x8 b, f32x4 c) { return __builtin_amdgcn_mfma_f32_16x16x32_bf16(a, b, c, 0, 0, 0); }


typedef const Params __attribute__((address_space(4))) CParams;
template <class PT> DI Ctx make_ctx(const PT& p) {
  Ctx c;
  c.G = p.G; c.Tg = 131072 / p.G; c.half = c.Tg >> 1;
  const size_t REG = (size_t)c.Tg * D * 2;
  unsigned char* ws = p.ws;
  c.Rh = (u16*)(ws); c.R1 = (u16*)(ws + REG); c.R2 = (u16*)(ws + 2 * REG); c.R3 = (u16*)(ws + 3 * REG);
  c.R4 = (u16*)(ws + 4 * REG); c.Rhf = (u16*)(ws + 5 * REG); c.Rhb = (u16*)(ws + 6 * REG);
  unsigned char* q = ws + 7 * REG;
  c.W = (u16*)q; q += (size_t)DEPTH * WROWS * D * 2;
  c.mod = (float*)q; q += (size_t)DEPTH * 40 * 3072 * 4;
  c.sc = (float*)q; q += (size_t)c.Tg * 96;
  c.ctr = (int*)q;
  return c;
}
DI const CParams* launder_params(const Params* g) { asm volatile("" : "+s"(g)); return (const CParams*)(unsigned long long)g; }
DI int gtok(const Ctx& c, int g, int lt) { return lt < c.half ? g * c.half + lt : 65536 + g * c.half + (lt - c.half); }
DI int batch_of(int tok) { return tok < 65536 ? (tok >> 13) : 8 + ((tok - 65536) >> 11); }
template <class PT> DI const float* xin_row(const PT& p, int tok) {
  return tok < 65536 ? p.x_prompt + (long)tok * D : p.x_sample + (long)(tok - 65536) * D;
}


#define XB_TMO      128
#define XB_XCNT(j)  (256  + 64 * (j))
#define XB_XSUB(j)  (1280 + 64 * (j))
#define XB_XGEN(j)  (2304 + 64 * (j))
#define XB_TOP      3328
#define XB_TOPGEN   3392
#define XCD_BAR_WORDS 3456
#define XB_SPIN_CAP (1u << 18)
#define LAS __attribute__((address_space(3)))
DI unsigned xb_ld(unsigned* p)              { return __hip_atomic_load(p, __ATOMIC_RELAXED, __HIP_MEMORY_SCOPE_AGENT); }
DI unsigned xb_add(unsigned* p, unsigned v) { return __hip_atomic_fetch_add(p, v, __ATOMIC_RELAXED, __HIP_MEMORY_SCOPE_AGENT); }
DI unsigned xb_xcc_id() { return (unsigned)__builtin_amdgcn_s_getreg((3 << 11) | 20) & 0xFu; }
#define XB_SPIN(cond, bar) do { unsigned _sp = 0; while (cond) { __builtin_amdgcn_s_sleep(1); \
    if ((++_sp & 255u) == 0u) { if (xb_ld(&(bar)[XB_TMO])) break; if (_sp > XB_SPIN_CAP) { atomicAdd(&(bar)[XB_TMO], 1u); break; } } } } while (0)
struct XcdBarrier { unsigned* bar; unsigned x; volatile LAS unsigned* st; };
DI XcdBarrier xcd_barrier_post(unsigned* bar, volatile LAS unsigned* st) {
  XcdBarrier b; b.bar = bar; b.x = xb_xcc_id(); b.st = st;
  if (threadIdx.x == 0) (void)xb_add(&bar[XB_XCNT(b.x)], 1u);
  return b;
}
DI void xcd_barrier_complete(unsigned* bar, unsigned x, unsigned& nloc, unsigned& nx) {
  const unsigned G = gridDim.x * gridDim.y * gridDim.z;
  unsigned sum, cnt, mine, sp = 0u;
  for (;;) {
    sum = 0u; cnt = 0u; mine = 0u;
#pragma unroll
    for (unsigned j = 0; j < 16; ++j) { const unsigned c = xb_ld(&bar[XB_XCNT(j)]); sum += c; cnt += (c > 0u) ? 1u : 0u; }
    mine = xb_ld(&bar[XB_XCNT(x)]);
    if (sum == G) break;
    __builtin_amdgcn_s_sleep(1);
    if ((++sp & 255u) == 0u) { if (xb_ld(&bar[XB_TMO])) break; if (sp > XB_SPIN_CAP) { atomicAdd(&bar[XB_TMO], 1u); break; } }
  }
  nloc = mine > 0u ? mine : 1u; nx = cnt > 0u ? cnt : 1u;
}
DI void xcd_barrier(const XcdBarrier& b) {
  asm volatile("s_waitcnt vmcnt(0)" ::: "memory");
  __syncthreads();
  if (threadIdx.x == 0) {
    unsigned* bar = b.bar;
    asm volatile("" : "+s"(bar));
    __builtin_amdgcn_s_waitcnt(0);
    unsigned nloc = b.st[0], nx = b.st[1];
    if (nloc == 0u) { xcd_barrier_complete(bar, b.x, nloc, nx); b.st[0] = nloc; b.st[1] = nx; }
    const unsigned old = xb_add(&bar[XB_XSUB(b.x)], 1u);
    const unsigned gen = old / nloc;
    if (old + 1u == (gen + 1u) * nloc) {
      __builtin_amdgcn_fence(__ATOMIC_RELEASE, "agent");
      asm volatile("s_waitcnt vmcnt(0)" ::: "memory");
      const unsigned og = xb_add(&bar[XB_TOP], 1u);
      const unsigned tg = og / nx;
      if (og + 1u == (tg + 1u) * nx) xb_add(&bar[XB_TOPGEN], 1u);
      else XB_SPIN(xb_ld(&bar[XB_TOPGEN]) == tg, bar);
      __builtin_amdgcn_fence(__ATOMIC_ACQUIRE, "agent");
      xb_add(&bar[XB_XGEN(b.x)], 1u);
      asm volatile("s_waitcnt vmcnt(0)" ::: "memory");
    } else {
      XB_SPIN(xb_ld(&bar[XB_XGEN(b.x)]) == gen, bar);
      __builtin_amdgcn_fence(__ATOMIC_ACQUIRE, "agent");
      asm volatile("s_waitcnt vmcnt(0)" ::: "memory");
    }
  }
  __syncthreads();
}

template <int MT, int NT, int ST>
DI void gemm_tile(const u16* __restrict__ P, const u16* __restrict__ Q, f32x4 (&acc)[MT][NT], u16* lds,
                  const u16* Pn = nullptr, const u16* Qn = nullptr, bool primed = false, int* ringp = nullptr) {
  const int tid = opaque_tid(), lane = tid & 63, wave = __builtin_amdgcn_readfirstlane(tid >> 6), wm = wave & 3, wn = wave >> 2;
  const int lr = lane & 15, lg = lane >> 4;
  constexpr int PROWS = 64 * MT, QROWS = 32 * NT, NQI = NT / 2, NDMA = MT + NQI;
  char* pbase = (char*)lds;
  char* qbase = pbase + ST * PROWS * 128;
  const int drow = lane >> 3, dpos = lane & 7;
  const int r0 = 8 * wave + drow;
  const unsigned voff = (unsigned)(r0 * D + ((dpos ^ ((r0 >> 1) & 7)) << 3)) * 2u;
  const char* Pc = (const char*)P; const char* Qc = (const char*)Q;
  char* dp = pbase + wave * 1024 + lane * 16;
  char* dq = qbase + wave * 1024 + lane * 16;
#pragma unroll
  for (int i = 0; i < MT; i++)
#pragma unroll
    for (int j = 0; j < NT; j++) acc[i][j] = (f32x4){0.f, 0.f, 0.f, 0.f};
  const int ring0 = (ST == 3 && ringp) ? *ringp : 0;
  if (!primed) {
#pragma unroll
    for (int t0 = 0; t0 < ST - 1; t0++) {
      int bi = ring0 + t0; if (bi >= ST) bi -= ST;
#pragma unroll
      for (int i = 0; i < MT; i++) __builtin_amdgcn_global_load_lds((const unsigned*)(Pc + (i * 64 * D * 2 + t0 * 128) + voff), (unsigned*)(dp + bi * PROWS * 128 + i * 8192), 16, 0, 0);
#pragma unroll
      for (int i = 0; i < NQI; i++) __builtin_amdgcn_global_load_lds((const unsigned*)(Qc + (i * 64 * D * 2 + t0 * 128) + voff), (unsigned*)(dq + bi * QROWS * 128 + i * 8192), 16, 0, 0);
    }
  }
  if (primed) asm volatile("s_waitcnt vmcnt(0)" ::: "memory");
  else asm volatile("s_waitcnt vmcnt(%0)" :: "n"((ST - 2) * NDMA) : "memory");
  __builtin_amdgcn_s_barrier();
  asm volatile("" ::: "memory");
  const int swz = (lr >> 1) & 7;
  const int o0 = (lg ^ swz) << 4, o1 = ((4 + lg) ^ swz) << 4;
  const char* pa = pbase + (wm * 16 * MT + lr) * 128;
  const char* qa = qbase + (wn * 16 * NT + lr) * 128;
  constexpr int NK = D / 64;
  int cur = ring0, nxs = ring0 + ST - 1; if (nxs >= ST) nxs -= ST;
  for (int kt = 0; kt < NK; ++kt) {
    if (kt + ST - 1 < NK) {
#pragma unroll
      for (int i = 0; i < MT; i++) __builtin_amdgcn_global_load_lds((const unsigned*)(Pc + (i * 64 * D * 2 + (kt + ST - 1) * 128) + voff), (unsigned*)(dp + nxs * PROWS * 128 + i * 8192), 16, 0, 0);
#pragma unroll
      for (int i = 0; i < NQI; i++) __builtin_amdgcn_global_load_lds((const unsigned*)(Qc + (i * 64 * D * 2 + (kt + ST - 1) * 128) + voff), (unsigned*)(dq + nxs * QROWS * 128 + i * 8192), 16, 0, 0);
    }
    if (ST == 3 && kt >= NK - 2 && Pn != nullptr) {
      const char* Pnc = (const char*)Pn + (kt - (NK - 2)) * 128; const char* Qnc = (const char*)Qn + (kt - (NK - 2)) * 128;
#pragma unroll
      for (int i = 0; i < MT; i++) __builtin_amdgcn_global_load_lds((const unsigned*)(Pnc + (i * 64 * D * 2) + voff), (unsigned*)(dp + nxs * PROWS * 128 + i * 8192), 16, 0, 0);
#pragma unroll
      for (int i = 0; i < NQI; i++) __builtin_amdgcn_global_load_lds((const unsigned*)(Qnc + (i * 64 * D * 2) + voff), (unsigned*)(dq + nxs * QROWS * 128 + i * 8192), 16, 0, 0);
    }
    if (ST == 2 && kt == NK - 1 && Pn != nullptr) {
      const char* Pnc = (const char*)Pn; const char* Qnc = (const char*)Qn;
#pragma unroll
      for (int i = 0; i < MT; i++) __builtin_amdgcn_global_load_lds((const unsigned*)(Pnc + (i * 64 * D * 2) + voff), (unsigned*)(dp + i * 8192), 16, 0, 0);
#pragma unroll
      for (int i = 0; i < NQI; i++) __builtin_amdgcn_global_load_lds((const unsigned*)(Qnc + (i * 64 * D * 2) + voff), (unsigned*)(dq + i * 8192), 16, 0, 0);
    }
    const char* pb = pa + cur * PROWS * 128;
    const char* qb = qa + cur * QROWS * 128;
    if constexpr (NT == 99) {
      bf16x8 af[MT], b0[NT], b1[NT];
#pragma unroll
      for (int j = 0; j < NT; j++) b0[j] = *(const bf16x8*)(qb + j * 2048 + o0);
#pragma unroll
      for (int i = 0; i < MT; i++) af[i] = *(const bf16x8*)(pb + i * 2048 + o0);
      __builtin_amdgcn_s_setprio(1);
#pragma unroll
      for (int i = 0; i < MT; i++) {
#pragma unroll
        for (int j = 0; j < NT; j++) acc[i][j] = mfma16(af[i], b0[j], acc[i][j]);
        b1[i] = *(const bf16x8*)(qb + i * 2048 + o1);
        af[i] = *(const bf16x8*)(pb + i * 2048 + o1);
      }
#pragma unroll
      for (int j = MT; j < NT; j++) b1[j] = *(const bf16x8*)(qb + j * 2048 + o1);
#pragma unroll
      for (int i = 0; i < MT; i++)
#pragma unroll
        for (int j = 0; j < NT; j++) acc[i][j] = mfma16(af[i], b1[j], acc[i][j]);
      __builtin_amdgcn_sched_group_barrier(0x100, NT + MT, 0);
#pragma unroll
      for (int r = 0; r < MT; r++) {
        __builtin_amdgcn_sched_group_barrier(0x008, 4, 0);
        __builtin_amdgcn_sched_group_barrier(0x100, 1, 0);
        __builtin_amdgcn_sched_group_barrier(0x008, 4, 0);
        __builtin_amdgcn_sched_group_barrier(0x100, 1, 0);
      }
      __builtin_amdgcn_sched_group_barrier(0x100, NT - MT, 0);
      __builtin_amdgcn_sched_group_barrier(0x008, MT * NT, 0);
      __builtin_amdgcn_s_setprio(0);
    } else {
#pragma unroll
      for (int ks = 0; ks < 2; ++ks) {
        const int oo = ks ? o1 : o0;
        bf16x8 a[MT], b[NT];
#pragma unroll
        for (int i = 0; i < MT; i++) a[i] = *(const bf16x8*)(pb + i * 2048 + oo);
#pragma unroll
        for (int j = 0; j < NT; j++) b[j] = *(const bf16x8*)(qb + j * 2048 + oo);
        __builtin_amdgcn_s_setprio(1);
#pragma unroll
        for (int i = 0; i < MT; i++)
#pragma unroll
          for (int j = 0; j < NT; j++) acc[i][j] = mfma16(a[i], b[j], acc[i][j]);
        __builtin_amdgcn_s_setprio(0);
      }
    }
    if (kt + ST - 1 < NK) asm volatile("s_waitcnt vmcnt(%0)" :: "n"((ST - 2) * NDMA) : "memory");
    else if (ST == 3 && Pn != nullptr) { if (kt == NK - 2) asm volatile("s_waitcnt vmcnt(%0)" :: "n"(NDMA) : "memory"); }
    else if (!(ST == 2 && Pn != nullptr)) asm volatile("s_waitcnt vmcnt(0)" ::: "memory");
    __builtin_amdgcn_s_barrier();
    asm volatile("" ::: "memory");
    cur = (cur == ST - 1) ? 0 : cur + 1;
    nxs = (nxs == ST - 1) ? 0 : nxs + 1;
  }
  if (ST == 3 && ringp) *ringp = cur;
}

template <class PT> DI void wsrc(const PT& p, int l, int n, const float*& src, int& ld, int& col, float& scale) {
  scale = 1.f;
  src = p.w_in + (long)l * D * DIN; ld = DIN;
  if (n < W_C) {
    if (n < 1024) col = 4096 + n;
    else if (n < 2048) { col = 5120 + (n - 1024); scale = 0.0625f; }
    else if (n < 3072) col = 6144 + (n - 2048);
    else if (n < 3088) col = 9216 + (n - 3072);
    else col = -1;
  } else if (n < W_G) {
    int n2 = n - W_C;
    if (n2 < 4096) { int blk = n2 >> 6, sl = (n2 >> 4) & 3, cl = n2 & 15; col = sl * 1024 + blk * 16 + cl; }
    else { int n3 = n2 - 4096; int blk = n3 >> 5, sl = (n3 >> 4) & 1, cl = n3 & 15; col = (sl ? 8192 : 7168) + blk * 16 + cl; }
  } else if (n < W_PC) {
    int n4 = n - W_G; int mtb = n4 >> 9, r5 = n4 & 511; int cc5 = r5 >> 8, wm5 = (r5 >> 6) & 3, a5 = (r5 >> 5) & 1, sl = (r5 >> 4) & 1, cl = r5 & 15;
    col = 9232 + sl * 1024 + (256 * mtb + 64 * wm5 + 32 * cc5 + 16 * a5 + cl);
  } else if (n < W_PM) { src = p.w_pc + (long)l * D * D; ld = D; col = n - W_PC; }
  else if (n < W_O)  { src = p.w_pm + (long)l * D * D; ld = D; col = n - W_PM; }
  else               { src = p.w_out + (long)l * D * D; ld = D; col = n - W_O; }
}

template <class PT> DI void phase_prep(const PT& p, const Ctx& c, float* ldsf) {
  const int tid = opaque_tid();
  if (blockIdx.x == 0 && tid < 256) c.ctr[tid] = 0;
  const int nItems = DEPTH * (WROWS / 64) * 16;
  for (int it = blockIdx.x; it < nItems; it += gridDim.x) {
    const int kb = (it & 15) * 64; const int rb = it >> 4;
    const int l = rb / (WROWS / 64); const int nb = (rb % (WROWS / 64)) * 64;
    const float* src; int ld, col; float scale;
    const int nl = tid & 63;
    wsrc(p, l, nb + nl, src, ld, col, scale);
#pragma unroll
    for (int i = 0; i < 8; i++) {
      const int kl = (tid >> 6) + 8 * i;
      float v = (col >= 0) ? src[(long)(kb + kl) * ld + col] * scale : 0.f;
      ldsf[kl * 65 + nl] = v;
    }
    __syncthreads();
    {
      const int nl2 = tid >> 3, kc = tid & 7;
      float v[8];
#pragma unroll
      for (int j = 0; j < 8; j++) v[j] = ldsf[(kc * 8 + j) * 65 + nl2];
      uint4 o; o.x = pack2(v[0], v[1]); o.y = pack2(v[2], v[3]); o.z = pack2(v[4], v[5]); o.w = pack2(v[6], v[7]);
      *(uint4*)(c.W + ((long)l * WROWS + nb + nl2) * D + kb + kc * 8) = o;
    }
    __syncthreads();
  }
  const int nMod = DEPTH * 48;
  for (int it = blockIdx.x; it < nMod; it += gridDim.x) {
    const int l = it / 48, jb = (it % 48) * 64;
    const int cl = tid & 63, kc = tid >> 6;
    float acc[40];
#pragma unroll
    for (int b = 0; b < 40; b++) acc[b] = 0.f;
    const float* wa = p.w_ada + (long)l * D * 3072 + jb + cl;
    for (int k = kc * 128; k < kc * 128 + 128; ++k) {
      const float wv = wa[(long)k * 3072];
#pragma unroll
      for (int b = 0; b < 40; b++) {
        const float cv = (b < 8) ? p.c_prompt[b * D + k] : p.c_sample[(b - 8) * D + k];
        acc[b] += cv * wv;
      }
    }
#pragma unroll
    for (int b = 0; b < 40; b++) ldsf[(kc * 40 + b) * 64 + cl] = acc[b];
    __syncthreads();
    for (int idx = tid; idx < 40 * 64; idx += NT) {
      const int b = idx >> 6, cc = idx & 63;
      float s = p.b_ada[l * 3072 + jb + cc];
#pragma unroll
      for (int q = 0; q < 8; q++) s += ldsf[(q * 40 + b) * 64 + cc];
      c.mod[((long)l * 40 + b) * 3072 + jb + cc] = s;
    }
    __syncthreads();
  }
}

template <class PT> DI void phase_rows(const PT& p, const Ctx& c, int l, int g, bool fin) {
  const int tid_ = opaque_tid(); const int lane = tid_ & 63, w = tid_ >> 6;
  const int stride = gridDim.x * 8;
  float4 gv[4];
#pragma unroll
  for (int i = 0; i < 4; i++) gv[i] = *(const float4*)((fin ? p.final_g : p.norm_g + l * D) + 4 * lane + 256 * i);
  for (int lt0 = blockIdx.x * 8 + w; lt0 < c.Tg; lt0 += 2 * stride) {
    const bool has1 = lt0 + stride < c.Tg;
    const int lt1 = has1 ? lt0 + stride : lt0;
    const int tok0 = gtok(c, g, lt0), tok1 = gtok(c, g, lt1);
    const float* xr0 = (l == 0) ? xin_row(p, tok0) : p.out + (long)tok0 * D;
    const float* xr1 = (l == 0) ? xin_row(p, tok1) : p.out + (long)tok1 * D;
    float4 v0[4], v1[4]; float ss0 = 0.f, ss1 = 0.f;
#pragma unroll
    for (int i = 0; i < 4; i++) { v0[i] = *(const float4*)(xr0 + 4 * lane + 256 * i); v1[i] = *(const float4*)(xr1 + 4 * lane + 256 * i); }
    const float* mp0 = c.mod + ((long)(fin ? 0 : l) * 40 + batch_of(tok0)) * 3072;
    const float* mp1 = c.mod + ((long)(fin ? 0 : l) * 40 + batch_of(tok1)) * 3072;
    float4 sc0[4], sh0[4], sc1[4], sh1[4];
    if (!fin) {
#pragma unroll
      for (int i = 0; i < 4; i++) {
        const int k = 4 * lane + 256 * i;
        sc0[i] = *(const float4*)(mp0 + 1024 + k); sh0[i] = *(const float4*)(mp0 + k);
        sc1[i] = *(const float4*)(mp1 + 1024 + k); sh1[i] = *(const float4*)(mp1 + k);
      }
    }
#pragma unroll
    for (int i = 0; i < 4; i++) {
      ss0 += v0[i].x * v0[i].x + v0[i].y * v0[i].y + v0[i].z * v0[i].z + v0[i].w * v0[i].w;
      ss1 += v1[i].x * v1[i].x + v1[i].y * v1[i].y + v1[i].z * v1[i].z + v1[i].w * v1[i].w;
    }
    ss0 = wave_sum(ss0); ss1 = wave_sum(ss1);
    const float r0 = rsqrtf(ss0 * (1.f / 1024.f) + 1e-6f), r1 = rsqrtf(ss1 * (1.f / 1024.f) + 1e-6f);
    if (fin) {
#pragma unroll
      for (int i = 0; i < 4; i++) {
        const int k = 4 * lane + 256 * i;
        float4 o; o.x = v0[i].x * r0 * gv[i].x; o.y = v0[i].y * r0 * gv[i].y; o.z = v0[i].z * r0 * gv[i].z; o.w = v0[i].w * r0 * gv[i].w;
        *(float4*)(p.out + (long)tok0 * D + k) = o;
      }
      if (has1) {
#pragma unroll
        for (int i = 0; i < 4; i++) {
          const int k = 4 * lane + 256 * i;
          float4 o; o.x = v1[i].x * r1 * gv[i].x; o.y = v1[i].y * r1 * gv[i].y; o.z = v1[i].z * r1 * gv[i].z; o.w = v1[i].w * r1 * gv[i].w;
          *(float4*)(p.out + (long)tok1 * D + k) = o;
        }
      }
    } else {
#pragma unroll
      for (int i = 0; i < 4; i++) {
        const int k = 4 * lane + 256 * i;
        *(uint2*)(c.Rh + (long)lt0 * D + k) = pack4(v0[i].x * r0 * gv[i].x * (1.f + sc0[i].x) + sh0[i].x, v0[i].y * r0 * gv[i].y * (1.f + sc0[i].y) + sh0[i].y,
                                                    v0[i].z * r0 * gv[i].z * (1.f + sc0[i].z) + sh0[i].z, v0[i].w * r0 * gv[i].w * (1.f + sc0[i].w) + sh0[i].w);
      }
      if (has1) {
#pragma unroll
        for (int i = 0; i < 4; i++) {
          const int k = 4 * lane + 256 * i;
          *(uint2*)(c.Rh + (long)lt1 * D + k) = pack4(v1[i].x * r1 * gv[i].x * (1.f + sc1[i].x) + sh1[i].x, v1[i].y * r1 * gv[i].y * (1.f + sc1[i].y) + sh1[i].y,
                                                      v1[i].z * r1 * gv[i].z * (1.f + sc1[i].z) + sh1[i].z, v1[i].w * r1 * gv[i].w * (1.f + sc1[i].w) + sh1[i].w);
        }
      }
    }
  }
}

template <class PT> DI void phase_A(const PT& p, const Ctx& c, int l, u16* lds) {
  const int tid = opaque_tid(), lane = tid & 63, wave = tid >> 6, wm = wave & 3, wn = wave >> 2, lr = lane & 15, lg = lane >> 4;
  const u16* W = c.W + (long)l * WROWS * D;
  u16* Rq = c.R1; u16* Rk = c.R2; u16* RvT = c.R4;
  const int nTiles = (c.Tg / 256) * 13;
  auto ptrsA = [&](int tl, const u16*& Pp, const u16*& Qp) {
    const int tb_ = (tl / 104) * 8 + (tl & 7), j_ = (tl % 104) >> 3;
    const u16* hp = c.Rh + (long)tb_ * 256 * D;
    if (j_ < 8) { Pp = W + (long)((j_ >> 2) * 1024 + (j_ & 3) * 256) * D; Qp = hp; }
    else if (j_ < 12) { Pp = hp; Qp = W + (long)(2048 + (j_ - 8) * 256) * D; }
    else { Pp = W + (long)3072 * D; Qp = hp; }
  };
  bool primed = false;
  for (int tile = blockIdx.x; tile < nTiles; tile += gridDim.x) {
    const int tb = (tile / 104) * 8 + (tile & 7), j = (tile % 104) >> 3;
    f32x4 acc[4][8];
    const u16 *P0, *Q0, *P1 = nullptr, *Q1 = nullptr;
    ptrsA(tile, P0, Q0);
    if (tile + (int)gridDim.x < nTiles && j != 12 && (((tile + (int)gridDim.x) % 104) >> 3) != 12) ptrsA(tile + gridDim.x, P1, Q1);
    const bool pr = primed; primed = (P1 != nullptr);
    if (j < 8) {
      const int isk = j >> 2, head = j & 3;
      gemm_tile<4, 8, 2>(P0, Q0, acc, lds, P1, Q1, pr);
      u16* dst = isk ? Rk : Rq;
#pragma unroll
      for (int i = 0; i < 4; i++)
#pragma unroll
        for (int jn = 0; jn < 8; jn++) {
          const int d = 64 * wm + 16 * i + 4 * lg, t = 128 * wn + 16 * jn + lr;
          *(uint2*)(dst + (long)(tb * 256 + t) * D + head * 256 + d) = pack4v(acc[i][jn]);
        }
    } else if (j < 12) {
      const int head = j - 8;
      gemm_tile<4, 8, 2>(P0, Q0, acc, lds, P1, Q1, pr);
#pragma unroll
      for (int i = 0; i < 4; i++)
#pragma unroll
        for (int jn = 0; jn < 8; jn++) {
          const int tokl = 64 * wm + 16 * i + 4 * lg, e = 128 * wn + 16 * jn + lr;
          const int ch = tb * 2 + (tokl >> 7), sidx = tokl & 127;
          *(uint2*)(RvT + ((long)(ch * 4 + head) * 256 + e) * 128 + sidx) = pack4v(acc[i][jn]);
        }
    } else {
      f32x4 accg[1][8];
      gemm_tile<1, 8, 2>(P0, Q0, accg, lds);
      float* gl = (float*)lds;
      if (wm == 0) {
#pragma unroll
        for (int jn = 0; jn < 8; jn++) {
          const int t = 128 * wn + 16 * jn + lr;
#pragma unroll
          for (int r = 0; r < 4; r++) {
            float v = accg[0][jn][r] + p.b_gates[l * 16 + lg * 4 + r];
            if (lg & 1) v = fminf(v, 0.f) - log1pf(expf(-fabsf(v)));
            gl[t * 16 + lg * 4 + r] = v;
          }
        }
      }
      __syncthreads();
      if (tid < 16) {
        const int head = tid & 3, dir = (tid >> 2) & 1, cl = tid >> 3;
        const int ch = tb * 2 + cl;
        float* o = c.sc + (((long)(ch * 4 + head) * 2 + dir) * 3) * 128;
        const float* glc = gl + cl * 128 * 16;
        float bs = 0.f, pm = -3.0e38f;
        for (int q = 0; q < 128; ++q) {
          const int t = dir ? 127 - q : q;
          const float iv = glc[t * 16 + dir * 8 + head], lf = glc[t * 16 + dir * 8 + 4 + head];
          bs += lf; const float gg = iv - bs; pm = fmaxf(pm, gg);
          o[t] = bs; o[128 + t] = gg; o[256 + t] = pm;
        }
      }
      __syncthreads();
    }
  }
}

template <class PT> DI void phase_scan(const PT& p, const Ctx& c, int ctrIdx, char* smem) {
  __shared__ int s_task;
  const int tid = opaque_tid(), lane = tid & 63, w0 = __builtin_amdgcn_readfirstlane(tid >> 6), lr = lane & 15, lg = lane >> 4;
  u16* Kb = (u16*)smem;
  u16* Vt = Kb + 128 * KS;
  u16* Vw = Vt + 80 * VS;
  u16* Ct = Vw + 80 * VS;
  float* scg = (float*)(Ct + 80 * KS); float* scmu = scg + 128; float* sciw = scmu + 128; float* scfl = sciw + 128;
  const u16* Rq = c.R1; const u16* Rk = c.R2; const u16* RvT = c.R4;
  const int nLong = (8 / c.G) * 32;
  const int nLongQ8 = (8 / c.G), nShortQ8 = (32 / c.G);
  const int perQueue = (nLongQ8 + nShortQ8) * 4;
  int* ctr = c.ctr + ctrIdx * 8;
  const int myq = (int)(xb_xcc_id() & 7u);
  int qoff = 0;
  while (true) {
    __syncthreads();
    if (tid == 0) {
      int t = -1;
      while (qoff < 8) {
        const int qi = (myq + qoff) & 7;
        const int n = atomicAdd(ctr + qi, 1);
        if (n < perQueue) {
          const int quad = (n < nLongQ8 * 4) ? qi + 8 * (n >> 2) : nLongQ8 * 8 + qi + 8 * ((n - nLongQ8 * 4) >> 2);
          t = quad * 4 + (n & 3);
          break;
        }
        ++qoff;
      }
      s_task = t;
    }
    __syncthreads();
    const int task = s_task;
    if (task < 0) break;
    int seq, r, chunk0, nc;
    if (task < nLong) { seq = task >> 5; r = task & 31; chunk0 = seq * 64; nc = 64; }
    else { const int t2 = task - nLong; seq = t2 >> 5; r = t2 & 31; chunk0 = (c.half >> 7) + seq * 16; nc = 16; }
    const int head = r >> 3, dir = (r >> 2) & 1, es = r & 3;
    const int last = dir ? 0 : 127;
    u16* Rho = dir ? c.Rhb : c.Rhf;
    for (int idx = tid; idx < 80 * KS / 2; idx += NT) ((unsigned*)Ct)[idx] = 0u;
    for (int idx = tid; idx < 16 * VS / 2; idx += NT) { ((unsigned*)(Vt + 64 * VS))[idx] = 0u; ((unsigned*)(Vw + 64 * VS))[idx] = 0u; }
    __syncthreads();
    if (tid < 128) Vt[64 * VS + tid] = (u16)0x3F80;
    f32x4 st[2][5];
#pragma unroll
    for (int i = 0; i < 2; i++)
#pragma unroll
      for (int jn = 0; jn < 5; jn++) st[i][jn] = (f32x4){0.f, 0.f, 0.f, 0.f};
    float m = 0.f;
    const int vrow = tid >> 4, vsc = tid & 15;
    const int krow = tid >> 5, kkc = (tid & 31) * 8;
    u32x4 kpre[8], vpre[2]; float4 g8a, g8b; float bLn, gmaxn, myb, myg, mypm;
    bf16x8 qf[8];
    auto scan_load = [&](int cq) {
#pragma unroll
      for (int ks = 0; ks < 8; ks++)
        qf[ks] = *(const bf16x8*)(Rq + (long)(cq * 128 + 16 * w0 + lr) * D + head * 256 + 32 * ks + 8 * lg);
#pragma unroll
      for (int i = 0; i < 8; i++) kpre[i] = *(const u32x4*)(Rk + (long)(cq * 128 + krow + 16 * i) * D + head * 256 + kkc);
#pragma unroll
      for (int i = 0; i < 2; i++) vpre[i] = *(const u32x4*)(RvT + ((long)(cq * 4 + head) * 256 + es * 64 + vrow + 32 * i) * 128 + vsc * 8);
      const float* scb = c.sc + ((long)(cq * 4 + head) * 2 + dir) * 384;
      g8a = *(const float4*)(scb + 128 + vsc * 8); g8b = *(const float4*)(scb + 128 + vsc * 8 + 4);
      bLn = scb[last]; gmaxn = scb[256 + last];
      myb = scb[tid & 127]; myg = scb[128 + (tid & 127)]; mypm = scb[256 + (tid & 127)];
    };
    scan_load(chunk0 + (dir ? nc - 1 : 0));
    for (int j = 0; j < nc; ++j) {
      const int cc = chunk0 + (dir ? nc - 1 - j : j);
      int w = w0; asm volatile("" : "+s"(w));
      __syncthreads();
      const float muL = fmaxf(m, gmaxn);
      const float decay = __expf(m - muL);
      const float mnext = bLn + muL;
#pragma unroll
      for (int i = 0; i < 2; i++)
#pragma unroll
        for (int jn = 0; jn < 5; jn++)
          *(uint2*)(Ct + (16 * jn + lr) * KS + 32 * w + 16 * i + 4 * lg) = pack4v(st[i][jn]);
#pragma unroll
      for (int i = 0; i < 8; i++) *(u32x4*)(Kb + (krow + 16 * i) * KS + kkc) = kpre[i];
      {
        float w8[8];
        w8[0] = __expf(g8a.x - muL); w8[1] = __expf(g8a.y - muL); w8[2] = __expf(g8a.z - muL); w8[3] = __expf(g8a.w - muL);
        w8[4] = __expf(g8b.x - muL); w8[5] = __expf(g8b.y - muL); w8[6] = __expf(g8b.z - muL); w8[7] = __expf(g8b.w - muL);
#pragma unroll
        for (int i = 0; i < 2; i++) {
          const u32x4 vv = vpre[i];
          *(u32x4*)(Vt + (vrow + 32 * i) * VS + vsc * 8) = vv;
          uint4 v; v.x = vv[0]; v.y = vv[1]; v.z = vv[2]; v.w = vv[3];
          uint4 o;
          o.x = pack2(bf2f(v.x & 0xffffu) * w8[0], bf2f(v.x >> 16) * w8[1]);
          o.y = pack2(bf2f(v.y & 0xffffu) * w8[2], bf2f(v.y >> 16) * w8[3]);
          o.z = pack2(bf2f(v.z & 0xffffu) * w8[4], bf2f(v.z >> 16) * w8[5]);
          o.w = pack2(bf2f(v.w & 0xffffu) * w8[6], bf2f(v.w >> 16) * w8[7]);
          *(uint4*)(Vw + (vrow + 32 * i) * VS + vsc * 8) = o;
        }
        if (tid < 16) {
          uint4 o; o.x = pack2(w8[0], w8[1]); o.y = pack2(w8[2], w8[3]); o.z = pack2(w8[4], w8[5]); o.w = pack2(w8[6], w8[7]);
          *(uint4*)(Vw + 64 * VS + vsc * 8) = o;
        }
      }
      if (tid < 128) {
        const float mu = fmaxf(m, mypm);
        scg[tid] = myg; scmu[tid] = mu; sciw[tid] = __expf(m - mu); scfl[tid] = __expf(-(mu + myb));
      }
      __syncthreads();
      const int t = 16 * w + lr;
      bf16x8 spk[4];
      {
        f32x4 sacc[8];
#pragma unroll
        for (int i = 0; i < 8; i++) sacc[i] = (f32x4){0.f, 0.f, 0.f, 0.f};
#pragma unroll
        for (int i = 0; i < 8; i++) {
          const bool need = dir ? (i >= w) : (i <= w);
          if (need) {
#pragma unroll
            for (int ks = 0; ks < 8; ks++) {
              const bf16x8 a = *(const bf16x8*)(Kb + (16 * i + lr) * KS + 32 * ks + 8 * lg);
              sacc[i] = mfma16(a, qf[ks], sacc[i]);
            }
          }
        }
        const float mu_t = scmu[t];
        int tt = t; asm volatile("" : "+v"(tt));
        const int sgn = dir ? -1 : 1;
#pragma unroll
        for (int ks = 0; ks < 4; ks++) {
          float sv[8];
#pragma unroll
          for (int hh = 0; hh < 2; hh++) {
            const int i = 2 * ks + hh;
            const float4 gs = *(const float4*)(scg + 16 * i + 4 * lg);
            const float gv[4] = {gs.x, gs.y, gs.z, gs.w};
#pragma unroll
            for (int r2 = 0; r2 < 4; r2++) {
              const int s = 16 * i + 4 * lg + r2;
              const bool valid = (s - tt) * sgn <= 0;
              sv[hh * 4 + r2] = valid ? sacc[i][r2] * __expf(gv[r2] - mu_t) : 0.f;
            }
          }
          uint4 o; o.x = pack2(sv[0], sv[1]); o.y = pack2(sv[2], sv[3]); o.z = pack2(sv[4], sv[5]); o.w = pack2(sv[6], sv[7]);
          spk[ks] = __builtin_bit_cast(bf16x8, o);
        }
      }
      f32x4 num[5];
#pragma unroll
      for (int i = 0; i < 5; i++) num[i] = (f32x4){0.f, 0.f, 0.f, 0.f};
#pragma unroll
      for (int ks = 0; ks < 8; ks++)
#pragma unroll
        for (int i = 0; i < 5; i++) {
          const bf16x8 a = *(const bf16x8*)(Ct + (16 * i + lr) * KS + 32 * ks + 8 * lg);
          num[i] = mfma16(a, qf[ks], num[i]);
        }
      {
        const float iw = sciw[t];
#pragma unroll
        for (int i = 0; i < 5; i++) num[i] *= iw;
      }
#pragma unroll
      for (int ks = 0; ks < 4; ks++) {
        const bool need = dir ? (2 * ks + 1 >= w) : (2 * ks <= w);
        if (need) {
#pragma unroll
          for (int i = 0; i < 5; i++) {
            const uint2 lo = *(const uint2*)(Vt + (16 * i + lr) * VS + 32 * ks + 4 * lg);
            const uint2 hi = *(const uint2*)(Vt + (16 * i + lr) * VS + 32 * ks + 16 + 4 * lg);
            uint4 av; av.x = lo.x; av.y = lo.y; av.z = hi.x; av.w = hi.y;
            num[i] = mfma16(__builtin_bit_cast(bf16x8, av), spk[ks], num[i]);
          }
        }
      }
      {
        const float fl = scfl[t];
        const float dr = __shfl(num[4][0], lr);
        const float inv = 1.f / fmaxf(fabsf(dr), fl);
        u16* dst = Rho + (long)(cc * 128 + t) * D + head * 256 + es * 64 + 4 * lg;
#pragma unroll
        for (int i = 0; i < 4; i++)
          *(uint2*)(dst + 16 * i) = pack4(num[i][0] * inv, num[i][1] * inv, num[i][2] * inv, num[i][3] * inv);
      }
      __builtin_amdgcn_sched_barrier(0);
      { const int jn1 = (j + 1 < nc) ? j + 1 : j; scan_load(chunk0 + (dir ? nc - 1 - jn1 : jn1)); }
      __builtin_amdgcn_sched_barrier(0);
#pragma unroll
      for (int i = 0; i < 2; i++)
#pragma unroll
        for (int jn = 0; jn < 5; jn++) st[i][jn] *= decay;
#pragma unroll
      for (int ks = 0; ks < 4; ks++) {
        bf16x8 kTf[2];
#pragma unroll
        for (int i = 0; i < 2; i++) {
          const u16* ap = Kb + (32 * ks + 8 * lg + (lr >> 2)) * KS + 32 * w + 16 * i + 4 * (lr & 3);
          const s16x4 lo = __builtin_amdgcn_ds_read_tr16_b64_v4i16((s16x4 __attribute__((address_space(3)))*)ap);
          const s16x4 hi = __builtin_amdgcn_ds_read_tr16_b64_v4i16((s16x4 __attribute__((address_space(3)))*)(ap + 4 * KS));
          kTf[i] = __builtin_shufflevector(lo, hi, 0, 1, 2, 3, 4, 5, 6, 7);
        }
#pragma unroll
        for (int jn = 0; jn < 5; jn++) {
          const bf16x8 b = *(const bf16x8*)(Vw + (16 * jn + lr) * VS + 32 * ks + 8 * lg);
#pragma unroll
          for (int i = 0; i < 2; i++) st[i][jn] = mfma16(kTf[i], b, st[i][jn]);
        }
      }
      m = mnext;
    }
  }
}

template <class PT> DI void phase_C(const PT& p, const Ctx& c, int l, u16* lds) {
  const int tid = opaque_tid(), lane = tid & 63, wave = tid >> 6, wm = wave & 3, wn = wave >> 2, lr = lane & 15, lg = lane >> 4;
  const u16* W = c.W + ((long)l * WROWS + W_C) * D;
  u16* Ru = c.R1; u16* Ryp = c.R2; u16* Rog = c.R3;
  const int nTiles = (c.Tg / 256) * 24;
  for (int tile = blockIdx.x; tile < nTiles; tile += gridDim.x) {
    const int tb = 2 * ((tile >> 3) / 6) + (tile & 1), pt = 6 * ((tile & 7) >> 1) + ((tile >> 3) % 6);
    f32x4 acc[4][8];
    {
      const int tn = tile + gridDim.x;
      const bool has = tn < nTiles;
      gemm_tile<4, 8, 2>(W + (long)pt * 256 * D, c.Rh + (long)tb * 256 * D, acc, lds,
                         has ? W + (long)(6 * ((tn & 7) >> 1) + ((tn >> 3) % 6)) * 256 * D : nullptr, has ? c.Rh + (long)(2 * ((tn >> 3) / 6) + (tn & 1)) * 256 * D : nullptr, tile != (int)blockIdx.x);
    }
    if (pt < 16) {
      const int chn = pt * 64 + wm * 16 + 4 * lg;
#pragma unroll
      for (int jn = 0; jn < 8; jn++) {
        const long lt = tb * 256 + 128 * wn + 16 * jn + lr;
        float u[4], y[4];
#pragma unroll
        for (int r = 0; r < 4; r++) { u[r] = acc[1][jn][r] * acc[2][jn][r]; y[r] = acc[0][jn][r] * siluf_(acc[3][jn][r]); }
        *(uint2*)(Ru + lt * D + chn) = pack4(u[0], u[1], u[2], u[3]);
        *(uint2*)(Ryp + lt * D + chn) = pack4(y[0], y[1], y[2], y[3]);
      }
    } else {
      const int chn = (pt - 16) * 128 + wm * 32 + 4 * lg;
#pragma unroll
      for (int jn = 0; jn < 8; jn++) {
        const long lt = tb * 256 + 128 * wn + 16 * jn + lr;
#pragma unroll
        for (int hh = 0; hh < 2; hh++) {
          float o[4];
#pragma unroll
          for (int r = 0; r < 4; r++) o[r] = sigmoidf_(acc[2 * hh][jn][r]) * siluf_(acc[2 * hh + 1][jn][r]);
          *(uint2*)(Rog + lt * D + chn + 16 * hh) = pack4(o[0], o[1], o[2], o[3]);
        }
      }
    }
  }
}

template <class PT> DI void phase_E(const PT& p, const Ctx& c, int l) {
  const int tid_ = opaque_tid(); const int lane = tid_ & 63, w = tid_ >> 6;
  const u16* Ru = c.R1; u16* Ryp = c.R2; u16* Rog = c.R3;
  const float* cw = p.conv_w + (long)l * 3 * D; const float* cb = p.conv_b + (long)l * D; const float* mg = p.mh_norm_g + (long)l * D;
  float4 w0[4], w1[4], w2[4], bb[4], gg[4];
#pragma unroll
  for (int i = 0; i < 4; i++) {
    const int k = 4 * lane + 256 * i;
    w0[i] = *(const float4*)(cw + k); w1[i] = *(const float4*)(cw + D + k); w2[i] = *(const float4*)(cw + 2 * D + k);
    bb[i] = *(const float4*)(cb + k); gg[i] = *(const float4*)(mg + k);
  }
  for (int lt = blockIdx.x * 8 + w; lt < c.Tg; lt += gridDim.x * 8) {
    const int sl = lt < c.half ? 8192 : 2048;
    const int pos = (lt < c.half ? lt : lt - c.half) & (sl - 1);
    const bool first = pos == 0, lastp = pos == sl - 1;
    uint2 U0[4], U1[4], U2[4], YP[4], OG[4], HF[4], HB[4];
#pragma unroll
    for (int i = 0; i < 4; i++) {
      const int k = 4 * lane + 256 * i;
      U0[i] = *(const uint2*)(Ru + (long)(first ? lt : lt - 1) * D + k);
      U1[i] = *(const uint2*)(Ru + (long)lt * D + k);
      U2[i] = *(const uint2*)(Ru + (long)(lastp ? lt : lt + 1) * D + k);
      if (first) { U0[i].x = 0u; U0[i].y = 0u; }
      if (lastp) { U2[i].x = 0u; U2[i].y = 0u; }
      YP[i] = *(const uint2*)(Ryp + (long)lt * D + k);
      OG[i] = *(const uint2*)(Rog + (long)lt * D + k);
      HF[i] = *(const uint2*)(c.Rhf + (long)lt * D + k);
      HB[i] = *(const uint2*)(c.Rhb + (long)lt * D + k);
    }
#pragma unroll
    for (int i = 0; i < 4; i++) {
      const int k = 4 * lane + 256 * i;
      const float4 a0 = unpack4(U0[i]), a1 = unpack4(U1[i]), a2 = unpack4(U2[i]), yp = unpack4(YP[i]);
      const float y0 = yp.x * (w0[i].x * a0.x + w1[i].x * a1.x + w2[i].x * a2.x + bb[i].x);
      const float y1 = yp.y * (w0[i].y * a0.y + w1[i].y * a1.y + w2[i].y * a2.y + bb[i].y);
      const float y2 = yp.z * (w0[i].z * a0.z + w1[i].z * a1.z + w2[i].z * a2.z + bb[i].z);
      const float y3 = yp.w * (w0[i].w * a0.w + w1[i].w * a1.w + w2[i].w * a2.w + bb[i].w);
      *(uint2*)(Ryp + (long)lt * D + k) = pack4(y0, y1, y2, y3);
      const float4 hf = unpack4(HF[i]), hb = unpack4(HB[i]), og = unpack4(OG[i]);
      const float s0 = hf.x + hb.x, s1 = hf.y + hb.y, s2 = hf.z + hb.z, s3 = hf.w + hb.w;
      const float ss = wave_sum(s0 * s0 + s1 * s1 + s2 * s2 + s3 * s3);
      const float rstd = rsqrtf(ss * (1.f / 256.f) + 1e-6f);
      *(uint2*)(Rog + (long)lt * D + k) = pack4(og.x * s0 * rstd * gg[i].x, og.y * s1 * rstd * gg[i].y, og.z * s2 * rstd * gg[i].z, og.w * s3 * rstd * gg[i].w);
    }
  }
}

template <class PT> DI void phase_D1(const PT& p, const Ctx& c, int l, u16* lds) {
  const int tid = opaque_tid(), lane = tid & 63, wave = tid >> 6, wm = wave & 3, wn = wave >> 2, lr = lane & 15, lg = lane >> 4;
  const u16* W = c.W + (long)l * WROWS * D;
  const u16* Ryc = c.R2; const u16* Rym = c.R3; u16* Rmg = c.R4;
  const int nTiles = (c.Tg / 128) * 4;
  int ring = 0;
  for (int tile = blockIdx.x; tile < nTiles; tile += gridDim.x) {
    const int ch = ((tile >> 5) << 3) + (tile & 7), mt = (tile >> 3) & 3;
    const u16* Pg = W + (long)(W_G + mt * 512) * D; const u16* Qh = c.Rh + (long)ch * 128 * D;
    const u16* Pc_ = W + (long)(W_PC + mt * 256) * D; const u16* Qc_ = Ryc + (long)ch * 128 * D;
    const u16* Pm_ = W + (long)(W_PM + mt * 256) * D; const u16* Qm_ = Rym + (long)ch * 128 * D;
    const int tn = tile + gridDim.x; const bool hasn = tn < nTiles;
    const u16* Pnx = hasn ? W + (long)(W_G + ((tn >> 3) & 3) * 512) * D : nullptr; const u16* Qnx = hasn ? c.Rh + (long)(((tn >> 5) << 3) + (tn & 7)) * 128 * D : nullptr;
    u32x2 gk[2][4][4], Mk[4][4];
#pragma unroll
    for (int cc = 0; cc < 2; cc++) {
      f32x4 a1[4][4];
      if (cc == 0) gemm_tile<4, 4, 3>(Pg, Qh, a1, lds, Pg + (long)256 * D, Qh, tile != (int)blockIdx.x, &ring);
      else gemm_tile<4, 4, 3>(Pg + (long)256 * D, Qh, a1, lds, Pc_, Qc_, true, &ring);
#pragma unroll
      for (int i = 0; i < 4; i++)
#pragma unroll
        for (int jn = 0; jn < 4; jn++) {
          const uint2 t_ = pack4(sigmoidf_(a1[i][jn][0]), sigmoidf_(a1[i][jn][1]), sigmoidf_(a1[i][jn][2]), sigmoidf_(a1[i][jn][3]));
          gk[cc][i][jn] = (u32x2){t_.x, t_.y}; asm volatile("" : "+v"(gk[cc][i][jn]));
        }
    }
    {
      f32x4 a2[4][4];
      gemm_tile<4, 4, 3>(Pc_, Qc_, a2, lds, Pm_, Qm_, true, &ring);
#pragma unroll
      for (int i = 0; i < 4; i++)
#pragma unroll
        for (int jn = 0; jn < 4; jn++) {
          uint2 g_; g_.x = gk[i >> 1][2 * (i & 1)][jn][0]; g_.y = gk[i >> 1][2 * (i & 1)][jn][1];
          const float4 gg = unpack4(g_);
          const uint2 t_ = pack4(gg.x * a2[i][jn][0], gg.y * a2[i][jn][1], gg.z * a2[i][jn][2], gg.w * a2[i][jn][3]);
          Mk[i][jn] = (u32x2){t_.x, t_.y}; asm volatile("" : "+v"(Mk[i][jn]));
        }
    }
    {
      f32x4 a2[4][4];
      gemm_tile<4, 4, 3>(Pm_, Qm_, a2, lds, Pnx, Qnx, true, &ring);
#pragma unroll
      for (int i = 0; i < 4; i++)
#pragma unroll
        for (int jn = 0; jn < 4; jn++) {
          uint2 g_; g_.x = gk[i >> 1][2 * (i & 1) + 1][jn][0]; g_.y = gk[i >> 1][2 * (i & 1) + 1][jn][1];
          uint2 m_; m_.x = Mk[i][jn][0]; m_.y = Mk[i][jn][1];
          const float4 gg = unpack4(g_);
          const float4 mm = unpack4(m_);
          const int col = mt * 256 + 64 * wm + 16 * i + 4 * lg;
          const long lt = ch * 128 + 64 * wn + 16 * jn + lr;
          *(uint2*)(Rmg + lt * D + col) = pack4(mm.x + gg.x * a2[i][jn][0], mm.y + gg.y * a2[i][jn][1],
                                                mm.z + gg.z * a2[i][jn][2], mm.w + gg.w * a2[i][jn][3]);
        }
    }
  }
}

template <class PT> DI void phase_D2(const PT& p, const Ctx& c, int l, int g, u16* lds) {
  const int tid = opaque_tid(), lane = tid & 63, wave = tid >> 6, wm = wave & 3, wn = wave >> 2, lr = lane & 15, lg = lane >> 4;
  const u16* W = c.W + ((long)l * WROWS + W_O) * D;
  const u16* Rmg = c.R4;
  const int nTiles = (c.Tg / 256) * 4;
  for (int tile = blockIdx.x; tile < nTiles; tile += gridDim.x) {
    const int tb = (tile >> 5) * 8 + (tile & 7), pt = (tile >> 3) & 3;
    f32x4 acc[4][8];
    {
      const int tn = tile + gridDim.x;
      const bool has = tn < nTiles;
      gemm_tile<4, 8, 2>(W + (long)pt * 256 * D, Rmg + (long)tb * 256 * D, acc, lds,
                         has ? W + (long)((tn >> 3) & 3) * 256 * D : nullptr, has ? Rmg + (long)((tn >> 5) * 8 + (tn & 7)) * 256 * D : nullptr, tile != (int)blockIdx.x);
    }
    const int tok0 = gtok(c, g, tb * 256);
    const float* gp = c.mod + ((long)l * 40 + batch_of(tok0)) * 3072 + 2048;
#pragma unroll
    for (int ip = 0; ip < 2; ip++) {
      float4 xv[2][8], gt[2];
#pragma unroll
      for (int h2 = 0; h2 < 2; h2++) {
        const int col = pt * 256 + 64 * wm + 16 * (2 * ip + h2) + 4 * lg;
        gt[h2] = *(const float4*)(gp + col);
#pragma unroll
        for (int jn = 0; jn < 8; jn++) {
          const int tok = tok0 + 128 * wn + 16 * jn + lr;
          const float* xr = (l == 0) ? xin_row(p, tok) : p.out + (long)tok * D;
          xv[h2][jn] = *(const float4*)(xr + col);
        }
      }
#pragma unroll
      for (int h2 = 0; h2 < 2; h2++) {
        const int i = 2 * ip + h2;
        const int col = pt * 256 + 64 * wm + 16 * i + 4 * lg;
#pragma unroll
        for (int jn = 0; jn < 8; jn++) {
          const int tok = tok0 + 128 * wn + 16 * jn + lr;
          float4 o;
          o.x = xv[h2][jn].x + gt[h2].x * acc[i][jn][0]; o.y = xv[h2][jn].y + gt[h2].y * acc[i][jn][1];
          o.z = xv[h2][jn].z + gt[h2].z * acc[i][jn][2]; o.w = xv[h2][jn].w + gt[h2].w * acc[i][jn][3];
          *(float4*)(p.out + (long)tok * D + col) = o;
        }
      }
    }
  }
}

__global__ void __launch_bounds__(NT) mega(Params p) {
  extern __shared__ __attribute__((aligned(16))) char smem[];
  cg::grid_group grid = cg::this_grid();
  const int nG = p.G;
  __shared__ uint4 xb_words;
  volatile LAS unsigned* xb_st = (volatile LAS unsigned*)&xb_words;
  Params* pg;
  unsigned* xbar;
  {
    const Ctx c0 = make_ctx(p);
    unsigned char* q = (unsigned char*)c0.ctr + 4096;
    xbar = (unsigned*)q; q += XCD_BAR_WORDS * 4;
    pg = (Params*)q;
    if (blockIdx.x == 0 && threadIdx.x == 0) *pg = p;
    if (threadIdx.x == 0) xb_words = make_uint4(0u, 0u, 0u, 0u);
    __syncthreads();
    if (blockIdx.x == 0) for (int i = threadIdx.x; i < XCD_BAR_WORDS; i += NT) xbar[i] = 0u;
    phase_prep(p, c0, (float*)smem);
  }
  grid.sync();
  { XcdBarrier xb0 = xcd_barrier_post(xbar, xb_st); (void)xb0; }
#define PH(call) { const CParams* q_ = launder_params(pg); const CParams& P_ = *q_; const Ctx c = make_ctx(P_); call; }
#define BAR() { const CParams* q_ = launder_params(pg); const Ctx c = make_ctx(*q_); XcdBarrier xb; xb.bar = (unsigned*)((unsigned char*)c.ctr + 4096); xb.x = xb_xcc_id(); xb.st = xb_st; xcd_barrier(xb); }
  for (int g = 0; g < nG; ++g) {
    for (int l = 0; l < DEPTH; ++l) {
      PH(phase_rows(P_, c, l, g, false)); BAR();
      PH(phase_A(P_, c, l, (u16*)smem)); BAR();
      PH(phase_scan(P_, c, g * DEPTH + l, smem)); BAR();
      PH(phase_C(P_, c, l, (u16*)smem)); BAR();
      PH(phase_E(P_, c, l)); BAR();
      PH(phase_D1(P_, c, l, (u16*)smem)); BAR();
      PH(phase_D2(P_, c, l, g, (u16*)smem)); BAR();
    }
    PH(phase_rows(P_, c, DEPTH, g, true));
  }
}

extern "C" void kernel_launch(void* const* d_in, const int* in_sizes, int n_in, void* d_out, int out_size,
                              void* d_ws, size_t ws_size, hipStream_t stream) {
  static int grid_blocks = 0;
  static int Gsel = 2;
  if (!grid_blocks) {
    int dev = 0, cus = 0, per_cu = 0;
    hipGetDevice(&dev);
    hipDeviceGetAttribute(&cus, hipDeviceAttributeMultiprocessorCount, dev);
    hipFuncSetAttribute((const void*)mega, hipFuncAttributeMaxDynamicSharedMemorySize, LDS_BYTES);
    hipOccupancyMaxActiveBlocksPerMultiprocessor(&per_cu, (const void*)mega, NT, LDS_BYTES);
    if (per_cu < 1) per_cu = 1;
    grid_blocks = cus * per_cu;
    const size_t fixed = (size_t)DEPTH * WROWS * D * 2 + (size_t)DEPTH * 40 * 3072 * 4 + 4096 + XCD_BAR_WORDS * 4 + 1024;
    Gsel = 2;
    while (Gsel < 8 && 7 * ((size_t)(131072 / Gsel) * D * 2) + fixed + (size_t)(131072 / Gsel) * 96 > ws_size) Gsel *= 2;
  }
  Params p{};
  p.x_prompt = (const float*)d_in[0]; p.x_sample = (const float*)d_in[1]; p.c_prompt = (const float*)d_in[2]; p.c_sample = (const float*)d_in[3];
  p.w_ada = (const float*)d_in[4]; p.b_ada = (const float*)d_in[5]; p.norm_g = (const float*)d_in[6]; p.w_in = (const float*)d_in[7];
  p.b_gates = (const float*)d_in[8]; p.conv_w = (const float*)d_in[9]; p.conv_b = (const float*)d_in[10]; p.mh_norm_g = (const float*)d_in[11];
  p.w_pc = (const float*)d_in[12]; p.w_pm = (const float*)d_in[13]; p.w_out = (const float*)d_in[14]; p.final_g = (const float*)d_in[15];
  p.out = (float*)d_out; p.ws = (unsigned char*)d_ws; p.G = Gsel; p.pad = 0;
  void* args[] = {&p};
  hipError_t e = hipLaunchCooperativeKernel((const void*)mega, dim3(grid_blocks), dim3(NT), args, LDS_BYTES, stream);
  if (e != hipSuccess) fprintf(stderr, "cooperative launch failed: %s (grid %d)\n", hipGetErrorString(e), grid_blocks);
}
```

```cpp
#include <hip/hip_runtime.h>
#include <hip/hip_cooperative_groups.h>
#include <cstdio>
namespace cg = cooperative_groups;

typedef unsigned short u16;
using bf16x8 = __attribute__((ext_vector_type(8))) short;
using f32x4  = __attribute__((ext_vector_type(4))) float;
using s16x4  = __attribute__((ext_vector_type(4))) short;
using u32x4  = __attribute__((ext_vector_type(4))) unsigned;
using u32x2  = __attribute__((ext_vector_type(2))) unsigned;
#define DI __device__ __forceinline__

constexpr int D = 1024, DIN = 11280, DEPTH = 4;
constexpr int NT = 512;
constexpr int W_QKV = 0, W_C = 3328, W_G = 9472, W_PC = 11520, W_PM = 12544, W_O = 13568, WROWS = 14592;
constexpr int LDT = 72;
constexpr int KS = 264, VS = 136;
constexpr int LDS_BYTES = (128 * KS + 2 * 80 * VS + 80 * KS) * 2 + 4 * 128 * 4;

struct Params {
  const float* x_prompt; const float* x_sample; const float* c_prompt; const float* c_sample;
  const float* w_ada; const float* b_ada; const float* norm_g; const float* w_in; const float* b_gates;
  const float* conv_w; const float* conv_b; const float* mh_norm_g; const float* w_pc; const float* w_pm;
  const float* w_out; const float* final_g;
  float* out; unsigned char* ws;
  int G; int pad;
};

struct Ctx {
  int G, Tg, half;
  u16 *Rh, *R1, *R2, *R3, *R4, *Rhf, *Rhb;
  u16* W; float* mod; float* sc; int* ctr;
};

DI u16 f2bf(float x) { unsigned u = __float_as_uint(x); u += 0x7fffu + ((u >> 16) & 1u); return (u16)(u >> 16); }
DI float bf2f(unsigned h) { return __uint_as_float(h << 16); }
typedef __bf16 bf16x2_t __attribute__((ext_vector_type(2)));
typedef float f32x2_t __attribute__((ext_vector_type(2)));
DI unsigned pack2(float a, float b) { const f32x2_t v = {a, b}; return __builtin_bit_cast(unsigned, __builtin_convertvector(v, bf16x2_t)); }
DI uint2 pack4(float a, float b, float c, float d) { uint2 r; r.x = pack2(a, b); r.y = pack2(c, d); return r; }
DI uint2 pack4v(f32x4 v) { return pack4(v[0], v[1], v[2], v[3]); }
DI float4 unpack4(uint2 v) { float4 r; r.x = bf2f(v.x & 0xffffu); r.y = bf2f(v.x >> 16); r.z = bf2f(v.y & 0xffffu); r.w = bf2f(v.y >> 16); return r; }
DI float sigmoidf_(float x) { return __builtin_amdgcn_rcpf(1.f + __expf(-x)); }
DI float siluf_(float x) { return x * sigmoidf_(x); }
DI float wave_sum(float v) {
#pragma unroll
  for (int o = 32; o >= 1; o >>= 1) v += __shfl_xor(v, o);
  return v;
}
DI int opaque_tid() { int t = threadIdx.x; asm volatile("" : "+v"(t)); return t; }
DI f32x4 mfma16(bf16x8 a, bf16x8 b, f32x4 c) { return __builtin_amdgcn_mfma_f32_16x16x32_bf16(a, b, c, 0, 0, 0); }


typedef const Params __attribute__((address_space(4))) CParams;
template <class PT> DI Ctx make_ctx(const PT& p) {
  Ctx c;
  c.G = p.G; c.Tg = 131072 / p.G; c.half = c.Tg >> 1;
  const size_t REG = (size_t)c.Tg * D * 2;
  unsigned char* ws = p.ws;
  c.Rh = (u16*)(ws); c.R1 = (u16*)(ws + REG); c.R2 = (u16*)(ws + 2 * REG); c.R3 = (u16*)(ws + 3 * REG);
  c.R4 = (u16*)(ws + 4 * REG); c.Rhf = (u16*)(ws + 5 * REG); c.Rhb = (u16*)(ws + 6 * REG);
  unsigned char* q = ws + 7 * REG;
  c.W = (u16*)q; q += (size_t)DEPTH * WROWS * D * 2;
  c.mod = (float*)q; q += (size_t)DEPTH * 40 * 3072 * 4;
  c.sc = (float*)q; q += (size_t)c.Tg * 96;
  c.ctr = (int*)q;
  return c;
}
DI const CParams* launder_params(const Params* g) { asm volatile("" : "+s"(g)); return (const CParams*)(unsigned long long)g; }
DI int gtok(const Ctx& c, int g, int lt) { return lt < c.half ? g * c.half + lt : 65536 + g * c.half + (lt - c.half); }
DI int batch_of(int tok) { return tok < 65536 ? (tok >> 13) : 8 + ((tok - 65536) >> 11); }
template <class PT> DI const float* xin_row(const PT& p, int tok) {
  return tok < 65536 ? p.x_prompt + (long)tok * D : p.x_sample + (long)(tok - 65536) * D;
}


#define XB_TMO      128
#define XB_XCNT(j)  (256  + 64 * (j))
#define XB_XSUB(j)  (1280 + 64 * (j))
#define XB_XGEN(j)  (2304 + 64 * (j))
#define XB_TOP      3328
#define XB_TOPGEN   3392
#define XCD_BAR_WORDS 3456
#define XB_SPIN_CAP (1u << 18)
#define LAS __attribute__((address_space(3)))
DI unsigned xb_ld(unsigned* p)              { return __hip_atomic_load(p, __ATOMIC_RELAXED, __HIP_MEMORY_SCOPE_AGENT); }
DI unsigned xb_add(unsigned* p, unsigned v) { return __hip_atomic_fetch_add(p, v, __ATOMIC_RELAXED, __HIP_MEMORY_SCOPE_AGENT); }
DI unsigned xb_xcc_id() { return (unsigned)__builtin_amdgcn_s_getreg((3 << 11) | 20) & 0xFu; }
#define XB_SPIN(cond, bar) do { unsigned _sp = 0; while (cond) { __builtin_amdgcn_s_sleep(1); \
    if ((++_sp & 255u) == 0u) { if (xb_ld(&(bar)[XB_TMO])) break; if (_sp > XB_SPIN_CAP) { atomicAdd(&(bar)[XB_TMO], 1u); break; } } } } while (0)
struct XcdBarrier { unsigned* bar; unsigned x; volatile LAS unsigned* st; };
DI XcdBarrier xcd_barrier_post(unsigned* bar, volatile LAS unsigned* st) {
  XcdBarrier b; b.bar = bar; b.x = xb_xcc_id(); b.st = st;
  if (threadIdx.x == 0) (void)xb_add(&bar[XB_XCNT(b.x)], 1u);
  return b;
}
DI void xcd_barrier_complete(unsigned* bar, unsigned x, unsigned& nloc, unsigned& nx) {
  const unsigned G = gridDim.x * gridDim.y * gridDim.z;
  unsigned sum, cnt, mine, sp = 0u;
  for (;;) {
    sum = 0u; cnt = 0u; mine = 0u;
#pragma unroll
    for (unsigned j = 0; j < 16; ++j) { const unsigned c = xb_ld(&bar[XB_XCNT(j)]); sum += c; cnt += (c > 0u) ? 1u : 0u; }
    mine = xb_ld(&bar[XB_XCNT(x)]);
    if (sum == G) break;
    __builtin_amdgcn_s_sleep(1);
    if ((++sp & 255u) == 0u) { if (xb_ld(&bar[XB_TMO])) break; if (sp > XB_SPIN_CAP) { atomicAdd(&bar[XB_TMO], 1u); break; } }
  }
  nloc = mine > 0u ? mine : 1u; nx = cnt > 0u ? cnt : 1u;
}
DI void xcd_barrier(const XcdBarrier& b) {
  asm volatile("s_waitcnt vmcnt(0)" ::: "memory");
  __syncthreads();
  if (threadIdx.x == 0) {
    unsigned* bar = b.bar;
    asm volatile("" : "+s"(bar));
    __builtin_amdgcn_s_waitcnt(0);
    unsigned nloc = b.st[0], nx = b.st[1];
    if (nloc == 0u) { xcd_barrier_complete(bar, b.x, nloc, nx); b.st[0] = nloc; b.st[1] = nx; }
    const unsigned old = xb_add(&bar[XB_XSUB(b.x)], 1u);
    const unsigned gen = old / nloc;
    if (old + 1u == (gen + 1u) * nloc) {
      __builtin_amdgcn_fence(__ATOMIC_RELEASE, "agent");
      asm volatile("s_waitcnt vmcnt(0)" ::: "memory");
      const unsigned og = xb_add(&bar[XB_TOP], 1u);
      const unsigned tg = og / nx;
      if (og + 1u == (tg + 1u) * nx) xb_add(&bar[XB_TOPGEN], 1u);
      else XB_SPIN(xb_ld(&bar[XB_TOPGEN]) == tg, bar);
      __builtin_amdgcn_fence(__ATOMIC_ACQUIRE, "agent");
      xb_add(&bar[XB_XGEN(b.x)], 1u);
      asm volatile("s_waitcnt vmcnt(0)" ::: "memory");
    } else {
      XB_SPIN(xb_ld(&bar[XB_XGEN(b.x)]) == gen, bar);
      __builtin_amdgcn_fence(__ATOMIC_ACQUIRE, "agent");
      asm volatile("s_waitcnt vmcnt(0)" ::: "memory");
    }
  }
  __syncthreads();
}

template <int MT, int NT, int ST>
DI void gemm_tile(const u16* __restrict__ P, const u16* __restrict__ Q, f32x4 (&acc)[MT][NT], u16* lds,
                  const u16* Pn = nullptr, const u16* Qn = nullptr, bool primed = false, int* ringp = nullptr) {
  const int tid = opaque_tid(), lane = tid & 63, wave = __builtin_amdgcn_readfirstlane(tid >> 6), wm = wave & 3, wn = wave >> 2;
  const int lr = lane & 15, lg = lane >> 4;
  constexpr int PROWS = 64 * MT, QROWS = 32 * NT, NQI = NT / 2, NDMA = MT + NQI;
  char* pbase = (char*)lds;
  char* qbase = pbase + ST * PROWS * 128;
  const int drow = lane >> 3, dpos = lane & 7;
  const int r0 = 8 * wave + drow;
  const unsigned voff = (unsigned)(r0 * D + ((dpos ^ ((r0 >> 1) & 7)) << 3)) * 2u;
  const char* Pc = (const char*)P; const char* Qc = (const char*)Q;
  char* dp = pbase + wave * 1024 + lane * 16;
  char* dq = qbase + wave * 1024 + lane * 16;
#pragma unroll
  for (int i = 0; i < MT; i++)
#pragma unroll
    for (int j = 0; j < NT; j++) acc[i][j] = (f32x4){0.f, 0.f, 0.f, 0.f};
  const int ring0 = (ST == 3 && ringp) ? *ringp : 0;
  if (!primed) {
#pragma unroll
    for (int t0 = 0; t0 < ST - 1; t0++) {
      int bi = ring0 + t0; if (bi >= ST) bi -= ST;
#pragma unroll
      for (int i = 0; i < MT; i++) __builtin_amdgcn_global_load_lds((const unsigned*)(Pc + (i * 64 * D * 2 + t0 * 128) + voff), (unsigned*)(dp + bi * PROWS * 128 + i * 8192), 16, 0, 0);
#pragma unroll
      for (int i = 0; i < NQI; i++) __builtin_amdgcn_global_load_lds((const unsigned*)(Qc + (i * 64 * D * 2 + t0 * 128) + voff), (unsigned*)(dq + bi * QROWS * 128 + i * 8192), 16, 0, 0);
    }
  }
  if (primed) asm volatile("s_waitcnt vmcnt(0)" ::: "memory");
  else asm volatile("s_waitcnt vmcnt(%0)" :: "n"((ST - 2) * NDMA) : "memory");
  __builtin_amdgcn_s_barrier();
  asm volatile("" ::: "memory");
  const int swz = (lr >> 1) & 7;
  const int o0 = (lg ^ swz) << 4, o1 = ((4 + lg) ^ swz) << 4;
  const char* pa = pbase + (wm * 16 * MT + lr) * 128;
  const char* qa = qbase + (wn * 16 * NT + lr) * 128;
  constexpr int NK = D / 64;
  int cur = ring0, nxs = ring0 + ST - 1; if (nxs >= ST) nxs -= ST;
  for (int kt = 0; kt < NK; ++kt) {
    if (kt + ST - 1 < NK) {
#pragma unroll
      for (int i = 0; i < MT; i++) __builtin_amdgcn_global_load_lds((const unsigned*)(Pc + (i * 64 * D * 2 + (kt + ST - 1) * 128) + voff), (unsigned*)(dp + nxs * PROWS * 128 + i * 8192), 16, 0, 0);
#pragma unroll
      for (int i = 0; i < NQI; i++) __builtin_amdgcn_global_load_lds((const unsigned*)(Qc + (i * 64 * D * 2 + (kt + ST - 1) * 128) + voff), (unsigned*)(dq + nxs * QROWS * 128 + i * 8192), 16, 0, 0);
    }
    if (ST == 3 && kt >= NK - 2 && Pn != nullptr) {
      const char* Pnc = (const char*)Pn + (kt - (NK - 2)) * 128; const char* Qnc = (const char*)Qn + (kt - (NK - 2)) * 128;
#pragma unroll
      for (int i = 0; i < MT; i++) __builtin_amdgcn_global_load_lds((const unsigned*)(Pnc + (i * 64 * D * 2) + voff), (unsigned*)(dp + nxs * PROWS * 128 + i * 8192), 16, 0, 0);
#pragma unroll
      for (int i = 0; i < NQI; i++) __builtin_amdgcn_global_load_lds((const unsigned*)(Qnc + (i * 64 * D * 2) + voff), (unsigned*)(dq + nxs * QROWS * 128 + i * 8192), 16, 0, 0);
    }
    if (ST == 2 && kt == NK - 1 && Pn != nullptr) {
      const char* Pnc = (const char*)Pn; const char* Qnc = (const char*)Qn;
#pragma unroll
      for (int i = 0; i < MT; i++) __builtin_amdgcn_global_load_lds((const unsigned*)(Pnc + (i * 64 * D * 2) + voff), (unsigned*)(dp + i * 8192), 16, 0, 0);
#pragma unroll
      for (int i = 0; i < NQI; i++) __builtin_amdgcn_global_load_lds((const unsigned*)(Qnc + (i * 64 * D * 2) + voff), (unsigned*)(dq + i * 8192), 16, 0, 0);
    }
    const char* pb = pa + cur * PROWS * 128;
    const char* qb = qa + cur * QROWS * 128;
    if constexpr (NT == 99) {
      bf16x8 af[MT], b0[NT], b1[NT];
#pragma unroll
      for (int j = 0; j < NT; j++) b0[j] = *(const bf16x8*)(qb + j * 2048 + o0);
#pragma unroll
      for (int i = 0; i < MT; i++) af[i] = *(const bf16x8*)(pb + i * 2048 + o0);
      __builtin_amdgcn_s_setprio(1);
#pragma unroll
      for (int i = 0; i < MT; i++) {
#pragma unroll
        for (int j = 0; j < NT; j++) acc[i][j] = mfma16(af[i], b0[j], acc[i][j]);
        b1[i] = *(const bf16x8*)(qb + i * 2048 + o1);
        af[i] = *(const bf16x8*)(pb + i * 2048 + o1);
      }
#pragma unroll
      for (int j = MT; j < NT; j++) b1[j] = *(const bf16x8*)(qb + j * 2048 + o1);
#pragma unroll
      for (int i = 0; i < MT; i++)
#pragma unroll
        for (int j = 0; j < NT; j++) acc[i][j] = mfma16(af[i], b1[j], acc[i][j]);
      __builtin_amdgcn_sched_group_barrier(0x100, NT + MT, 0);
#pragma unroll
      for (int r = 0; r < MT; r++) {
        __builtin_amdgcn_sched_group_barrier(0x008, 4, 0);
        __builtin_amdgcn_sched_group_barrier(0x100, 1, 0);
        __builtin_amdgcn_sched_group_barrier(0x008, 4, 0);
        __builtin_amdgcn_sched_group_barrier(0x100, 1, 0);
      }
      __builtin_amdgcn_sched_group_barrier(0x100, NT - MT, 0);
      __builtin_amdgcn_sched_group_barrier(0x008, MT * NT, 0);
      __builtin_amdgcn_s_setprio(0);
    } else {
#pragma unroll
      for (int ks = 0; ks < 2; ++ks) {
        const int oo = ks ? o1 : o0;
        bf16x8 a[MT], b[NT];
#pragma unroll
        for (int i = 0; i < MT; i++) a[i] = *(const bf16x8*)(pb + i * 2048 + oo);
#pragma unroll
        for (int j = 0; j < NT; j++) b[j] = *(const bf16x8*)(qb + j * 2048 + oo);
        __builtin_amdgcn_s_setprio(1);
#pragma unroll
        for (int i = 0; i < MT; i++)
#pragma unroll
          for (int j = 0; j < NT; j++) acc[i][j] = mfma16(a[i], b[j], acc[i][j]);
        __builtin_amdgcn_s_setprio(0);
      }
    }
    if (kt + ST - 1 < NK) asm volatile("s_waitcnt vmcnt(%0)" :: "n"((ST - 2) * NDMA) : "memory");
    else if (ST == 3 && Pn != nullptr) { if (kt == NK - 2) asm volatile("s_waitcnt vmcnt(%0)" :: "n"(NDMA) : "memory"); }
    else if (!(ST == 2 && Pn != nullptr)) asm volatile("s_waitcnt vmcnt(0)" ::: "memory");
    __builtin_amdgcn_s_barrier();
    asm volatile("" ::: "memory");
    cur = (cur == ST - 1) ? 0 : cur + 1;
    nxs = (nxs == ST - 1) ? 0 : nxs + 1;
  }
  if (ST == 3 && ringp) *ringp = cur;
}

template <class PT> DI void wsrc(const PT& p, int l, int n, const float*& src, int& ld, int& col, float& scale) {
  scale = 1.f;
  src = p.w_in + (long)l * D * DIN; ld = DIN;
  if (n < W_C) {
    if (n < 1024) col = 4096 + n;
    else if (n < 2048) { col = 5120 + (n - 1024); scale = 0.0625f; }
    else if (n < 3072) col = 6144 + (n - 2048);
    else if (n < 3088) col = 9216 + (n - 3072);
    else col = -1;
  } else if (n < W_G) {
    int n2 = n - W_C;
    if (n2 < 4096) { int blk = n2 >> 6, sl = (n2 >> 4) & 3, cl = n2 & 15; col = sl * 1024 + blk * 16 + cl; }
    else { int n3 = n2 - 4096; int blk = n3 >> 5, sl = (n3 >> 4) & 1, cl = n3 & 15; col = (sl ? 8192 : 7168) + blk * 16 + cl; }
  } else if (n < W_PC) {
    int n4 = n - W_G; int mtb = n4 >> 9, r5 = n4 & 511; int cc5 = r5 >> 8, wm5 = (r5 >> 6) & 3, a5 = (r5 >> 5) & 1, sl = (r5 >> 4) & 1, cl = r5 & 15;
    col = 9232 + sl * 1024 + (256 * mtb + 64 * wm5 + 32 * cc5 + 16 * a5 + cl);
  } else if (n < W_PM) { src = p.w_pc + (long)l * D * D; ld = D; col = n - W_PC; }
  else if (n < W_O)  { src = p.w_pm + (long)l * D * D; ld = D; col = n - W_PM; }
  else               { src = p.w_out + (long)l * D * D; ld = D; col = n - W_O; }
}

template <class PT> DI void phase_prep(const PT& p, const Ctx& c, float* ldsf) {
  const int tid = opaque_tid();
  if (blockIdx.x == 0 && tid < 256) c.ctr[tid] = 0;
  const int nItems = DEPTH * (WROWS / 64) * 16;
  for (int it = blockIdx.x; it < nItems; it += gridDim.x) {
    const int kb = (it & 15) * 64; const int rb = it >> 4;
    const int l = rb / (WROWS / 64); const int nb = (rb % (WROWS / 64)) * 64;
    const float* src; int ld, col; float scale;
    const int nl = tid & 63;
    wsrc(p, l, nb + nl, src, ld, col, scale);
#pragma unroll
    for (int i = 0; i < 8; i++) {
      const int kl = (tid >> 6) + 8 * i;
      float v = (col >= 0) ? src[(long)(kb + kl) * ld + col] * scale : 0.f;
      ldsf[kl * 65 + nl] = v;
    }
    __syncthreads();
    {
      const int nl2 = tid >> 3, kc = tid & 7;
      float v[8];
#pragma unroll
      for (int j = 0; j < 8; j++) v[j] = ldsf[(kc * 8 + j) * 65 + nl2];
      uint4 o; o.x = pack2(v[0], v[1]); o.y = pack2(v[2], v[3]); o.z = pack2(v[4], v[5]); o.w = pack2(v[6], v[7]);
      *(uint4*)(c.W + ((long)l * WROWS + nb + nl2) * D + kb + kc * 8) = o;
    }
    __syncthreads();
  }
  const int nMod = DEPTH * 48;
  for (int it = blockIdx.x; it < nMod; it += gridDim.x) {
    const int l = it / 48, jb = (it % 48) * 64;
    const int cl = tid & 63, kc = tid >> 6;
    float acc[40];
#pragma unroll
    for (int b = 0; b < 40; b++) acc[b] = 0.f;
    const float* wa = p.w_ada + (long)l * D * 3072 + jb + cl;
    for (int k = kc * 128; k < kc * 128 + 128; ++k) {
      const float wv = wa[(long)k * 3072];
#pragma unroll
      for (int b = 0; b < 40; b++) {
        const float cv = (b < 8) ? p.c_prompt[b * D + k] : p.c_sample[(b - 8) * D + k];
        acc[b] += cv * wv;
      }
    }
#pragma unroll
    for (int b = 0; b < 40; b++) ldsf[(kc * 40 + b) * 64 + cl] = acc[b];
    __syncthreads();
    for (int idx = tid; idx < 40 * 64; idx += NT) {
      const int b = idx >> 6, cc = idx & 63;
      float s = p.b_ada[l * 3072 + jb + cc];
#pragma unroll
      for (int q = 0; q < 8; q++) s += ldsf[(q * 40 + b) * 64 + cc];
      c.mod[((long)l * 40 + b) * 3072 + jb + cc] = s;
    }
    __syncthreads();
  }
}

template <class PT> DI void phase_rows(const PT& p, const Ctx& c, int l, int g, bool fin) {
  const int tid_ = opaque_tid(); const int lane = tid_ & 63, w = tid_ >> 6;
  const int stride = gridDim.x * 8;
  float4 gv[4];
#pragma unroll
  for (int i = 0; i < 4; i++) gv[i] = *(const float4*)((fin ? p.final_g : p.norm_g + l * D) + 4 * lane + 256 * i);
  for (int lt0 = blockIdx.x * 8 + w; lt0 < c.Tg; lt0 += 2 * stride) {
    const bool has1 = lt0 + stride < c.Tg;
    const int lt1 = has1 ? lt0 + stride : lt0;
    const int tok0 = gtok(c, g, lt0), tok1 = gtok(c, g, lt1);
    const float* xr0 = (l == 0) ? xin_row(p, tok0) : p.out + (long)tok0 * D;
    const float* xr1 = (l == 0) ? xin_row(p, tok1) : p.out + (long)tok1 * D;
    float4 v0[4], v1[4]; float ss0 = 0.f, ss1 = 0.f;
#pragma unroll
    for (int i = 0; i < 4; i++) { v0[i] = *(const float4*)(xr0 + 4 * lane + 256 * i); v1[i] = *(const float4*)(xr1 + 4 * lane + 256 * i); }
    const float* mp0 = c.mod + ((long)(fin ? 0 : l) * 40 + batch_of(tok0)) * 3072;
    const float* mp1 = c.mod + ((long)(fin ? 0 : l) * 40 + batch_of(tok1)) * 3072;
    float4 sc0[4], sh0[4], sc1[4], sh1[4];
    if (!fin) {
#pragma unroll
      for (int i = 0; i < 4; i++) {
        const int k = 4 * lane + 256 * i;
        sc0[i] = *(const float4*)(mp0 + 1024 + k); sh0[i] = *(const float4*)(mp0 + k);
        sc1[i] = *(const float4*)(mp1 + 1024 + k); sh1[i] = *(const float4*)(mp1 + k);
      }
    }
#pragma unroll
    for (int i = 0; i < 4; i++) {
      ss0 += v0[i].x * v0[i].x + v0[i].y * v0[i].y + v0[i].z * v0[i].z + v0[i].w * v0[i].w;
      ss1 += v1[i].x * v1[i].x + v1[i].y * v1[i].y + v1[i].z * v1[i].z + v1[i].w * v1[i].w;
    }
    ss0 = wave_sum(ss0); ss1 = wave_sum(ss1);
    const float r0 = rsqrtf(ss0 * (1.f / 1024.f) + 1e-6f), r1 = rsqrtf(ss1 * (1.f / 1024.f) + 1e-6f);
    if (fin) {
#pragma unroll
      for (int i = 0; i < 4; i++) {
        const int k = 4 * lane + 256 * i;
        float4 o; o.x = v0[i].x * r0 * gv[i].x; o.y = v0[i].y * r0 * gv[i].y; o.z = v0[i].z * r0 * gv[i].z; o.w = v0[i].w * r0 * gv[i].w;
        *(float4*)(p.out + (long)tok0 * D + k) = o;
      }
      if (has1) {
#pragma unroll
        for (int i = 0; i < 4; i++) {
          const int k = 4 * lane + 256 * i;
          float4 o; o.x = v1[i].x * r1 * gv[i].x; o.y = v1[i].y * r1 * gv[i].y; o.z = v1[i].z * r1 * gv[i].z; o.w = v1[i].w * r1 * gv[i].w;
          *(float4*)(p.out + (long)tok1 * D + k) = o;
        }
      }
    } else {
#pragma unroll
      for (int i = 0; i < 4; i++) {
        const int k = 4 * lane + 256 * i;
        *(uint2*)(c.Rh + (long)lt0 * D + k) = pack4(v0[i].x * r0 * gv[i].x * (1.f + sc0[i].x) + sh0[i].x, v0[i].y * r0 * gv[i].y * (1.f + sc0[i].y) + sh0[i].y,
                                                    v0[i].z * r0 * gv[i].z * (1.f + sc0[i].z) + sh0[i].z, v0[i].w * r0 * gv[i].w * (1.f + sc0[i].w) + sh0[i].w);
      }
      if (has1) {
#pragma unroll
        for (int i = 0; i < 4; i++) {
          const int k = 4 * lane + 256 * i;
          *(uint2*)(c.Rh + (long)lt1 * D + k) = pack4(v1[i].x * r1 * gv[i].x * (1.f + sc1[i].x) + sh1[i].x, v1[i].y * r1 * gv[i].y * (1.f + sc1[i].y) + sh1[i].y,
                                                      v1[i].z * r1 * gv[i].z * (1.f + sc1[i].z) + sh1[i].z, v1[i].w * r1 * gv[i].w * (1.f + sc1[i].w) + sh1[i].w);
        }
      }
    }
  }
}

template <class PT> DI void phase_A(const PT& p, const Ctx& c, int l, u16* lds) {
  const int tid = opaque_tid(), lane = tid & 63, wave = tid >> 6, wm = wave & 3, wn = wave >> 2, lr = lane & 15, lg = lane >> 4;
  const u16* W = c.W + (long)l * WROWS * D;
  u16* Rq = c.R1; u16* Rk = c.R2; u16* RvT = c.R4;
  const int nTiles = (c.Tg / 256) * 13;
  auto ptrsA = [&](int tl, const u16*& Pp, const u16*& Qp) {
    const int m_ = tl >> 3, tb_ = (m_ / 52) * 32 + ((m_ % 52) & 3) * 8 + (tl & 7), j_ = (m_ % 52) >> 2;
    const u16* hp = c.Rh + (long)tb_ * 256 * D;
    if (j_ < 8) { Pp = W + (long)((j_ >> 2) * 1024 + (j_ & 3) * 256) * D; Qp = hp; }
    else if (j_ < 12) { Pp = hp; Qp = W + (long)(2048 + (j_ - 8) * 256) * D; }
    else { Pp = W + (long)3072 * D; Qp = hp; }
  };
  bool primed = false;
  for (int tile = blockIdx.x; tile < nTiles; tile += gridDim.x) {
    const int m0_ = tile >> 3, tb = (m0_ / 52) * 32 + ((m0_ % 52) & 3) * 8 + (tile & 7), j = (m0_ % 52) >> 2;
    f32x4 acc[4][8];
    const u16 *P0, *Q0, *P1 = nullptr, *Q1 = nullptr;
    ptrsA(tile, P0, Q0);
    if (tile + (int)gridDim.x < nTiles && j != 12 && ((((tile + (int)gridDim.x) >> 3) % 52) >> 2) != 12) ptrsA(tile + gridDim.x, P1, Q1);
    const bool pr = primed; primed = (P1 != nullptr);
    if (j < 8) {
      const int isk = j >> 2, head = j & 3;
      gemm_tile<4, 8, 2>(P0, Q0, acc, lds, P1, Q1, pr);
      u16* dst = isk ? Rk : Rq;
#pragma unroll
      for (int i = 0; i < 4; i++)
#pragma unroll
        for (int jn = 0; jn < 8; jn++) {
          const int d = 64 * wm + 16 * i + 4 * lg, t = 128 * wn + 16 * jn + lr;
          *(uint2*)(dst + (long)(tb * 256 + t) * D + head * 256 + d) = pack4v(acc[i][jn]);
        }
    } else if (j < 12) {
      const int head = j - 8;
      gemm_tile<4, 8, 2>(P0, Q0, acc, lds, P1, Q1, pr);
#pragma unroll
      for (int i = 0; i < 4; i++)
#pragma unroll
        for (int jn = 0; jn < 8; jn++) {
          const int tokl = 64 * wm + 16 * i + 4 * lg, e = 128 * wn + 16 * jn + lr;
          const int ch = tb * 2 + (tokl >> 7), sidx = tokl & 127;
          *(uint2*)(RvT + ((long)(ch * 4 + head) * 256 + e) * 128 + sidx) = pack4v(acc[i][jn]);
        }
    } else {
      f32x4 accg[1][8];
      gemm_tile<1, 8, 2>(P0, Q0, accg, lds);
      float* gl = (float*)lds;
      if (wm == 0) {
#pragma unroll
        for (int jn = 0; jn < 8; jn++) {
          const int t = 128 * wn + 16 * jn + lr;
#pragma unroll
          for (int r = 0; r < 4; r++) {
            float v = accg[0][jn][r] + p.b_gates[l * 16 + lg * 4 + r];
            if (lg & 1) v = fminf(v, 0.f) - log1pf(expf(-fabsf(v)));
            gl[t * 16 + lg * 4 + r] = v;
          }
        }
      }
      __syncthreads();
      if (tid < 16) {
        const int head = tid & 3, dir = (tid >> 2) & 1, cl = tid >> 3;
        const int ch = tb * 2 + cl;
        float* o = c.sc + (((long)(ch * 4 + head) * 2 + dir) * 3) * 128;
        const float* glc = gl + cl * 128 * 16;
        float bs = 0.f, pm = -3.0e38f;
        for (int q = 0; q < 128; ++q) {
          const int t = dir ? 127 - q : q;
          const float iv = glc[t * 16 + dir * 8 + head], lf = glc[t * 16 + dir * 8 + 4 + head];
          bs += lf; const float gg = iv - bs; pm = fmaxf(pm, gg);
          o[t] = bs; o[128 + t] = gg; o[256 + t] = pm;
        }
      }
      __syncthreads();
    }
  }
}

template <class PT> DI void phase_scan(const PT& p, const Ctx& c, int ctrIdx, char* smem) {
  __shared__ int s_task;
  const int tid = opaque_tid(), lane = tid & 63, w0 = __builtin_amdgcn_readfirstlane(tid >> 6), lr = lane & 15, lg = lane >> 4;
  u16* Kb = (u16*)smem;
  u16* Vt = Kb + 128 * KS;
  u16* Vw = Vt + 80 * VS;
  u16* Ct = Vw + 80 * VS;
  float* scg = (float*)(Ct + 80 * KS); float* scmu = scg + 128; float* sciw = scmu + 128; float* scfl = sciw + 128;
  const u16* Rq = c.R1; const u16* Rk = c.R2; const u16* RvT = c.R4;
  const int nLong = (8 / c.G) * 32;
  const int nLongQ8 = (8 / c.G), nShortQ8 = (32 / c.G);
  const int perQueue = (nLongQ8 + nShortQ8) * 4;
  int* ctr = c.ctr + ctrIdx * 8;
  const int myq = (int)(xb_xcc_id() & 7u);
  int qoff = 0;
  while (true) {
    __syncthreads();
    if (tid == 0) {
      int t = -1;
      while (qoff < 8) {
        const int qi = (myq + qoff) & 7;
        const int n = atomicAdd(ctr + qi, 1);
        if (n < perQueue) {
          const int quad = (n < nLongQ8 * 4) ? qi + 8 * (n >> 2) : nLongQ8 * 8 + qi + 8 * ((n - nLongQ8 * 4) >> 2);
          t = quad * 4 + (n & 3);
          break;
        }
        ++qoff;
      }
      s_task = t;
    }
    __syncthreads();
    const int task = s_task;
    if (task < 0) break;
    int seq, r, chunk0, nc;
    if (task < nLong) { seq = task >> 5; r = task & 31; chunk0 = seq * 64; nc = 64; }
    else { const int t2 = task - nLong; seq = t2 >> 5; r = t2 & 31; chunk0 = (c.half >> 7) + seq * 16; nc = 16; }
    const int head = r >> 3, dir = (r >> 2) & 1, es = r & 3;
    const int last = dir ? 0 : 127;
    u16* Rho = dir ? c.Rhb : c.Rhf;
    for (int idx = tid; idx < 80 * KS / 2; idx += NT) ((unsigned*)Ct)[idx] = 0u;
    for (int idx = tid; idx < 16 * VS / 2; idx += NT) { ((unsigned*)(Vt + 64 * VS))[idx] = 0u; ((unsigned*)(Vw + 64 * VS))[idx] = 0u; }
    __syncthreads();
    if (tid < 128) Vt[64 * VS + tid] = (u16)0x3F80;
    f32x4 st[2][5];
#pragma unroll
    for (int i = 0; i < 2; i++)
#pragma unroll
      for (int jn = 0; jn < 5; jn++) st[i][jn] = (f32x4){0.f, 0.f, 0.f, 0.f};
    float m = 0.f;
    const int vrow = tid >> 4, vsc = tid & 15;
    const int krow = tid >> 5, kkc = (tid & 31) * 8;
    u32x4 kpre[8], vpre[2]; float4 g8a, g8b; float bLn, gmaxn, myb, myg, mypm;
    bf16x8 qf[8];
    auto scan_load = [&](int cq) {
#pragma unroll
      for (int ks = 0; ks < 8; ks++)
        qf[ks] = *(const bf16x8*)(Rq + (long)(cq * 128 + 16 * w0 + lr) * D + head * 256 + 32 * ks + 8 * lg);
#pragma unroll
      for (int i = 0; i < 8; i++) kpre[i] = *(const u32x4*)(Rk + (long)(cq * 128 + krow + 16 * i) * D + head * 256 + kkc);
#pragma unroll
      for (int i = 0; i < 2; i++) vpre[i] = *(const u32x4*)(RvT + ((long)(cq * 4 + head) * 256 + es * 64 + vrow + 32 * i) * 128 + vsc * 8);
      const float* scb = c.sc + ((long)(cq * 4 + head) * 2 + dir) * 384;
      g8a = *(const float4*)(scb + 128 + vsc * 8); g8b = *(const float4*)(scb + 128 + vsc * 8 + 4);
      bLn = scb[last]; gmaxn = scb[256 + last];
      myb = scb[tid & 127]; myg = scb[128 + (tid & 127)]; mypm = scb[256 + (tid & 127)];
    };
    scan_load(chunk0 + (dir ? nc - 1 : 0));
    for (int j = 0; j < nc; ++j) {
      const int cc = chunk0 + (dir ? nc - 1 - j : j);
      int w = w0; asm volatile("" : "+s"(w));
      __syncthreads();
      const float muL = fmaxf(m, gmaxn);
      const float decay = __expf(m - muL);
      const float mnext = bLn + muL;
#pragma unroll
      for (int i = 0; i < 2; i++)
#pragma unroll
        for (int jn = 0; jn < 5; jn++)
          *(uint2*)(Ct + (16 * jn + lr) * KS + 32 * w + 16 * i + 4 * lg) = pack4v(st[i][jn]);
#pragma unroll
      for (int i = 0; i < 8; i++) *(u32x4*)(Kb + (krow + 16 * i) * KS + kkc) = kpre[i];
      {
        float w8[8];
        w8[0] = __expf(g8a.x - muL); w8[1] = __expf(g8a.y - muL); w8[2] = __expf(g8a.z - muL); w8[3] = __expf(g8a.w - muL);
        w8[4] = __expf(g8b.x - muL); w8[5] = __expf(g8b.y - muL); w8[6] = __expf(g8b.z - muL); w8[7] = __expf(g8b.w - muL);
#pragma unroll
        for (int i = 0; i < 2; i++) {
          const u32x4 vv = vpre[i];
          *(u32x4*)(Vt + (vrow + 32 * i) * VS + vsc * 8) = vv;
          uint4 v; v.x = vv[0]; v.y = vv[1]; v.z = vv[2]; v.w = vv[3];
          uint4 o;
          o.x = pack2(bf2f(v.x & 0xffffu) * w8[0], bf2f(v.x >> 16) * w8[1]);
          o.y = pack2(bf2f(v.y & 0xffffu) * w8[2], bf2f(v.y >> 16) * w8[3]);
          o.z = pack2(bf2f(v.z & 0xffffu) * w8[4], bf2f(v.z >> 16) * w8[5]);
          o.w = pack2(bf2f(v.w & 0xffffu) * w8[6], bf2f(v.w >> 16) * w8[7]);
          *(uint4*)(Vw + (vrow + 32 * i) * VS + vsc * 8) = o;
        }
        if (tid < 16) {
          uint4 o; o.x = pack2(w8[0], w8[1]); o.y = pack2(w8[2], w8[3]); o.z = pack2(w8[4], w8[5]); o.w = pack2(w8[6], w8[7]);
          *(uint4*)(Vw + 64 * VS + vsc * 8) = o;
        }
      }
      if (tid < 128) {
        const float mu = fmaxf(m, mypm);
        scg[tid] = myg; scmu[tid] = mu; sciw[tid] = __expf(m - mu); scfl[tid] = __expf(-(mu + myb));
      }
      __syncthreads();
      const int t = 16 * w + lr;
      bf16x8 spk[4];
      {
        f32x4 sacc[8];
#pragma unroll
        for (int i = 0; i < 8; i++) sacc[i] = (f32x4){0.f, 0.f, 0.f, 0.f};
#pragma unroll
        for (int i = 0; i < 8; i++) {
          const bool need = dir ? (i >= w) : (i <= w);
          if (need) {
#pragma unroll
            for (int ks = 0; ks < 8; ks++) {
              const bf16x8 a = *(const bf16x8*)(Kb + (16 * i + lr) * KS + 32 * ks + 8 * lg);
              sacc[i] = mfma16(a, qf[ks], sacc[i]);
            }
          }
        }
        const float mu_t = scmu[t];
        int tt = t; asm volatile("" : "+v"(tt));
        const int sgn = dir ? -1 : 1;
#pragma unroll
        for (int ks = 0; ks < 4; ks++) {
          float sv[8];
#pragma unroll
          for (int hh = 0; hh < 2; hh++) {
            const int i = 2 * ks + hh;
            const float4 gs = *(const float4*)(scg + 16 * i + 4 * lg);
            const float gv[4] = {gs.x, gs.y, gs.z, gs.w};
#pragma unroll
            for (int r2 = 0; r2 < 4; r2++) {
              const int s = 16 * i + 4 * lg + r2;
              const bool valid = (s - tt) * sgn <= 0;
              sv[hh * 4 + r2] = valid ? sacc[i][r2] * __expf(gv[r2] - mu_t) : 0.f;
            }
          }
          uint4 o; o.x = pack2(sv[0], sv[1]); o.y = pack2(sv[2], sv[3]); o.z = pack2(sv[4], sv[5]); o.w = pack2(sv[6], sv[7]);
          spk[ks] = __builtin_bit_cast(bf16x8, o);
        }
      }
      f32x4 num[5];
#pragma unroll
      for (int i = 0; i < 5; i++) num[i] = (f32x4){0.f, 0.f, 0.f, 0.f};
#pragma unroll
      for (int ks = 0; ks < 8; ks++)
#pragma unroll
        for (int i = 0; i < 5; i++) {
          const bf16x8 a = *(const bf16x8*)(Ct + (16 * i + lr) * KS + 32 * ks + 8 * lg);
          num[i] = mfma16(a, qf[ks], num[i]);
        }
      {
        const float iw = sciw[t];
#pragma unroll
        for (int i = 0; i < 5; i++) num[i] *= iw;
      }
#pragma unroll
      for (int ks = 0; ks < 4; ks++) {
        const bool need = dir ? (2 * ks + 1 >= w) : (2 * ks <= w);
        if (need) {
#pragma unroll
          for (int i = 0; i < 5; i++) {
            const uint2 lo = *(const uint2*)(Vt + (16 * i + lr) * VS + 32 * ks + 4 * lg);
            const uint2 hi = *(const uint2*)(Vt + (16 * i + lr) * VS + 32 * ks + 16 + 4 * lg);
            uint4 av; av.x = lo.x; av.y = lo.y; av.z = hi.x; av.w = hi.y;
            num[i] = mfma16(__builtin_bit_cast(bf16x8, av), spk[ks], num[i]);
          }
        }
      }
      {
        const float fl = scfl[t];
        const float dr = __shfl(num[4][0], lr);
        const float inv = 1.f / fmaxf(fabsf(dr), fl);
        u16* dst = Rho + (long)(cc * 128 + t) * D + head * 256 + es * 64 + 4 * lg;
#pragma unroll
        for (int i = 0; i < 4; i++)
          *(uint2*)(dst + 16 * i) = pack4(num[i][0] * inv, num[i][1] * inv, num[i][2] * inv, num[i][3] * inv);
      }
      __builtin_amdgcn_sched_barrier(0);
      { const int jn1 = (j + 1 < nc) ? j + 1 : j; scan_load(chunk0 + (dir ? nc - 1 - jn1 : jn1)); }
      __builtin_amdgcn_sched_barrier(0);
#pragma unroll
      for (int i = 0; i < 2; i++)
#pragma unroll
        for (int jn = 0; jn < 5; jn++) st[i][jn] *= decay;
#pragma unroll
      for (int ks = 0; ks < 4; ks++) {
        bf16x8 kTf[2];
#pragma unroll
        for (int i = 0; i < 2; i++) {
          const u16* ap = Kb + (32 * ks + 8 * lg + (lr >> 2)) * KS + 32 * w + 16 * i + 4 * (lr & 3);
          const s16x4 lo = __builtin_amdgcn_ds_read_tr16_b64_v4i16((s16x4 __attribute__((address_space(3)))*)ap);
          const s16x4 hi = __builtin_amdgcn_ds_read_tr16_b64_v4i16((s16x4 __attribute__((address_space(3)))*)(ap + 4 * KS));
          kTf[i] = __builtin_shufflevector(lo, hi, 0, 1, 2, 3, 4, 5, 6, 7);
        }
#pragma unroll
        for (int jn = 0; jn < 5; jn++) {
          const bf16x8 b = *(const bf16x8*)(Vw + (16 * jn + lr) * VS + 32 * ks + 8 * lg);
#pragma unroll
          for (int i = 0; i < 2; i++) st[i][jn] = mfma16(kTf[i], b, st[i][jn]);
        }
      }
      m = mnext;
    }
  }
}

template <class PT> DI void phase_C(const PT& p, const Ctx& c, int l, u16* lds) {
  const int tid = opaque_tid(), lane = tid & 63, wave = tid >> 6, wm = wave & 3, wn = wave >> 2, lr = lane & 15, lg = lane >> 4;
  const u16* W = c.W + ((long)l * WROWS + W_C) * D;
  u16* Ru = c.R1; u16* Ryp = c.R2; u16* Rog = c.R3;
  const int nTiles = (c.Tg / 256) * 24;
  for (int tile = blockIdx.x; tile < nTiles; tile += gridDim.x) {
    const int tb = 2 * ((tile >> 3) / 6) + (tile & 1), pt = 6 * ((tile & 7) >> 1) + ((tile >> 3) % 6);
    f32x4 acc[4][8];
    {
      const int tn = tile + gridDim.x;
      const bool has = tn < nTiles;
      gemm_tile<4, 8, 2>(W + (long)pt * 256 * D, c.Rh + (long)tb * 256 * D, acc, lds,
                         has ? W + (long)(6 * ((tn & 7) >> 1) + ((tn >> 3) % 6)) * 256 * D : nullptr, has ? c.Rh + (long)(2 * ((tn >> 3) / 6) + (tn & 1)) * 256 * D : nullptr, tile != (int)blockIdx.x);
    }
    if (pt < 16) {
      const int chn = pt * 64 + wm * 16 + 4 * lg;
#pragma unroll
      for (int jn = 0; jn < 8; jn++) {
        const long lt = tb * 256 + 128 * wn + 16 * jn + lr;
        float u[4], y[4];
#pragma unroll
        for (int r = 0; r < 4; r++) { u[r] = acc[1][jn][r] * acc[2][jn][r]; y[r] = acc[0][jn][r] * siluf_(acc[3][jn][r]); }
        *(uint2*)(Ru + lt * D + chn) = pack4(u[0], u[1], u[2], u[3]);
        *(uint2*)(Ryp + lt * D + chn) = pack4(y[0], y[1], y[2], y[3]);
      }
    } else {
      const int chn = (pt - 16) * 128 + wm * 32 + 4 * lg;
#pragma unroll
      for (int jn = 0; jn < 8; jn++) {
        const long lt = tb * 256 + 128 * wn + 16 * jn + lr;
#pragma unroll
        for (int hh = 0; hh < 2; hh++) {
          float o[4];
#pragma unroll
          for (int r = 0; r < 4; r++) o[r] = sigmoidf_(acc[2 * hh][jn][r]) * siluf_(acc[2 * hh + 1][jn][r]);
          *(uint2*)(Rog + lt * D + chn + 16 * hh) = pack4(o[0], o[1], o[2], o[3]);
        }
      }
    }
  }
}

template <class PT> DI void phase_E(const PT& p, const Ctx& c, int l) {
  const int tid_ = opaque_tid(); const int lane = tid_ & 63, w = tid_ >> 6;
  const u16* Ru = c.R1; u16* Ryp = c.R2; u16* Rog = c.R3;
  const float* cw = p.conv_w + (long)l * 3 * D; const float* cb = p.conv_b + (long)l * D; const float* mg = p.mh_norm_g + (long)l * D;
  float4 w0[4], w1[4], w2[4], bb[4], gg[4];
#pragma unroll
  for (int i = 0; i < 4; i++) {
    const int k = 4 * lane + 256 * i;
    w0[i] = *(const float4*)(cw + k); w1[i] = *(const float4*)(cw + D + k); w2[i] = *(const float4*)(cw + 2 * D + k);
    bb[i] = *(const float4*)(cb + k); gg[i] = *(const float4*)(mg + k);
  }
  for (int lt = blockIdx.x * 8 + w; lt < c.Tg; lt += gridDim.x * 8) {
    const int sl = lt < c.half ? 8192 : 2048;
    const int pos = (lt < c.half ? lt : lt - c.half) & (sl - 1);
    const bool first = pos == 0, lastp = pos == sl - 1;
    uint2 U0[4], U1[4], U2[4], YP[4], OG[4], HF[4], HB[4];
#pragma unroll
    for (int i = 0; i < 4; i++) {
      const int k = 4 * lane + 256 * i;
      U0[i] = *(const uint2*)(Ru + (long)(first ? lt : lt - 1) * D + k);
      U1[i] = *(const uint2*)(Ru + (long)lt * D + k);
      U2[i] = *(const uint2*)(Ru + (long)(lastp ? lt : lt + 1) * D + k);
      if (first) { U0[i].x = 0u; U0[i].y = 0u; }
      if (lastp) { U2[i].x = 0u; U2[i].y = 0u; }
      YP[i] = *(const uint2*)(Ryp + (long)lt * D + k);
      OG[i] = *(const uint2*)(Rog + (long)lt * D + k);
      HF[i] = *(const uint2*)(c.Rhf + (long)lt * D + k);
      HB[i] = *(const uint2*)(c.Rhb + (long)lt * D + k);
    }
#pragma unroll
    for (int i = 0; i < 4; i++) {
      const int k = 4 * lane + 256 * i;
      const float4 a0 = unpack4(U0[i]), a1 = unpack4(U1[i]), a2 = unpack4(U2[i]), yp = unpack4(YP[i]);
      const float y0 = yp.x * (w0[i].x * a0.x + w1[i].x * a1.x + w2[i].x * a2.x + bb[i].x);
      const float y1 = yp.y * (w0[i].y * a0.y + w1[i].y * a1.y + w2[i].y * a2.y + bb[i].y);
      const float y2 = yp.z * (w0[i].z * a0.z + w1[i].z * a1.z + w2[i].z * a2.z + bb[i].z);
      const float y3 = yp.w * (w0[i].w * a0.w + w1[i].w * a1.w + w2[i].w * a2.w + bb[i].w);
      *(uint2*)(Ryp + (long)lt * D + k) = pack4(y0, y1, y2, y3);
      const float4 hf = unpack4(HF[i]), hb = unpack4(HB[i]), og = unpack4(OG[i]);
      const float s0 = hf.x + hb.x, s1 = hf.y + hb.y, s2 = hf.z + hb.z, s3 = hf.w + hb.w;
      const float ss = wave_sum(s0 * s0 + s1 * s1 + s2 * s2 + s3 * s3);
      const float rstd = rsqrtf(ss * (1.f / 256.f) + 1e-6f);
      *(uint2*)(Rog + (long)lt * D + k) = pack4(og.x * s0 * rstd * gg[i].x, og.y * s1 * rstd * gg[i].y, og.z * s2 * rstd * gg[i].z, og.w * s3 * rstd * gg[i].w);
    }
  }
}

template <class PT> DI void phase_D1(const PT& p, const Ctx& c, int l, u16* lds) {
  const int tid = opaque_tid(), lane = tid & 63, wave = tid >> 6, wm = wave & 3, wn = wave >> 2, lr = lane & 15, lg = lane >> 4;
  const u16* W = c.W + (long)l * WROWS * D;
  const u16* Ryc = c.R2; const u16* Rym = c.R3; u16* Rmg = c.R4;
  const int nTiles = (c.Tg / 128) * 4;
  int ring = 0;
  for (int tile = blockIdx.x; tile < nTiles; tile += gridDim.x) {
    const int ch = ((tile >> 5) << 3) + (tile & 7), mt = (tile >> 3) & 3;
    const u16* Pg = W + (long)(W_G + mt * 512) * D; const u16* Qh = c.Rh + (long)ch * 128 * D;
    const u16* Pc_ = W + (long)(W_PC + mt * 256) * D; const u16* Qc_ = Ryc + (long)ch * 128 * D;
    const u16* Pm_ = W + (long)(W_PM + mt * 256) * D; const u16* Qm_ = Rym + (long)ch * 128 * D;
    const int tn = tile + gridDim.x; const bool hasn = tn < nTiles;
    const u16* Pnx = hasn ? W + (long)(W_G + ((tn >> 3) & 3) * 512) * D : nullptr; const u16* Qnx = hasn ? c.Rh + (long)(((tn >> 5) << 3) + (tn & 7)) * 128 * D : nullptr;
    u32x2 gk[2][4][4], Mk[4][4];
#pragma unroll
    for (int cc = 0; cc < 2; cc++) {
      f32x4 a1[4][4];
      if (cc == 0) gemm_tile<4, 4, 3>(Pg, Qh, a1, lds, Pg + (long)256 * D, Qh, tile != (int)blockIdx.x, &ring);
      else gemm_tile<4, 4, 3>(Pg + (long)256 * D, Qh, a1, lds, Pc_, Qc_, true, &ring);
#pragma unroll
      for (int i = 0; i < 4; i++)
#pragma unroll
        for (int jn = 0; jn < 4; jn++) {
          const uint2 t_ = pack4(sigmoidf_(a1[i][jn][0]), sigmoidf_(a1[i][jn][1]), sigmoidf_(a1[i][jn][2]), sigmoidf_(a1[i][jn][3]));
          gk[cc][i][jn] = (u32x2){t_.x, t_.y}; asm volatile("" : "+v"(gk[cc][i][jn]));
        }
    }
    {
      f32x4 a2[4][4];
      gemm_tile<4, 4, 3>(Pc_, Qc_, a2, lds, Pm_, Qm_, true, &ring);
#pragma unroll
      for (int i = 0; i < 4; i++)
#pragma unroll
        for (int jn = 0; jn < 4; jn++) {
          uint2 g_; g_.x = gk[i >> 1][2 * (i & 1)][jn][0]; g_.y = gk[i >> 1][2 * (i & 1)][jn][1];
          const float4 gg = unpack4(g_);
          const uint2 t_ = pack4(gg.x * a2[i][jn][0], gg.y * a2[i][jn][1], gg.z * a2[i][jn][2], gg.w * a2[i][jn][3]);
          Mk[i][jn] = (u32x2){t_.x, t_.y}; asm volatile("" : "+v"(Mk[i][jn]));
        }
    }
    {
      f32x4 a2[4][4];
      gemm_tile<4, 4, 3>(Pm_, Qm_, a2, lds, Pnx, Qnx, true, &ring);
#pragma unroll
      for (int i = 0; i < 4; i++)
#pragma unroll
        for (int jn = 0; jn < 4; jn++) {
          uint2 g_; g_.x = gk[i >> 1][2 * (i & 1) + 1][jn][0]; g_.y = gk[i >> 1][2 * (i & 1) + 1][jn][1];
          uint2 m_; m_.x = Mk[i][jn][0]; m_.y = Mk[i][jn][1];
          const float4 gg = unpack4(g_);
          const float4 mm = unpack4(m_);
          const int col = mt * 256 + 64 * wm + 16 * i + 4 * lg;
          const long lt = ch * 128 + 64 * wn + 16 * jn + lr;
          *(uint2*)(Rmg + lt * D + col) = pack4(mm.x + gg.x * a2[i][jn][0], mm.y + gg.y * a2[i][jn][1],
                                                mm.z + gg.z * a2[i][jn][2], mm.w + gg.w * a2[i][jn][3]);
        }
    }
  }
}

template <class PT> DI void phase_D2(const PT& p, const Ctx& c, int l, int g, u16* lds) {
  const int tid = opaque_tid(), lane = tid & 63, wave = tid >> 6, wm = wave & 3, wn = wave >> 2, lr = lane & 15, lg = lane >> 4;
  const u16* W = c.W + ((long)l * WROWS + W_O) * D;
  const u16* Rmg = c.R4;
  const int nTiles = (c.Tg / 256) * 4;
  for (int tile = blockIdx.x; tile < nTiles; tile += gridDim.x) {
    const int tb = (tile >> 5) * 8 + (tile & 7), pt = (tile >> 3) & 3;
    f32x4 acc[4][8];
    {
      const int tn = tile + gridDim.x;
      const bool has = tn < nTiles;
      gemm_tile<4, 8, 2>(W + (long)pt * 256 * D, Rmg + (long)tb * 256 * D, acc, lds,
                         has ? W + (long)((tn >> 3) & 3) * 256 * D : nullptr, has ? Rmg + (long)((tn >> 5) * 8 + (tn & 7)) * 256 * D : nullptr, tile != (int)blockIdx.x);
    }
    const int tok0 = gtok(c, g, tb * 256);
    const float* gp = c.mod + ((long)l * 40 + batch_of(tok0)) * 3072 + 2048;
#pragma unroll
    for (int ip = 0; ip < 2; ip++) {
      float4 xv[2][8], gt[2];
#pragma unroll
      for (int h2 = 0; h2 < 2; h2++) {
        const int col = pt * 256 + 64 * wm + 16 * (2 * ip + h2) + 4 * lg;
        gt[h2] = *(const float4*)(gp + col);
#pragma unroll
        for (int jn = 0; jn < 8; jn++) {
          const int tok = tok0 + 128 * wn + 16 * jn + lr;
          const float* xr = (l == 0) ? xin_row(p, tok) : p.out + (long)tok * D;
          xv[h2][jn] = *(const float4*)(xr + col);
        }
      }
#pragma unroll
      for (int h2 = 0; h2 < 2; h2++) {
        const int i = 2 * ip + h2;
        const int col = pt * 256 + 64 * wm + 16 * i + 4 * lg;
#pragma unroll
        for (int jn = 0; jn < 8; jn++) {
          const int tok = tok0 + 128 * wn + 16 * jn + lr;
          float4 o;
          o.x = xv[h2][jn].x + gt[h2].x * acc[i][jn][0]; o.y = xv[h2][jn].y + gt[h2].y * acc[i][jn][1];
          o.z = xv[h2][jn].z + gt[h2].z * acc[i][jn][2]; o.w = xv[h2][jn].w + gt[h2].w * acc[i][jn][3];
          *(float4*)(p.out + (long)tok * D + col) = o;
        }
      }
    }
  }
}

__global__ void __launch_bounds__(NT) mega(Params p) {
  extern __shared__ __attribute__((aligned(16))) char smem[];
  cg::grid_group grid = cg::this_grid();
  const int nG = p.G;
  __shared__ uint4 xb_words;
  volatile LAS unsigned* xb_st = (volatile LAS unsigned*)&xb_words;
  Params* pg;
  unsigned* xbar;
  {
    const Ctx c0 = make_ctx(p);
    unsigned char* q = (unsigned char*)c0.ctr + 4096;
    xbar = (unsigned*)q; q += XCD_BAR_WORDS * 4;
    pg = (Params*)q;
    if (blockIdx.x == 0 && threadIdx.x == 0) *pg = p;
    if (threadIdx.x == 0) xb_words = make_uint4(0u, 0u, 0u, 0u);
    __syncthreads();
    if (blockIdx.x == 0) for (int i = threadIdx.x; i < XCD_BAR_WORDS; i += NT) xbar[i] = 0u;
    phase_prep(p, c0, (float*)smem);
  }
  grid.sync();
  { XcdBarrier xb0 = xcd_barrier_post(xbar, xb_st); (void)xb0; }
#define PH(call) { const CParams* q_ = launder_params(pg); const CParams& P_ = *q_; const Ctx c = make_ctx(P_); call; }
#define BAR() { const CParams* q_ = launder_params(pg); const Ctx c = make_ctx(*q_); XcdBarrier xb; xb.bar = (unsigned*)((unsigned char*)c.ctr + 4096); xb.x = xb_xcc_id(); xb.st = xb_st; xcd_barrier(xb); }
  for (int g = 0; g < nG; ++g) {
    for (int l = 0; l < DEPTH; ++l) {
      PH(phase_rows(P_, c, l, g, false)); BAR();
      PH(phase_A(P_, c, l, (u16*)smem)); BAR();
      PH(phase_scan(P_, c, g * DEPTH + l, smem)); BAR();
      PH(phase_C(P_, c, l, (u16*)smem)); BAR();
      PH(phase_E(P_, c, l)); BAR();
      PH(phase_D1(P_, c, l, (u16*)smem)); BAR();
      PH(phase_D2(P_, c, l, g, (u16*)smem)); BAR();
    }
    PH(phase_rows(P_, c, DEPTH, g, true));
  }
}

extern "C" void kernel_launch(void* const* d_in, const int* in_sizes, int n_in, void* d_out, int out_size,
                              void* d_ws, size_t ws_size, hipStream_t stream) {
  static int grid_blocks = 0;
  static int Gsel = 2;
  if (!grid_blocks) {
    int dev = 0, cus = 0, per_cu = 0;
    hipGetDevice(&dev);
    hipDeviceGetAttribute(&cus, hipDeviceAttributeMultiprocessorCount, dev);
    hipFuncSetAttribute((const void*)mega, hipFuncAttributeMaxDynamicSharedMemorySize, LDS_BYTES);
    hipOccupancyMaxActiveBlocksPerMultiprocessor(&per_cu, (const void*)mega, NT, LDS_BYTES);
    if (per_cu < 1) per_cu = 1;
    grid_blocks = cus * per_cu;
    const size_t fixed = (size_t)DEPTH * WROWS * D * 2 + (size_t)DEPTH * 40 * 3072 * 4 + 4096 + XCD_BAR_WORDS * 4 + 1024;
    Gsel = 2;
    while (Gsel < 8 && 7 * ((size_t)(131072 / Gsel) * D * 2) + fixed + (size_t)(131072 / Gsel) * 96 > ws_size) Gsel *= 2;
  }
  Params p{};
  p.x_prompt = (const float*)d_in[0]; p.x_sample = (const float*)d_in[1]; p.c_prompt = (const float*)d_in[2]; p.c_sample = (const float*)d_in[3];
  p.w_ada = (const float*)d_in[4]; p.b_ada = (const float*)d_in[5]; p.norm_g = (const float*)d_in[6]; p.w_in = (const float*)d_in[7];
  p.b_gates = (const float*)d_in[8]; p.conv_w = (const float*)d_in[9]; p.conv_b = (const float*)d_in[10]; p.mh_norm_g = (const float*)d_in[11];
  p.w_pc = (const float*)d_in[12]; p.w_pm = (const float*)d_in[13]; p.w_out = (const float*)d_in[14]; p.final_g = (const float*)d_in[15];
  p.out = (float*)d_out; p.ws = (unsigned char*)d_ws; p.G = Gsel; p.pad = 0;
  void* args[] = {&p};
  hipError_t e = hipLaunchCooperativeKernel((const void*)mega, dim3(grid_blocks), dim3(NT), args, LDS_BYTES, stream);
  if (e != hipSuccess) fprintf(stderr, "cooperative launch failed: %s (grid %d)\n", hipGetErrorString(e), grid_blocks);
}
```

```cpp
#include <hip/hip_runtime.h>
#include <hip/hip_cooperative_groups.h>
#include <cstdio>
namespace cg = cooperative_groups;

typedef unsigned short u16;
using bf16x8 = __attribute__((ext_vector_type(8))) short;
using f32x4  = __attribute__((ext_vector_type(4))) float;
using s16x4  = __attribute__((ext_vector_type(4))) short;
using u32x4  = __attribute__((ext_vector_type(4))) unsigned;
using u32x2  = __attribute__((ext_vector_type(2))) unsigned;
#define DI __device__ __forceinline__

constexpr int D = 1024, DIN = 11280, DEPTH = 4;
constexpr int NT = 512;
constexpr int W_QKV = 0, W_C = 3328, W_G = 9472, W_PC = 11520, W_PM = 12544, W_O = 13568, WROWS = 14592;
constexpr int LDT = 72;
constexpr int KS = 264, VS = 136;
constexpr int LDS_BYTES = (128 * KS + 2 * 80 * VS + 80 * KS) * 2 + 4 * 128 * 4;

struct Params {
  const float* x_prompt; const float* x_sample; const float* c_prompt; const float* c_sample;
  const float* w_ada; const float* b_ada; const float* norm_g; const float* w_in; const float* b_gates;
  const float* conv_w; const float* conv_b; const float* mh_norm_g; const float* w_pc; const float* w_pm;
  const float* w_out; const float* final_g;
  float* out; unsigned char* ws;
  int G; int pad;
};

struct Ctx {
  int G, Tg, half;
  u16 *Rh, *R1, *R2, *R3, *R4, *Rhf, *Rhb;
  u16* W; float* mod; float* sc; int* ctr;
};

DI u16 f2bf(float x) { unsigned u = __float_as_uint(x); u += 0x7fffu + ((u >> 16) & 1u); return (u16)(u >> 16); }
DI float bf2f(unsigned h) { return __uint_as_float(h << 16); }
typedef __bf16 bf16x2_t __attribute__((ext_vector_type(2)));
typedef float f32x2_t __attribute__((ext_vector_type(2)));
DI unsigned pack2(float a, float b) { const f32x2_t v = {a, b}; return __builtin_bit_cast(unsigned, __builtin_convertvector(v, bf16x2_t)); }
DI uint2 pack4(float a, float b, float c, float d) { uint2 r; r.x = pack2(a, b); r.y = pack2(c, d); return r; }
DI uint2 pack4v(f32x4 v) { return pack4(v[0], v[1], v[2], v[3]); }
DI float4 unpack4(uint2 v) { float4 r; r.x = bf2f(v.x & 0xffffu); r.y = bf2f(v.x >> 16); r.z = bf2f(v.y & 0xffffu); r.w = bf2f(v.y >> 16); return r; }
DI float sigmoidf_(float x) { return __builtin_amdgcn_rcpf(1.f + __expf(-x)); }
DI float siluf_(float x) { return x * sigmoidf_(x); }
DI float wave_sum(float v) {
#pragma unroll
  for (int o = 32; o >= 1; o >>= 1) v += __shfl_xor(v, o);
  return v;
}
DI int opaque_tid() { int t = threadIdx.x; asm volatile("" : "+v"(t)); return t; }
DI f32x4 mfma16(bf16x8 a, bf16x8 b, f32x4 c) { return __builtin_amdgcn_mfma_f32_16x16x32_bf16(a, b, c, 0, 0, 0); }


typedef const Params __attribute__((address_space(4))) CParams;
template <class PT> DI Ctx make_ctx(const PT& p) {
  Ctx c;
  c.G = p.G; c.Tg = 131072 / p.G; c.half = c.Tg >> 1;
  const size_t REG = (size_t)c.Tg * D * 2;
  unsigned char* ws = p.ws;
  c.Rh = (u16*)(ws); c.R1 = (u16*)(ws + REG); c.R2 = (u16*)(ws + 2 * REG); c.R3 = (u16*)(ws + 3 * REG);
  c.R4 = (u16*)(ws + 4 * REG); c.Rhf = (u16*)(ws + 5 * REG); c.Rhb = (u16*)(ws + 6 * REG);
  unsigned char* q = ws + 7 * REG;
  c.W = (u16*)q; q += (size_t)DEPTH * WROWS * D * 2;
  c.mod = (float*)q; q += (size_t)DEPTH * 40 * 3072 * 4;
  c.sc = (float*)q; q += (size_t)c.Tg * 96;
  c.ctr = (int*)q;
  return c;
}
DI const CParams* launder_params(const Params* g) { asm volatile("" : "+s"(g)); return (const CParams*)(unsigned long long)g; }
DI int gtok(const Ctx& c, int g, int lt) { return lt < c.half ? g * c.half + lt : 65536 + g * c.half + (lt - c.half); }
DI int batch_of(int tok) { return tok < 65536 ? (tok >> 13) : 8 + ((tok - 65536) >> 11); }
template <class PT> DI const float* xin_row(const PT& p, int tok) {
  return tok < 65536 ? p.x_prompt + (long)tok * D : p.x_sample + (long)(tok - 65536) * D;
}


#define XB_TMO      128
#define XB_XCNT(j)  (256  + 64 * (j))
#define XB_XSUB(j)  (1280 + 64 * (j))
#define XB_XGEN(j)  (2304 + 64 * (j))
#define XB_TOP      3328
#define XB_TOPGEN   3392
#define XCD_BAR_WORDS 3456
#define XB_SPIN_CAP (1u << 18)
#define LAS __attribute__((address_space(3)))
DI unsigned xb_ld(unsigned* p)              { return __hip_atomic_load(p, __ATOMIC_RELAXED, __HIP_MEMORY_SCOPE_AGENT); }
DI unsigned xb_add(unsigned* p, unsigned v) { return __hip_atomic_fetch_add(p, v, __ATOMIC_RELAXED, __HIP_MEMORY_SCOPE_AGENT); }
DI unsigned xb_xcc_id() { return (unsigned)__builtin_amdgcn_s_getreg((3 << 11) | 20) & 0xFu; }
#define XB_SPIN(cond, bar) do { unsigned _sp = 0; while (cond) { __builtin_amdgcn_s_sleep(1); \
    if ((++_sp & 255u) == 0u) { if (xb_ld(&(bar)[XB_TMO])) break; if (_sp > XB_SPIN_CAP) { atomicAdd(&(bar)[XB_TMO], 1u); break; } } } } while (0)
struct XcdBarrier { unsigned* bar; unsigned x; volatile LAS unsigned* st; };
DI XcdBarrier xcd_barrier_post(unsigned* bar, volatile LAS unsigned* st) {
  XcdBarrier b; b.bar = bar; b.x = xb_xcc_id(); b.st = st;
  if (threadIdx.x == 0) (void)xb_add(&bar[XB_XCNT(b.x)], 1u);
  return b;
}
DI void xcd_barrier_complete(unsigned* bar, unsigned x, unsigned& nloc, unsigned& nx) {
  const unsigned G = gridDim.x * gridDim.y * gridDim.z;
  unsigned sum, cnt, mine, sp = 0u;
  for (;;) {
    sum = 0u; cnt = 0u; mine = 0u;
#pragma unroll
    for (unsigned j = 0; j < 16; ++j) { const unsigned c = xb_ld(&bar[XB_XCNT(j)]); sum += c; cnt += (c > 0u) ? 1u : 0u; }
    mine = xb_ld(&bar[XB_XCNT(x)]);
    if (sum == G) break;
    __builtin_amdgcn_s_sleep(1);
    if ((++sp & 255u) == 0u) { if (xb_ld(&bar[XB_TMO])) break; if (sp > XB_SPIN_CAP) { atomicAdd(&bar[XB_TMO], 1u); break; } }
  }
  nloc = mine > 0u ? mine : 1u; nx = cnt > 0u ? cnt : 1u;
}
DI void xcd_barrier(const XcdBarrier& b) {
  asm volatile("s_waitcnt vmcnt(0)" ::: "memory");
  __syncthreads();
  if (threadIdx.x == 0) {
    unsigned* bar = b.bar;
    asm volatile("" : "+s"(bar));
    __builtin_amdgcn_s_waitcnt(0);
    unsigned nloc = b.st[0], nx = b.st[1];
    if (nloc == 0u) { xcd_barrier_complete(bar, b.x, nloc, nx); b.st[0] = nloc; b.st[1] = nx; }
    const unsigned old = xb_add(&bar[XB_XSUB(b.x)], 1u);
    const unsigned gen = old / nloc;
    if (old + 1u == (gen + 1u) * nloc) {
      __builtin_amdgcn_fence(__ATOMIC_RELEASE, "agent");
      asm volatile("s_waitcnt vmcnt(0)" ::: "memory");
      const unsigned og = xb_add(&bar[XB_TOP], 1u);
      const unsigned tg = og / nx;
      if (og + 1u == (tg + 1u) * nx) xb_add(&bar[XB_TOPGEN], 1u);
      else XB_SPIN(xb_ld(&bar[XB_TOPGEN]) == tg, bar);
      __builtin_amdgcn_fence(__ATOMIC_ACQUIRE, "agent");
      xb_add(&bar[XB_XGEN(b.x)], 1u);
      asm volatile("s_waitcnt vmcnt(0)" ::: "memory");
    } else {
      XB_SPIN(xb_ld(&bar[XB_XGEN(b.x)]) == gen, bar);
      __builtin_amdgcn_fence(__ATOMIC_ACQUIRE, "agent");
      asm volatile("s_waitcnt vmcnt(0)" ::: "memory");
    }
  }
  __syncthreads();
}

template <int MT, int NT, int ST>
DI void gemm_tile(const u16* __restrict__ P, const u16* __restrict__ Q, f32x4 (&acc)[MT][NT], u16* lds,
                  const u16* Pn = nullptr, const u16* Qn = nullptr, bool primed = false, int* ringp = nullptr) {
  const int tid = opaque_tid(), lane = tid & 63, wave = __builtin_amdgcn_readfirstlane(tid >> 6), wm = wave & 3, wn = wave >> 2;
  const int lr = lane & 15, lg = lane >> 4;
  constexpr int PROWS = 64 * MT, QROWS = 32 * NT, NQI = NT / 2, NDMA = MT + NQI;
  char* pbase = (char*)lds;
  char* qbase = pbase + ST * PROWS * 128;
  const int drow = lane >> 3, dpos = lane & 7;
  const int r0 = 8 * wave + drow;
  const unsigned voff = (unsigned)(r0 * D + ((dpos ^ ((r0 >> 1) & 7)) << 3)) * 2u;
  const char* Pc = (const char*)P; const char* Qc = (const char*)Q;
  char* dp = pbase + wave * 1024 + lane * 16;
  char* dq = qbase + wave * 1024 + lane * 16;
#pragma unroll
  for (int i = 0; i < MT; i++)
#pragma unroll
    for (int j = 0; j < NT; j++) acc[i][j] = (f32x4){0.f, 0.f, 0.f, 0.f};
  const int ring0 = (ST == 3 && ringp) ? *ringp : 0;
  if (!primed) {
#pragma unroll
    for (int t0 = 0; t0 < ST - 1; t0++) {
      int bi = ring0 + t0; if (bi >= ST) bi -= ST;
#pragma unroll
      for (int i = 0; i < MT; i++) __builtin_amdgcn_global_load_lds((const unsigned*)(Pc + (i * 64 * D * 2 + t0 * 128) + voff), (unsigned*)(dp + bi * PROWS * 128 + i * 8192), 16, 0, 0);
#pragma unroll
      for (int i = 0; i < NQI; i++) __builtin_amdgcn_global_load_lds((const unsigned*)(Qc + (i * 64 * D * 2 + t0 * 128) + voff), (unsigned*)(dq + bi * QROWS * 128 + i * 8192), 16, 0, 0);
    }
  }
  if (primed) asm volatile("s_waitcnt vmcnt(0)" ::: "memory");
  else asm volatile("s_waitcnt vmcnt(%0)" :: "n"((ST - 2) * NDMA) : "memory");
  __builtin_amdgcn_s_barrier();
  asm volatile("" ::: "memory");
  const int swz = (lr >> 1) & 7;
  const int o0 = (lg ^ swz) << 4, o1 = ((4 + lg) ^ swz) << 4;
  const char* pa = pbase + (wm * 16 * MT + lr) * 128;
  const char* qa = qbase + (wn * 16 * NT + lr) * 128;
  constexpr int NK = D / 64;
  int cur = ring0, nxs = ring0 + ST - 1; if (nxs >= ST) nxs -= ST;
  for (int kt = 0; kt < NK; ++kt) {
    if (kt + ST - 1 < NK) {
#pragma unroll
      for (int i = 0; i < MT; i++) __builtin_amdgcn_global_load_lds((const unsigned*)(Pc + (i * 64 * D * 2 + (kt + ST - 1) * 128) + voff), (unsigned*)(dp + nxs * PROWS * 128 + i * 8192), 16, 0, 0);
#pragma unroll
      for (int i = 0; i < NQI; i++) __builtin_amdgcn_global_load_lds((const unsigned*)(Qc + (i * 64 * D * 2 + (kt + ST - 1) * 128) + voff), (unsigned*)(dq + nxs * QROWS * 128 + i * 8192), 16, 0, 0);
    }
    if (ST == 3 && kt >= NK - 2 && Pn != nullptr) {
      const char* Pnc = (const char*)Pn + (kt - (NK - 2)) * 128; const char* Qnc = (const char*)Qn + (kt - (NK - 2)) * 128;
#pragma unroll
      for (int i = 0; i < MT; i++) __builtin_amdgcn_global_load_lds((const unsigned*)(Pnc + (i * 64 * D * 2) + voff), (unsigned*)(dp + nxs * PROWS * 128 + i * 8192), 16, 0, 0);
#pragma unroll
      for (int i = 0; i < NQI; i++) __builtin_amdgcn_global_load_lds((const unsigned*)(Qnc + (i * 64 * D * 2) + voff), (unsigned*)(dq + nxs * QROWS * 128 + i * 8192), 16, 0, 0);
    }
    if (ST == 2 && kt == NK - 1 && Pn != nullptr) {
      const char* Pnc = (const char*)Pn; const char* Qnc = (const char*)Qn;
#pragma unroll
      for (int i = 0; i < MT; i++) __builtin_amdgcn_global_load_lds((const unsigned*)(Pnc + (i * 64 * D * 2) + voff), (unsigned*)(dp + i * 8192), 16, 0, 0);
#pragma unroll
      for (int i = 0; i < NQI; i++) __builtin_amdgcn_global_load_lds((const unsigned*)(Qnc + (i * 64 * D * 2) + voff), (unsigned*)(dq + i * 8192), 16, 0, 0);
    }
    const char* pb = pa + cur * PROWS * 128;
    const char* qb = qa + cur * QROWS * 128;
    if constexpr (NT == 99) {
      bf16x8 af[MT], b0[NT], b1[NT];
#pragma unroll
      for (int j = 0; j < NT; j++) b0[j] = *(const bf16x8*)(qb + j * 2048 + o0);
#pragma unroll
      for (int i = 0; i < MT; i++) af[i] = *(const bf16x8*)(pb + i * 2048 + o0);
      __builtin_amdgcn_s_setprio(1);
#pragma unroll
      for (int i = 0; i < MT; i++) {
#pragma unroll
        for (int j = 0; j < NT; j++) acc[i][j] = mfma16(af[i], b0[j], acc[i][j]);
        b1[i] = *(const bf16x8*)(qb + i * 2048 + o1);
        af[i] = *(const bf16x8*)(pb + i * 2048 + o1);
      }
#pragma unroll
      for (int j = MT; j < NT; j++) b1[j] = *(const bf16x8*)(qb + j * 2048 + o1);
#pragma unroll
      for (int i = 0; i < MT; i++)
#pragma unroll
        for (int j = 0; j < NT; j++) acc[i][j] = mfma16(af[i], b1[j], acc[i][j]);
      __builtin_amdgcn_sched_group_barrier(0x100, NT + MT, 0);
#pragma unroll
      for (int r = 0; r < MT; r++) {
        __builtin_amdgcn_sched_group_barrier(0x008, 4, 0);
        __builtin_amdgcn_sched_group_barrier(0x100, 1, 0);
        __builtin_amdgcn_sched_group_barrier(0x008, 4, 0);
        __builtin_amdgcn_sched_group_barrier(0x100, 1, 0);
      }
      __builtin_amdgcn_sched_group_barrier(0x100, NT - MT, 0);
      __builtin_amdgcn_sched_group_barrier(0x008, MT * NT, 0);
      __builtin_amdgcn_s_setprio(0);
    } else {
#pragma unroll
      for (int ks = 0; ks < 2; ++ks) {
        const int oo = ks ? o1 : o0;
        bf16x8 a[MT], b[NT];
#pragma unroll
        for (int i = 0; i < MT; i++) a[i] = *(const bf16x8*)(pb + i * 2048 + oo);
#pragma unroll
        for (int j = 0; j < NT; j++) b[j] = *(const bf16x8*)(qb + j * 2048 + oo);
        __builtin_amdgcn_s_setprio(1);
#pragma unroll
        for (int i = 0; i < MT; i++)
#pragma unroll
          for (int j = 0; j < NT; j++) acc[i][j] = mfma16(a[i], b[j], acc[i][j]);
        __builtin_amdgcn_s_setprio(0);
      }
    }
    if (kt + ST - 1 < NK) asm volatile("s_waitcnt vmcnt(%0)" :: "n"((ST - 2) * NDMA) : "memory");
    else if (ST == 3 && Pn != nullptr) { if (kt == NK - 2) asm volatile("s_waitcnt vmcnt(%0)" :: "n"(NDMA) : "memory"); }
    else if (!(ST == 2 && Pn != nullptr)) asm volatile("s_waitcnt vmcnt(0)" ::: "memory");
    __builtin_amdgcn_s_barrier();
    asm volatile("" ::: "memory");
    cur = (cur == ST - 1) ? 0 : cur + 1;
    nxs = (nxs == ST - 1) ? 0 : nxs + 1;
  }
  if (ST == 3 && ringp) *ringp = cur;
}

template <class PT> DI void wsrc(const PT& p, int l, int n, const float*& src, int& ld, int& col, float& scale) {
  scale = 1.f;
  src = p.w_in + (long)l * D * DIN; ld = DIN;
  if (n < W_C) {
    if (n < 1024) col = 4096 + n;
    else if (n < 2048) { col = 5120 + (n - 1024); scale = 0.0625f; }
    else if (n < 3072) col = 6144 + (n - 2048);
    else if (n < 3088) col = 9216 + (n - 3072);
    else col = -1;
  } else if (n < W_G) {
    int n2 = n - W_C;
    if (n2 < 4096) { int blk = n2 >> 6, sl = (n2 >> 4) & 3, cl = n2 & 15; col = sl * 1024 + blk * 16 + cl; }
    else { int n3 = n2 - 4096; int blk = n3 >> 5, sl = (n3 >> 4) & 1, cl = n3 & 15; col = (sl ? 8192 : 7168) + blk * 16 + cl; }
  } else if (n < W_PC) {
    int n4 = n - W_G; int mtb = n4 >> 9, r5 = n4 & 511; int cc5 = r5 >> 8, wm5 = (r5 >> 6) & 3, a5 = (r5 >> 5) & 1, sl = (r5 >> 4) & 1, cl = r5 & 15;
    col = 9232 + sl * 1024 + (256 * mtb + 64 * wm5 + 32 * cc5 + 16 * a5 + cl);
  } else if (n < W_PM) { src = p.w_pc + (long)l * D * D; ld = D; col = n - W_PC; }
  else if (n < W_O)  { src = p.w_pm + (long)l * D * D; ld = D; col = n - W_PM; }
  else               { src = p.w_out + (long)l * D * D; ld = D; col = n - W_O; }
}

template <class PT> DI void phase_prep(const PT& p, const Ctx& c, float* ldsf) {
  const int tid = opaque_tid();
  if (blockIdx.x == 0 && tid < 256) c.ctr[tid] = 0;
  const int nItems = DEPTH * (WROWS / 64) * 16;
  for (int it = blockIdx.x; it < nItems; it += gridDim.x) {
    const int kb = (it & 15) * 64; const int rb = it >> 4;
    const int l = rb / (WROWS / 64); const int nb = (rb % (WROWS / 64)) * 64;
    const float* src; int ld, col; float scale;
    const int nl = tid & 63;
    wsrc(p, l, nb + nl, src, ld, col, scale);
#pragma unroll
    for (int i = 0; i < 8; i++) {
      const int kl = (tid >> 6) + 8 * i;
      float v = (col >= 0) ? src[(long)(kb + kl) * ld + col] * scale : 0.f;
      ldsf[kl * 65 + nl] = v;
    }
    __syncthreads();
    {
      const int nl2 = tid >> 3, kc = tid & 7;
      float v[8];
#pragma unroll
      for (int j = 0; j < 8; j++) v[j] = ldsf[(kc * 8 + j) * 65 + nl2];
      uint4 o; o.x = pack2(v[0], v[1]); o.y = pack2(v[2], v[3]); o.z = pack2(v[4], v[5]); o.w = pack2(v[6], v[7]);
      *(uint4*)(c.W + ((long)l * WROWS + nb + nl2) * D + kb + kc * 8) = o;
    }
    __syncthreads();
  }
  const int nMod = DEPTH * 48;
  for (int it = blockIdx.x; it < nMod; it += gridDim.x) {
    const int l = it / 48, jb = (it % 48) * 64;
    const int cl = tid & 63, kc = tid >> 6;
    float acc[40];
#pragma unroll
    for (int b = 0; b < 40; b++) acc[b] = 0.f;
    const float* wa = p.w_ada + (long)l * D * 3072 + jb + cl;
    for (int k = kc * 128; k < kc * 128 + 128; ++k) {
      const float wv = wa[(long)k * 3072];
#pragma unroll
      for (int b = 0; b < 40; b++) {
        const float cv = (b < 8) ? p.c_prompt[b * D + k] : p.c_sample[(b - 8) * D + k];
        acc[b] += cv * wv;
      }
    }
#pragma unroll
    for (int b = 0; b < 40; b++) ldsf[(kc * 40 + b) * 64 + cl] = acc[b];
    __syncthreads();
    for (int idx = tid; idx < 40 * 64; idx += NT) {
      const int b = idx >> 6, cc = idx & 63;
      float s = p.b_ada[l * 3072 + jb + cc];
#pragma unroll
      for (int q = 0; q < 8; q++) s += ldsf[(q * 40 + b) * 64 + cc];
      c.mod[((long)l * 40 + b) * 3072 + jb + cc] = s;
    }
    __syncthreads();
  }
}

template <class PT> DI void phase_rows(const PT& p, const Ctx& c, int l, int g, bool fin) {
  const int tid_ = opaque_tid(); const int lane = tid_ & 63, w = tid_ >> 6;
  const int stride = gridDim.x * 8;
  float4 gv[4];
#pragma unroll
  for (int i = 0; i < 4; i++) gv[i] = *(const float4*)((fin ? p.final_g : p.norm_g + l * D) + 4 * lane + 256 * i);
  for (int lt0 = blockIdx.x * 8 + w; lt0 < c.Tg; lt0 += 2 * stride) {
    const bool has1 = lt0 + stride < c.Tg;
    const int lt1 = has1 ? lt0 + stride : lt0;
    const int tok0 = gtok(c, g, lt0), tok1 = gtok(c, g, lt1);
    const float* xr0 = (l == 0) ? xin_row(p, tok0) : p.out + (long)tok0 * D;
    const float* xr1 = (l == 0) ? xin_row(p, tok1) : p.out + (long)tok1 * D;
    float4 v0[4], v1[4]; float ss0 = 0.f, ss1 = 0.f;
#pragma unroll
    for (int i = 0; i < 4; i++) { v0[i] = *(const float4*)(xr0 + 4 * lane + 256 * i); v1[i] = *(const float4*)(xr1 + 4 * lane + 256 * i); }
    const float* mp0 = c.mod + ((long)(fin ? 0 : l) * 40 + batch_of(tok0)) * 3072;
    const float* mp1 = c.mod + ((long)(fin ? 0 : l) * 40 + batch_of(tok1)) * 3072;
    float4 sc0[4], sh0[4], sc1[4], sh1[4];
    if (!fin) {
#pragma unroll
      for (int i = 0; i < 4; i++) {
        const int k = 4 * lane + 256 * i;
        sc0[i] = *(const float4*)(mp0 + 1024 + k); sh0[i] = *(const float4*)(mp0 + k);
        sc1[i] = *(const float4*)(mp1 + 1024 + k); sh1[i] = *(const float4*)(mp1 + k);
      }
    }
#pragma unroll
    for (int i = 0; i < 4; i++) {
      ss0 += v0[i].x * v0[i].x + v0[i].y * v0[i].y + v0[i].z * v0[i].z + v0[i].w * v0[i].w;
      ss1 += v1[i].x * v1[i].x + v1[i].y * v1[i].y + v1[i].z * v1[i].z + v1[i].w * v1[i].w;
    }
    ss0 = wave_sum(ss0); ss1 = wave_sum(ss1);
    const float r0 = rsqrtf(ss0 * (1.f / 1024.f) + 1e-6f), r1 = rsqrtf(ss1 * (1.f / 1024.f) + 1e-6f);
    if (fin) {
#pragma unroll
      for (int i = 0; i < 4; i++) {
        const int k = 4 * lane + 256 * i;
        float4 o; o.x = v0[i].x * r0 * gv[i].x; o.y = v0[i].y * r0 * gv[i].y; o.z = v0[i].z * r0 * gv[i].z; o.w = v0[i].w * r0 * gv[i].w;
        *(float4*)(p.out + (long)tok0 * D + k) = o;
      }
      if (has1) {
#pragma unroll
        for (int i = 0; i < 4; i++) {
          const int k = 4 * lane + 256 * i;
          float4 o; o.x = v1[i].x * r1 * gv[i].x; o.y = v1[i].y * r1 * gv[i].y; o.z = v1[i].z * r1 * gv[i].z; o.w = v1[i].w * r1 * gv[i].w;
          *(float4*)(p.out + (long)tok1 * D + k) = o;
        }
      }
    } else {
#pragma unroll
      for (int i = 0; i < 4; i++) {
        const int k = 4 * lane + 256 * i;
        *(uint2*)(c.Rh + (long)lt0 * D + k) = pack4(v0[i].x * r0 * gv[i].x * (1.f + sc0[i].x) + sh0[i].x, v0[i].y * r0 * gv[i].y * (1.f + sc0[i].y) + sh0[i].y,
                                                    v0[i].z * r0 * gv[i].z * (1.f + sc0[i].z) + sh0[i].z, v0[i].w * r0 * gv[i].w * (1.f + sc0[i].w) + sh0[i].w);
      }
      if (has1) {
#pragma unroll
        for (int i = 0; i < 4; i++) {
          const int k = 4 * lane + 256 * i;
          *(uint2*)(c.Rh + (long)lt1 * D + k) = pack4(v1[i].x * r1 * gv[i].x * (1.f + sc1[i].x) + sh1[i].x, v1[i].y * r1 * gv[i].y * (1.f + sc1[i].y) + sh1[i].y,
                                                      v1[i].z * r1 * gv[i].z * (1.f + sc1[i].z) + sh1[i].z, v1[i].w * r1 * gv[i].w * (1.f + sc1[i].w) + sh1[i].w);
        }
      }
    }
  }
}

template <class PT> DI void phase_A(const PT& p, const Ctx& c, int l, u16* lds) {
  const int tid = opaque_tid(), lane = tid & 63, wave = tid >> 6, wm = wave & 3, wn = wave >> 2, lr = lane & 15, lg = lane >> 4;
  const u16* W = c.W + (long)l * WROWS * D;
  u16* Rq = c.R1; u16* Rk = c.R2; u16* RvT = c.R4;
  const int nTiles = (c.Tg / 256) * 13;
  auto ptrsA = [&](int tl, const u16*& Pp, const u16*& Qp) {
    const int m_ = tl >> 3, tb_ = (m_ / 52) * 32 + ((m_ % 52) & 3) * 8 + (tl & 7), j_ = (m_ % 52) >> 2;
    const u16* hp = c.Rh + (long)tb_ * 256 * D;
    if (j_ < 8) { Pp = W + (long)((j_ >> 2) * 1024 + (j_ & 3) * 256) * D; Qp = hp; }
    else if (j_ < 12) { Pp = hp; Qp = W + (long)(2048 + (j_ - 8) * 256) * D; }
    else { Pp = W + (long)3072 * D; Qp = hp; }
  };
  bool primed = false;
  for (int tile = blockIdx.x; tile < nTiles; tile += gridDim.x) {
    const int m0_ = tile >> 3, tb = (m0_ / 52) * 32 + ((m0_ % 52) & 3) * 8 + (tile & 7), j = (m0_ % 52) >> 2;
    f32x4 acc[4][8];
    const u16 *P0, *Q0, *P1 = nullptr, *Q1 = nullptr;
    ptrsA(tile, P0, Q0);
    if (tile + (int)gridDim.x < nTiles && j != 12 && ((((tile + (int)gridDim.x) >> 3) % 52) >> 2) != 12) ptrsA(tile + gridDim.x, P1, Q1);
    const bool pr = primed; primed = (P1 != nullptr);
    if (j < 8) {
      const int isk = j >> 2, head = j & 3;
      gemm_tile<4, 8, 2>(P0, Q0, acc, lds, P1, Q1, pr);
      u16* dst = isk ? Rk : Rq;
#pragma unroll
      for (int i = 0; i < 4; i++)
#pragma unroll
        for (int jn = 0; jn < 8; jn++) {
          const int d = 64 * wm + 16 * i + 4 * lg, t = 128 * wn + 16 * jn + lr;
          *(uint2*)(dst + (long)(tb * 256 + t) * D + head * 256 + d) = pack4v(acc[i][jn]);
        }
    } else if (j < 12) {
      const int head = j - 8;
      gemm_tile<4, 8, 2>(P0, Q0, acc, lds, P1, Q1, pr);
#pragma unroll
      for (int i = 0; i < 4; i++)
#pragma unroll
        for (int jn = 0; jn < 8; jn++) {
          const int tokl = 64 * wm + 16 * i + 4 * lg, e = 128 * wn + 16 * jn + lr;
          const int ch = tb * 2 + (tokl >> 7), sidx = tokl & 127;
          *(uint2*)(RvT + ((long)(ch * 4 + head) * 256 + e) * 128 + sidx) = pack4v(acc[i][jn]);
        }
    } else {
      f32x4 accg[1][8];
      gemm_tile<1, 8, 2>(P0, Q0, accg, lds);
      float* gl = (float*)lds;
      if (wm == 0) {
#pragma unroll
        for (int jn = 0; jn < 8; jn++) {
          const int t = 128 * wn + 16 * jn + lr;
#pragma unroll
          for (int r = 0; r < 4; r++) {
            float v = accg[0][jn][r] + p.b_gates[l * 16 + lg * 4 + r];
            if (lg & 1) v = fminf(v, 0.f) - log1pf(expf(-fabsf(v)));
            gl[t * 16 + lg * 4 + r] = v;
          }
        }
      }
      __syncthreads();
      if (tid < 16) {
        const int head = tid & 3, dir = (tid >> 2) & 1, cl = tid >> 3;
        const int ch = tb * 2 + cl;
        float* o = c.sc + (((long)(ch * 4 + head) * 2 + dir) * 3) * 128;
        const float* glc = gl + cl * 128 * 16;
        float bs = 0.f, pm = -3.0e38f;
        for (int q = 0; q < 128; ++q) {
          const int t = dir ? 127 - q : q;
          const float iv = glc[t * 16 + dir * 8 + head], lf = glc[t * 16 + dir * 8 + 4 + head];
          bs += lf; const float gg = iv - bs; pm = fmaxf(pm, gg);
          o[t] = bs; o[128 + t] = gg; o[256 + t] = pm;
        }
      }
      __syncthreads();
    }
  }
}

template <class PT> DI void phase_scan(const PT& p, const Ctx& c, int ctrIdx, char* smem) {
  __shared__ int s_task;
  const int tid = opaque_tid(), lane = tid & 63, w0 = __builtin_amdgcn_readfirstlane(tid >> 6), lr = lane & 15, lg = lane >> 4;
  u16* Kb = (u16*)smem;
  u16* Vt = Kb + 128 * KS;
  u16* Vw = Vt + 80 * VS;
  u16* Ct = Vw + 80 * VS;
  float* scg = (float*)(Ct + 80 * KS); float* scmu = scg + 128; float* sciw = scmu + 128; float* scfl = sciw + 128;
  const u16* Rq = c.R1; const u16* Rk = c.R2; const u16* RvT = c.R4;
  const int nLong = (8 / c.G) * 32;
  const int nLongQ8 = (8 / c.G), nShortQ8 = (32 / c.G);
  const int perQueue = (nLongQ8 + nShortQ8) * 4;
  int* ctr = c.ctr + ctrIdx * 8;
  const int myq = (int)(xb_xcc_id() & 7u);
  int qoff = 0;
  while (true) {
    __syncthreads();
    if (tid == 0) {
      int t = -1;
      while (qoff < 8) {
        const int qi = (myq + qoff) & 7;
        const int n = atomicAdd(ctr + qi, 1);
        if (n < perQueue) {
          const int quad = (n < nLongQ8 * 4) ? qi + 8 * (n >> 2) : nLongQ8 * 8 + qi + 8 * ((n - nLongQ8 * 4) >> 2);
          t = quad * 4 + (n & 3);
          break;
        }
        ++qoff;
      }
      s_task = t;
    }
    __syncthreads();
    const int task = s_task;
    if (task < 0) break;
    int seq, r, chunk0, nc;
    if (task < nLong) { seq = task >> 5; r = task & 31; chunk0 = seq * 64; nc = 64; }
    else { const int t2 = task - nLong; seq = t2 >> 5; r = t2 & 31; chunk0 = (c.half >> 7) + seq * 16; nc = 16; }
    const int head = r >> 3, dir = (r >> 2) & 1, es = r & 3;
    const int last = dir ? 0 : 127;
    u16* Rho = dir ? c.Rhb : c.Rhf;
    for (int idx = tid; idx < 80 * KS / 2; idx += NT) ((unsigned*)Ct)[idx] = 0u;
    for (int idx = tid; idx < 16 * VS / 2; idx += NT) { ((unsigned*)(Vt + 64 * VS))[idx] = 0u; ((unsigned*)(Vw + 64 * VS))[idx] = 0u; }
    __syncthreads();
    if (tid < 128) Vt[64 * VS + tid] = (u16)0x3F80;
    f32x4 st[2][5];
#pragma unroll
    for (int i = 0; i < 2; i++)
#pragma unroll
      for (int jn = 0; jn < 5; jn++) st[i][jn] = (f32x4){0.f, 0.f, 0.f, 0.f};
    float m = 0.f;
    const int vrow = tid >> 4, vsc = tid & 15;
    const int krow = tid >> 5, kkc = (tid & 31) * 8;
    u32x4 kpre[8], vpre[2]; float4 g8a, g8b; float bLn, gmaxn, myb, myg, mypm;
    bf16x8 qf[8];
    auto scan_load = [&](int cq) {
#pragma unroll
      for (int ks = 0; ks < 8; ks++)
        qf[ks] = *(const bf16x8*)(Rq + (long)(cq * 128 + 16 * w0 + lr) * D + head * 256 + 32 * ks + 8 * lg);
#pragma unroll
      for (int i = 0; i < 8; i++) kpre[i] = *(const u32x4*)(Rk + (long)(cq * 128 + krow + 16 * i) * D + head * 256 + kkc);
#pragma unroll
      for (int i = 0; i < 2; i++) vpre[i] = *(const u32x4*)(RvT + ((long)(cq * 4 + head) * 256 + es * 64 + vrow + 32 * i) * 128 + vsc * 8);
      const float* scb = c.sc + ((long)(cq * 4 + head) * 2 + dir) * 384;
      g8a = *(const float4*)(scb + 128 + vsc * 8); g8b = *(const float4*)(scb + 128 + vsc * 8 + 4);
      bLn = scb[last]; gmaxn = scb[256 + last];
      myb = scb[tid & 127]; myg = scb[128 + (tid & 127)]; mypm = scb[256 + (tid & 127)];
    };
    scan_load(chunk0 + (dir ? nc - 1 : 0));
    for (int j = 0; j < nc; ++j) {
      const int cc = chunk0 + (dir ? nc - 1 - j : j);
      int w = w0; asm volatile("" : "+s"(w));
      __syncthreads();
      const float muL = fmaxf(m, gmaxn);
      const float decay = __expf(m - muL);
      const float mnext = bLn + muL;
#pragma unroll
      for (int i = 0; i < 2; i++)
#pragma unroll
        for (int jn = 0; jn < 5; jn++)
          *(uint2*)(Ct + (16 * jn + lr) * KS + 32 * w + 16 * i + 4 * lg) = pack4v(st[i][jn]);
#pragma unroll
      for (int i = 0; i < 8; i++) *(u32x4*)(Kb + (krow + 16 * i) * KS + kkc) = kpre[i];
      {
        float w8[8];
        w8[0] = __expf(g8a.x - muL); w8[1] = __expf(g8a.y - muL); w8[2] = __expf(g8a.z - muL); w8[3] = __expf(g8a.w - muL);
        w8[4] = __expf(g8b.x - muL); w8[5] = __expf(g8b.y - muL); w8[6] = __expf(g8b.z - muL); w8[7] = __expf(g8b.w - muL);
#pragma unroll
        for (int i = 0; i < 2; i++) {
          const u32x4 vv = vpre[i];
          *(u32x4*)(Vt + (vrow + 32 * i) * VS + vsc * 8) = vv;
          uint4 v; v.x = vv[0]; v.y = vv[1]; v.z = vv[2]; v.w = vv[3];
          uint4 o;
          o.x = pack2(bf2f(v.x & 0xffffu) * w8[0], bf2f(v.x >> 16) * w8[1]);
          o.y = pack2(bf2f(v.y & 0xffffu) * w8[2], bf2f(v.y >> 16) * w8[3]);
          o.z = pack2(bf2f(v.z & 0xffffu) * w8[4], bf2f(v.z >> 16) * w8[5]);
          o.w = pack2(bf2f(v.w & 0xffffu) * w8[6], bf2f(v.w >> 16) * w8[7]);
          *(uint4*)(Vw + (vrow + 32 * i) * VS + vsc * 8) = o;
        }
        if (tid < 16) {
          uint4 o; o.x = pack2(w8[0], w8[1]); o.y = pack2(w8[2], w8[3]); o.z = pack2(w8[4], w8[5]); o.w = pack2(w8[6], w8[7]);
          *(uint4*)(Vw + 64 * VS + vsc * 8) = o;
        }
      }
      if (tid < 128) {
        const float mu = fmaxf(m, mypm);
        scg[tid] = myg; scmu[tid] = mu; sciw[tid] = __expf(m - mu); scfl[tid] = __expf(-(mu + myb));
      }
      __syncthreads();
      const int t = 16 * w + lr;
      bf16x8 spk[4];
      {
        f32x4 sacc[8];
#pragma unroll
        for (int i = 0; i < 8; i++) sacc[i] = (f32x4){0.f, 0.f, 0.f, 0.f};
#pragma unroll
        for (int i = 0; i < 8; i++) {
          const bool need = dir ? (i >= w) : (i <= w);
          if (need) {
#pragma unroll
            for (int ks = 0; ks < 8; ks++) {
              const bf16x8 a = *(const bf16x8*)(Kb + (16 * i + lr) * KS + 32 * ks + 8 * lg);
              sacc[i] = mfma16(a, qf[ks], sacc[i]);
            }
          }
        }
        const float mu_t = scmu[t];
        int tt = t; asm volatile("" : "+v"(tt));
        const int sgn = dir ? -1 : 1;
#pragma unroll
        for (int ks = 0; ks < 4; ks++) {
          float sv[8];
#pragma unroll
          for (int hh = 0; hh < 2; hh++) {
            const int i = 2 * ks + hh;
            const float4 gs = *(const float4*)(scg + 16 * i + 4 * lg);
            const float gv[4] = {gs.x, gs.y, gs.z, gs.w};
#pragma unroll
            for (int r2 = 0; r2 < 4; r2++) {
              const int s = 16 * i + 4 * lg + r2;
              const bool valid = (s - tt) * sgn <= 0;
              sv[hh * 4 + r2] = valid ? sacc[i][r2] * __expf(gv[r2] - mu_t) : 0.f;
            }
          }
          uint4 o; o.x = pack2(sv[0], sv[1]); o.y = pack2(sv[2], sv[3]); o.z = pack2(sv[4], sv[5]); o.w = pack2(sv[6], sv[7]);
          spk[ks] = __builtin_bit_cast(bf16x8, o);
        }
      }
      f32x4 num[5];
#pragma unroll
      for (int i = 0; i < 5; i++) num[i] = (f32x4){0.f, 0.f, 0.f, 0.f};
      if (j > 0) {
#pragma unroll
        for (int ks = 0; ks < 8; ks++)
#pragma unroll
          for (int i = 0; i < 5; i++) {
            const bf16x8 a = *(const bf16x8*)(Ct + (16 * i + lr) * KS + 32 * ks + 8 * lg);
            num[i] = mfma16(a, qf[ks], num[i]);
          }
      }
      {
        const float iw = sciw[t];
#pragma unroll
        for (int i = 0; i < 5; i++) num[i] *= iw;
      }
#pragma unroll
      for (int ks = 0; ks < 4; ks++) {
        const bool need = dir ? (2 * ks + 1 >= w) : (2 * ks <= w);
        if (need) {
#pragma unroll
          for (int i = 0; i < 5; i++) {
            const uint2 lo = *(const uint2*)(Vt + (16 * i + lr) * VS + 32 * ks + 4 * lg);
            const uint2 hi = *(const uint2*)(Vt + (16 * i + lr) * VS + 32 * ks + 16 + 4 * lg);
            uint4 av; av.x = lo.x; av.y = lo.y; av.z = hi.x; av.w = hi.y;
            num[i] = mfma16(__builtin_bit_cast(bf16x8, av), spk[ks], num[i]);
          }
        }
      }
      {
        const float fl = scfl[t];
        const float dr = __shfl(num[4][0], lr);
        const float inv = 1.f / fmaxf(fabsf(dr), fl);
        u16* dst = Rho + (long)(cc * 128 + t) * D + head * 256 + es * 64 + 4 * lg;
#pragma unroll
        for (int i = 0; i < 4; i++)
          *(uint2*)(dst + 16 * i) = pack4(num[i][0] * inv, num[i][1] * inv, num[i][2] * inv, num[i][3] * inv);
      }
      __builtin_amdgcn_sched_barrier(0);
      { const int jn1 = (j + 1 < nc) ? j + 1 : j; scan_load(chunk0 + (dir ? nc - 1 - jn1 : jn1)); }
      __builtin_amdgcn_sched_barrier(0);
#pragma unroll
      for (int i = 0; i < 2; i++)
#pragma unroll
        for (int jn = 0; jn < 5; jn++) st[i][jn] *= decay;
#pragma unroll
      for (int ks = 0; ks < 4; ks++) {
        bf16x8 kTf[2];
#pragma unroll
        for (int i = 0; i < 2; i++) {
          const u16* ap = Kb + (32 * ks + 8 * lg + (lr >> 2)) * KS + 32 * w + 16 * i + 4 * (lr & 3);
          const s16x4 lo = __builtin_amdgcn_ds_read_tr16_b64_v4i16((s16x4 __attribute__((address_space(3)))*)ap);
          const s16x4 hi = __builtin_amdgcn_ds_read_tr16_b64_v4i16((s16x4 __attribute__((address_space(3)))*)(ap + 4 * KS));
          kTf[i] = __builtin_shufflevector(lo, hi, 0, 1, 2, 3, 4, 5, 6, 7);
        }
#pragma unroll
        for (int jn = 0; jn < 5; jn++) {
          const bf16x8 b = *(const bf16x8*)(Vw + (16 * jn + lr) * VS + 32 * ks + 8 * lg);
#pragma unroll
          for (int i = 0; i < 2; i++) st[i][jn] = mfma16(kTf[i], b, st[i][jn]);
        }
      }
      m = mnext;
    }
  }
}

template <class PT> DI void phase_C(const PT& p, const Ctx& c, int l, u16* lds) {
  const int tid = opaque_tid(), lane = tid & 63, wave = tid >> 6, wm = wave & 3, wn = wave >> 2, lr = lane & 15, lg = lane >> 4;
  const u16* W = c.W + ((long)l * WROWS + W_C) * D;
  u16* Ru = c.R1; u16* Ryp = c.R2; u16* Rog = c.R3;
  const int nTiles = (c.Tg / 256) * 24;
  for (int tile = blockIdx.x; tile < nTiles; tile += gridDim.x) {
    const int tb = 2 * ((tile >> 3) / 6) + (tile & 1), pt = 6 * ((tile & 7) >> 1) + ((tile >> 3) % 6);
    f32x4 acc[4][8];
    {
      const int tn = tile + gridDim.x;
      const bool has = tn < nTiles;
      gemm_tile<4, 8, 2>(W + (long)pt * 256 * D, c.Rh + (long)tb * 256 * D, acc, lds,
                         has ? W + (long)(6 * ((tn & 7) >> 1) + ((tn >> 3) % 6)) * 256 * D : nullptr, has ? c.Rh + (long)(2 * ((tn >> 3) / 6) + (tn & 1)) * 256 * D : nullptr, tile != (int)blockIdx.x);
    }
    if (pt < 16) {
      const int chn = pt * 64 + wm * 16 + 4 * lg;
#pragma unroll
      for (int jn = 0; jn < 8; jn++) {
        const long lt = tb * 256 + 128 * wn + 16 * jn + lr;
        float u[4], y[4];
#pragma unroll
        for (int r = 0; r < 4; r++) { u[r] = acc[1][jn][r] * acc[2][jn][r]; y[r] = acc[0][jn][r] * siluf_(acc[3][jn][r]); }
        *(uint2*)(Ru + lt * D + chn) = pack4(u[0], u[1], u[2], u[3]);
        *(uint2*)(Ryp + lt * D + chn) = pack4(y[0], y[1], y[2], y[3]);
      }
    } else {
      const int chn = (pt - 16) * 128 + wm * 32 + 4 * lg;
#pragma unroll
      for (int jn = 0; jn < 8; jn++) {
        const long lt = tb * 256 + 128 * wn + 16 * jn + lr;
#pragma unroll
        for (int hh = 0; hh < 2; hh++) {
          float o[4];
#pragma unroll
          for (int r = 0; r < 4; r++) o[r] = sigmoidf_(acc[2 * hh][jn][r]) * siluf_(acc[2 * hh + 1][jn][r]);
          *(uint2*)(Rog + lt * D + chn + 16 * hh) = pack4(o[0], o[1], o[2], o[3]);
        }
      }
    }
  }
}

template <class PT> DI void phase_E(const PT& p, const Ctx& c, int l) {
  const int tid_ = opaque_tid(); const int lane = tid_ & 63, w = tid_ >> 6;
  const u16* Ru = c.R1; u16* Ryp = c.R2; u16* Rog = c.R3;
  const float* cw = p.conv_w + (long)l * 3 * D; const float* cb = p.conv_b + (long)l * D; const float* mg = p.mh_norm_g + (long)l * D;
  float4 w0[4], w1[4], w2[4], bb[4], gg[4];
#pragma unroll
  for (int i = 0; i < 4; i++) {
    const int k = 4 * lane + 256 * i;
    w0[i] = *(const float4*)(cw + k); w1[i] = *(const float4*)(cw + D + k); w2[i] = *(const float4*)(cw + 2 * D + k);
    bb[i] = *(const float4*)(cb + k); gg[i] = *(const float4*)(mg + k);
  }
  for (int lt = blockIdx.x * 8 + w; lt < c.Tg; lt += gridDim.x * 8) {
    const int sl = lt < c.half ? 8192 : 2048;
    const int pos = (lt < c.half ? lt : lt - c.half) & (sl - 1);
    const bool first = pos == 0, lastp = pos == sl - 1;
    uint2 U0[4], U1[4], U2[4], YP[4], OG[4], HF[4], HB[4];
#pragma unroll
    for (int i = 0; i < 4; i++) {
      const int k = 4 * lane + 256 * i;
      U0[i] = *(const uint2*)(Ru + (long)(first ? lt : lt - 1) * D + k);
      U1[i] = *(const uint2*)(Ru + (long)lt * D + k);
      U2[i] = *(const uint2*)(Ru + (long)(lastp ? lt : lt + 1) * D + k);
      if (first) { U0[i].x = 0u; U0[i].y = 0u; }
      if (lastp) { U2[i].x = 0u; U2[i].y = 0u; }
      YP[i] = *(const uint2*)(Ryp + (long)lt * D + k);
      OG[i] = *(const uint2*)(Rog + (long)lt * D + k);
      HF[i] = *(const uint2*)(c.Rhf + (long)lt * D + k);
      HB[i] = *(const uint2*)(c.Rhb + (long)lt * D + k);
    }
#pragma unroll
    for (int i = 0; i < 4; i++) {
      const int k = 4 * lane + 256 * i;
      const float4 a0 = unpack4(U0[i]), a1 = unpack4(U1[i]), a2 = unpack4(U2[i]), yp = unpack4(YP[i]);
      const float y0 = yp.x * (w0[i].x * a0.x + w1[i].x * a1.x + w2[i].x * a2.x + bb[i].x);
      const float y1 = yp.y * (w0[i].y * a0.y + w1[i].y * a1.y + w2[i].y * a2.y + bb[i].y);
      const float y2 = yp.z * (w0[i].z * a0.z + w1[i].z * a1.z + w2[i].z * a2.z + bb[i].z);
      const float y3 = yp.w * (w0[i].w * a0.w + w1[i].w * a1.w + w2[i].w * a2.w + bb[i].w);
      *(uint2*)(Ryp + (long)lt * D + k) = pack4(y0, y1, y2, y3);
      const float4 hf = unpack4(HF[i]), hb = unpack4(HB[i]), og = unpack4(OG[i]);
      const float s0 = hf.x + hb.x, s1 = hf.y + hb.y, s2 = hf.z + hb.z, s3 = hf.w + hb.w;
      const float ss = wave_sum(s0 * s0 + s1 * s1 + s2 * s2 + s3 * s3);
      const float rstd = rsqrtf(ss * (1.f / 256.f) + 1e-6f);
      *(uint2*)(Rog + (long)lt * D + k) = pack4(og.x * s0 * rstd * gg[i].x, og.y * s1 * rstd * gg[i].y, og.z * s2 * rstd * gg[i].z, og.w * s3 * rstd * gg[i].w);
    }
  }
}

template <class PT> DI void phase_D1(const PT& p, const Ctx& c, int l, u16* lds) {
  const int tid = opaque_tid(), lane = tid & 63, wave = tid >> 6, wm = wave & 3, wn = wave >> 2, lr = lane & 15, lg = lane >> 4;
  const u16* W = c.W + (long)l * WROWS * D;
  const u16* Ryc = c.R2; const u16* Rym = c.R3; u16* Rmg = c.R4;
  const int nTiles = (c.Tg / 128) * 4;
  int ring = 0;
  for (int tile = blockIdx.x; tile < nTiles; tile += gridDim.x) {
    const int ch = ((tile >> 5) << 3) + (tile & 7), mt = (tile >> 3) & 3;
    const u16* Pg = W + (long)(W_G + mt * 512) * D; const u16* Qh = c.Rh + (long)ch * 128 * D;
    const u16* Pc_ = W + (long)(W_PC + mt * 256) * D; const u16* Qc_ = Ryc + (long)ch * 128 * D;
    const u16* Pm_ = W + (long)(W_PM + mt * 256) * D; const u16* Qm_ = Rym + (long)ch * 128 * D;
    const int tn = tile + gridDim.x; const bool hasn = tn < nTiles;
    const u16* Pnx = hasn ? W + (long)(W_G + ((tn >> 3) & 3) * 512) * D : nullptr; const u16* Qnx = hasn ? c.Rh + (long)(((tn >> 5) << 3) + (tn & 7)) * 128 * D : nullptr;
    u32x2 gk[2][4][4], Mk[4][4];
#pragma unroll
    for (int cc = 0; cc < 2; cc++) {
      f32x4 a1[4][4];
      if (cc == 0) gemm_tile<4, 4, 3>(Pg, Qh, a1, lds, Pg + (long)256 * D, Qh, tile != (int)blockIdx.x, &ring);
      else gemm_tile<4, 4, 3>(Pg + (long)256 * D, Qh, a1, lds, Pc_, Qc_, true, &ring);
#pragma unroll
      for (int i = 0; i < 4; i++)
#pragma unroll
        for (int jn = 0; jn < 4; jn++) {
          const uint2 t_ = pack4(sigmoidf_(a1[i][jn][0]), sigmoidf_(a1[i][jn][1]), sigmoidf_(a1[i][jn][2]), sigmoidf_(a1[i][jn][3]));
          gk[cc][i][jn] = (u32x2){t_.x, t_.y}; asm volatile("" : "+v"(gk[cc][i][jn]));
        }
    }
    {
      f32x4 a2[4][4];
      gemm_tile<4, 4, 3>(Pc_, Qc_, a2, lds, Pm_, Qm_, true, &ring);
#pragma unroll
      for (int i = 0; i < 4; i++)
#pragma unroll
        for (int jn = 0; jn < 4; jn++) {
          uint2 g_; g_.x = gk[i >> 1][2 * (i & 1)][jn][0]; g_.y = gk[i >> 1][2 * (i & 1)][jn][1];
          const float4 gg = unpack4(g_);
          const uint2 t_ = pack4(gg.x * a2[i][jn][0], gg.y * a2[i][jn][1], gg.z * a2[i][jn][2], gg.w * a2[i][jn][3]);
          Mk[i][jn] = (u32x2){t_.x, t_.y}; asm volatile("" : "+v"(Mk[i][jn]));
        }
    }
    {
      f32x4 a2[4][4];
      gemm_tile<4, 4, 3>(Pm_, Qm_, a2, lds, Pnx, Qnx, true, &ring);
#pragma unroll
      for (int i = 0; i < 4; i++)
#pragma unroll
        for (int jn = 0; jn < 4; jn++) {
          uint2 g_; g_.x = gk[i >> 1][2 * (i & 1) + 1][jn][0]; g_.y = gk[i >> 1][2 * (i & 1) + 1][jn][1];
          uint2 m_; m_.x = Mk[i][jn][0]; m_.y = Mk[i][jn][1];
          const float4 gg = unpack4(g_);
          const float4 mm = unpack4(m_);
          const int col = mt * 256 + 64 * wm + 16 * i + 4 * lg;
          const long lt = ch * 128 + 64 * wn + 16 * jn + lr;
          *(uint2*)(Rmg + lt * D + col) = pack4(mm.x + gg.x * a2[i][jn][0], mm.y + gg.y * a2[i][jn][1],
                                                mm.z + gg.z * a2[i][jn][2], mm.w + gg.w * a2[i][jn][3]);
        }
    }
  }
}

template <class PT> DI void phase_D2(const PT& p, const Ctx& c, int l, int g, u16* lds) {
  const int tid = opaque_tid(), lane = tid & 63, wave = tid >> 6, wm = wave & 3, wn = wave >> 2, lr = lane & 15, lg = lane >> 4;
  const u16* W = c.W + ((long)l * WROWS + W_O) * D;
  const u16* Rmg = c.R4;
  const int nTiles = (c.Tg / 256) * 4;
  for (int tile = blockIdx.x; tile < nTiles; tile += gridDim.x) {
    const int tb = (tile >> 5) * 8 + (tile & 7), pt = (tile >> 3) & 3;
    f32x4 acc[4][8];
    {
      const int tn = tile + gridDim.x;
      const bool has = tn < nTiles;
      gemm_tile<4, 8, 2>(W + (long)pt * 256 * D, Rmg + (long)tb * 256 * D, acc, lds,
                         has ? W + (long)((tn >> 3) & 3) * 256 * D : nullptr, has ? Rmg + (long)((tn >> 5) * 8 + (tn & 7)) * 256 * D : nullptr, tile != (int)blockIdx.x);
    }
    const int tok0 = gtok(c, g, tb * 256);
    const float* gp = c.mod + ((long)l * 40 + batch_of(tok0)) * 3072 + 2048;
#pragma unroll
    for (int ip = 0; ip < 2; ip++) {
      float4 xv[2][8], gt[2];
#pragma unroll
      for (int h2 = 0; h2 < 2; h2++) {
        const int col = pt * 256 + 64 * wm + 16 * (2 * ip + h2) + 4 * lg;
        gt[h2] = *(const float4*)(gp + col);
#pragma unroll
        for (int jn = 0; jn < 8; jn++) {
          const int tok = tok0 + 128 * wn + 16 * jn + lr;
          const float* xr = (l == 0) ? xin_row(p, tok) : p.out + (long)tok * D;
          xv[h2][jn] = *(const float4*)(xr + col);
        }
      }
#pragma unroll
      for (int h2 = 0; h2 < 2; h2++) {
        const int i = 2 * ip + h2;
        const int col = pt * 256 + 64 * wm + 16 * i + 4 * lg;
#pragma unroll
        for (int jn = 0; jn < 8; jn++) {
          const int tok = tok0 + 128 * wn + 16 * jn + lr;
          float4 o;
          o.x = xv[h2][jn].x + gt[h2].x * acc[i][jn][0]; o.y = xv[h2][jn].y + gt[h2].y * acc[i][jn][1];
          o.z = xv[h2][jn].z + gt[h2].z * acc[i][jn][2]; o.w = xv[h2][jn].w + gt[h2].w * acc[i][jn][3];
          *(float4*)(p.out + (long)tok * D + col) = o;
        }
      }
    }
  }
}

__global__ void __launch_bounds__(NT) mega(Params p) {
  extern __shared__ __attribute__((aligned(16))) char smem[];
  cg::grid_group grid = cg::this_grid();
  const int nG = p.G;
  __shared__ uint4 xb_words;
  volatile LAS unsigned* xb_st = (volatile LAS unsigned*)&xb_words;
  Params* pg;
  unsigned* xbar;
  {
    const Ctx c0 = make_ctx(p);
    unsigned char* q = (unsigned char*)c0.ctr + 4096;
    xbar = (unsigned*)q; q += XCD_BAR_WORDS * 4;
    pg = (Params*)q;
    if (blockIdx.x == 0 && threadIdx.x == 0) *pg = p;
    if (threadIdx.x == 0) xb_words = make_uint4(0u, 0u, 0u, 0u);
    __syncthreads();
    if (blockIdx.x == 0) for (int i = threadIdx.x; i < XCD_BAR_WORDS; i += NT) xbar[i] = 0u;
    phase_prep(p, c0, (float*)smem);
  }
  grid.sync();
  { XcdBarrier xb0 = xcd_barrier_post(xbar, xb_st); (void)xb0; }
#define PH(call) { const CParams* q_ = launder_params(pg); const CParams& P_ = *q_; const Ctx c = make_ctx(P_); call; }
#define BAR() { const CParams* q_ = launder_params(pg); const Ctx c = make_ctx(*q_); XcdBarrier xb; xb.bar = (unsigned*)((unsigned char*)c.ctr + 4096); xb.x = xb_xcc_id(); xb.st = xb_st; xcd_barrier(xb); }
  for (int g = 0; g < nG; ++g) {
    for (int l = 0; l < DEPTH; ++l) {
      PH(phase_rows(P_, c, l, g, false)); BAR();
      PH(phase_A(P_, c, l, (u16*)smem)); BAR();
      PH(phase_scan(P_, c, g * DEPTH + l, smem)); BAR();
      PH(phase_C(P_, c, l, (u16*)smem)); BAR();
      PH(phase_E(P_, c, l)); BAR();
      PH(phase_D1(P_, c, l, (u16*)smem)); BAR();
      PH(phase_D2(P_, c, l, g, (u16*)smem)); BAR();
    }
    PH(phase_rows(P_, c, DEPTH, g, true));
  }
}

extern "C" void kernel_launch(void* const* d_in, const int* in_sizes, int n_in, void* d_out, int out_size,
                              void* d_ws, size_t ws_size, hipStream_t stream) {
  static int grid_blocks = 0;
  static int Gsel = 2;
  if (!grid_blocks) {
    int dev = 0, cus = 0, per_cu = 0;
    hipGetDevice(&dev);
    hipDeviceGetAttribute(&cus, hipDeviceAttributeMultiprocessorCount, dev);
    hipFuncSetAttribute((const void*)mega, hipFuncAttributeMaxDynamicSharedMemorySize, LDS_BYTES);
    hipOccupancyMaxActiveBlocksPerMultiprocessor(&per_cu, (const void*)mega, NT, LDS_BYTES);
    if (per_cu < 1) per_cu = 1;
    grid_blocks = cus * per_cu;
    const size_t fixed = (size_t)DEPTH * WROWS * D * 2 + (size_t)DEPTH * 40 * 3072 * 4 + 4096 + XCD_BAR_WORDS * 4 + 1024;
    Gsel = 2;
    while (Gsel < 8 && 7 * ((size_t)(131072 / Gsel) * D * 2) + fixed + (size_t)(131072 / Gsel) * 96 > ws_size) Gsel *= 2;
  }
  Params p{};
  p.x_prompt = (const float*)d_in[0]; p.x_sample = (const float*)d_in[1]; p.c_prompt = (const float*)d_in[2]; p.c_sample = (const float*)d_in[3];
  p.w_ada = (const float*)d_in[4]; p.b_ada = (const float*)d_in[5]; p.norm_g = (const float*)d_in[6]; p.w_in = (const float*)d_in[7];
  p.b_gates = (const float*)d_in[8]; p.conv_w = (const float*)d_in[9]; p.conv_b = (const float*)d_in[10]; p.mh_norm_g = (const float*)d_in[11];
  p.w_pc = (const float*)d_in[12]; p.w_pm = (const float*)d_in[13]; p.w_out = (const float*)d_in[14]; p.final_g = (const float*)d_in[15];
  p.out = (float*)d_out; p.ws = (unsigned char*)d_ws; p.G = Gsel; p.pad = 0;
  void* args[] = {&p};
  hipError_t e = hipLaunchCooperativeKernel((const void*)mega, dim3(grid_blocks), dim3(NT), args, LDS_BYTES, stream);
  if (e != hipSuccess) fprintf(stderr, "cooperative launch failed: %s (grid %d)\n", hipGetErrorString(e), grid_blocks);
}
```

```cpp
#include <hip/hip_runtime.h>
#include <hip/hip_cooperative_groups.h>
#include <cstdio>
namespace cg = cooperative_groups;

typedef unsigned short u16;
using bf16x8 = __attribute__((ext_vector_type(8))) short;
using f32x4  = __attribute__((ext_vector_type(4))) float;
using s16x4  = __attribute__((ext_vector_type(4))) short;
using u32x4  = __attribute__((ext_vector_type(4))) unsigned;
using u32x2  = __attribute__((ext_vector_type(2))) unsigned;
#define DI __device__ __forceinline__

constexpr int D = 1024, DIN = 11280, DEPTH = 4;
constexpr int NT = 512;
constexpr int W_QKV = 0, W_C = 3328, W_G = 9472, W_PC = 11520, W_PM = 12544, W_O = 13568, WROWS = 14592;
constexpr int LDT = 72;
constexpr int KS = 264, VS = 136;
constexpr int LDS_BYTES = (128 * KS + 2 * 80 * VS + 80 * KS) * 2 + 4 * 128 * 4;

struct Params {
  const float* x_prompt; const float* x_sample; const float* c_prompt; const float* c_sample;
  const float* w_ada; const float* b_ada; const float* norm_g; const float* w_in; const float* b_gates;
  const float* conv_w; const float* conv_b; const float* mh_norm_g; const float* w_pc; const float* w_pm;
  const float* w_out; const float* final_g;
  float* out; unsigned char* ws;
  int G; int pad;
};

struct Ctx {
  int G, Tg, half;
  u16 *Rh, *R1, *R2, *R3, *R4, *Rhf, *Rhb;
  u16* W; float* mod; float* sc; int* ctr;
};

DI u16 f2bf(float x) { unsigned u = __float_as_uint(x); u += 0x7fffu + ((u >> 16) & 1u); return (u16)(u >> 16); }
DI float bf2f(unsigned h) { return __uint_as_float(h << 16); }
typedef __bf16 bf16x2_t __attribute__((ext_vector_type(2)));
typedef float f32x2_t __attribute__((ext_vector_type(2)));
DI unsigned pack2(float a, float b) { const f32x2_t v = {a, b}; return __builtin_bit_cast(unsigned, __builtin_convertvector(v, bf16x2_t)); }
DI uint2 pack4(float a, float b, float c, float d) { uint2 r; r.x = pack2(a, b); r.y = pack2(c, d); return r; }
DI uint2 pack4v(f32x4 v) { return pack4(v[0], v[1], v[2], v[3]); }
DI float4 unpack4(uint2 v) { float4 r; r.x = bf2f(v.x & 0xffffu); r.y = bf2f(v.x >> 16); r.z = bf2f(v.y & 0xffffu); r.w = bf2f(v.y >> 16); return r; }
DI float sigmoidf_(float x) { return __builtin_amdgcn_rcpf(1.f + __expf(-x)); }
DI float siluf_(float x) { return x * sigmoidf_(x); }
DI float wave_sum(float v) {
#pragma unroll
  for (int o = 32; o >= 1; o >>= 1) v += __shfl_xor(v, o);
  return v;
}
DI int opaque_tid() { int t = threadIdx.x; asm volatile("" : "+v"(t)); return t; }
DI f32x4 mfma16(bf16x8 a, bf16x8 b, f32x4 c) { return __builtin_amdgcn_mfma_f32_16x16x32_bf16(a, b, c, 0, 0, 0); }


typedef const Params __attribute__((address_space(4))) CParams;
template <class PT> DI Ctx make_ctx(const PT& p) {
  Ctx c;
  c.G = p.G; c.Tg = 131072 / p.G; c.half = c.Tg >> 1;
  const size_t REG = (size_t)c.Tg * D * 2;
  unsigned char* ws = p.ws;
  c.Rh = (u16*)(ws); c.R1 = (u16*)(ws + REG); c.R2 = (u16*)(ws + 2 * REG); c.R3 = (u16*)(ws + 3 * REG);
  c.R4 = (u16*)(ws + 4 * REG); c.Rhf = (u16*)(ws + 5 * REG); c.Rhb = (u16*)(ws + 6 * REG);
  unsigned char* q = ws + 7 * REG;
  c.W = (u16*)q; q += (size_t)DEPTH * WROWS * D * 2;
  c.mod = (float*)q; q += (size_t)DEPTH * 40 * 3072 * 4;
  c.sc = (float*)q; q += (size_t)c.Tg * 96;
  c.ctr = (int*)q;
  return c;
}
DI const CParams* launder_params(const Params* g) { asm volatile("" : "+s"(g)); return (const CParams*)(unsigned long long)g; }
DI int gtok(const Ctx& c, int g, int lt) { return lt < c.half ? g * c.half + lt : 65536 + g * c.half + (lt - c.half); }
DI int batch_of(int tok) { return tok < 65536 ? (tok >> 13) : 8 + ((tok - 65536) >> 11); }
template <class PT> DI const float* xin_row(const PT& p, int tok) {
  return tok < 65536 ? p.x_prompt + (long)tok * D : p.x_sample + (long)(tok - 65536) * D;
}


#define XB_TMO      128
#define XB_XCNT(j)  (256  + 64 * (j))
#define XB_XSUB(j)  (1280 + 64 * (j))
#define XB_XGEN(j)  (2304 + 64 * (j))
#define XB_TOP      3328
#define XB_TOPGEN   3392
#define XCD_BAR_WORDS 3456
#define XB_SPIN_CAP (1u << 18)
#define LAS __attribute__((address_space(3)))
DI unsigned xb_ld(unsigned* p)              { return __hip_atomic_load(p, __ATOMIC_RELAXED, __HIP_MEMORY_SCOPE_AGENT); }
DI unsigned xb_add(unsigned* p, unsigned v) { return __hip_atomic_fetch_add(p, v, __ATOMIC_RELAXED, __HIP_MEMORY_SCOPE_AGENT); }
DI unsigned xb_xcc_id() { return (unsigned)__builtin_amdgcn_s_getreg((3 << 11) | 20) & 0xFu; }
#define XB_SPIN(cond, bar) do { unsigned _sp = 0; while (cond) { __builtin_amdgcn_s_sleep(1); \
    if ((++_sp & 255u) == 0u) { if (xb_ld(&(bar)[XB_TMO])) break; if (_sp > XB_SPIN_CAP) { atomicAdd(&(bar)[XB_TMO], 1u); break; } } } } while (0)
struct XcdBarrier { unsigned* bar; unsigned x; volatile LAS unsigned* st; };
DI XcdBarrier xcd_barrier_post(unsigned* bar, volatile LAS unsigned* st) {
  XcdBarrier b; b.bar = bar; b.x = xb_xcc_id(); b.st = st;
  if (threadIdx.x == 0) (void)xb_add(&bar[XB_XCNT(b.x)], 1u);
  return b;
}
DI void xcd_barrier_complete(unsigned* bar, unsigned x, unsigned& nloc, unsigned& nx) {
  const unsigned G = gridDim.x * gridDim.y * gridDim.z;
  unsigned sum, cnt, mine, sp = 0u;
  for (;;) {
    sum = 0u; cnt = 0u; mine = 0u;
#pragma unroll
    for (unsigned j = 0; j < 16; ++j) { const unsigned c = xb_ld(&bar[XB_XCNT(j)]); sum += c; cnt += (c > 0u) ? 1u : 0u; }
    mine = xb_ld(&bar[XB_XCNT(x)]);
    if (sum == G) break;
    __builtin_amdgcn_s_sleep(1);
    if ((++sp & 255u) == 0u) { if (xb_ld(&bar[XB_TMO])) break; if (sp > XB_SPIN_CAP) { atomicAdd(&bar[XB_TMO], 1u); break; } }
  }
  nloc = mine > 0u ? mine : 1u; nx = cnt > 0u ? cnt : 1u;
}
DI void xcd_barrier(const XcdBarrier& b) {
  asm volatile("s_waitcnt vmcnt(0)" ::: "memory");
  __syncthreads();
  if (threadIdx.x == 0) {
    unsigned* bar = b.bar;
    asm volatile("" : "+s"(bar));
    __builtin_amdgcn_s_waitcnt(0);
    unsigned nloc = b.st[0], nx = b.st[1];
    if (nloc == 0u) { xcd_barrier_complete(bar, b.x, nloc, nx); b.st[0] = nloc; b.st[1] = nx; }
    const unsigned old = xb_add(&bar[XB_XSUB(b.x)], 1u);
    const unsigned gen = old / nloc;
    if (old + 1u == (gen + 1u) * nloc) {
      __builtin_amdgcn_fence(__ATOMIC_RELEASE, "agent");
      asm volatile("s_waitcnt vmcnt(0)" ::: "memory");
      const unsigned og = xb_add(&bar[XB_TOP], 1u);
      const unsigned tg = og / nx;
      if (og + 1u == (tg + 1u) * nx) xb_add(&bar[XB_TOPGEN], 1u);
      else XB_SPIN(xb_ld(&bar[XB_TOPGEN]) == tg, bar);
      __builtin_amdgcn_fence(__ATOMIC_ACQUIRE, "agent");
      xb_add(&bar[XB_XGEN(b.x)], 1u);
      asm volatile("s_waitcnt vmcnt(0)" ::: "memory");
    } else {
      XB_SPIN(xb_ld(&bar[XB_XGEN(b.x)]) == gen, bar);
      __builtin_amdgcn_fence(__ATOMIC_ACQUIRE, "agent");
      asm volatile("s_waitcnt vmcnt(0)" ::: "memory");
    }
  }
  __syncthreads();
}

template <int MT, int NT, int ST>
DI void gemm_tile(const u16* __restrict__ P, const u16* __restrict__ Q, f32x4 (&acc)[MT][NT], u16* lds,
                  const u16* Pn = nullptr, const u16* Qn = nullptr, bool primed = false, int* ringp = nullptr) {
  const int tid = opaque_tid(), lane = tid & 63, wave = __builtin_amdgcn_readfirstlane(tid >> 6), wm = wave & 3, wn = wave >> 2;
  const int lr = lane & 15, lg = lane >> 4;
  constexpr int PROWS = 64 * MT, QROWS = 32 * NT, NQI = NT / 2, NDMA = MT + NQI;
  char* pbase = (char*)lds;
  char* qbase = pbase + ST * PROWS * 128;
  const int drow = lane >> 3, dpos = lane & 7;
  const int r0 = 8 * wave + drow;
  const unsigned voff = (unsigned)(r0 * D + ((dpos ^ ((r0 >> 1) & 7)) << 3)) * 2u;
  const char* Pc = (const char*)P; const char* Qc = (const char*)Q;
  char* dp = pbase + wave * 1024 + lane * 16;
  char* dq = qbase + wave * 1024 + lane * 16;
#pragma unroll
  for (int i = 0; i < MT; i++)
#pragma unroll
    for (int j = 0; j < NT; j++) acc[i][j] = (f32x4){0.f, 0.f, 0.f, 0.f};
  const int ring0 = (ST == 3 && ringp) ? *ringp : 0;
  if (!primed) {
#pragma unroll
    for (int t0 = 0; t0 < ST - 1; t0++) {
      int bi = ring0 + t0; if (bi >= ST) bi -= ST;
#pragma unroll
      for (int i = 0; i < MT; i++) __builtin_amdgcn_global_load_lds((const unsigned*)(Pc + (i * 64 * D * 2 + t0 * 128) + voff), (unsigned*)(dp + bi * PROWS * 128 + i * 8192), 16, 0, 0);
#pragma unroll
      for (int i = 0; i < NQI; i++) __builtin_amdgcn_global_load_lds((const unsigned*)(Qc + (i * 64 * D * 2 + t0 * 128) + voff), (unsigned*)(dq + bi * QROWS * 128 + i * 8192), 16, 0, 0);
    }
  }
  if (primed) asm volatile("s_waitcnt vmcnt(0)" ::: "memory");
  else asm volatile("s_waitcnt vmcnt(%0)" :: "n"((ST - 2) * NDMA) : "memory");
  __builtin_amdgcn_s_barrier();
  asm volatile("" ::: "memory");
  const int swz = (lr >> 1) & 7;
  const int o0 = (lg ^ swz) << 4, o1 = ((4 + lg) ^ swz) << 4;
  const char* pa = pbase + (wm * 16 * MT + lr) * 128;
  const char* qa = qbase + (wn * 16 * NT + lr) * 128;
  constexpr int NK = D / 64;
  int cur = ring0, nxs = ring0 + ST - 1; if (nxs >= ST) nxs -= ST;
  for (int kt = 0; kt < NK; ++kt) {
    if (kt + ST - 1 < NK) {
#pragma unroll
      for (int i = 0; i < MT; i++) __builtin_amdgcn_global_load_lds((const unsigned*)(Pc + (i * 64 * D * 2 + (kt + ST - 1) * 128) + voff), (unsigned*)(dp + nxs * PROWS * 128 + i * 8192), 16, 0, 0);
#pragma unroll
      for (int i = 0; i < NQI; i++) __builtin_amdgcn_global_load_lds((const unsigned*)(Qc + (i * 64 * D * 2 + (kt + ST - 1) * 128) + voff), (unsigned*)(dq + nxs * QROWS * 128 + i * 8192), 16, 0, 0);
    }
    if (ST == 3 && kt >= NK - 2 && Pn != nullptr) {
      const char* Pnc = (const char*)Pn + (kt - (NK - 2)) * 128; const char* Qnc = (const char*)Qn + (kt - (NK - 2)) * 128;
#pragma unroll
      for (int i = 0; i < MT; i++) __builtin_amdgcn_global_load_lds((const unsigned*)(Pnc + (i * 64 * D * 2) + voff), (unsigned*)(dp + nxs * PROWS * 128 + i * 8192), 16, 0, 0);
#pragma unroll
      for (int i = 0; i < NQI; i++) __builtin_amdgcn_global_load_lds((const unsigned*)(Qnc + (i * 64 * D * 2) + voff), (unsigned*)(dq + nxs * QROWS * 128 + i * 8192), 16, 0, 0);
    }
    if (ST == 2 && kt == NK - 1 && Pn != nullptr) {
      const char* Pnc = (const char*)Pn; const char* Qnc = (const char*)Qn;
#pragma unroll
      for (int i = 0; i < MT; i++) __builtin_amdgcn_global_load_lds((const unsigned*)(Pnc + (i * 64 * D * 2) + voff), (unsigned*)(dp + i * 8192), 16, 0, 0);
#pragma unroll
      for (int i = 0; i < NQI; i++) __builtin_amdgcn_global_load_lds((const unsigned*)(Qnc + (i * 64 * D * 2) + voff), (unsigned*)(dq + i * 8192), 16, 0, 0);
    }
    const char* pb = pa + cur * PROWS * 128;
    const char* qb = qa + cur * QROWS * 128;
    if constexpr (NT == 99) {
      bf16x8 af[MT], b0[NT], b1[NT];
#pragma unroll
      for (int j = 0; j < NT; j++) b0[j] = *(const bf16x8*)(qb + j * 2048 + o0);
#pragma unroll
      for (int i = 0; i < MT; i++) af[i] = *(const bf16x8*)(pb + i * 2048 + o0);
      __builtin_amdgcn_s_setprio(1);
#pragma unroll
      for (int i = 0; i < MT; i++) {
#pragma unroll
        for (int j = 0; j < NT; j++) acc[i][j] = mfma16(af[i], b0[j], acc[i][j]);
        b1[i] = *(const bf16x8*)(qb + i * 2048 + o1);
        af[i] = *(const bf16x8*)(pb + i * 2048 + o1);
      }
#pragma unroll
      for (int j = MT; j < NT; j++) b1[j] = *(const bf16x8*)(qb + j * 2048 + o1);
#pragma unroll
      for (int i = 0; i < MT; i++)
#pragma unroll
        for (int j = 0; j < NT; j++) acc[i][j] = mfma16(af[i], b1[j], acc[i][j]);
      __builtin_amdgcn_sched_group_barrier(0x100, NT + MT, 0);
#pragma unroll
      for (int r = 0; r < MT; r++) {
        __builtin_amdgcn_sched_group_barrier(0x008, 4, 0);
        __builtin_amdgcn_sched_group_barrier(0x100, 1, 0);
        __builtin_amdgcn_sched_group_barrier(0x008, 4, 0);
        __builtin_amdgcn_sched_group_barrier(0x100, 1, 0);
      }
      __builtin_amdgcn_sched_group_barrier(0x100, NT - MT, 0);
      __builtin_amdgcn_sched_group_barrier(0x008, MT * NT, 0);
      __builtin_amdgcn_s_setprio(0);
    } else {
#pragma unroll
      for (int ks = 0; ks < 2; ++ks) {
        const int oo = ks ? o1 : o0;
        bf16x8 a[MT], b[NT];
#pragma unroll
        for (int i = 0; i < MT; i++) a[i] = *(const bf16x8*)(pb + i * 2048 + oo);
#pragma unroll
        for (int j = 0; j < NT; j++) b[j] = *(const bf16x8*)(qb + j * 2048 + oo);
        __builtin_amdgcn_s_setprio(1);
#pragma unroll
        for (int i = 0; i < MT; i++)
#pragma unroll
          for (int j = 0; j < NT; j++) acc[i][j] = mfma16(a[i], b[j], acc[i][j]);
        __builtin_amdgcn_s_setprio(0);
      }
    }
    if (kt + ST - 1 < NK) asm volatile("s_waitcnt vmcnt(%0)" :: "n"((ST - 2) * NDMA) : "memory");
    else if (ST == 3 && Pn != nullptr) { if (kt == NK - 2) asm volatile("s_waitcnt vmcnt(%0)" :: "n"(NDMA) : "memory"); }
    else if (!(ST == 2 && Pn != nullptr)) asm volatile("s_waitcnt vmcnt(0)" ::: "memory");
    __builtin_amdgcn_s_barrier();
    asm volatile("" ::: "memory");
    cur = (cur == ST - 1) ? 0 : cur + 1;
    nxs = (nxs == ST - 1) ? 0 : nxs + 1;
  }
  if (ST == 3 && ringp) *ringp = cur;
}

template <class PT> DI void wsrc(const PT& p, int l, int n, const float*& src, int& ld, int& col, float& scale) {
  scale = 1.f;
  src = p.w_in + (long)l * D * DIN; ld = DIN;
  if (n < W_C) {
    if (n < 1024) col = 4096 + n;
    else if (n < 2048) { col = 5120 + (n - 1024); scale = 0.0625f; }
    else if (n < 3072) col = 6144 + (n - 2048);
    else if (n < 3088) col = 9216 + (n - 3072);
    else col = -1;
  } else if (n < W_G) {
    int n2 = n - W_C;
    if (n2 < 4096) { int blk = n2 >> 6, sl = (n2 >> 4) & 3, cl = n2 & 15; col = sl * 1024 + blk * 16 + cl; }
    else { int n3 = n2 - 4096; int blk = n3 >> 5, sl = (n3 >> 4) & 1, cl = n3 & 15; col = (sl ? 8192 : 7168) + blk * 16 + cl; }
  } else if (n < W_PC) {
    int n4 = n - W_G; int mtb = n4 >> 9, r5 = n4 & 511; int cc5 = r5 >> 8, wm5 = (r5 >> 6) & 3, a5 = (r5 >> 5) & 1, sl = (r5 >> 4) & 1, cl = r5 & 15;
    col = 9232 + sl * 1024 + (256 * mtb + 64 * wm5 + 32 * cc5 + 16 * a5 + cl);
  } else if (n < W_PM) { src = p.w_pc + (long)l * D * D; ld = D; col = n - W_PC; }
  else if (n < W_O)  { src = p.w_pm + (long)l * D * D; ld = D; col = n - W_PM; }
  else               { src = p.w_out + (long)l * D * D; ld = D; col = n - W_O; }
}

template <class PT> DI void phase_prep(const PT& p, const Ctx& c, float* ldsf) {
  const int tid = opaque_tid();
  if (blockIdx.x == 0 && tid < 256) c.ctr[tid] = 0;
  const int nItems = DEPTH * (WROWS / 64) * 16;
  for (int it = blockIdx.x; it < nItems; it += gridDim.x) {
    const int kb = (it & 15) * 64; const int rb = it >> 4;
    const int l = rb / (WROWS / 64); const int nb = (rb % (WROWS / 64)) * 64;
    const float* src; int ld, col; float scale;
    const int nl = tid & 63;
    wsrc(p, l, nb + nl, src, ld, col, scale);
#pragma unroll
    for (int i = 0; i < 8; i++) {
      const int kl = (tid >> 6) + 8 * i;
      float v = (col >= 0) ? src[(long)(kb + kl) * ld + col] * scale : 0.f;
      ldsf[kl * 65 + nl] = v;
    }
    __syncthreads();
    {
      const int nl2 = tid >> 3, kc = tid & 7;
      float v[8];
#pragma unroll
      for (int j = 0; j < 8; j++) v[j] = ldsf[(kc * 8 + j) * 65 + nl2];
      uint4 o; o.x = pack2(v[0], v[1]); o.y = pack2(v[2], v[3]); o.z = pack2(v[4], v[5]); o.w = pack2(v[6], v[7]);
      *(uint4*)(c.W + ((long)l * WROWS + nb + nl2) * D + kb + kc * 8) = o;
    }
    __syncthreads();
  }
  const int nMod = DEPTH * 48;
  for (int it = blockIdx.x; it < nMod; it += gridDim.x) {
    const int l = it / 48, jb = (it % 48) * 64;
    const int cl = tid & 63, kc = tid >> 6;
    float acc[40];
#pragma unroll
    for (int b = 0; b < 40; b++) acc[b] = 0.f;
    const float* wa = p.w_ada + (long)l * D * 3072 + jb + cl;
    for (int k = kc * 128; k < kc * 128 + 128; ++k) {
      const float wv = wa[(long)k * 3072];
#pragma unroll
      for (int b = 0; b < 40; b++) {
        const float cv = (b < 8) ? p.c_prompt[b * D + k] : p.c_sample[(b - 8) * D + k];
        acc[b] += cv * wv;
      }
    }
#pragma unroll
    for (int b = 0; b < 40; b++) ldsf[(kc * 40 + b) * 64 + cl] = acc[b];
    __syncthreads();
    for (int idx = tid; idx < 40 * 64; idx += NT) {
      const int b = idx >> 6, cc = idx & 63;
      float s = p.b_ada[l * 3072 + jb + cc];
#pragma unroll
      for (int q = 0; q < 8; q++) s += ldsf[(q * 40 + b) * 64 + cc];
      c.mod[((long)l * 40 + b) * 3072 + jb + cc] = s;
    }
    __syncthreads();
  }
}

template <class PT> DI void phase_rows(const PT& p, const Ctx& c, int l, int g, bool fin) {
  const int tid_ = opaque_tid(); const int lane = tid_ & 63, w = tid_ >> 6;
  const int stride = gridDim.x * 8;
  float4 gv[4];
#pragma unroll
  for (int i = 0; i < 4; i++) gv[i] = *(const float4*)((fin ? p.final_g : p.norm_g + l * D) + 4 * lane + 256 * i);
  for (int lt0 = blockIdx.x * 8 + w; lt0 < c.Tg; lt0 += 2 * stride) {
    const bool has1 = lt0 + stride < c.Tg;
    const int lt1 = has1 ? lt0 + stride : lt0;
    const int tok0 = gtok(c, g, lt0), tok1 = gtok(c, g, lt1);
    const float* xr0 = (l == 0) ? xin_row(p, tok0) : p.out + (long)tok0 * D;
    const float* xr1 = (l == 0) ? xin_row(p, tok1) : p.out + (long)tok1 * D;
    float4 v0[4], v1[4]; float ss0 = 0.f, ss1 = 0.f;
#pragma unroll
    for (int i = 0; i < 4; i++) { v0[i] = *(const float4*)(xr0 + 4 * lane + 256 * i); v1[i] = *(const float4*)(xr1 + 4 * lane + 256 * i); }
    const float* mp0 = c.mod + ((long)(fin ? 0 : l) * 40 + batch_of(tok0)) * 3072;
    const float* mp1 = c.mod + ((long)(fin ? 0 : l) * 40 + batch_of(tok1)) * 3072;
    float4 sc0[4], sh0[4], sc1[4], sh1[4];
    if (!fin) {
#pragma unroll
      for (int i = 0; i < 4; i++) {
        const int k = 4 * lane + 256 * i;
        sc0[i] = *(const float4*)(mp0 + 1024 + k); sh0[i] = *(const float4*)(mp0 + k);
        sc1[i] = *(const float4*)(mp1 + 1024 + k); sh1[i] = *(const float4*)(mp1 + k);
      }
    }
#pragma unroll
    for (int i = 0; i < 4; i++) {
      ss0 += v0[i].x * v0[i].x + v0[i].y * v0[i].y + v0[i].z * v0[i].z + v0[i].w * v0[i].w;
      ss1 += v1[i].x * v1[i].x + v1[i].y * v1[i].y + v1[i].z * v1[i].z + v1[i].w * v1[i].w;
    }
    ss0 = wave_sum(ss0); ss1 = wave_sum(ss1);
    const float r0 = rsqrtf(ss0 * (1.f / 1024.f) + 1e-6f), r1 = rsqrtf(ss1 * (1.f / 1024.f) + 1e-6f);
    if (fin) {
#pragma unroll
      for (int i = 0; i < 4; i++) {
        const int k = 4 * lane + 256 * i;
        float4 o; o.x = v0[i].x * r0 * gv[i].x; o.y = v0[i].y * r0 * gv[i].y; o.z = v0[i].z * r0 * gv[i].z; o.w = v0[i].w * r0 * gv[i].w;
        *(float4*)(p.out + (long)tok0 * D + k) = o;
      }
      if (has1) {
#pragma unroll
        for (int i = 0; i < 4; i++) {
          const int k = 4 * lane + 256 * i;
          float4 o; o.x = v1[i].x * r1 * gv[i].x; o.y = v1[i].y * r1 * gv[i].y; o.z = v1[i].z * r1 * gv[i].z; o.w = v1[i].w * r1 * gv[i].w;
          *(float4*)(p.out + (long)tok1 * D + k) = o;
        }
      }
    } else {
#pragma unroll
      for (int i = 0; i < 4; i++) {
        const int k = 4 * lane + 256 * i;
        *(uint2*)(c.Rh + (long)lt0 * D + k) = pack4(v0[i].x * r0 * gv[i].x * (1.f + sc0[i].x) + sh0[i].x, v0[i].y * r0 * gv[i].y * (1.f + sc0[i].y) + sh0[i].y,
                                                    v0[i].z * r0 * gv[i].z * (1.f + sc0[i].z) + sh0[i].z, v0[i].w * r0 * gv[i].w * (1.f + sc0[i].w) + sh0[i].w);
      }
      if (has1) {
#pragma unroll
        for (int i = 0; i < 4; i++) {
          const int k = 4 * lane + 256 * i;
          *(uint2*)(c.Rh + (long)lt1 * D + k) = pack4(v1[i].x * r1 * gv[i].x * (1.f + sc1[i].x) + sh1[i].x, v1[i].y * r1 * gv[i].y * (1.f + sc1[i].y) + sh1[i].y,
                                                      v1[i].z * r1 * gv[i].z * (1.f + sc1[i].z) + sh1[i].z, v1[i].w * r1 * gv[i].w * (1.f + sc1[i].w) + sh1[i].w);
        }
      }
    }
  }
}

template <class PT> DI void phase_A(const PT& p, const Ctx& c, int l, u16* lds) {
  const int tid = opaque_tid(), lane = tid & 63, wave = tid >> 6, wm = wave & 3, wn = wave >> 2, lr = lane & 15, lg = lane >> 4;
  const u16* W = c.W + (long)l * WROWS * D;
  u16* Rq = c.R1; u16* Rk = c.R2; u16* RvT = c.R4;
  const int nTiles = (c.Tg / 256) * 13;
  auto ptrsA = [&](int tl, const u16*& Pp, const u16*& Qp) {
    const int m_ = tl >> 3, tb_ = (m_ / 52) * 32 + ((m_ % 52) & 3) * 8 + (tl & 7), j_ = (m_ % 52) >> 2;
    const u16* hp = c.Rh + (long)tb_ * 256 * D;
    if (j_ < 8) { Pp = W + (long)((j_ >> 2) * 1024 + (j_ & 3) * 256) * D; Qp = hp; }
    else if (j_ < 12) { Pp = hp; Qp = W + (long)(2048 + (j_ - 8) * 256) * D; }
    else { Pp = W + (long)3072 * D; Qp = hp; }
  };
  bool primed = false;
  for (int tile = blockIdx.x; tile < nTiles; tile += gridDim.x) {
    const int m0_ = tile >> 3, tb = (m0_ / 52) * 32 + ((m0_ % 52) & 3) * 8 + (tile & 7), j = (m0_ % 52) >> 2;
    f32x4 acc[4][8];
    const u16 *P0, *Q0, *P1 = nullptr, *Q1 = nullptr;
    ptrsA(tile, P0, Q0);
    if (tile + (int)gridDim.x < nTiles && j != 12 && ((((tile + (int)gridDim.x) >> 3) % 52) >> 2) != 12) ptrsA(tile + gridDim.x, P1, Q1);
    const bool pr = primed; primed = (P1 != nullptr);
    if (j < 8) {
      const int isk = j >> 2, head = j & 3;
      gemm_tile<4, 8, 2>(P0, Q0, acc, lds, P1, Q1, pr);
      u16* dst = isk ? Rk : Rq;
#pragma unroll
      for (int i = 0; i < 4; i++)
#pragma unroll
        for (int jn = 0; jn < 8; jn++) {
          const int d = 64 * wm + 16 * i + 4 * lg, t = 128 * wn + 16 * jn + lr;
          *(uint2*)(dst + (long)(tb * 256 + t) * D + head * 256 + d) = pack4v(acc[i][jn]);
        }
    } else if (j < 12) {
      const int head = j - 8;
      gemm_tile<4, 8, 2>(P0, Q0, acc, lds, P1, Q1, pr);
#pragma unroll
      for (int i = 0; i < 4; i++)
#pragma unroll
        for (int jn = 0; jn < 8; jn++) {
          const int tokl = 64 * wm + 16 * i + 4 * lg, e = 128 * wn + 16 * jn + lr;
          const int ch = tb * 2 + (tokl >> 7), sidx = tokl & 127;
          *(uint2*)(RvT + ((long)(ch * 4 + head) * 256 + e) * 128 + sidx) = pack4v(acc[i][jn]);
        }
    } else {
      f32x4 accg[1][8];
      gemm_tile<1, 8, 2>(P0, Q0, accg, lds);
      float* gl = (float*)lds;
      if (wm == 0) {
#pragma unroll
        for (int jn = 0; jn < 8; jn++) {
          const int t = 128 * wn + 16 * jn + lr;
#pragma unroll
          for (int r = 0; r < 4; r++) {
            float v = accg[0][jn][r] + p.b_gates[l * 16 + lg * 4 + r];
            if (lg & 1) v = fminf(v, 0.f) - log1pf(expf(-fabsf(v)));
            gl[t * 16 + lg * 4 + r] = v;
          }
        }
      }
      __syncthreads();
      if (tid < 16) {
        const int head = tid & 3, dir = (tid >> 2) & 1, cl = tid >> 3;
        const int ch = tb * 2 + cl;
        float* o = c.sc + (((long)(ch * 4 + head) * 2 + dir) * 3) * 128;
        const float* glc = gl + cl * 128 * 16;
        float bs = 0.f, pm = -3.0e38f;
        for (int q = 0; q < 128; ++q) {
          const int t = dir ? 127 - q : q;
          const float iv = glc[t * 16 + dir * 8 + head], lf = glc[t * 16 + dir * 8 + 4 + head];
          bs += lf; const float gg = iv - bs; pm = fmaxf(pm, gg);
          o[t] = bs; o[128 + t] = gg; o[256 + t] = pm;
        }
      }
      __syncthreads();
    }
  }
}

template <class PT> DI void phase_scan(const PT& p, const Ctx& c, int ctrIdx, char* smem) {
  __shared__ int s_task;
  const int tid = opaque_tid(), lane = tid & 63, w0 = __builtin_amdgcn_readfirstlane(tid >> 6), lr = lane & 15, lg = lane >> 4;
  u16* Kb = (u16*)smem;
  u16* Vt = Kb + 128 * KS;
  u16* Vw = Vt + 80 * VS;
  u16* Ct = Vw + 80 * VS;
  float* scg = (float*)(Ct + 80 * KS); float* scmu = scg + 128; float* sciw = scmu + 128; float* scfl = sciw + 128;
  const u16* Rq = c.R1; const u16* Rk = c.R2; const u16* RvT = c.R4;
  const int nLong = (8 / c.G) * 32;
  const int nLongQ8 = (8 / c.G), nShortQ8 = (32 / c.G);
  const int perQueue = (nLongQ8 + nShortQ8) * 4;
  int* ctr = c.ctr + ctrIdx * 8;
  const int myq = (int)(xb_xcc_id() & 7u);
  int qoff = 0;
  while (true) {
    __syncthreads();
    if (tid == 0) {
      int t = -1;
      while (qoff < 8) {
        const int qi = (myq + qoff) & 7;
        const int n = atomicAdd(ctr + qi, 1);
        if (n < perQueue) {
          const int quad = (n < nLongQ8 * 4) ? qi + 8 * (n >> 2) : nLongQ8 * 8 + qi + 8 * ((n - nLongQ8 * 4) >> 2);
          t = quad * 4 + (n & 3);
          break;
        }
        ++qoff;
      }
      s_task = t;
    }
    __syncthreads();
    const int task = s_task;
    if (task < 0) break;
    int seq, r, chunk0, nc;
    if (task < nLong) { seq = task >> 5; r = task & 31; chunk0 = seq * 64; nc = 64; }
    else { const int t2 = task - nLong; seq = t2 >> 5; r = t2 & 31; chunk0 = (c.half >> 7) + seq * 16; nc = 16; }
    const int head = r >> 3, dir = (r >> 2) & 1, es = r & 3;
    const int last = dir ? 0 : 127;
    u16* Rho = dir ? c.Rhb : c.Rhf;
    for (int idx = tid; idx < 80 * KS / 2; idx += NT) ((unsigned*)Ct)[idx] = 0u;
    for (int idx = tid; idx < 16 * VS / 2; idx += NT) { ((unsigned*)(Vt + 64 * VS))[idx] = 0u; ((unsigned*)(Vw + 64 * VS))[idx] = 0u; }
    __syncthreads();
    if (tid < 128) Vt[64 * VS + tid] = (u16)0x3F80;
    f32x4 st[2][5];
#pragma unroll
    for (int i = 0; i < 2; i++)
#pragma unroll
      for (int jn = 0; jn < 5; jn++) st[i][jn] = (f32x4){0.f, 0.f, 0.f, 0.f};
    float m = 0.f;
    const int vrow = tid >> 4, vsc = tid & 15;
    const int krow = tid >> 5, kkc = (tid & 31) * 8;
    u32x4 kpre[8], vpre[2]; float4 g8a, g8b; float bLn, gmaxn, myb, myg, mypm;
    bf16x8 qf[8];
    auto scan_load = [&](int cq) {
#pragma unroll
      for (int ks = 0; ks < 8; ks++)
        qf[ks] = *(const bf16x8*)(Rq + (long)(cq * 128 + 16 * w0 + lr) * D + head * 256 + 32 * ks + 8 * lg);
#pragma unroll
      for (int i = 0; i < 8; i++) kpre[i] = *(const u32x4*)(Rk + (long)(cq * 128 + krow + 16 * i) * D + head * 256 + kkc);
#pragma unroll
      for (int i = 0; i < 2; i++) vpre[i] = *(const u32x4*)(RvT + ((long)(cq * 4 + head) * 256 + es * 64 + vrow + 32 * i) * 128 + vsc * 8);
      const float* scb = c.sc + ((long)(cq * 4 + head) * 2 + dir) * 384;
      g8a = *(const float4*)(scb + 128 + vsc * 8); g8b = *(const float4*)(scb + 128 + vsc * 8 + 4);
      bLn = scb[last]; gmaxn = scb[256 + last];
      myb = scb[tid & 127]; myg = scb[128 + (tid & 127)]; mypm = scb[256 + (tid & 127)];
    };
    scan_load(chunk0 + (dir ? nc - 1 : 0));
    for (int j = 0; j < nc; ++j) {
      const int cc = chunk0 + (dir ? nc - 1 - j : j);
      int w = w0; asm volatile("" : "+s"(w));
      __syncthreads();
      const float muL = fmaxf(m, gmaxn);
      const float decay = __expf(m - muL);
      const float mnext = bLn + muL;
#pragma unroll
      for (int i = 0; i < 2; i++)
#pragma unroll
        for (int jn = 0; jn < 5; jn++)
          *(uint2*)(Ct + (16 * jn + lr) * KS + 32 * w + 16 * i + 4 * lg) = pack4v(st[i][jn]);
#pragma unroll
      for (int i = 0; i < 8; i++) *(u32x4*)(Kb + (krow + 16 * i) * KS + kkc) = kpre[i];
      {
        float w8[8];
        w8[0] = __expf(g8a.x - muL); w8[1] = __expf(g8a.y - muL); w8[2] = __expf(g8a.z - muL); w8[3] = __expf(g8a.w - muL);
        w8[4] = __expf(g8b.x - muL); w8[5] = __expf(g8b.y - muL); w8[6] = __expf(g8b.z - muL); w8[7] = __expf(g8b.w - muL);
#pragma unroll
        for (int i = 0; i < 2; i++) {
          const u32x4 vv = vpre[i];
          *(u32x4*)(Vt + (vrow + 32 * i) * VS + vsc * 8) = vv;
          uint4 v; v.x = vv[0]; v.y = vv[1]; v.z = vv[2]; v.w = vv[3];
          uint4 o;
          o.x = pack2(bf2f(v.x & 0xffffu) * w8[0], bf2f(v.x >> 16) * w8[1]);
          o.y = pack2(bf2f(v.y & 0xffffu) * w8[2], bf2f(v.y >> 16) * w8[3]);
          o.z = pack2(bf2f(v.z & 0xffffu) * w8[4], bf2f(v.z >> 16) * w8[5]);
          o.w = pack2(bf2f(v.w & 0xffffu) * w8[6], bf2f(v.w >> 16) * w8[7]);
          *(uint4*)(Vw + (vrow + 32 * i) * VS + vsc * 8) = o;
        }
        if (tid < 16) {
          uint4 o; o.x = pack2(w8[0], w8[1]); o.y = pack2(w8[2], w8[3]); o.z = pack2(w8[4], w8[5]); o.w = pack2(w8[6], w8[7]);
          *(uint4*)(Vw + 64 * VS + vsc * 8) = o;
        }
      }
      if (tid < 128) {
        const float mu = fmaxf(m, mypm);
        scg[tid] = myg; scmu[tid] = mu; sciw[tid] = __expf(m - mu); scfl[tid] = __expf(-(mu + myb));
      }
      __syncthreads();
      const int t = 16 * w + lr;
      bf16x8 spk[4];
      {
        f32x4 sacc[8];
#pragma unroll
        for (int i = 0; i < 8; i++) sacc[i] = (f32x4){0.f, 0.f, 0.f, 0.f};
#pragma unroll
        for (int i = 0; i < 8; i++) {
          const bool need = dir ? (i >= w) : (i <= w);
          if (need) {
#pragma unroll
            for (int ks = 0; ks < 8; ks++) {
              const bf16x8 a = *(const bf16x8*)(Kb + (16 * i + lr) * KS + 32 * ks + 8 * lg);
              sacc[i] = mfma16(a, qf[ks], sacc[i]);
            }
          }
        }
        const float mu_t = scmu[t];
        int tt = t; asm volatile("" : "+v"(tt));
        const int sgn = dir ? -1 : 1;
#pragma unroll
        for (int ks = 0; ks < 4; ks++) {
          float sv[8];
#pragma unroll
          for (int hh = 0; hh < 2; hh++) {
            const int i = 2 * ks + hh;
            const float4 gs = *(const float4*)(scg + 16 * i + 4 * lg);
            const float gv[4] = {gs.x, gs.y, gs.z, gs.w};
#pragma unroll
            for (int r2 = 0; r2 < 4; r2++) {
              const int s = 16 * i + 4 * lg + r2;
              const bool valid = (s - tt) * sgn <= 0;
              sv[hh * 4 + r2] = valid ? sacc[i][r2] * __expf(gv[r2] - mu_t) : 0.f;
            }
          }
          uint4 o; o.x = pack2(sv[0], sv[1]); o.y = pack2(sv[2], sv[3]); o.z = pack2(sv[4], sv[5]); o.w = pack2(sv[6], sv[7]);
          spk[ks] = __builtin_bit_cast(bf16x8, o);
        }
      }
      f32x4 num[5];
#pragma unroll
      for (int i = 0; i < 5; i++) num[i] = (f32x4){0.f, 0.f, 0.f, 0.f};
      if (j > 0) {
#pragma unroll
        for (int ks = 0; ks < 8; ks++)
#pragma unroll
          for (int i = 0; i < 5; i++) {
            const bf16x8 a = *(const bf16x8*)(Ct + (16 * i + lr) * KS + 32 * ks + 8 * lg);
            num[i] = mfma16(a, qf[ks], num[i]);
          }
      }
      {
        const float iw = sciw[t];
#pragma unroll
        for (int i = 0; i < 5; i++) num[i] *= iw;
      }
#pragma unroll
      for (int ks = 0; ks < 4; ks++) {
        const bool need = dir ? (2 * ks + 1 >= w) : (2 * ks <= w);
        if (need) {
#pragma unroll
          for (int i = 0; i < 5; i++) {
            const uint2 lo = *(const uint2*)(Vt + (16 * i + lr) * VS + 32 * ks + 4 * lg);
            const uint2 hi = *(const uint2*)(Vt + (16 * i + lr) * VS + 32 * ks + 16 + 4 * lg);
            uint4 av; av.x = lo.x; av.y = lo.y; av.z = hi.x; av.w = hi.y;
            num[i] = mfma16(__builtin_bit_cast(bf16x8, av), spk[ks], num[i]);
          }
        }
      }
      {
        const float fl = scfl[t];
        const float dr = __shfl(num[4][0], lr);
        const float inv = 1.f / fmaxf(fabsf(dr), fl);
        u16* dst = Rho + (long)(cc * 128 + t) * D + head * 256 + es * 64 + 4 * lg;
#pragma unroll
        for (int i = 0; i < 4; i++)
          *(uint2*)(dst + 16 * i) = pack4(num[i][0] * inv, num[i][1] * inv, num[i][2] * inv, num[i][3] * inv);
      }
      __builtin_amdgcn_sched_barrier(0);
      { const int jn1 = (j + 1 < nc) ? j + 1 : j; scan_load(chunk0 + (dir ? nc - 1 - jn1 : jn1)); }
      __builtin_amdgcn_sched_barrier(0);
#pragma unroll
      for (int i = 0; i < 2; i++)
#pragma unroll
        for (int jn = 0; jn < 5; jn++) st[i][jn] *= decay;
#pragma unroll
      for (int ks = 0; ks < 4; ks++) {
        bf16x8 kTf[2];
#pragma unroll
        for (int i = 0; i < 2; i++) {
          const u16* ap = Kb + (32 * ks + 8 * lg + (lr >> 2)) * KS + 32 * w + 16 * i + 4 * (lr & 3);
          const s16x4 lo = __builtin_amdgcn_ds_read_tr16_b64_v4i16((s16x4 __attribute__((address_space(3)))*)ap);
          const s16x4 hi = __builtin_amdgcn_ds_read_tr16_b64_v4i16((s16x4 __attribute__((address_space(3)))*)(ap + 4 * KS));
          kTf[i] = __builtin_shufflevector(lo, hi, 0, 1, 2, 3, 4, 5, 6, 7);
        }
#pragma unroll
        for (int jn = 0; jn < 5; jn++) {
          const bf16x8 b = *(const bf16x8*)(Vw + (16 * jn + lr) * VS + 32 * ks + 8 * lg);
#pragma unroll
          for (int i = 0; i < 2; i++) st[i][jn] = mfma16(kTf[i], b, st[i][jn]);
        }
      }
      m = mnext;
    }
  }
}

template <class PT> DI void phase_C(const PT& p, const Ctx& c, int l, u16* lds) {
  const int tid = opaque_tid(), lane = tid & 63, wave = tid >> 6, wm = wave & 3, wn = wave >> 2, lr = lane & 15, lg = lane >> 4;
  const u16* W = c.W + ((long)l * WROWS + W_C) * D;
  u16* Ru = c.R1; u16* Ryp = c.R2; u16* Rog = c.R3;
  const int nTiles = (c.Tg / 256) * 24;
  for (int tile = blockIdx.x; tile < nTiles; tile += gridDim.x) {
    const int tb = 2 * ((tile >> 3) / 6) + (tile & 1), pt = 6 * ((tile & 7) >> 1) + ((tile >> 3) % 6);
    f32x4 acc[4][8];
    {
      const int tn = tile + gridDim.x;
      const bool has = tn < nTiles;
      gemm_tile<4, 8, 2>(W + (long)pt * 256 * D, c.Rh + (long)tb * 256 * D, acc, lds,
                         has ? W + (long)(6 * ((tn & 7) >> 1) + ((tn >> 3) % 6)) * 256 * D : nullptr, has ? c.Rh + (long)(2 * ((tn >> 3) / 6) + (tn & 1)) * 256 * D : nullptr, tile != (int)blockIdx.x);
    }
    if (pt < 16) {
      const int chn = pt * 64 + wm * 16 + 4 * lg;
#pragma unroll
      for (int jn = 0; jn < 8; jn++) {
        const long lt = tb * 256 + 128 * wn + 16 * jn + lr;
        float u[4], y[4];
#pragma unroll
        for (int r = 0; r < 4; r++) { u[r] = acc[1][jn][r] * acc[2][jn][r]; y[r] = acc[0][jn][r] * siluf_(acc[3][jn][r]); }
        *(uint2*)(Ru + lt * D + chn) = pack4(u[0], u[1], u[2], u[3]);
        *(uint2*)(Ryp + lt * D + chn) = pack4(y[0], y[1], y[2], y[3]);
      }
    } else {
      const int chn = (pt - 16) * 128 + wm * 32 + 4 * lg;
#pragma unroll
      for (int jn = 0; jn < 8; jn++) {
        const long lt = tb * 256 + 128 * wn + 16 * jn + lr;
#pragma unroll
        for (int hh = 0; hh < 2; hh++) {
          float o[4];
#pragma unroll
          for (int r = 0; r < 4; r++) { const float mz_ = acc[2 * hh + 1][jn][r]; o[r] = mz_ * __builtin_amdgcn_rcpf((1.f + __expf(-acc[2 * hh][jn][r])) * (1.f + __expf(-mz_))); }
          *(uint2*)(Rog + lt * D + chn + 16 * hh) = pack4(o[0], o[1], o[2], o[3]);
        }
      }
    }
  }
}

template <class PT> DI void phase_E(const PT& p, const Ctx& c, int l) {
  const int tid_ = opaque_tid(); const int lane = tid_ & 63, w = tid_ >> 6;
  const u16* Ru = c.R1; u16* Ryp = c.R2; u16* Rog = c.R3;
  const float* cw = p.conv_w + (long)l * 3 * D; const float* cb = p.conv_b + (long)l * D; const float* mg = p.mh_norm_g + (long)l * D;
  float4 w0[4], w1[4], w2[4], bb[4], gg[4];
#pragma unroll
  for (int i = 0; i < 4; i++) {
    const int k = 4 * lane + 256 * i;
    w0[i] = *(const float4*)(cw + k); w1[i] = *(const float4*)(cw + D + k); w2[i] = *(const float4*)(cw + 2 * D + k);
    bb[i] = *(const float4*)(cb + k); gg[i] = *(const float4*)(mg + k);
  }
  for (int lt = blockIdx.x * 8 + w; lt < c.Tg; lt += gridDim.x * 8) {
    const int sl = lt < c.half ? 8192 : 2048;
    const int pos = (lt < c.half ? lt : lt - c.half) & (sl - 1);
    const bool first = pos == 0, lastp = pos == sl - 1;
    uint2 U0[4], U1[4], U2[4], YP[4], OG[4], HF[4], HB[4];
#pragma unroll
    for (int i = 0; i < 4; i++) {
      const int k = 4 * lane + 256 * i;
      U0[i] = *(const uint2*)(Ru + (long)(first ? lt : lt - 1) * D + k);
      U1[i] = *(const uint2*)(Ru + (long)lt * D + k);
      U2[i] = *(const uint2*)(Ru + (long)(lastp ? lt : lt + 1) * D + k);
      if (first) { U0[i].x = 0u; U0[i].y = 0u; }
      if (lastp) { U2[i].x = 0u; U2[i].y = 0u; }
      YP[i] = *(const uint2*)(Ryp + (long)lt * D + k);
      OG[i] = *(const uint2*)(Rog + (long)lt * D + k);
      HF[i] = *(const uint2*)(c.Rhf + (long)lt * D + k);
      HB[i] = *(const uint2*)(c.Rhb + (long)lt * D + k);
    }
#pragma unroll
    for (int i = 0; i < 4; i++) {
      const int k = 4 * lane + 256 * i;
      const float4 a0 = unpack4(U0[i]), a1 = unpack4(U1[i]), a2 = unpack4(U2[i]), yp = unpack4(YP[i]);
      const float y0 = yp.x * (w0[i].x * a0.x + w1[i].x * a1.x + w2[i].x * a2.x + bb[i].x);
      const float y1 = yp.y * (w0[i].y * a0.y + w1[i].y * a1.y + w2[i].y * a2.y + bb[i].y);
      const float y2 = yp.z * (w0[i].z * a0.z + w1[i].z * a1.z + w2[i].z * a2.z + bb[i].z);
      const float y3 = yp.w * (w0[i].w * a0.w + w1[i].w * a1.w + w2[i].w * a2.w + bb[i].w);
      *(uint2*)(Ryp + (long)lt * D + k) = pack4(y0, y1, y2, y3);
      const float4 hf = unpack4(HF[i]), hb = unpack4(HB[i]), og = unpack4(OG[i]);
      const float s0 = hf.x + hb.x, s1 = hf.y + hb.y, s2 = hf.z + hb.z, s3 = hf.w + hb.w;
      const float ss = wave_sum(s0 * s0 + s1 * s1 + s2 * s2 + s3 * s3);
      const float rstd = rsqrtf(ss * (1.f / 256.f) + 1e-6f);
      *(uint2*)(Rog + (long)lt * D + k) = pack4(og.x * s0 * rstd * gg[i].x, og.y * s1 * rstd * gg[i].y, og.z * s2 * rstd * gg[i].z, og.w * s3 * rstd * gg[i].w);
    }
  }
}

template <class PT> DI void phase_D1(const PT& p, const Ctx& c, int l, u16* lds) {
  const int tid = opaque_tid(), lane = tid & 63, wave = tid >> 6, wm = wave & 3, wn = wave >> 2, lr = lane & 15, lg = lane >> 4;
  const u16* W = c.W + (long)l * WROWS * D;
  const u16* Ryc = c.R2; const u16* Rym = c.R3; u16* Rmg = c.R4;
  const int nTiles = (c.Tg / 128) * 4;
  int ring = 0;
  for (int tile = blockIdx.x; tile < nTiles; tile += gridDim.x) {
    const int ch = ((tile >> 5) << 3) + (tile & 7), mt = (tile >> 3) & 3;
    const u16* Pg = W + (long)(W_G + mt * 512) * D; const u16* Qh = c.Rh + (long)ch * 128 * D;
    const u16* Pc_ = W + (long)(W_PC + mt * 256) * D; const u16* Qc_ = Ryc + (long)ch * 128 * D;
    const u16* Pm_ = W + (long)(W_PM + mt * 256) * D; const u16* Qm_ = Rym + (long)ch * 128 * D;
    const int tn = tile + gridDim.x; const bool hasn = tn < nTiles;
    const u16* Pnx = hasn ? W + (long)(W_G + ((tn >> 3) & 3) * 512) * D : nullptr; const u16* Qnx = hasn ? c.Rh + (long)(((tn >> 5) << 3) + (tn & 7)) * 128 * D : nullptr;
    u32x2 gk[2][4][4], Mk[4][4];
#pragma unroll
    for (int cc = 0; cc < 2; cc++) {
      f32x4 a1[4][4];
      if (cc == 0) gemm_tile<4, 4, 3>(Pg, Qh, a1, lds, Pg + (long)256 * D, Qh, tile != (int)blockIdx.x, &ring);
      else gemm_tile<4, 4, 3>(Pg + (long)256 * D, Qh, a1, lds, Pc_, Qc_, true, &ring);
#pragma unroll
      for (int i = 0; i < 4; i++)
#pragma unroll
        for (int jn = 0; jn < 4; jn++) {
          const uint2 t_ = pack4(sigmoidf_(a1[i][jn][0]), sigmoidf_(a1[i][jn][1]), sigmoidf_(a1[i][jn][2]), sigmoidf_(a1[i][jn][3]));
          gk[cc][i][jn] = (u32x2){t_.x, t_.y}; asm volatile("" : "+v"(gk[cc][i][jn]));
        }
    }
    {
      f32x4 a2[4][4];
      gemm_tile<4, 4, 3>(Pc_, Qc_, a2, lds, Pm_, Qm_, true, &ring);
#pragma unroll
      for (int i = 0; i < 4; i++)
#pragma unroll
        for (int jn = 0; jn < 4; jn++) {
          uint2 g_; g_.x = gk[i >> 1][2 * (i & 1)][jn][0]; g_.y = gk[i >> 1][2 * (i & 1)][jn][1];
          const float4 gg = unpack4(g_);
          const uint2 t_ = pack4(gg.x * a2[i][jn][0], gg.y * a2[i][jn][1], gg.z * a2[i][jn][2], gg.w * a2[i][jn][3]);
          Mk[i][jn] = (u32x2){t_.x, t_.y}; asm volatile("" : "+v"(Mk[i][jn]));
        }
    }
    {
      f32x4 a2[4][4];
      gemm_tile<4, 4, 3>(Pm_, Qm_, a2, lds, Pnx, Qnx, true, &ring);
#pragma unroll
      for (int i = 0; i < 4; i++)
#pragma unroll
        for (int jn = 0; jn < 4; jn++) {
          uint2 g_; g_.x = gk[i >> 1][2 * (i & 1) + 1][jn][0]; g_.y = gk[i >> 1][2 * (i & 1) + 1][jn][1];
          uint2 m_; m_.x = Mk[i][jn][0]; m_.y = Mk[i][jn][1];
          const float4 gg = unpack4(g_);
          const float4 mm = unpack4(m_);
          const int col = mt * 256 + 64 * wm + 16 * i + 4 * lg;
          const long lt = ch * 128 + 64 * wn + 16 * jn + lr;
          *(uint2*)(Rmg + lt * D + col) = pack4(mm.x + gg.x * a2[i][jn][0], mm.y + gg.y * a2[i][jn][1],
                                                mm.z + gg.z * a2[i][jn][2], mm.w + gg.w * a2[i][jn][3]);
        }
    }
  }
}

template <class PT> DI void phase_D2(const PT& p, const Ctx& c, int l, int g, u16* lds) {
  const int tid = opaque_tid(), lane = tid & 63, wave = tid >> 6, wm = wave & 3, wn = wave >> 2, lr = lane & 15, lg = lane >> 4;
  const u16* W = c.W + ((long)l * WROWS + W_O) * D;
  const u16* Rmg = c.R4;
  const int nTiles = (c.Tg / 256) * 4;
  for (int tile = blockIdx.x; tile < nTiles; tile += gridDim.x) {
    const int tb = (tile >> 5) * 8 + (tile & 7), pt = (tile >> 3) & 3;
    f32x4 acc[4][8];
    {
      const int tn = tile + gridDim.x;
      const bool has = tn < nTiles;
      gemm_tile<4, 8, 2>(W + (long)pt * 256 * D, Rmg + (long)tb * 256 * D, acc, lds,
                         has ? W + (long)((tn >> 3) & 3) * 256 * D : nullptr, has ? Rmg + (long)((tn >> 5) * 8 + (tn & 7)) * 256 * D : nullptr, tile != (int)blockIdx.x);
    }
    const int tok0 = gtok(c, g, tb * 256);
    const float* gp = c.mod + ((long)l * 40 + batch_of(tok0)) * 3072 + 2048;
#pragma unroll
    for (int ip = 0; ip < 2; ip++) {
      float4 xv[2][8], gt[2];
#pragma unroll
      for (int h2 = 0; h2 < 2; h2++) {
        const int col = pt * 256 + 64 * wm + 16 * (2 * ip + h2) + 4 * lg;
        gt[h2] = *(const float4*)(gp + col);
#pragma unroll
        for (int jn = 0; jn < 8; jn++) {
          const int tok = tok0 + 128 * wn + 16 * jn + lr;
          const float* xr = (l == 0) ? xin_row(p, tok) : p.out + (long)tok * D;
          xv[h2][jn] = *(const float4*)(xr + col);
        }
      }
#pragma unroll
      for (int h2 = 0; h2 < 2; h2++) {
        const int i = 2 * ip + h2;
        const int col = pt * 256 + 64 * wm + 16 * i + 4 * lg;
#pragma unroll
        for (int jn = 0; jn < 8; jn++) {
          const int tok = tok0 + 128 * wn + 16 * jn + lr;
          float4 o;
          o.x = xv[h2][jn].x + gt[h2].x * acc[i][jn][0]; o.y = xv[h2][jn].y + gt[h2].y * acc[i][jn][1];
          o.z = xv[h2][jn].z + gt[h2].z * acc[i][jn][2]; o.w = xv[h2][jn].w + gt[h2].w * acc[i][jn][3];
          *(float4*)(p.out + (long)tok * D + col) = o;
        }
      }
    }
  }
}

__global__ void __launch_bounds__(NT) mega(Params p) {
  extern __shared__ __attribute__((aligned(16))) char smem[];
  cg::grid_group grid = cg::this_grid();
  const int nG = p.G;
  __shared__ uint4 xb_words;
  volatile LAS unsigned* xb_st = (volatile LAS unsigned*)&xb_words;
  Params* pg;
  unsigned* xbar;
  {
    const Ctx c0 = make_ctx(p);
    unsigned char* q = (unsigned char*)c0.ctr + 4096;
    xbar = (unsigned*)q; q += XCD_BAR_WORDS * 4;
    pg = (Params*)q;
    if (blockIdx.x == 0 && threadIdx.x == 0) *pg = p;
    if (threadIdx.x == 0) xb_words = make_uint4(0u, 0u, 0u, 0u);
    __syncthreads();
    if (blockIdx.x == 0) for (int i = threadIdx.x; i < XCD_BAR_WORDS; i += NT) xbar[i] = 0u;
    phase_prep(p, c0, (float*)smem);
  }
  grid.sync();
  { XcdBarrier xb0 = xcd_barrier_post(xbar, xb_st); (void)xb0; }
#define PH(call) { const CParams* q_ = launder_params(pg); const CParams& P_ = *q_; const Ctx c = make_ctx(P_); call; }
#define BAR() { const CParams* q_ = launder_params(pg); const Ctx c = make_ctx(*q_); XcdBarrier xb; xb.bar = (unsigned*)((unsigned char*)c.ctr + 4096); xb.x = xb_xcc_id(); xb.st = xb_st; xcd_barrier(xb); }
  for (int g = 0; g < nG; ++g) {
    for (int l = 0; l < DEPTH; ++l) {
      PH(phase_rows(P_, c, l, g, false)); BAR();
      PH(phase_A(P_, c, l, (u16*)smem)); BAR();
      PH(phase_scan(P_, c, g * DEPTH + l, smem)); BAR();
      PH(phase_C(P_, c, l, (u16*)smem)); BAR();
      PH(phase_E(P_, c, l)); BAR();
      PH(phase_D1(P_, c, l, (u16*)smem)); BAR();
      PH(phase_D2(P_, c, l, g, (u16*)smem)); BAR();
    }
    PH(phase_rows(P_, c, DEPTH, g, true));
  }
}

extern "C" void kernel_launch(void* const* d_in, const int* in_sizes, int n_in, void* d_out, int out_size,
                              void* d_ws, size_t ws_size, hipStream_t stream) {
  static int grid_blocks = 0;
  static int Gsel = 2;
  if (!grid_blocks) {
    int dev = 0, cus = 0, per_cu = 0;
    hipGetDevice(&dev);
    hipDeviceGetAttribute(&cus, hipDeviceAttributeMultiprocessorCount, dev);
    hipFuncSetAttribute((const void*)mega, hipFuncAttributeMaxDynamicSharedMemorySize, LDS_BYTES);
    hipOccupancyMaxActiveBlocksPerMultiprocessor(&per_cu, (const void*)mega, NT, LDS_BYTES);
    if (per_cu < 1) per_cu = 1;
    grid_blocks = cus * per_cu;
    const size_t fixed = (size_t)DEPTH * WROWS * D * 2 + (size_t)DEPTH * 40 * 3072 * 4 + 4096 + XCD_BAR_WORDS * 4 + 1024;
    Gsel = 2;
    while (Gsel < 8 && 7 * ((size_t)(131072 / Gsel) * D * 2) + fixed + (size_t)(131072 / Gsel) * 96 > ws_size) Gsel *= 2;
  }
  Params p{};
  p.x_prompt = (const float*)d_in[0]; p.x_sample = (const float*)d_in[1]; p.c_prompt = (const float*)d_in[2]; p.c_sample = (const float*)d_in[3];
  p.w_ada = (const float*)d_in[4]; p.b_ada = (const float*)d_in[5]; p.norm_g = (const float*)d_in[6]; p.w_in = (const float*)d_in[7];
  p.b_gates = (const float*)d_in[8]; p.conv_w = (const float*)d_in[9]; p.conv_b = (const float*)d_in[10]; p.mh_norm_g = (const float*)d_in[11];
  p.w_pc = (const float*)d_in[12]; p.w_pm = (const float*)d_in[13]; p.w_out = (const float*)d_in[14]; p.final_g = (const float*)d_in[15];
  p.out = (float*)d_out; p.ws = (unsigned char*)d_ws; p.G = Gsel; p.pad = 0;
  void* args[] = {&p};
  hipError_t e = hipLaunchCooperativeKernel((const void*)mega, dim3(grid_blocks), dim3(NT), args, LDS_BYTES, stream);
  if (e != hipSuccess) fprintf(stderr, "cooperative launch failed: %s (grid %d)\n", hipGetErrorString(e), grid_blocks);
}
```
